# Optimizing an MI355X kernel written in HIP

```python
import math
import jax, jax.numpy as jnp
from jax import lax
import numpy as np

D_MODEL = 1024
BATCH = 8
SEQ = 2048
DEPTH = 2
DEC_BATCH = 128
DEC_SEQ = 4
PAST_LEN = 16384
PAGE_SIZE = 128

LRU_WIDTH = D_MODEL // 2
LRU_HEADS = 8
LRU_HEAD_DIM = LRU_WIDTH // LRU_HEADS
LRU_CONV = 4
LRU_C = 8.0
SC_WIDTH = D_MODEL // 2
SC_CONV = 3
SSM_WIDTH = D_MODEL // 2
SSM_GROUP = 16
SSM_GROUPS = SSM_WIDTH // SSM_GROUP
SSM_STATE = 64
N_BRANCH = 3
D_FF = 4 * D_MODEL
N_IN = 2 * LRU_WIDTH + 3 * SC_WIDTH + SSM_WIDTH + N_BRANCH * D_MODEL
SPLITS = [LRU_WIDTH, 2 * LRU_WIDTH, 2 * LRU_WIDTH + SC_WIDTH, 2 * LRU_WIDTH + 2 * SC_WIDTH,
          2 * LRU_WIDTH + 3 * SC_WIDTH, 2 * LRU_WIDTH + 3 * SC_WIDTH + SSM_WIDTH]
ALPHA = (2 * DEPTH) ** 0.25
BETA = (8 * DEPTH) ** -0.25
LN_EPS = 1e-5

kernel_name = "hybrid_rglru_shortconv_s5_step"

F32 = jnp.float32


def layer_norm(x, g, b):
    xf = x.astype(F32)
    mu = jnp.mean(xf, axis=-1, keepdims=True)
    var = jnp.mean(jnp.square(xf - mu), axis=-1, keepdims=True)
    y = (xf - mu) * lax.rsqrt(var + LN_EPS) * g.astype(F32) + b.astype(F32)
    return y.astype(x.dtype)


def causal_conv(u, buf, w):
    K = w.shape[0]
    L = u.shape[1]
    up = jnp.concatenate([buf.astype(u.dtype), u], axis=1)
    out = up[:, 0:L] * w[0]
    for k in range(1, K):
        out = out + up[:, k:k + L] * w[k]
    return out, up[:, -(K - 1):]


def real_linear_scan(a, b, h0):
    def comb(e1, e2):
        a1, b1 = e1
        a2, b2 = e2
        return a1 * a2, a2 * b1 + b2
    A, B = lax.associative_scan(comb, (a, b), axis=1)
    h = A * h0[:, None] + B
    return h, h[:, -1]


def complex_linear_scan(a_re, a_im, b_re, b_im, h0_re, h0_im):
    def comb(e1, e2):
        ar1, ai1, br1, bi1 = e1
        ar2, ai2, br2, bi2 = e2
        return (ar2 * ar1 - ai2 * ai1, ar2 * ai1 + ai2 * ar1,
                ar2 * br1 - ai2 * bi1 + br2, ar2 * bi1 + ai2 * br1 + bi2)
    Ar, Ai, Br, Bi = lax.associative_scan(comb, (a_re, a_im, b_re, b_im), axis=1)
    h0r = h0_re[:, None]
    h0i = h0_im[:, None]
    h_re = Ar * h0r - Ai * h0i + Br
    h_im = Ar * h0i + Ai * h0r + Bi
    return h_re, h_im


def mixer(x, lru_conv_buf, lru_h, sc_buf, ssm_re, ssm_im, p):
    bsz, L, _ = x.shape
    dt_ = x.dtype
    z = x @ p["w_in"]
    xa, ya, sb, sc, sh, us, gl = jnp.split(z, SPLITS, axis=-1)

    xa_c, new_lru_conv = causal_conv(xa, lru_conv_buf, p["conv_a_w"])
    xa_c = xa_c + p["conv_a_b"]
    xh = xa_c.reshape(bsz, L, LRU_HEADS, LRU_HEAD_DIM)
    gx = jax.nn.sigmoid(jnp.einsum('blhi,hij->blhj', xh, p["gate_x_w"]).reshape(bsz, L, LRU_WIDTH) + p["gate_x_b"])
    ga = jax.nn.sigmoid(jnp.einsum('blhi,hij->blhj', xh, p["gate_a_w"]).reshape(bsz, L, LRU_WIDTH) + p["gate_a_b"])
    log_a = -LRU_C * ga.astype(F32) * jax.nn.softplus(-p["lru_lambda"].astype(F32))
    a = jnp.exp(log_a)
    bx = jnp.sqrt(-jnp.expm1(2.0 * log_a)) * (gx * xa_c).astype(F32)
    h, h_last = real_linear_scan(a, bx, lru_h.astype(F32))
    out_a = (h.astype(dt_) * jax.nn.gelu(ya)) @ p["proj_a"]

    u = sc * sh
    cu, new_sc = causal_conv(u, sc_buf, p["conv_b_w"])
    out_b = (sb * cu) @ p["proj_b"]

    a_re = p["ssm_a_re"].astype(F32)
    a_im = p["ssm_a_im"].astype(F32)
    step = jnp.exp(p["ssm_log_dt"].astype(F32))
    mag = jnp.exp(step * a_re)
    abar_re = mag * jnp.cos(step * a_im)
    abar_im = mag * jnp.sin(step * a_im)
    den = a_re * a_re + a_im * a_im
    nr = abar_re - 1.0
    ni = abar_im
    coef_re = (nr * a_re + ni * a_im) / den
    coef_im = (ni * a_re - nr * a_im) / den
    b_re = p["ssm_b_re"].astype(F32)
    b_im = p["ssm_b_im"].astype(F32)
    bbar_re = coef_re[..., None] * b_re - coef_im[..., None] * b_im
    bbar_im = coef_re[..., None] * b_im + coef_im[..., None] * b_re
    uf = us.astype(F32)
    ug = uf.reshape(bsz, L, SSM_GROUPS, SSM_GROUP)
    bu_re = jnp.einsum('blgc,gpc->blgp', ug, bbar_re)
    bu_im = jnp.einsum('blgc,gpc->blgp', ug, bbar_im)
    h_re, h_im = complex_linear_scan(jnp.broadcast_to(abar_re, bu_re.shape),
                                     jnp.broadcast_to(abar_im, bu_im.shape),
                                     bu_re, bu_im, ssm_re.astype(F32), ssm_im.astype(F32))
    y = (jnp.einsum('blgp,gcp->blgc', h_re, p["ssm_c_re"].astype(F32))
         - jnp.einsum('blgp,gcp->blgc', h_im, p["ssm_c_im"].astype(F32)))
    y = y.reshape(bsz, L, SSM_WIDTH) + p["ssm_d"].astype(F32) * uf
    zc = jax.nn.gelu(y).astype(dt_)
    out_c = (zc * jax.nn.sigmoid(zc @ p["glu_w"] + p["glu_b"])) @ p["proj_c"]

    g = jax.nn.sigmoid(gl).reshape(bsz, L, N_BRANCH, D_MODEL)
    m = g[:, :, 0] * out_a + g[:, :, 1] * out_b + g[:, :, 2] * out_c
    out = m @ p["w_out"]
    new_states = (new_lru_conv.astype(lru_conv_buf.dtype), h_last.astype(lru_h.dtype),
                  new_sc.astype(sc_buf.dtype), h_re[:, -1].astype(ssm_re.dtype),
                  h_im[:, -1].astype(ssm_im.dtype))
    return out, new_states


def trunk_layer(x, lru_conv_buf, lru_h, sc_buf, ssm_re, ssm_im, p):
    m, st = mixer(x, lru_conv_buf, lru_h, sc_buf, ssm_re, ssm_im, p)
    x = layer_norm(ALPHA * x + m, p["ln1_g"], p["ln1_b"])
    f = jnp.square(jax.nn.relu(x @ p["mlp_up"])) @ p["mlp_down"]
    x = layer_norm(ALPHA * x + f, p["ln2_g"], p["ln2_b"])
    return x, st


def setup_inputs(seed: int = 0) -> dict:
    key = jax.random.key(seed)
    ks = jax.random.split(key, 40)
    nrm = lambda k, s, sc: jax.random.normal(k, s, F32) * sc
    rad = jax.random.uniform(ks[12], (DEPTH, LRU_WIDTH), F32, 0.9, 0.999)
    n_idx = jnp.arange(SSM_STATE, dtype=F32)
    lo, hi = math.log(0.001), math.log(0.1)
    return {
        "x_prompt": nrm(ks[0], (BATCH, SEQ, D_MODEL), 1.0),
        "x_sample": nrm(ks[1], (DEC_BATCH, DEC_SEQ, D_MODEL), 1.0),
        "state_lru_conv": nrm(ks[2], (DEPTH, DEC_BATCH, LRU_CONV - 1, LRU_WIDTH), 1.0),
        "state_lru_h": nrm(ks[3], (DEPTH, DEC_BATCH, LRU_WIDTH), 0.5),
        "state_sconv": nrm(ks[4], (DEPTH, DEC_BATCH, SC_CONV - 1, SC_WIDTH), 0.5),
        "state_ssm_re": nrm(ks[5], (DEPTH, DEC_BATCH, SSM_GROUPS, SSM_STATE), 0.3),
        "state_ssm_im": nrm(ks[6], (DEPTH, DEC_BATCH, SSM_GROUPS, SSM_STATE), 0.3),
        "w_in": nrm(ks[7], (DEPTH, D_MODEL, N_IN), D_MODEL ** -0.5),
        "conv_a_w": nrm(ks[8], (DEPTH, LRU_CONV, LRU_WIDTH), LRU_CONV ** -0.5),
        "conv_a_b": nrm(ks[9], (DEPTH, LRU_WIDTH), 0.01),
        "gate_x_w": nrm(ks[10], (DEPTH, LRU_HEADS, LRU_HEAD_DIM, LRU_HEAD_DIM), LRU_HEAD_DIM ** -0.5),
        "gate_x_b": nrm(ks[11], (DEPTH, LRU_WIDTH), 0.01),
        "gate_a_w": nrm(ks[13], (DEPTH, LRU_HEADS, LRU_HEAD_DIM, LRU_HEAD_DIM), LRU_HEAD_DIM ** -0.5),
        "gate_a_b": nrm(ks[14], (DEPTH, LRU_WIDTH), 0.01),
        "lru_lambda": jnp.log(rad) - jnp.log1p(-rad),
        "conv_b_w": nrm(ks[15], (DEPTH, SC_CONV, SC_WIDTH), SC_CONV ** -0.5),
        "ssm_a_re": -0.5 + nrm(ks[16], (DEPTH, SSM_GROUPS, SSM_STATE), 0.01),
        "ssm_a_im": math.pi * n_idx + nrm(ks[17], (DEPTH, SSM_GROUPS, SSM_STATE), 0.01),
        "ssm_log_dt": lo + (hi - lo) * jax.random.uniform(ks[18], (DEPTH, SSM_GROUPS, SSM_STATE), F32),
        "ssm_b_re": nrm(ks[19], (DEPTH, SSM_GROUPS, SSM_STATE, SSM_GROUP), (2 * SSM_GROUP) ** -0.5),
        "ssm_b_im": nrm(ks[20], (DEPTH, SSM_GROUPS, SSM_STATE, SSM_GROUP), (2 * SSM_GROUP) ** -0.5),
        "ssm_c_re": nrm(ks[21], (DEPTH, SSM_GROUPS, SSM_GROUP, SSM_STATE), (2 * SSM_STATE) ** -0.5),
        "ssm_c_im": nrm(ks[22], (DEPTH, SSM_GROUPS, SSM_GROUP, SSM_STATE), (2 * SSM_STATE) ** -0.5),
        "ssm_d": nrm(ks[23], (DEPTH, SSM_WIDTH), 1.0),
        "glu_w": nrm(ks[24], (DEPTH, SSM_WIDTH, SSM_WIDTH), SSM_WIDTH ** -0.5),
        "glu_b": nrm(ks[25], (DEPTH, SSM_WIDTH), 0.01),
        "proj_a": nrm(ks[26], (DEPTH, LRU_WIDTH, D_MODEL), LRU_WIDTH ** -0.5),
        "proj_b": nrm(ks[27], (DEPTH, SC_WIDTH, D_MODEL), SC_WIDTH ** -0.5),
        "proj_c": nrm(ks[28], (DEPTH, SSM_WIDTH, D_MODEL), SSM_WIDTH ** -0.5),
        "w_out": nrm(ks[29], (DEPTH, D_MODEL, D_MODEL), BETA * D_MODEL ** -0.5),
        "ln1_g": 1.0 + nrm(ks[30], (DEPTH, D_MODEL), 0.01),
        "ln1_b": nrm(ks[31], (DEPTH, D_MODEL), 0.01),
        "mlp_up": nrm(ks[32], (DEPTH, D_MODEL, D_FF), D_MODEL ** -0.5),
        "mlp_down": nrm(ks[33], (DEPTH, D_FF, D_MODEL), BETA * D_FF ** -0.5),
        "ln2_g": 1.0 + nrm(ks[34], (DEPTH, D_MODEL), 0.01),
        "ln2_b": nrm(ks[35], (DEPTH, D_MODEL), 0.01),
    }


def reference(x_prompt, x_sample, state_lru_conv, state_lru_h, state_sconv, state_ssm_re, state_ssm_im,
              w_in, conv_a_w, conv_a_b, gate_x_w, gate_x_b, gate_a_w, gate_a_b, lru_lambda, conv_b_w,
              ssm_a_re, ssm_a_im, ssm_log_dt, ssm_b_re, ssm_b_im, ssm_c_re, ssm_c_im, ssm_d, glu_w, glu_b,
              proj_a, proj_b, proj_c, w_out, ln1_g, ln1_b, mlp_up, mlp_down, ln2_g, ln2_b):
    dt_ = x_prompt.dtype
    z_lru_conv = jnp.zeros((BATCH, LRU_CONV - 1, LRU_WIDTH), dt_)
    z_lru_h = jnp.zeros((BATCH, LRU_WIDTH), dt_)
    z_sconv = jnp.zeros((BATCH, SC_CONV - 1, SC_WIDTH), dt_)
    z_ssm = jnp.zeros((BATCH, SSM_GROUPS, SSM_STATE), dt_)

    yp, ys = x_prompt, x_sample
    sp = [[] for _ in range(5)]
    ss = [[] for _ in range(5)]
    for i in range(DEPTH):
        p = {
            "w_in": w_in[i], "conv_a_w": conv_a_w[i], "conv_a_b": conv_a_b[i],
            "gate_x_w": gate_x_w[i], "gate_x_b": gate_x_b[i], "gate_a_w": gate_a_w[i],
            "gate_a_b": gate_a_b[i], "lru_lambda": lru_lambda[i], "conv_b_w": conv_b_w[i],
            "ssm_a_re": ssm_a_re[i], "ssm_a_im": ssm_a_im[i], "ssm_log_dt": ssm_log_dt[i],
            "ssm_b_re": ssm_b_re[i], "ssm_b_im": ssm_b_im[i], "ssm_c_re": ssm_c_re[i],
            "ssm_c_im": ssm_c_im[i], "ssm_d": ssm_d[i], "glu_w": glu_w[i], "glu_b": glu_b[i],
            "proj_a": proj_a[i], "proj_b": proj_b[i], "proj_c": proj_c[i], "w_out": w_out[i],
            "ln1_g": ln1_g[i], "ln1_b": ln1_b[i], "mlp_up": mlp_up[i], "mlp_down": mlp_down[i],
            "ln2_g": ln2_g[i], "ln2_b": ln2_b[i],
        }
        yp, stp = trunk_layer(yp, z_lru_conv, z_lru_h, z_sconv, z_ssm, z_ssm, p)
        ys, sts = trunk_layer(ys, state_lru_conv[i], state_lru_h[i], state_sconv[i],
                              state_ssm_re[i], state_ssm_im[i], p)
        for j in range(5):
            sp[j].append(stp[j])
            ss[j].append(sts[j])
    new_lru_conv_p = jnp.stack(sp[0], 0)
    new_lru_h_p = jnp.stack(sp[1], 0)
    new_sconv_p = jnp.stack(sp[2], 0)
    new_ssm_re_p = jnp.stack(sp[3], 0)
    new_ssm_im_p = jnp.stack(sp[4], 0)
    new_lru_conv_s = jnp.stack(ss[0], 0)
    new_lru_h_s = jnp.stack(ss[1], 0)
    new_sconv_s = jnp.stack(ss[2], 0)
    new_ssm_re_s = jnp.stack(ss[3], 0)
    new_ssm_im_s = jnp.stack(ss[4], 0)
    return (yp, ys, new_lru_conv_p, new_lru_h_p, new_sconv_p, new_ssm_re_p, new_ssm_im_p,
            new_lru_conv_s, new_lru_h_s, new_sconv_s, new_ssm_re_s, new_ssm_im_s)
```

```cpp
#include <hip/hip_runtime.h>
#include <hip/hip_cooperative_groups.h>
#include <cstdio>
namespace cg = cooperative_groups;

#define LAS __attribute__((address_space(3)))
typedef unsigned short bf16_t;
typedef short bf16x8 __attribute__((ext_vector_type(8)));
typedef float f32x4 __attribute__((ext_vector_type(4)));
typedef float f32x2 __attribute__((ext_vector_type(2)));
typedef unsigned u32x4 __attribute__((ext_vector_type(4)));
typedef unsigned u32x2 __attribute__((ext_vector_type(2)));

constexpr int MP = 16384, MS = 512, M = MP + MS, D = 1024, NIN = 6144, BW = 512, DFF = 4096;
constexpr int NTHR = 512;
constexpr float ALPHA = 1.41421356237f;
constexpr float LN_EPS = 1e-5f;

constexpr size_t S17 = (size_t)M * 512 * 2;
constexpr size_t OFF_WUP = 0;
constexpr size_t OFF_WDOWN = OFF_WUP + (size_t)4096 * 1024 * 2;
constexpr size_t OFF_R = OFF_WDOWN + (size_t)4096 * 1024 * 2;
constexpr size_t OFF_XB = OFF_R + 4 * S17;
constexpr size_t OFF_BIG = OFF_XB + 2 * S17;
constexpr size_t OFF_H = OFF_BIG;
constexpr size_t OFF_WIN = OFF_BIG;
constexpr size_t OFF_WP = OFF_WIN + (size_t)6144 * 1024 * 2;
constexpr size_t OFF_WGLU = OFF_WP + (size_t)3 * 1024 * 512 * 2;
constexpr size_t OFF_WOUT = OFF_WGLU + (size_t)512 * 512 * 2;
constexpr size_t OFF_WGATE = OFF_WOUT + (size_t)1024 * 1024 * 2;
constexpr size_t OFF_W1T = OFF_WGATE + (size_t)1024 * 512 * 2;
constexpr size_t OFF_WYT = OFF_W1T + (size_t)32 * 128 * 256 * 2;
constexpr size_t OFF_GL8 = OFF_WYT + (size_t)32 * 256 * 384 * 2;
constexpr size_t OFF_YA = OFF_GL8 + (size_t)M * 3072;
constexpr size_t OFF_APACK = OFF_YA + S17;
constexpr size_t OFF_S = OFF_APACK + (size_t)32 * 1024 * 384 * 2;
constexpr size_t OFF_MB = OFF_APACK;
constexpr size_t OFF_USS = OFF_S + (size_t)32 * 1024 * 128 * 4;
constexpr size_t OFF_CAR = OFF_USS + (size_t)512 * 512 * 2;
constexpr size_t WS_END = OFF_CAR + (size_t)8 * 32 * 512 * 8;
static_assert(WS_END <= (size_t)268435456, "workspace map exceeds 256 MiB");
static_assert(OFF_MB + (size_t)M * 1024 * 2 <= OFF_USS, "m overlay");
static_assert(OFF_H + (size_t)M * 4096 * 2 <= (size_t)268435456, "h overlay");

constexpr size_t O_Y = 0;
constexpr size_t O_LCP = (size_t)M * 1024;
constexpr size_t O_LHP = O_LCP + 2 * 8 * 3 * 512;
constexpr size_t O_SCP = O_LHP + 2 * 8 * 512;
constexpr size_t O_SRP = O_SCP + 2 * 8 * 2 * 512;
constexpr size_t O_SIP = O_SRP + 2 * 8 * 2048;
constexpr size_t O_LCS = O_SIP + 2 * 8 * 2048;
constexpr size_t O_LHS = O_LCS + 2 * 128 * 3 * 512;
constexpr size_t O_SCS = O_LHS + 2 * 128 * 512;
constexpr size_t O_SRS = O_SCS + 2 * 128 * 2 * 512;
constexpr size_t O_SIS = O_SRS + 2 * 128 * 2048;

struct Args { const float* in[36]; float* out; unsigned char* ws; };
typedef const __attribute__((address_space(4))) Args* AP;
__device__ __forceinline__ AP ld_args() {
#if defined(__HIP_DEVICE_COMPILE__)
    auto p = __builtin_amdgcn_kernarg_segment_ptr();
    asm volatile("" : "+s"(p));
    return (AP)p;
#else
    return nullptr;
#endif
}
enum { I_XP = 0, I_XS, I_SLC, I_SLH, I_SSC, I_SSR, I_SSI, I_WIN, I_CAW, I_CAB, I_GXW, I_GXB, I_GAW, I_GAB, I_LAM, I_CBW, I_SAR, I_SAI, I_SDT,
       I_SBR, I_SBI, I_SCR, I_SCI, I_SD, I_GLW, I_GLB, I_PA, I_PB, I_PC, I_WO, I_L1G, I_L1B, I_UP, I_DN, I_L2G, I_L2B };

__device__ __forceinline__ unsigned cvt_pk_bf16(float lo, float hi) { unsigned r; asm volatile("v_cvt_pk_bf16_f32 %0, %1, %2" : "=v"(r) : "v"(lo), "v"(hi)); return r; }
__device__ __forceinline__ bf16_t f2bf(float f) { return (bf16_t)(cvt_pk_bf16(f, 0.f) & 0xffffu); }
__device__ __forceinline__ float bf2f(unsigned short b) { return __uint_as_float(((unsigned)b) << 16); }
__device__ __forceinline__ float bflo(unsigned w) { return __uint_as_float(w << 16); }
__device__ __forceinline__ float bfhi(unsigned w) { return __uint_as_float(w & 0xffff0000u); }
__device__ __forceinline__ float sigm(float x) { return 1.0f / (1.0f + __expf(-x)); }
__device__ __forceinline__ float gelu_t(float x) { const float u = 0.7978845608f * (x + 0.044715f * x * x * x); return x / (1.0f + __expf(-2.0f * u)); }
__device__ __forceinline__ u32x4 pack8(const f32x4 a, const f32x4 b) { u32x4 w; w.x = cvt_pk_bf16(a[0], a[1]); w.y = cvt_pk_bf16(a[2], a[3]); w.z = cvt_pk_bf16(b[0], b[1]); w.w = cvt_pk_bf16(b[2], b[3]); return w; }
__device__ __forceinline__ void unpack8(const u32x4 w, float (&f)[8]) { f[0] = bflo(w.x); f[1] = bfhi(w.x); f[2] = bflo(w.y); f[3] = bfhi(w.y); f[4] = bflo(w.z); f[5] = bfhi(w.z); f[6] = bflo(w.w); f[7] = bfhi(w.w); }

__device__ __forceinline__ int otid() { int t = threadIdx.x; asm volatile("" : "+v"(t)); return t; }

constexpr int BM = 256, BK = 64, HALF = 128, HTB = HALF * BK * 2, STAGE_BYTES = 8 * HTB;
__device__ __forceinline__ int lds_byte(int r, int c) { const int st = (r >> 4) * 2 + (c >> 5), rr = r & 15, cc = c & 31, ob = rr * 64 + cc * 2; return st * 1024 + (ob ^ (((ob >> 9) & 1) << 5)); }
__device__ __forceinline__ void stage_rc(int b, int& R, int& C) { const int st = b / 1024, sb = b % 1024, swz = sb ^ (((sb >> 9) & 1) << 5); R = (st >> 1) * 16 + swz / 64; C = (st & 1) * 32 + (swz % 64) / 2; }
__device__ __forceinline__ int perm32(int rho) { const int n = rho >> 4, i = rho & 15; return 8 * (i >> 2) + 4 * n + (i & 3); }
struct Unit { int pm, pn, z; };
__device__ __forceinline__ void tile_map(int L, int nM, int nN, int& pm, int& pn) {
    const int nwg = nM * nN; int wgid = L;
    { const int q = nwg / 8, r = nwg % 8, xcd = wgid % 8, off = wgid / 8; wgid = (xcd < r ? xcd * (q + 1) : r * (q + 1) + (xcd - r) * q) + off; }
    const int nig = 8 * nN, gid = wgid / nig, fm = gid * 8, gsz = (nM - fm) < 8 ? (nM - fm) : 8;
    pm = fm + ((wgid % nig) % gsz); pn = (wgid % nig) / gsz;
}

template <class P>
__device__ __forceinline__ void gemm_phase(LAS unsigned char* lds, const P& p) {
    const int tid = otid(), wid = __builtin_amdgcn_readfirstlane(tid >> 6), lane = tid & 63, wr = wid >> 2, wc = wid & 3, fr = lane & 15, fq = lane >> 4;
    const int K = p.K, nt = K / BK;
    unsigned voffA[2], voffB[2];
#pragma unroll
    for (int i = 0; i < 2; ++i) { int R, C; stage_rc(tid * 16 + i * 8192, R, C); const int Rb = P::PERM ? ((R & ~31) + perm32(R & 31)) : R;
        voffA[i] = (unsigned)(R * p.lda + C) * 2u; voffB[i] = (unsigned)(Rb * p.ldb + C) * 2u; }
    const size_t kstep = (size_t)(BK * 2);
    const size_t hA = (size_t)HALF * p.lda * 2, hB = (size_t)HALF * p.ldb * 2;
    const unsigned ldsw = (unsigned)wid * 1024u;
    const int aoff = lds_byte(wr * 64 + fr, fq * 8), boff = lds_byte(wc * 32 + fr, fq * 8);
#define PG8_SA(b, h) (((b) * 2 + (h)) * HTB)
#define PG8_SB(b, h) ((4 + (b) * 2 + (h)) * HTB)
#define PG8_STAGE(bufoff, gbase, voff) do { _Pragma("unroll") for (int _i = 0; _i < 2; ++_i) \
        __builtin_amdgcn_global_load_lds((const unsigned*)((const char*)(gbase) + (voff)[_i]), (LAS unsigned*)(lds + (bufoff) + ldsw + _i * 8192), 16, 0, 0); } while (0)
#define PG8_LDA(dst, b, h) do { _Pragma("unroll") for (int m = 0; m < 4; ++m) _Pragma("unroll") for (int k = 0; k < 2; ++k) dst[m][k] = *(const LAS bf16x8*)(lds + PG8_SA(b, h) + aoff + m * 2048 + k * 1024); } while (0)
#define PG8_LDB(dst, b, h) do { _Pragma("unroll") for (int n = 0; n < 2; ++n) _Pragma("unroll") for (int k = 0; k < 2; ++k) dst[n][k] = *(const LAS bf16x8*)(lds + PG8_SB(b, h) + boff + n * 2048 + k * 1024); } while (0)
#define PG8_MMA(ai, bj, At, Bt) do { __builtin_amdgcn_s_setprio(1); _Pragma("unroll") for (int m = 0; m < 4; ++m) _Pragma("unroll") for (int n = 0; n < 2; ++n) _Pragma("unroll") for (int k = 0; k < 2; ++k) \
        acc[ai][bj][m][n] = __builtin_amdgcn_mfma_f32_16x16x32_bf16(Bt[n][k], At[m][k], acc[ai][bj][m][n], 0, 0, 0); __builtin_amdgcn_s_setprio(0); } while (0)
#define PG8_WAIT_V(n) asm volatile("s_waitcnt vmcnt(" #n ")" ::: "memory")
#define PG8_WAIT_L(n) asm volatile("s_waitcnt lgkmcnt(" #n ")" ::: "memory")
#define PG8_BAR __builtin_amdgcn_s_barrier()
#define PG8_SCHED __builtin_amdgcn_sched_barrier(0)
    Unit cur, nxt; int ui = 0;
    if (!p.next(0, cur)) return;
    f32x4 acc[2][2][4][2];
#pragma unroll
    for (int a = 0; a < 2; ++a)
#pragma unroll
        for (int b = 0; b < 2; ++b)
#pragma unroll
            for (int m = 0; m < 4; ++m)
#pragma unroll
                for (int n = 0; n < 2; ++n) acc[a][b][m][n] = (f32x4){0.f, 0.f, 0.f, 0.f};
    bf16x8 At[4][2], B0[2][2], B1[2][2];
    const char* cA = p.aptr(cur); const char* cB = p.bptr(cur);
    PG8_STAGE(PG8_SB(0, 0), cB, voffB); PG8_STAGE(PG8_SA(0, 0), cA, voffA); PG8_STAGE(PG8_SB(0, 1), cB + hB, voffB); PG8_STAGE(PG8_SA(0, 1), cA + hA, voffA);
    if (wr == 1) PG8_BAR;
    PG8_WAIT_V(4); PG8_BAR;
    PG8_STAGE(PG8_SB(1, 0), cB + kstep, voffB); PG8_STAGE(PG8_SA(1, 0), cA + kstep, voffA); PG8_STAGE(PG8_SB(1, 1), cB + hB + kstep, voffB);
    PG8_WAIT_V(6); PG8_BAR;
    for (;;) {
        const bool has_next = p.next(ui + 1, nxt);
        const char* nA = has_next ? p.aptr(nxt) : cA; const char* nB = has_next ? p.bptr(nxt) : cB;
        for (int t = 0; t < nt; t += 2) {
            const bool last = (t == nt - 2);
            const char* a1 = cA + (size_t)(t + 1) * kstep;
            const char* a2 = last ? nA : cA + (size_t)(t + 2) * kstep; const char* b2 = last ? nB : cB + (size_t)(t + 2) * kstep;
            const char* a3 = a2 + kstep; const char* b3 = b2 + kstep;
            PG8_LDB(B0, 0, 0); PG8_SCHED; PG8_LDA(At, 0, 0); PG8_STAGE(PG8_SA(1, 1), a1 + hA, voffA);
            PG8_WAIT_L(8); PG8_BAR; PG8_WAIT_L(0); PG8_MMA(0, 0, At, B0); PG8_BAR; PG8_SCHED;
            PG8_LDB(B1, 0, 1); PG8_STAGE(PG8_SB(0, 0), b2, voffB);
            PG8_BAR; PG8_WAIT_L(0); PG8_MMA(0, 1, At, B1); PG8_BAR;
            PG8_LDA(At, 0, 1); PG8_STAGE(PG8_SA(0, 0), a2, voffA);
            PG8_BAR; PG8_WAIT_L(0); PG8_MMA(1, 0, At, B0); PG8_BAR; PG8_SCHED;
            PG8_STAGE(PG8_SB(0, 1), b2 + hB, voffB);
            PG8_WAIT_V(6); PG8_BAR; PG8_MMA(1, 1, At, B1); PG8_BAR;
            PG8_LDB(B0, 1, 0); PG8_SCHED; PG8_LDA(At, 1, 0); PG8_STAGE(PG8_SA(0, 1), a2 + hA, voffA);
            PG8_WAIT_L(8); PG8_BAR; PG8_WAIT_L(0); PG8_MMA(0, 0, At, B0); PG8_BAR; PG8_SCHED;
            PG8_LDB(B1, 1, 1); PG8_STAGE(PG8_SB(1, 0), b3, voffB);
            PG8_BAR; PG8_WAIT_L(0); PG8_MMA(0, 1, At, B1); PG8_BAR;
            PG8_LDA(At, 1, 1); PG8_STAGE(PG8_SA(1, 0), a3, voffA);
            PG8_BAR; PG8_WAIT_L(0); PG8_MMA(1, 0, At, B0); PG8_BAR; PG8_SCHED;
            PG8_STAGE(PG8_SB(1, 1), b3 + hB, voffB);
            PG8_WAIT_V(6); PG8_BAR; PG8_MMA(1, 1, At, B1); PG8_BAR;
        }
        const bool rst = p.epi(acc, cur, wr, wc, fr, fq);
        if (!has_next) break;
        if (rst) {
#pragma unroll
            for (int a = 0; a < 2; ++a)
#pragma unroll
                for (int b = 0; b < 2; ++b)
#pragma unroll
                    for (int m = 0; m < 4; ++m)
#pragma unroll
                        for (int n = 0; n < 2; ++n) acc[a][b][m][n] = (f32x4){0.f, 0.f, 0.f, 0.f};
        }
        cur = nxt; cA = nA; cB = nB; ++ui;
    }
    PG8_WAIT_V(0);
    if (wr == 0) PG8_BAR;
    PG8_BAR;
#undef PG8_SA
#undef PG8_SB
#undef PG8_STAGE
#undef PG8_LDA
#undef PG8_LDB
#undef PG8_MMA
#undef PG8_WAIT_V
#undef PG8_WAIT_L
#undef PG8_BAR
#undef PG8_SCHED
}
typedef f32x4 Acc[2][2][4][2];

struct PG1 {
    static constexpr bool PERM = true;
    int K, lda, ldb, G, c;
    const bf16_t* A; const bf16_t* Bt;
    bf16_t *xa, *ya, *sb, *sc, *sh, *apack, *uss; unsigned char* gl8;
    __device__ __forceinline__ bool next(int i, Unit& u) const { const long L = (long)i * G + c; if (L >= 66 * 24) return false; tile_map((int)L, 66, 24, u.pm, u.pn); u.z = 0; return true; }
    __device__ __forceinline__ const char* aptr(const Unit& u) const { return (const char*)A + (size_t)u.pm * 256 * 1024 * 2; }
    __device__ __forceinline__ const char* bptr(const Unit& u) const { return (const char*)Bt + (size_t)u.pn * 256 * 1024 * 2; }
    __device__ __forceinline__ bool epi(Acc& acc, const Unit& u, int wr, int wc, int fr, int fq) const {
        const int pn = u.pn;
        if (pn < 10) {
            const int b = pn >> 1; bf16_t* base = b == 0 ? xa : b == 1 ? ya : b == 2 ? sb : b == 3 ? sc : sh;
#pragma unroll
            for (int ai = 0; ai < 2; ++ai)
#pragma unroll
                for (int m = 0; m < 4; ++m) { const size_t r = (size_t)u.pm * 256 + ai * 128 + wr * 64 + m * 16 + fr;
#pragma unroll
                    for (int bj = 0; bj < 2; ++bj) { const int col = (pn & 1) * 256 + bj * 128 + wc * 32 + 8 * fq;
                        *(u32x4*)(base + r * 512 + col) = pack8(acc[ai][bj][m][0], acc[ai][bj][m][1]); } }
        } else if (pn < 12) {
#pragma unroll
            for (int ai = 0; ai < 2; ++ai)
#pragma unroll
                for (int m = 0; m < 4; ++m) { const int r = u.pm * 256 + ai * 128 + wr * 64 + m * 16 + fr;
#pragma unroll
                    for (int bj = 0; bj < 2; ++bj) { const int cc = (pn - 10) * 256 + bj * 128 + wc * 32 + 8 * fq;
                        bf16_t* dst = (u.pm < 64) ? apack + ((size_t)((cc >> 4) * 1024 + (r >> 4)) * 384 + 128 + (r & 15) * 16 + (cc & 15)) : uss + (size_t)(r - MP) * 512 + cc;
                        *(u32x4*)dst = pack8(acc[ai][bj][m][0], acc[ai][bj][m][1]); } }
        } else {
#pragma unroll
            for (int ai = 0; ai < 2; ++ai)
#pragma unroll
                for (int m = 0; m < 4; ++m) { const size_t r = (size_t)u.pm * 256 + ai * 128 + wr * 64 + m * 16 + fr;
#pragma unroll
                    for (int bj = 0; bj < 2; ++bj) { const int col = (pn - 12) * 256 + bj * 128 + wc * 32 + 8 * fq;
                        unsigned q[8];
#pragma unroll
                        for (int n = 0; n < 2; ++n)
#pragma unroll
                            for (int j = 0; j < 4; ++j) { int v = (int)(sigm(acc[ai][bj][m][n][j]) * 256.0f); v = v < 0 ? 0 : (v > 255 ? 255 : v); q[n * 4 + j] = (unsigned)v; }
                        u32x2 w; w.x = q[0] | (q[1] << 8) | (q[2] << 16) | (q[3] << 24); w.y = q[4] | (q[5] << 8) | (q[6] << 16) | (q[7] << 24);
                        *(u32x2*)(gl8 + r * 3072 + col) = w; } }
        }
        return true;
    }
};

struct PGate {
    static constexpr bool PERM = false;
    int K, lda, ldb, G, c;
    const bf16_t* A; const bf16_t* Bt;
    const float *gxb, *gab, *lam; float* aout; bf16_t* bxout;
    __device__ __forceinline__ bool next(int i, Unit& u) const { const long L = (long)i * G + c; if (L >= 66 * 4) return false; tile_map((int)L, 66, 4, u.pm, u.pn); u.z = 0; return true; }
    __device__ __forceinline__ const char* aptr(const Unit& u) const { return (const char*)A + (size_t)u.pm * 256 * 512 * 2; }
    __device__ __forceinline__ const char* bptr(const Unit& u) const { return (const char*)Bt + (size_t)u.pn * 256 * 512 * 2; }
    __device__ __forceinline__ bool epi(Acc& acc, const Unit& u, int wr, int wc, int fr, int fq) const {
#pragma unroll
        for (int n = 0; n < 2; ++n) {
            const int ch0 = u.pn * 128 + wc * 32 + n * 16 + 4 * fq;
            const f32x4 bx4 = *(const f32x4*)(gxb + ch0), ba4 = *(const f32x4*)(gab + ch0), lm4 = *(const f32x4*)(lam + ch0);
            f32x4 kk;
#pragma unroll
            for (int j = 0; j < 4; ++j) kk[j] = -8.0f * log1pf(expf(-lm4[j]));
#pragma unroll
            for (int ai = 0; ai < 2; ++ai)
#pragma unroll
                for (int m = 0; m < 4; ++m) { const size_t r = (size_t)u.pm * 256 + ai * 128 + wr * 64 + m * 16 + fr;
                    const u32x2 xw = *(const u32x2*)(A + r * 512 + ch0);
                    const float xc[4] = {bflo(xw.x), bfhi(xw.x), bflo(xw.y), bfhi(xw.y)};
                    f32x4 av; float bv[4];
#pragma unroll
                    for (int j = 0; j < 4; ++j) { const float gx = sigm(acc[ai][0][m][n][j] + bx4[j]), ga = sigm(acc[ai][1][m][n][j] + ba4[j]);
                        const float la = kk[j] * ga; av[j] = __expf(la); bv[j] = sqrtf(-expm1f(2.0f * la)) * gx * xc[j]; }
                    *(f32x4*)(aout + r * 512 + ch0) = av;
                    u32x2 w; w.x = cvt_pk_bf16(bv[0], bv[1]); w.y = cvt_pk_bf16(bv[2], bv[3]);
                    *(u32x2*)(bxout + r * 512 + ch0) = w; }
        }
        return true;
    }
};

struct PY {
    static constexpr bool PERM = true;
    int K, lda, ldb, G, c;
    const bf16_t* apack; const bf16_t* wyt; const float* dvec; bf16_t* zc;
    __device__ __forceinline__ bool next(int i, Unit& u) const { const long L = (long)i * G + c; if (L >= 128) return false; u.pm = (int)L; u.pn = (int)L >> 2; u.z = 0; return true; }
    __device__ __forceinline__ const char* aptr(const Unit& u) const { return (const char*)apack + (size_t)u.pm * 256 * 384 * 2; }
    __device__ __forceinline__ const char* bptr(const Unit& u) const { return (const char*)wyt + (size_t)u.pn * 256 * 384 * 2; }
    __device__ __forceinline__ bool epi(Acc& acc, const Unit& u, int wr, int wc, int fr, int fq) const {
        const int g = u.pn;
#pragma unroll
        for (int bj = 0; bj < 2; ++bj) {
            const int n0 = bj * 128 + wc * 32 + 8 * fq, ti = n0 >> 4, c0 = n0 & 15;
            const f32x4 d0 = *(const f32x4*)(dvec + g * 16 + c0), d1 = *(const f32x4*)(dvec + g * 16 + c0 + 4);
#pragma unroll
            for (int ai = 0; ai < 2; ++ai)
#pragma unroll
                for (int m = 0; m < 4; ++m) { const int rr = (u.pm & 3) * 256 + ai * 128 + wr * 64 + m * 16 + fr;
                    const u32x4 uw = *(const u32x4*)(apack + ((size_t)(g * 1024 + rr) * 384 + 128 + n0));
                    float uf[8]; unpack8(uw, uf);
                    f32x4 y0, y1;
#pragma unroll
                    for (int j = 0; j < 4; ++j) { y0[j] = gelu_t(acc[ai][bj][m][0][j] + d0[j] * uf[j]); y1[j] = gelu_t(acc[ai][bj][m][1][j] + d1[j] * uf[4 + j]); }
                    const size_t tok = (size_t)(rr >> 7) * 2048 + (rr & 127) * 16 + ti;
                    *(u32x4*)(zc + tok * 512 + g * 16 + c0) = pack8(y0, y1); }
        }
        return true;
    }
};

struct PGlu {
    static constexpr bool PERM = true;
    int K, lda, ldb, G, c;
    const bf16_t* A; const bf16_t* Bt; const float* bias; bf16_t* out;
    __device__ __forceinline__ bool next(int i, Unit& u) const { const long L = (long)i * G + c; if (L >= 66 * 2) return false; tile_map((int)L, 66, 2, u.pm, u.pn); u.z = 0; return true; }
    __device__ __forceinline__ const char* aptr(const Unit& u) const { return (const char*)A + (size_t)u.pm * 256 * 512 * 2; }
    __device__ __forceinline__ const char* bptr(const Unit& u) const { return (const char*)Bt + (size_t)u.pn * 256 * 512 * 2; }
    __device__ __forceinline__ bool epi(Acc& acc, const Unit& u, int wr, int wc, int fr, int fq) const {
#pragma unroll
        for (int bj = 0; bj < 2; ++bj) {
            const int col = u.pn * 256 + bj * 128 + wc * 32 + 8 * fq;
            const f32x4 b0 = *(const f32x4*)(bias + col), b1 = *(const f32x4*)(bias + col + 4);
#pragma unroll
            for (int ai = 0; ai < 2; ++ai)
#pragma unroll
                for (int m = 0; m < 4; ++m) { const size_t r = (size_t)u.pm * 256 + ai * 128 + wr * 64 + m * 16 + fr;
                    const u32x4 zw = *(const u32x4*)(A + r * 512 + col); float zf[8]; unpack8(zw, zf);
                    f32x4 y0, y1;
#pragma unroll
                    for (int j = 0; j < 4; ++j) { y0[j] = zf[j] * sigm(acc[ai][bj][m][0][j] + b0[j]); y1[j] = zf[4 + j] * sigm(acc[ai][bj][m][1][j] + b1[j]); }
                    *(u32x4*)(out + r * 512 + col) = pack8(y0, y1); }
        }
        return true;
    }
};

struct PMerge {
    static constexpr bool PERM = true;
    int K, lda, ldb, G, c;
    const bf16_t* a0; const bf16_t* wp; const unsigned char* gl8; bf16_t* mb;
    __device__ __forceinline__ bool next(int i, Unit& u) const { const int ti = i / 3; const long L = (long)ti * G + c; if (L >= 66 * 4) return false; tile_map((int)L, 66, 4, u.pm, u.pn); u.z = i - ti * 3; return true; }
    __device__ __forceinline__ const char* aptr(const Unit& u) const { const size_t off = (u.z == 2) ? (OFF_XB + S17 - OFF_R) : (size_t)u.z * S17; return (const char*)a0 + off + (size_t)u.pm * 256 * 512 * 2; }
    __device__ __forceinline__ const char* bptr(const Unit& u) const { return (const char*)wp + ((size_t)u.z * 1024 + (size_t)u.pn * 256) * 512 * 2; }
    __device__ __forceinline__ bool epi(Acc& acc, const Unit& u, int wr, int wc, int fr, int fq) const {
        const int br = u.z;
#pragma unroll
        for (int ai = 0; ai < 2; ++ai)
#pragma unroll
            for (int m = 0; m < 4; ++m) { const size_t r = (size_t)u.pm * 256 + ai * 128 + wr * 64 + m * 16 + fr;
#pragma unroll
                for (int bj = 0; bj < 2; ++bj) { const int col = u.pn * 256 + bj * 128 + wc * 32 + 8 * fq;
                    const u32x2 qc = *(const u32x2*)(gl8 + r * 3072 + br * 1024 + col);
                    if (br < 2) {
                        const u32x2 qn = *(const u32x2*)(gl8 + r * 3072 + (br + 1) * 1024 + col);
#pragma unroll
                        for (int j = 0; j < 4; ++j) {
                            const float gc0 = (float)((qc.x >> (8 * j)) & 255u) + 0.5f, gn0 = (float)((qn.x >> (8 * j)) & 255u) + 0.5f;
                            const float gc1 = (float)((qc.y >> (8 * j)) & 255u) + 0.5f, gn1 = (float)((qn.y >> (8 * j)) & 255u) + 0.5f;
                            acc[ai][bj][m][0][j] *= gc0 / gn0; acc[ai][bj][m][1][j] *= gc1 / gn1; }
                    } else {
                        f32x4 y0, y1;
#pragma unroll
                        for (int j = 0; j < 4; ++j) {
                            y0[j] = acc[ai][bj][m][0][j] * (((float)((qc.x >> (8 * j)) & 255u) + 0.5f) * (1.0f / 256.0f));
                            y1[j] = acc[ai][bj][m][1][j] * (((float)((qc.y >> (8 * j)) & 255u) + 0.5f) * (1.0f / 256.0f)); }
                        *(u32x4*)(mb + r * 1024 + col) = pack8(y0, y1);
                    } } }
        return br == 2;
    }
};

struct PWout {
    static constexpr bool PERM = false;
    int K, lda, ldb, G, c;
    const bf16_t* A; const bf16_t* Bt; const float* xp; const float* xs; float* R;
    __device__ __forceinline__ bool next(int i, Unit& u) const { const long L = (long)i * G + c; if (L >= 66 * 4) return false; tile_map((int)L, 66, 4, u.pm, u.pn); u.z = 0; return true; }
    __device__ __forceinline__ const char* aptr(const Unit& u) const { return (const char*)A + (size_t)u.pm * 256 * 1024 * 2; }
    __device__ __forceinline__ const char* bptr(const Unit& u) const { return (const char*)Bt + (size_t)u.pn * 256 * 1024 * 2; }
    __device__ __forceinline__ bool epi(Acc& acc, const Unit& u, int wr, int wc, int fr, int fq) const {
        const float* xsrc = (u.pm < 64) ? xp + (size_t)u.pm * 256 * 1024 : xs + (size_t)(u.pm - 64) * 256 * 1024;
#pragma unroll
        for (int ai = 0; ai < 2; ++ai)
#pragma unroll
            for (int m = 0; m < 4; ++m) { const int rl = ai * 128 + wr * 64 + m * 16 + fr; const size_t r = (size_t)u.pm * 256 + rl;
#pragma unroll
                for (int bj = 0; bj < 2; ++bj)
#pragma unroll
                    for (int n = 0; n < 2; ++n) { const int col = u.pn * 256 + bj * 128 + wc * 32 + n * 16 + 4 * fq;
                        const f32x4 xv = *(const f32x4*)(xsrc + (size_t)rl * 1024 + col);
                        *(f32x4*)(R + r * 1024 + col) = xv * ALPHA + acc[ai][bj][m][n]; } }
        return true;
    }
};

struct PUp {
    static constexpr bool PERM = true;
    int K, lda, ldb, G, c;
    const bf16_t* A; const bf16_t* Bt; bf16_t* h;
    __device__ __forceinline__ bool next(int i, Unit& u) const { const long L = (long)i * G + c; if (L >= 66 * 16) return false; tile_map((int)L, 66, 16, u.pm, u.pn); u.z = 0; return true; }
    __device__ __forceinline__ const char* aptr(const Unit& u) const { return (const char*)A + (size_t)u.pm * 256 * 1024 * 2; }
    __device__ __forceinline__ const char* bptr(const Unit& u) const { return (const char*)Bt + (size_t)u.pn * 256 * 1024 * 2; }
    __device__ __forceinline__ bool epi(Acc& acc, const Unit& u, int wr, int wc, int fr, int fq) const {
#pragma unroll
        for (int ai = 0; ai < 2; ++ai)
#pragma unroll
            for (int m = 0; m < 4; ++m) { const size_t r = (size_t)u.pm * 256 + ai * 128 + wr * 64 + m * 16 + fr;
#pragma unroll
                for (int bj = 0; bj < 2; ++bj) { const int col = u.pn * 256 + bj * 128 + wc * 32 + 8 * fq;
                    f32x4 y0, y1;
#pragma unroll
                    for (int j = 0; j < 4; ++j) { const float v0 = fmaxf(acc[ai][bj][m][0][j], 0.f), v1 = fmaxf(acc[ai][bj][m][1][j], 0.f); y0[j] = v0 * v0; y1[j] = v1 * v1; }
                    *(u32x4*)(h + r * 4096 + col) = pack8(y0, y1); } }
        return true;
    }
};

struct PDown {
    static constexpr bool PERM = false;
    int K, lda, ldb, G, c;
    const bf16_t* A; const bf16_t* Bt; float* R;
    __device__ __forceinline__ bool next(int i, Unit& u) const { const long L = (long)i * G + c; if (L >= 66 * 4) return false; tile_map((int)L, 66, 4, u.pm, u.pn); u.z = 0; return true; }
    __device__ __forceinline__ const char* aptr(const Unit& u) const { return (const char*)A + (size_t)u.pm * 256 * 4096 * 2; }
    __device__ __forceinline__ const char* bptr(const Unit& u) const { return (const char*)Bt + (size_t)u.pn * 256 * 4096 * 2; }
    __device__ __forceinline__ bool epi(Acc& acc, const Unit& u, int wr, int wc, int fr, int fq) const {
#pragma unroll
        for (int ai = 0; ai < 2; ++ai)
#pragma unroll
            for (int m = 0; m < 4; ++m) { const size_t r = (size_t)u.pm * 256 + ai * 128 + wr * 64 + m * 16 + fr;
#pragma unroll
                for (int bj = 0; bj < 2; ++bj)
#pragma unroll
                    for (int n = 0; n < 2; ++n) { const int col = u.pn * 256 + bj * 128 + wc * 32 + n * 16 + 4 * fq;
                        float* pp = R + r * 1024 + col; const f32x4 xv = *(const f32x4*)pp;
                        *(f32x4*)pp = xv * ALPHA + acc[ai][bj][m][n]; } }
        return true;
    }
};

__device__ __forceinline__ void tconv_tile(const float* W, bf16_t* Wt, int K, int N, int tk, int tn, float* sm) {
    const int tid = otid(), r = tid >> 3, c8 = (tid & 7) * 8;
    const float* src = W + (size_t)(tk * 64 + r) * N + tn * 64 + c8;
    const f32x4 v0 = *(const f32x4*)src, v1 = *(const f32x4*)(src + 4);
#pragma unroll
    for (int j = 0; j < 4; ++j) { sm[r * 65 + c8 + j] = v0[j]; sm[r * 65 + c8 + 4 + j] = v1[j]; }
    __syncthreads();
    const int n = tid >> 3, k8 = (tid & 7) * 8;
    u32x4 w;
    w.x = cvt_pk_bf16(sm[(k8 + 0) * 65 + n], sm[(k8 + 1) * 65 + n]); w.y = cvt_pk_bf16(sm[(k8 + 2) * 65 + n], sm[(k8 + 3) * 65 + n]);
    w.z = cvt_pk_bf16(sm[(k8 + 4) * 65 + n], sm[(k8 + 5) * 65 + n]); w.w = cvt_pk_bf16(sm[(k8 + 6) * 65 + n], sm[(k8 + 7) * 65 + n]);
    *(u32x4*)(Wt + (size_t)(tn * 64 + n) * K + tk * 64 + k8) = w;
    __syncthreads();
}

__device__ __forceinline__ void abar_pow(const float* are, const float* aim, const float* ldt, int sp, float e, float& pr, float& pi) {
    const float step = expf(ldt[sp]); const float x = e * step * are[sp], th = e * step * aim[sp];
    float s, c; sincosf(th, &s, &c); const float mg = expf(x); pr = mg * c; pi = mg * s;
}
__device__ __forceinline__ void ssm_coef(const float* are, const float* aim, const float* ldt, int sp, float& cr, float& ci) {
    const float step = expf(ldt[sp]); const float ar = are[sp], ai = aim[sp];
    const float x = step * ar, th = step * ai;
    float s, c; sincosf(th, &s, &c); const float em1 = expm1f(x); const float sh = sinf(0.5f * th);
    const float nr = em1 * c - 2.0f * sh * sh, ni = (em1 + 1.0f) * s;
    const float den = ar * ar + ai * ai;
    cr = (nr * ar + ni * ai) / den; ci = (ni * ar - nr * ai) / den;
}

__device__ __forceinline__ void prep_layer(AP a, int layer, float* sm) {
    unsigned char* ws = a->ws;
    const int G = gridDim.x;
    for (int t = blockIdx.x; t < 4288; t += G) {
        const float* W; bf16_t* Wt; int K, N, tt;
        if (t < 1536) { tt = t; W = a->in[I_WIN] + (size_t)layer * 1024 * 6144; Wt = (bf16_t*)(ws + OFF_WIN); K = 1024; N = 6144; }
        else if (t < 1920) { const int j = (t - 1536) / 128; tt = (t - 1536) % 128; W = a->in[I_PA + j] + (size_t)layer * 512 * 1024; Wt = (bf16_t*)(ws + OFF_WP) + (size_t)j * 1024 * 512; K = 512; N = 1024; }
        else if (t < 1984) { tt = t - 1920; W = a->in[I_GLW] + (size_t)layer * 512 * 512; Wt = (bf16_t*)(ws + OFF_WGLU); K = 512; N = 512; }
        else if (t < 2240) { tt = t - 1984; W = a->in[I_WO] + (size_t)layer * 1024 * 1024; Wt = (bf16_t*)(ws + OFF_WOUT); K = 1024; N = 1024; }
        else if (t < 3264) { tt = t - 2240; W = a->in[I_UP] + (size_t)layer * 1024 * 4096; Wt = (bf16_t*)(ws + OFF_WUP); K = 1024; N = 4096; }
        else { tt = t - 3264; W = a->in[I_DN] + (size_t)layer * 4096 * 1024; Wt = (bf16_t*)(ws + OFF_WDOWN); K = 4096; N = 1024; }
        const int ntn = N / 64; tconv_tile(W, Wt, K, N, tt / ntn, tt % ntn, sm);
    }
    const int gt = blockIdx.x * NTHR + otid(), GT = G * NTHR;
    {
        bf16_t* wg = (bf16_t*)(ws + OFF_WGATE);
        for (int idx = gt; idx < 1024 * 64; idx += GT) {
            const int n = idx >> 6, k0 = (idx & 63) * 8; const int pn = n >> 8, bj = (n >> 7) & 1, ch = pn * 128 + (n & 127), hd = ch >> 6, j = ch & 63;
            u32x4 w = (u32x4){0u, 0u, 0u, 0u};
            if ((k0 >> 6) == hd) { const float* src = a->in[bj ? I_GAW : I_GXW] + (size_t)layer * 8 * 64 * 64 + (size_t)hd * 4096 + (size_t)(k0 & 63) * 64 + j;
                w.x = cvt_pk_bf16(src[0], src[64]); w.y = cvt_pk_bf16(src[128], src[192]); w.z = cvt_pk_bf16(src[256], src[320]); w.w = cvt_pk_bf16(src[384], src[448]); }
            *(u32x4*)(wg + (size_t)n * 512 + k0) = w;
        }
    }
    const float* are = a->in[I_SAR] + layer * 2048; const float* aim = a->in[I_SAI] + layer * 2048; const float* ldt = a->in[I_SDT] + layer * 2048;
    const float* bre = a->in[I_SBR] + layer * 32768; const float* bim = a->in[I_SBI] + layer * 32768;
    const float* cre = a->in[I_SCR] + layer * 32768; const float* cim = a->in[I_SCI] + layer * 32768;
    {
        bf16_t* w1 = (bf16_t*)(ws + OFF_W1T);
        for (int idx = gt; idx < 32 * 128 * 32; idx += GT) {
            const int g = idx >> 12, n = (idx >> 5) & 127, k0 = (idx & 31) * 8, j = k0 >> 4, c0 = k0 & 15, p = n & 63, part = n >> 6, sp = g * 64 + p;
            float pr, pi, cr, ci; abar_pow(are, aim, ldt, sp, (float)(15 - j), pr, pi); ssm_coef(are, aim, ldt, sp, cr, ci);
            const float qr = pr * cr - pi * ci, qi = pr * ci + pi * cr;
            float o[8];
#pragma unroll
            for (int q = 0; q < 8; ++q) { const float br = bre[sp * 16 + c0 + q], bi = bim[sp * 16 + c0 + q]; o[q] = part ? (qr * bi + qi * br) : (qr * br - qi * bi); }
            u32x4 w; w.x = cvt_pk_bf16(o[0], o[1]); w.y = cvt_pk_bf16(o[2], o[3]); w.z = cvt_pk_bf16(o[4], o[5]); w.w = cvt_pk_bf16(o[6], o[7]);
            *(u32x4*)(w1 + ((size_t)(g * 128 + n) * 256 + k0)) = w;
        }
    }
    {
        bf16_t* wy = (bf16_t*)(ws + OFF_WYT);
        for (int idx = gt; idx < 32 * 256 * 16; idx += GT) {
            const int g = idx >> 12, n = (idx >> 4) & 255, k0 = (idx & 15) * 8, i = n >> 4, c = n & 15, part = k0 >> 6, p0 = k0 & 63;
            float o[8];
#pragma unroll
            for (int q = 0; q < 8; ++q) { const int p = p0 + q, sp = g * 64 + p; float pr, pi; abar_pow(are, aim, ldt, sp, (float)(i + 1), pr, pi);
                const float xr = cre[(g * 16 + c) * 64 + p], xi = cim[(g * 16 + c) * 64 + p];
                o[q] = part ? -(xr * pi + xi * pr) : (xr * pr - xi * pi); }
            u32x4 w; w.x = cvt_pk_bf16(o[0], o[1]); w.y = cvt_pk_bf16(o[2], o[3]); w.z = cvt_pk_bf16(o[4], o[5]); w.w = cvt_pk_bf16(o[6], o[7]);
            *(u32x4*)(wy + ((size_t)(g * 256 + n) * 384 + k0)) = w;
        }
        for (int idx = gt; idx < 32 * 16 * 256; idx += GT) {
            const int g = idx >> 12, d = (idx >> 8) & 15, c = (idx >> 4) & 15, c2 = idx & 15;
            float km = 0.f;
            for (int p = 0; p < 64; ++p) { const int sp = g * 64 + p; float pr, pi, cr, ci; abar_pow(are, aim, ldt, sp, (float)d, pr, pi); ssm_coef(are, aim, ldt, sp, cr, ci);
                const float br = bre[sp * 16 + c2], bi = bim[sp * 16 + c2];
                const float bbr = cr * br - ci * bi, bbi = cr * bi + ci * br;
                const float tr = pr * bbr - pi * bbi, ti = pr * bbi + pi * bbr;
                const float xr = cre[(g * 16 + c) * 64 + p], xi = cim[(g * 16 + c) * 64 + p];
                km += xr * tr - xi * ti; }
            const bf16_t kb = f2bf(km);
            for (int i = d; i < 16; ++i) wy[(size_t)(g * 256 + i * 16 + c) * 384 + 128 + (i - d) * 16 + c2] = kb;
            if (d > 0) for (int i = 0; i < 16 - d; ++i) wy[(size_t)(g * 256 + i * 16 + c) * 384 + 128 + (i + d) * 16 + c2] = (bf16_t)0;
        }
    }
}

__device__ __forceinline__ void prep_x(AP a) {
    bf16_t* xb = (bf16_t*)(a->ws + OFF_XB);
    const int gt = blockIdx.x * NTHR + otid(), GT = gridDim.x * NTHR;
    for (int idx = gt; idx < M * 128; idx += GT) {
        const size_t e = (size_t)idx * 8; const float* src = e < (size_t)MP * 1024 ? a->in[I_XP] + e : a->in[I_XS] + (e - (size_t)MP * 1024);
        const f32x4 v0 = *(const f32x4*)src, v1 = *(const f32x4*)(src + 4);
        *(u32x4*)(xb + e) = pack8(v0, v1);
    }
}

__device__ __forceinline__ void conv_phase(AP a, int layer) {
    unsigned char* ws = a->ws;
    const bf16_t* xa = (const bf16_t*)(ws + OFF_R); bf16_t* sb = (bf16_t*)(ws + OFF_R + S17);
    const bf16_t* sc = (const bf16_t*)(ws + OFF_R + 2 * S17); const bf16_t* sh = (const bf16_t*)(ws + OFF_R + 3 * S17);
    bf16_t* xac = (bf16_t*)(ws + OFF_XB);
    const float* caw = a->in[I_CAW] + layer * 4 * 512; const float* cab = a->in[I_CAB] + layer * 512; const float* cbw = a->in[I_CBW] + layer * 3 * 512;
    const int gt = blockIdx.x * NTHR + otid(), GT = gridDim.x * NTHR;
    for (int idx = gt; idx < (1024 + 128) * 64; idx += GT) {
        const int seg = idx >> 6, c0 = (idx & 63) * 8;
        const bool prompt = seg < 1024;
        int row0, nrows;
        float x0[8], x1[8], x2[8], u1[8], u2[8];
        if (prompt) { row0 = seg * 16; nrows = 16; const bool first = (seg & 127) == 0;
            if (first) {
#pragma unroll
                for (int j = 0; j < 8; ++j) { x0[j] = 0.f; x1[j] = 0.f; x2[j] = 0.f; u1[j] = 0.f; u2[j] = 0.f; }
            } else {
                unpack8(*(const u32x4*)(xa + (size_t)(row0 - 3) * 512 + c0), x0); unpack8(*(const u32x4*)(xa + (size_t)(row0 - 2) * 512 + c0), x1); unpack8(*(const u32x4*)(xa + (size_t)(row0 - 1) * 512 + c0), x2);
                float s1[8], s2[8];
                unpack8(*(const u32x4*)(sc + (size_t)(row0 - 2) * 512 + c0), u1); unpack8(*(const u32x4*)(sh + (size_t)(row0 - 2) * 512 + c0), s1);
                unpack8(*(const u32x4*)(sc + (size_t)(row0 - 1) * 512 + c0), u2); unpack8(*(const u32x4*)(sh + (size_t)(row0 - 1) * 512 + c0), s2);
#pragma unroll
                for (int j = 0; j < 8; ++j) { u1[j] *= s1[j]; u2[j] *= s2[j]; }
            }
        } else { const int b = seg - 1024; row0 = MP + b * 4; nrows = 4;
            const float* lc = a->in[I_SLC] + ((size_t)(layer * 128 + b) * 3) * 512 + c0; const float* scs = a->in[I_SSC] + ((size_t)(layer * 128 + b) * 2) * 512 + c0;
#pragma unroll
            for (int j = 0; j < 8; ++j) { x0[j] = lc[j]; x1[j] = lc[512 + j]; x2[j] = lc[1024 + j]; u1[j] = scs[j]; u2[j] = scs[512 + j]; }
        }
        float w0[8], w1[8], w2[8], w3[8], wb[8], v0[8], v1[8], v2[8];
#pragma unroll
        for (int j = 0; j < 8; ++j) { w0[j] = caw[c0 + j]; w1[j] = caw[512 + c0 + j]; w2[j] = caw[1024 + c0 + j]; w3[j] = caw[1536 + c0 + j]; wb[j] = cab[c0 + j];
            v0[j] = cbw[c0 + j]; v1[j] = cbw[512 + c0 + j]; v2[j] = cbw[1024 + c0 + j]; }
        for (int t = 0; t < nrows; ++t) {
            const size_t off = (size_t)(row0 + t) * 512 + c0;
            float xv[8], scv[8], shv[8], sbv[8];
            unpack8(*(const u32x4*)(xa + off), xv); unpack8(*(const u32x4*)(sc + off), scv); unpack8(*(const u32x4*)(sh + off), shv); unpack8(*(const u32x4*)(sb + off), sbv);
            f32x4 o0, o1, q0, q1;
#pragma unroll
            for (int j = 0; j < 8; ++j) {
                const float o = w0[j] * x0[j] + w1[j] * x1[j] + w2[j] * x2[j] + w3[j] * xv[j] + wb[j];
                const float uu = scv[j] * shv[j]; const float cu = v0[j] * u1[j] + v1[j] * u2[j] + v2[j] * uu; const float bi = sbv[j] * cu;
                if (j < 4) { o0[j] = o; q0[j] = bi; } else { o1[j - 4] = o; q1[j - 4] = bi; }
                x0[j] = x1[j]; x1[j] = x2[j]; x2[j] = xv[j]; u1[j] = u2[j]; u2[j] = uu;
            }
            *(u32x4*)(xac + off) = pack8(o0, o1);
            *(u32x4*)(sb + off) = pack8(q0, q1);
        }
        if (prompt) { if ((seg & 127) == 127) { const int b = seg >> 7;
                float* o1 = a->out + O_LCP + ((size_t)(layer * 8 + b) * 3) * 512 + c0; float* o2 = a->out + O_SCP + ((size_t)(layer * 8 + b) * 2) * 512 + c0;
#pragma unroll
                for (int j = 0; j < 8; ++j) { o1[j] = x0[j]; o1[512 + j] = x1[j]; o1[1024 + j] = x2[j]; o2[j] = u1[j]; o2[512 + j] = u2[j]; } }
        } else { const int b = seg - 1024;
            float* o1 = a->out + O_LCS + ((size_t)(layer * 128 + b) * 3) * 512 + c0; float* o2 = a->out + O_SCS + ((size_t)(layer * 128 + b) * 2) * 512 + c0;
#pragma unroll
            for (int j = 0; j < 8; ++j) { o1[j] = x0[j]; o1[512 + j] = x1[j]; o1[1024 + j] = x2[j]; o2[j] = u1[j]; o2[512 + j] = u2[j]; }
        }
    }
}

__device__ __forceinline__ void ssm_s_gemm(AP a) {
    const bf16_t* apack = (const bf16_t*)(a->ws + OFF_APACK); const bf16_t* w1 = (const bf16_t*)(a->ws + OFF_W1T); float* S = (float*)(a->ws + OFF_S);
    const int tid_ = otid(); const int lane = tid_ & 63, wv = blockIdx.x * 8 + (tid_ >> 6), NW = gridDim.x * 8;
    const int lr = lane & 15, kq = lane >> 4;
    for (int t = wv; t < 1024; t += NW) {
        const int g = t >> 5, rt = (t >> 1) & 15, ct = t & 1;
        f32x4 acc[4][4];
#pragma unroll
        for (int i = 0; i < 4; ++i)
#pragma unroll
            for (int j = 0; j < 4; ++j) acc[i][j] = (f32x4){0.f, 0.f, 0.f, 0.f};
        const bf16_t* ab = apack + ((size_t)(g * 1024 + rt * 64 + lr) * 384 + 128 + kq * 8);
        const bf16_t* bb = w1 + ((size_t)(g * 128 + ct * 64 + lr) * 256 + kq * 8);
#pragma unroll 2
        for (int ks = 0; ks < 8; ++ks) {
            bf16x8 af[4], bf[4];
#pragma unroll
            for (int i = 0; i < 4; ++i) { af[i] = *(const bf16x8*)(ab + (size_t)i * 16 * 384 + ks * 32); bf[i] = *(const bf16x8*)(bb + (size_t)i * 16 * 256 + ks * 32); }
#pragma unroll
            for (int i = 0; i < 4; ++i)
#pragma unroll
                for (int j = 0; j < 4; ++j) acc[i][j] = __builtin_amdgcn_mfma_f32_16x16x32_bf16(af[i], bf[j], acc[i][j], 0, 0, 0);
        }
#pragma unroll
        for (int i = 0; i < 4; ++i)
#pragma unroll
            for (int j = 0; j < 4; ++j)
#pragma unroll
                for (int q = 0; q < 4; ++q) S[(size_t)(g * 1024 + rt * 64 + i * 16 + kq * 4 + q) * 128 + ct * 64 + j * 16 + lr] = acc[i][j][q];
    }
}

__device__ __forceinline__ void ssm_carry(AP a, int layer, int widx) {
    bf16_t* apack = (bf16_t*)(a->ws + OFF_APACK); const float* S = (const float*)(a->ws + OFF_S);
    const int idx = widx * NTHR + otid();
    const int p = idx & 63, g = (idx >> 6) & 31, b = idx >> 11, sp = g * 64 + p;
    float ar, ai; abar_pow(a->in[I_SAR] + layer * 2048, a->in[I_SAI] + layer * 2048, a->in[I_SDT] + layer * 2048, sp, 16.0f, ar, ai);
    float hr = 0.f, hi = 0.f;
    const size_t rbase = (size_t)g * 1024 + b * 128;
#pragma unroll 8
    for (int c = 0; c < 128; ++c) {
        const float sr = S[(rbase + c) * 128 + p], si = S[(rbase + c) * 128 + 64 + p];
        apack[(rbase + c) * 384 + p] = f2bf(hr); apack[(rbase + c) * 384 + 64 + p] = f2bf(hi);
        const float nr = ar * hr - ai * hi + sr, ni = ar * hi + ai * hr + si; hr = nr; hi = ni;
    }
    a->out[O_SRP + (size_t)(layer * 8 + b) * 2048 + sp] = hr; a->out[O_SIP + (size_t)(layer * 8 + b) * 2048 + sp] = hi;
}

__device__ __forceinline__ void ssm_sample(AP a, int layer, int wv, int NW) {
    const bf16_t* uss = (const bf16_t*)(a->ws + OFF_USS); bf16_t* zc = (bf16_t*)(a->ws + OFF_XB);
    const float* are = a->in[I_SAR] + layer * 2048; const float* aim = a->in[I_SAI] + layer * 2048; const float* ldt = a->in[I_SDT] + layer * 2048;
    const float* bre = a->in[I_SBR] + layer * 32768; const float* bim = a->in[I_SBI] + layer * 32768;
    const float* cre = a->in[I_SCR] + layer * 32768; const float* cim = a->in[I_SCI] + layer * 32768; const float* dv = a->in[I_SD] + layer * 512;
    const int lane = otid() & 63;
    for (int t = wv; t < 128 * 32; t += NW) {
        const int b = t >> 5, g = t & 31, sp = g * 64 + lane;
        float ar, ai, cr, ci; abar_pow(are, aim, ldt, sp, 1.0f, ar, ai); ssm_coef(are, aim, ldt, sp, cr, ci);
        float bbr[16], bbi[16], xr[16], xi[16];
#pragma unroll
        for (int c = 0; c < 16; ++c) { const float br = bre[sp * 16 + c], bi = bim[sp * 16 + c]; bbr[c] = cr * br - ci * bi; bbi[c] = cr * bi + ci * br;
            xr[c] = cre[(g * 16 + c) * 64 + lane]; xi[c] = cim[(g * 16 + c) * 64 + lane]; }
        float hr = a->in[I_SSR][(size_t)(layer * 128 + b) * 2048 + sp], hi = a->in[I_SSI][(size_t)(layer * 128 + b) * 2048 + sp];
        const float dme = lane < 16 ? dv[g * 16 + lane] : 0.f;
        for (int tt = 0; tt < 4; ++tt) {
            const bf16_t* up = uss + (size_t)(b * 4 + tt) * 512 + g * 16;
            const u32x4 w0 = *(const u32x4*)up, w1 = *(const u32x4*)(up + 8);
            float u[16]; { float t0[8], t1[8]; unpack8(w0, t0); unpack8(w1, t1);
#pragma unroll
                for (int c = 0; c < 8; ++c) { u[c] = t0[c]; u[8 + c] = t1[c]; } }
            float br_ = 0.f, bi_ = 0.f;
#pragma unroll
            for (int c = 0; c < 16; ++c) { br_ += bbr[c] * u[c]; bi_ += bbi[c] * u[c]; }
            const float nr = ar * hr - ai * hi + br_, ni = ar * hi + ai * hr + bi_; hr = nr; hi = ni;
            float mine = 0.f, ume = 0.f;
#pragma unroll
            for (int c = 0; c < 16; ++c) { float y = xr[c] * hr - xi[c] * hi;
#pragma unroll
                for (int o = 32; o >= 1; o >>= 1) y += __shfl_xor(y, o);
                if (lane == c) { mine = y; ume = u[c]; } }
            if (lane < 16) zc[(size_t)(MP + b * 4 + tt) * 512 + g * 16 + lane] = f2bf(gelu_t(mine + dme * ume));
        }
        a->out[O_SRS + (size_t)(layer * 128 + b) * 2048 + sp] = hr; a->out[O_SIS + (size_t)(layer * 128 + b) * 2048 + sp] = hi;
    }
}

__device__ __forceinline__ void lru_local(AP a) {
    const float* av = (const float*)(a->ws + OFF_R + 2 * S17); const bf16_t* bx = (const bf16_t*)(a->ws + OFF_R); f32x2* car = (f32x2*)(a->ws + OFF_CAR);
    const int gt = blockIdx.x * NTHR + otid(), GT = gridDim.x * NTHR;
    for (int idx = gt; idx < 8 * 32 * 512; idx += GT) {
        const int c = idx & 511, sc = idx >> 9;
        const size_t base = (size_t)sc * 64 * 512 + c;
        float P = 1.f, h = 0.f;
#pragma unroll 8
        for (int t = 0; t < 64; ++t) { const float aa = av[base + (size_t)t * 512]; const float bb = bf2f(bx[base + (size_t)t * 512]); h = aa * h + bb; P *= aa; }
        car[idx] = (f32x2){P, h};
    }
}
__device__ __forceinline__ void lru_apply(AP a, int layer) {
    const float* av = (const float*)(a->ws + OFF_R + 2 * S17); bf16_t* bx = (bf16_t*)(a->ws + OFF_R); const f32x2* car = (const f32x2*)(a->ws + OFF_CAR);
    const bf16_t* ya = (const bf16_t*)(a->ws + OFF_YA);
    const int gt = blockIdx.x * NTHR + otid(), GT = gridDim.x * NTHR;
    for (int idx = gt; idx < 8 * 32 * 512 + 128 * 512; idx += GT) {
        float h; size_t base; int n; float* hout = nullptr;
        if (idx < 8 * 32 * 512) {
            const int c = idx & 511, sc = idx >> 9, seq = sc >> 5, chunk = sc & 31;
            h = 0.f;
            for (int k = 0; k < chunk; ++k) { const f32x2 ph = car[(seq * 32 + k) * 512 + c]; h = ph.x * h + ph.y; }
            base = (size_t)sc * 64 * 512 + c; n = 64;
            if (chunk == 31) hout = a->out + O_LHP + (size_t)(layer * 8 + seq) * 512 + c;
        } else {
            const int j = idx - 8 * 32 * 512, c = j & 511, b = j >> 9;
            h = a->in[I_SLH][(size_t)(layer * 128 + b) * 512 + c];
            base = (size_t)(MP + b * 4) * 512 + c; n = 4;
            hout = a->out + O_LHS + (size_t)(layer * 128 + b) * 512 + c;
        }
#pragma unroll 4
        for (int t = 0; t < n; ++t) { const size_t o = base + (size_t)t * 512; const float aa = av[o]; const float bb = bf2f(bx[o]); const float yy = bf2f(ya[o]);
            h = aa * h + bb; bx[o] = f2bf(h * gelu_t(yy)); }
        if (hout) *hout = h;
    }
}

__device__ __forceinline__ void ln_phase(const float* src, float* dst32, bf16_t* dst16, const float* gam, const float* bet) {
    const int tid_ = otid(); const int lane = tid_ & 63, wv = blockIdx.x * 8 + (tid_ >> 6), NW = gridDim.x * 8;
    for (int r = wv; r < M; r += NW) {
        const float* row = src + (size_t)r * 1024;
        f32x4 v[4]; float s = 0.f;
#pragma unroll
        for (int i = 0; i < 4; ++i) { v[i] = *(const f32x4*)(row + i * 256 + lane * 4); s += (v[i][0] + v[i][1]) + (v[i][2] + v[i][3]); }
#pragma unroll
        for (int o = 32; o >= 1; o >>= 1) s += __shfl_xor(s, o);
        const float mu = s * (1.0f / 1024.0f); float q = 0.f;
#pragma unroll
        for (int i = 0; i < 4; ++i) { const f32x4 d = v[i] - mu; q += (d[0] * d[0] + d[1] * d[1]) + (d[2] * d[2] + d[3] * d[3]); }
#pragma unroll
        for (int o = 32; o >= 1; o >>= 1) q += __shfl_xor(q, o);
        const float rs = rsqrtf(q * (1.0f / 1024.0f) + LN_EPS);
#pragma unroll
        for (int i = 0; i < 4; ++i) { const int col = i * 256 + lane * 4; const f32x4 gg = *(const f32x4*)(gam + col), bb = *(const f32x4*)(bet + col);
            const f32x4 y = (v[i] - mu) * rs * gg + bb;
            *(f32x4*)(dst32 + (size_t)r * 1024 + col) = y;
            u32x2 w; w.x = cvt_pk_bf16(y[0], y[1]); w.y = cvt_pk_bf16(y[2], y[3]);
            *(u32x2*)(dst16 + (size_t)r * 1024 + col) = w; }
    }
}

__global__ void __launch_bounds__(NTHR, 2) fwd_megakernel(Args a_unused) {
    extern __shared__ __attribute__((aligned(16))) unsigned char lds_raw[];
    cg::grid_group grid = cg::this_grid();
    LAS unsigned char* lds = (LAS unsigned char*)lds_raw;
    const int G = gridDim.x, bid = blockIdx.x;

    { const AP a = ld_args(); prep_layer(a, 0, (float*)lds_raw); prep_x(a); }
    grid.sync();

#pragma unroll 1
    for (int layer = 0; layer < 2; ++layer) {
        { const AP a = ld_args(); unsigned char* ws = a->ws;
          PG1 p; p.K = 1024; p.lda = 1024; p.ldb = 1024; p.G = G; p.c = bid; p.A = (const bf16_t*)(ws + OFF_XB); p.Bt = (const bf16_t*)(ws + OFF_WIN);
          p.xa = (bf16_t*)(ws + OFF_R); p.ya = (bf16_t*)(ws + OFF_YA); p.sb = (bf16_t*)(ws + OFF_R + S17); p.sc = (bf16_t*)(ws + OFF_R + 2 * S17); p.sh = (bf16_t*)(ws + OFF_R + 3 * S17);
          p.apack = (bf16_t*)(ws + OFF_APACK); p.uss = (bf16_t*)(ws + OFF_USS); p.gl8 = ws + OFF_GL8;
          gemm_phase(lds, p); }
        grid.sync();
        { const AP a = ld_args(); conv_phase(a, layer); }
        { const AP a = ld_args(); ssm_s_gemm(a); }
        grid.sync();
        if (bid >= G - 32) { const AP a = ld_args(); ssm_carry(a, layer, bid - (G - 32)); }
        { const AP a = ld_args(); unsigned char* ws = a->ws;
          PGate p; p.K = 512; p.lda = 512; p.ldb = 512; p.G = G; p.c = bid; p.A = (const bf16_t*)(ws + OFF_XB); p.Bt = (const bf16_t*)(ws + OFF_WGATE);
          p.gxb = a->in[I_GXB] + layer * 512; p.gab = a->in[I_GAB] + layer * 512; p.lam = a->in[I_LAM] + layer * 512;
          p.aout = (float*)(ws + OFF_R + 2 * S17); p.bxout = (bf16_t*)(ws + OFF_R);
          gemm_phase(lds, p); }
        grid.sync();
        { const AP a = ld_args(); unsigned char* ws = a->ws;
          PY p; p.K = 384; p.lda = 384; p.ldb = 384; p.G = G; p.c = bid; p.apack = (const bf16_t*)(ws + OFF_APACK); p.wyt = (const bf16_t*)(ws + OFF_WYT);
          p.dvec = a->in[I_SD] + layer * 512; p.zc = (bf16_t*)(ws + OFF_XB);
          gemm_phase(lds, p); }
        if (bid >= 128) { const AP a = ld_args(); ssm_sample(a, layer, (bid - 128) * 8 + (otid() >> 6), (G - 128) * 8); }
        { const AP a = ld_args(); lru_local(a); }
        grid.sync();
        { const AP a = ld_args(); unsigned char* ws = a->ws;
          PGlu p; p.K = 512; p.lda = 512; p.ldb = 512; p.G = G; p.c = bid; p.A = (const bf16_t*)(ws + OFF_XB); p.Bt = (const bf16_t*)(ws + OFF_WGLU);
          p.bias = a->in[I_GLB] + layer * 512; p.out = (bf16_t*)(ws + OFF_XB + S17);
          gemm_phase(lds, p); }
        { const AP a = ld_args(); lru_apply(a, layer); }
        grid.sync();
        { const AP a = ld_args(); unsigned char* ws = a->ws;
          PMerge p; p.K = 512; p.lda = 512; p.ldb = 512; p.G = G; p.c = bid; p.a0 = (const bf16_t*)(ws + OFF_R);
          p.wp = (const bf16_t*)(ws + OFF_WP); p.gl8 = ws + OFF_GL8; p.mb = (bf16_t*)(ws + OFF_MB);
          gemm_phase(lds, p); }
        grid.sync();
        { const AP a = ld_args(); unsigned char* ws = a->ws;
          PWout p; p.K = 1024; p.lda = 1024; p.ldb = 1024; p.G = G; p.c = bid; p.A = (const bf16_t*)(ws + OFF_MB); p.Bt = (const bf16_t*)(ws + OFF_WOUT);
          p.xp = layer == 0 ? a->in[I_XP] : a->out; p.xs = layer == 0 ? a->in[I_XS] : a->out + (size_t)MP * 1024; p.R = (float*)(ws + OFF_R);
          gemm_phase(lds, p); }
        grid.sync();
        { const AP a = ld_args(); unsigned char* ws = a->ws;
          ln_phase((const float*)(ws + OFF_R), (float*)(ws + OFF_R), (bf16_t*)(ws + OFF_XB), a->in[I_L1G] + layer * 1024, a->in[I_L1B] + layer * 1024); }
        grid.sync();
        { const AP a = ld_args(); unsigned char* ws = a->ws;
          PUp p; p.K = 1024; p.lda = 1024; p.ldb = 1024; p.G = G; p.c = bid; p.A = (const bf16_t*)(ws + OFF_XB); p.Bt = (const bf16_t*)(ws + OFF_WUP); p.h = (bf16_t*)(ws + OFF_H);
          gemm_phase(lds, p); }
        grid.sync();
        { const AP a = ld_args(); unsigned char* ws = a->ws;
          PDown p; p.K = 4096; p.lda = 4096; p.ldb = 4096; p.G = G; p.c = bid; p.A = (const bf16_t*)(ws + OFF_H); p.Bt = (const bf16_t*)(ws + OFF_WDOWN); p.R = (float*)(ws + OFF_R);
          gemm_phase(lds, p); }
        grid.sync();
        { const AP a = ld_args(); unsigned char* ws = a->ws;
          ln_phase((const float*)(ws + OFF_R), a->out, (bf16_t*)(ws + OFF_XB), a->in[I_L2G] + layer * 1024, a->in[I_L2B] + layer * 1024); }
        if (layer == 0) { __syncthreads(); { const AP a = ld_args(); prep_layer(a, 1, (float*)lds_raw); } grid.sync(); }
    }
}

extern "C" void kernel_launch(void* const* d_in, const int* in_sizes, int n_in, void* d_out, int out_size, void* d_ws, size_t ws_size, hipStream_t stream) {
    constexpr size_t kDynLds = STAGE_BYTES;
    static int grid_blocks = 0;
    if (!grid_blocks) {
        int dev = 0, cus = 0, per_cu = 0;
        hipGetDevice(&dev);
        hipDeviceGetAttribute(&cus, hipDeviceAttributeMultiprocessorCount, dev);
        hipFuncSetAttribute((const void*)fwd_megakernel, hipFuncAttributeMaxDynamicSharedMemorySize, (int)kDynLds);
        hipOccupancyMaxActiveBlocksPerMultiprocessor(&per_cu, (const void*)fwd_megakernel, NTHR, kDynLds);
        if (per_cu < 1) per_cu = 1;
        grid_blocks = cus * per_cu;
        if (grid_blocks > 256) grid_blocks = 256;
        if (ws_size < WS_END || n_in != 36) fprintf(stderr, "kernel_launch: unexpected ws_size %zu (need %zu) or n_in %d\n", ws_size, (size_t)WS_END, n_in);
    }
    Args a{};
    for (int i = 0; i < 36; ++i) a.in[i] = (const float*)d_in[i];
    a.out = (float*)d_out; a.ws = (unsigned char*)d_ws;
    void* args[] = {&a};
    hipError_t e = hipLaunchCooperativeKernel((const void*)fwd_megakernel, dim3(grid_blocks), dim3(NTHR), args, kDynLds, stream);
    if (e != hipSuccess) fprintf(stderr, "cooperative launch failed: %s (grid %d)\n", hipGetErrorString(e), grid_blocks);
}
```

```cpp
#include <hip/hip_runtime.h>
#include <hip/hip_cooperative_groups.h>
#include <cstdio>
namespace cg = cooperative_groups;
#define REP_GEMM 1
#define REP_ELEM 1
#define REP_SYNC 1
#define GSYNC() do { for (int _s = 0; _s < REP_SYNC; ++_s) { bar_n += (unsigned)G; gbar(bar_ctr, bar_n); } } while (0)

#define LAS __attribute__((address_space(3)))
typedef unsigned short bf16_t;
typedef short bf16x8 __attribute__((ext_vector_type(8)));
typedef float f32x4 __attribute__((ext_vector_type(4)));
typedef float f32x2 __attribute__((ext_vector_type(2)));
typedef unsigned u32x4 __attribute__((ext_vector_type(4)));
typedef unsigned u32x2 __attribute__((ext_vector_type(2)));

constexpr int MP = 16384, MS = 512, M = MP + MS, D = 1024, NIN = 6144, BW = 512, DFF = 4096;
constexpr int NTHR = 512;
constexpr float ALPHA = 1.41421356237f;
constexpr float LN_EPS = 1e-5f;

constexpr size_t S17 = (size_t)M * 512 * 2;
constexpr size_t OFF_WUP = 0;
constexpr size_t OFF_WDOWN = OFF_WUP + (size_t)4096 * 1024 * 2;
constexpr size_t OFF_R = OFF_WDOWN + (size_t)4096 * 1024 * 2;
constexpr size_t OFF_XB = OFF_R + 4 * S17;
constexpr size_t OFF_BIG = OFF_XB + 2 * S17;
constexpr size_t OFF_H = OFF_BIG;
constexpr size_t OFF_WIN = OFF_BIG;
constexpr size_t OFF_WP = OFF_WIN + (size_t)6144 * 1024 * 2;
constexpr size_t OFF_WGLU = OFF_WP + (size_t)3 * 1024 * 512 * 2;
constexpr size_t OFF_WOUT = OFF_WGLU + (size_t)512 * 512 * 2;
constexpr size_t OFF_WGATE = OFF_WOUT + (size_t)1024 * 1024 * 2;
constexpr size_t OFF_W1T = OFF_WGATE + (size_t)1024 * 512 * 2;
constexpr size_t OFF_WYT = OFF_W1T + (size_t)32 * 128 * 256 * 2;
constexpr size_t OFF_GL8 = OFF_WYT + (size_t)32 * 256 * 384 * 2;
constexpr size_t OFF_YA = OFF_GL8 + (size_t)M * 3072;
constexpr size_t OFF_APACK = OFF_YA + S17;
constexpr size_t OFF_S = OFF_APACK + (size_t)32 * 1024 * 384 * 2;
constexpr size_t OFF_MB = OFF_APACK;
constexpr size_t OFF_USS = OFF_S + (size_t)32 * 1024 * 128 * 4;
constexpr size_t OFF_CAR = OFF_USS + (size_t)512 * 512 * 2;
constexpr size_t OFF_BAR = OFF_CAR + (size_t)8 * 32 * 512 * 8;
constexpr size_t OFF_PD = OFF_BAR + 256;
constexpr size_t OFF_PW = OFF_GL8;
constexpr size_t PART_STRIDE = (size_t)MS * 1024;
constexpr size_t WS_END = OFF_PD + 3 * PART_STRIDE * 4;
static_assert(OFF_PD >= OFF_H + (size_t)M * 4096 * 2, "down partials must not overlap h");
static_assert(WS_END <= (size_t)268435456, "workspace map exceeds 256 MiB");
static_assert(OFF_MB + (size_t)M * 1024 * 2 <= OFF_USS, "m overlay");
static_assert(OFF_H + (size_t)M * 4096 * 2 <= (size_t)268435456, "h overlay");

constexpr size_t O_Y = 0;
constexpr size_t O_LCP = (size_t)M * 1024;
constexpr size_t O_LHP = O_LCP + 2 * 8 * 3 * 512;
constexpr size_t O_SCP = O_LHP + 2 * 8 * 512;
constexpr size_t O_SRP = O_SCP + 2 * 8 * 2 * 512;
constexpr size_t O_SIP = O_SRP + 2 * 8 * 2048;
constexpr size_t O_LCS = O_SIP + 2 * 8 * 2048;
constexpr size_t O_LHS = O_LCS + 2 * 128 * 3 * 512;
constexpr size_t O_SCS = O_LHS + 2 * 128 * 512;
constexpr size_t O_SRS = O_SCS + 2 * 128 * 2 * 512;
constexpr size_t O_SIS = O_SRS + 2 * 128 * 2048;

struct Args { const float* in[36]; float* out; unsigned char* ws; };
typedef const __attribute__((address_space(4))) Args* AP;
__device__ __forceinline__ AP ld_args() {
#if defined(__HIP_DEVICE_COMPILE__)
    auto p = __builtin_amdgcn_kernarg_segment_ptr();
    asm volatile("" : "+s"(p));
    return (AP)p;
#else
    return nullptr;
#endif
}
enum { I_XP = 0, I_XS, I_SLC, I_SLH, I_SSC, I_SSR, I_SSI, I_WIN, I_CAW, I_CAB, I_GXW, I_GXB, I_GAW, I_GAB, I_LAM, I_CBW, I_SAR, I_SAI, I_SDT,
       I_SBR, I_SBI, I_SCR, I_SCI, I_SD, I_GLW, I_GLB, I_PA, I_PB, I_PC, I_WO, I_L1G, I_L1B, I_UP, I_DN, I_L2G, I_L2B };

__device__ __forceinline__ unsigned cvt_pk_bf16(float lo, float hi) { unsigned r; asm volatile("v_cvt_pk_bf16_f32 %0, %1, %2" : "=v"(r) : "v"(lo), "v"(hi)); return r; }
__device__ __forceinline__ bf16_t f2bf(float f) { return (bf16_t)(cvt_pk_bf16(f, 0.f) & 0xffffu); }
__device__ __forceinline__ float bf2f(unsigned short b) { return __uint_as_float(((unsigned)b) << 16); }
__device__ __forceinline__ float bflo(unsigned w) { return __uint_as_float(w << 16); }
__device__ __forceinline__ float bfhi(unsigned w) { return __uint_as_float(w & 0xffff0000u); }
__device__ __forceinline__ float sigm(float x) { return 1.0f / (1.0f + __expf(-x)); }
__device__ __forceinline__ float gelu_t(float x) { const float u = 0.7978845608f * (x + 0.044715f * x * x * x); return x / (1.0f + __expf(-2.0f * u)); }
__device__ __forceinline__ u32x4 pack8(const f32x4 a, const f32x4 b) { u32x4 w; w.x = cvt_pk_bf16(a[0], a[1]); w.y = cvt_pk_bf16(a[2], a[3]); w.z = cvt_pk_bf16(b[0], b[1]); w.w = cvt_pk_bf16(b[2], b[3]); return w; }
__device__ __forceinline__ void unpack8(const u32x4 w, float (&f)[8]) { f[0] = bflo(w.x); f[1] = bfhi(w.x); f[2] = bflo(w.y); f[3] = bfhi(w.y); f[4] = bflo(w.z); f[5] = bfhi(w.z); f[6] = bflo(w.w); f[7] = bfhi(w.w); }

__device__ __forceinline__ int otid() { int t = threadIdx.x; asm volatile("" : "+v"(t)); return t; }

__device__ __forceinline__ void gbar(unsigned* ctr, unsigned target) {
    asm volatile("s_waitcnt vmcnt(0)" ::: "memory");
    __syncthreads();
    if (threadIdx.x == 0) {
        __builtin_amdgcn_fence(__ATOMIC_RELEASE, "agent");
        asm volatile("s_waitcnt vmcnt(0)" ::: "memory");
        __hip_atomic_fetch_add(ctr, 1u, __ATOMIC_RELAXED, __HIP_MEMORY_SCOPE_AGENT);
        while (__hip_atomic_load(ctr, __ATOMIC_RELAXED, __HIP_MEMORY_SCOPE_AGENT) < target) __builtin_amdgcn_s_sleep(1);
        __builtin_amdgcn_fence(__ATOMIC_ACQUIRE, "agent");
        asm volatile("s_waitcnt vmcnt(0)" ::: "memory");
    }
    __syncthreads();
}

constexpr int BM = 256, BK = 64, HALF = 128, HTB = HALF * BK * 2, STAGE_BYTES = 8 * HTB;
__device__ __forceinline__ int lds_byte(int r, int c) { const int st = (r >> 4) * 2 + (c >> 5), rr = r & 15, cc = c & 31, ob = rr * 64 + cc * 2; return st * 1024 + (ob ^ (((ob >> 9) & 1) << 5)); }
__device__ __forceinline__ void stage_rc(int b, int& R, int& C) { const int st = b / 1024, sb = b % 1024, swz = sb ^ (((sb >> 9) & 1) << 5); R = (st >> 1) * 16 + swz / 64; C = (st & 1) * 32 + (swz % 64) / 2; }
__device__ __forceinline__ int perm32(int rho) { const int n = rho >> 4, i = rho & 15; return 8 * (i >> 2) + 4 * n + (i & 3); }
struct Unit { int pm, pn, z; };
__device__ __forceinline__ void tile_map(int L, int nM, int nN, int& pm, int& pn) {
    const int nwg = nM * nN; int wgid = L;
    { const int q = nwg / 8, r = nwg % 8, xcd = wgid % 8, off = wgid / 8; wgid = (xcd < r ? xcd * (q + 1) : r * (q + 1) + (xcd - r) * q) + off; }
    const int nig = 8 * nN, gid = wgid / nig, fm = gid * 8, gsz = (nM - fm) < 8 ? (nM - fm) : 8;
    pm = fm + ((wgid % nig) % gsz); pn = (wgid % nig) / gsz;
}

template <class P>
__device__ __forceinline__ void gemm_phase(LAS unsigned char* lds, const P& p) {
    const int tid = otid(), wid = __builtin_amdgcn_readfirstlane(tid >> 6), lane = tid & 63, wr = wid >> 2, wc = wid & 3, fr = lane & 15, fq = lane >> 4;
    unsigned voffA[2], voffB[2];
#pragma unroll
    for (int i = 0; i < 2; ++i) { int R, C; stage_rc(tid * 16 + i * 8192, R, C); const int Rb = P::PERM ? ((R & ~31) + perm32(R & 31)) : R;
        voffA[i] = (unsigned)(R * p.lda + C) * 2u; voffB[i] = (unsigned)(Rb * p.ldb + C) * 2u; }
    const size_t kstep = (size_t)(BK * 2);
    const size_t hA = (size_t)HALF * p.lda * 2, hB = (size_t)HALF * p.ldb * 2;
    const unsigned ldsw = (unsigned)wid * 1024u;
    const int aoff = lds_byte(wr * 64 + fr, fq * 8), boff = lds_byte(wc * 32 + fr, fq * 8);
#define PG8_SA(b, h) (((b) * 2 + (h)) * HTB)
#define PG8_SB(b, h) ((4 + (b) * 2 + (h)) * HTB)
#define PG8_STAGE(bufoff, gbase, voff) do { _Pragma("unroll") for (int _i = 0; _i < 2; ++_i) \
        __builtin_amdgcn_global_load_lds((const unsigned*)((const char*)(gbase) + (voff)[_i]), (LAS unsigned*)(lds + (bufoff) + ldsw + _i * 8192), 16, 0, 0); } while (0)
#define PG8_LDA(dst, b, h) do { _Pragma("unroll") for (int m = 0; m < 4; ++m) _Pragma("unroll") for (int k = 0; k < 2; ++k) dst[m][k] = *(const LAS bf16x8*)(lds + PG8_SA(b, h) + aoff + m * 2048 + k * 1024); } while (0)
#define PG8_LDB(dst, b, h) do { _Pragma("unroll") for (int n = 0; n < 2; ++n) _Pragma("unroll") for (int k = 0; k < 2; ++k) dst[n][k] = *(const LAS bf16x8*)(lds + PG8_SB(b, h) + boff + n * 2048 + k * 1024); } while (0)
#define PG8_MMA(ai, bj, At, Bt) do { __builtin_amdgcn_s_setprio(1); _Pragma("unroll") for (int m = 0; m < 4; ++m) _Pragma("unroll") for (int n = 0; n < 2; ++n) _Pragma("unroll") for (int k = 0; k < 2; ++k) \
        acc[ai][bj][m][n] = __builtin_amdgcn_mfma_f32_16x16x32_bf16(Bt[n][k], At[m][k], acc[ai][bj][m][n], 0, 0, 0); __builtin_amdgcn_s_setprio(0); } while (0)
#define PG8_WAIT_V(n) asm volatile("s_waitcnt vmcnt(" #n ")" ::: "memory")
#define PG8_WAIT_L(n) asm volatile("s_waitcnt lgkmcnt(" #n ")" ::: "memory")
#define PG8_BAR __builtin_amdgcn_s_barrier()
#define PG8_SCHED __builtin_amdgcn_sched_barrier(0)
    Unit cur, nxt; int ui = 0;
    if (!p.next(0, cur)) return;
    f32x4 acc[2][2][4][2];
#pragma unroll
    for (int a = 0; a < 2; ++a)
#pragma unroll
        for (int b = 0; b < 2; ++b)
#pragma unroll
            for (int m = 0; m < 4; ++m)
#pragma unroll
                for (int n = 0; n < 2; ++n) acc[a][b][m][n] = (f32x4){0.f, 0.f, 0.f, 0.f};
    bf16x8 At[4][2], B0[2][2], B1[2][2];
    const char* cA = p.aptr(cur); const char* cB = p.bptr(cur);
    PG8_STAGE(PG8_SB(0, 0), cB, voffB); PG8_STAGE(PG8_SA(0, 0), cA, voffA); PG8_STAGE(PG8_SB(0, 1), cB + hB, voffB); PG8_STAGE(PG8_SA(0, 1), cA + hA, voffA);
    if (wr == 1) PG8_BAR;
    PG8_WAIT_V(4); PG8_BAR;
    PG8_STAGE(PG8_SB(1, 0), cB + kstep, voffB); PG8_STAGE(PG8_SA(1, 0), cA + kstep, voffA); PG8_STAGE(PG8_SB(1, 1), cB + hB + kstep, voffB);
    PG8_WAIT_V(6); PG8_BAR;
    for (;;) {
        const bool has_next = p.next(ui + 1, nxt);
        const int nt = p.nt(cur);
        const char* nA = has_next ? p.aptr(nxt) : cA; const char* nB = has_next ? p.bptr(nxt) : cB;
        for (int t = 0; t < nt; t += 2) {
            const bool last = (t == nt - 2);
            const char* a1 = cA + (size_t)(t + 1) * kstep;
            const char* a2 = last ? nA : cA + (size_t)(t + 2) * kstep; const char* b2 = last ? nB : cB + (size_t)(t + 2) * kstep;
            const char* a3 = a2 + kstep; const char* b3 = b2 + kstep;
            PG8_LDB(B0, 0, 0); PG8_SCHED; PG8_LDA(At, 0, 0); PG8_STAGE(PG8_SA(1, 1), a1 + hA, voffA);
            PG8_WAIT_L(8); PG8_BAR; PG8_WAIT_L(0); PG8_MMA(0, 0, At, B0); PG8_BAR; PG8_SCHED;
            PG8_LDB(B1, 0, 1); PG8_STAGE(PG8_SB(0, 0), b2, voffB);
            PG8_BAR; PG8_WAIT_L(0); PG8_MMA(0, 1, At, B1); PG8_BAR;
            PG8_LDA(At, 0, 1); PG8_STAGE(PG8_SA(0, 0), a2, voffA);
            PG8_BAR; PG8_WAIT_L(0); PG8_MMA(1, 0, At, B0); PG8_BAR; PG8_SCHED;
            PG8_STAGE(PG8_SB(0, 1), b2 + hB, voffB);
            PG8_WAIT_V(6); PG8_BAR; PG8_MMA(1, 1, At, B1); PG8_BAR;
            PG8_LDB(B0, 1, 0); PG8_SCHED; PG8_LDA(At, 1, 0); PG8_STAGE(PG8_SA(0, 1), a2 + hA, voffA);
            PG8_WAIT_L(8); PG8_BAR; PG8_WAIT_L(0); PG8_MMA(0, 0, At, B0); PG8_BAR; PG8_SCHED;
            PG8_LDB(B1, 1, 1); PG8_STAGE(PG8_SB(1, 0), b3, voffB);
            PG8_BAR; PG8_WAIT_L(0); PG8_MMA(0, 1, At, B1); PG8_BAR;
            PG8_LDA(At, 1, 1); PG8_STAGE(PG8_SA(1, 0), a3, voffA);
            PG8_BAR; PG8_WAIT_L(0); PG8_MMA(1, 0, At, B0); PG8_BAR; PG8_SCHED;
            PG8_STAGE(PG8_SB(1, 1), b3 + hB, voffB);
            PG8_WAIT_V(6); PG8_BAR; PG8_MMA(1, 1, At, B1); PG8_BAR;
        }
        const bool rst = p.epi(acc, cur, wr, wc, fr, fq);
        if (!has_next) break;
        if (rst) {
#pragma unroll
            for (int a = 0; a < 2; ++a)
#pragma unroll
                for (int b = 0; b < 2; ++b)
#pragma unroll
                    for (int m = 0; m < 4; ++m)
#pragma unroll
                        for (int n = 0; n < 2; ++n) acc[a][b][m][n] = (f32x4){0.f, 0.f, 0.f, 0.f};
        }
        cur = nxt; cA = nA; cB = nB; ++ui;
    }
    PG8_WAIT_V(0);
    if (wr == 0) PG8_BAR;
    PG8_BAR;
#undef PG8_SA
#undef PG8_SB
#undef PG8_STAGE
#undef PG8_LDA
#undef PG8_LDB
#undef PG8_MMA
#undef PG8_WAIT_V
#undef PG8_WAIT_L
#undef PG8_BAR
#undef PG8_SCHED
}
typedef f32x4 Acc[2][2][4][2];

struct PG1 {
    __device__ __forceinline__ int nt(const Unit&) const { return K / BK; }
    static constexpr bool PERM = true;
    int K, lda, ldb, G, c;
    const bf16_t* A; const bf16_t* Bt;
    bf16_t *xa, *ya, *sb, *sc, *sh, *apack, *uss; unsigned char* gl8;
    __device__ __forceinline__ bool next(int i, Unit& u) const { const long L = (long)i * G + c; if (L >= 66 * 24) return false; tile_map((int)L, 66, 24, u.pm, u.pn); u.z = 0; return true; }
    __device__ __forceinline__ const char* aptr(const Unit& u) const { return (const char*)A + (size_t)u.pm * 256 * 1024 * 2; }
    __device__ __forceinline__ const char* bptr(const Unit& u) const { return (const char*)Bt + (size_t)u.pn * 256 * 1024 * 2; }
    __device__ __forceinline__ bool epi(Acc& acc, const Unit& u, int wr, int wc, int fr, int fq) const {
        const int pn = u.pn;
        if (pn < 10) {
            const int b = pn >> 1; bf16_t* base = b == 0 ? xa : b == 1 ? ya : b == 2 ? sb : b == 3 ? sc : sh;
#pragma unroll
            for (int ai = 0; ai < 2; ++ai)
#pragma unroll
                for (int m = 0; m < 4; ++m) { const size_t r = (size_t)u.pm * 256 + ai * 128 + wr * 64 + m * 16 + fr;
#pragma unroll
                    for (int bj = 0; bj < 2; ++bj) { const int col = (pn & 1) * 256 + bj * 128 + wc * 32 + 8 * fq;
                        *(u32x4*)(base + r * 512 + col) = pack8(acc[ai][bj][m][0], acc[ai][bj][m][1]); } }
        } else if (pn < 12) {
#pragma unroll
            for (int ai = 0; ai < 2; ++ai)
#pragma unroll
                for (int m = 0; m < 4; ++m) { const int r = u.pm * 256 + ai * 128 + wr * 64 + m * 16 + fr;
#pragma unroll
                    for (int bj = 0; bj < 2; ++bj) { const int cc = (pn - 10) * 256 + bj * 128 + wc * 32 + 8 * fq;
                        bf16_t* dst = (u.pm < 64) ? apack + ((size_t)((cc >> 4) * 1024 + (r >> 4)) * 384 + 128 + (r & 15) * 16 + (cc & 15)) : uss + (size_t)(r - MP) * 512 + cc;
                        *(u32x4*)dst = pack8(acc[ai][bj][m][0], acc[ai][bj][m][1]); } }
        } else {
#pragma unroll
            for (int ai = 0; ai < 2; ++ai)
#pragma unroll
                for (int m = 0; m < 4; ++m) { const size_t r = (size_t)u.pm * 256 + ai * 128 + wr * 64 + m * 16 + fr;
#pragma unroll
                    for (int bj = 0; bj < 2; ++bj) { const int col = (pn - 12) * 256 + bj * 128 + wc * 32 + 8 * fq;
                        unsigned q[8];
#pragma unroll
                        for (int n = 0; n < 2; ++n)
#pragma unroll
                            for (int j = 0; j < 4; ++j) { int v = (int)(sigm(acc[ai][bj][m][n][j]) * 256.0f); v = v < 0 ? 0 : (v > 255 ? 255 : v); q[n * 4 + j] = (unsigned)v; }
                        u32x2 w; w.x = q[0] | (q[1] << 8) | (q[2] << 16) | (q[3] << 24); w.y = q[4] | (q[5] << 8) | (q[6] << 16) | (q[7] << 24);
                        *(u32x2*)(gl8 + r * 3072 + col) = w; } }
        }
        return true;
    }
};

struct PGate {
    __device__ __forceinline__ int nt(const Unit&) const { return K / BK; }
    static constexpr bool PERM = false;
    int K, lda, ldb, G, c;
    const bf16_t* A; const bf16_t* Bt;
    const float *gxb, *gab, *lam; float* aout; bf16_t* bxout;
    __device__ __forceinline__ bool next(int i, Unit& u) const { const long L = (long)i * G + c; if (L >= 66 * 4) return false; tile_map((int)L, 66, 4, u.pm, u.pn); u.z = 0; return true; }
    __device__ __forceinline__ const char* aptr(const Unit& u) const { return (const char*)A + (size_t)u.pm * 256 * 512 * 2; }
    __device__ __forceinline__ const char* bptr(const Unit& u) const { return (const char*)Bt + (size_t)u.pn * 256 * 512 * 2; }
    __device__ __forceinline__ bool epi(Acc& acc, const Unit& u, int wr, int wc, int fr, int fq) const {
#pragma unroll
        for (int n = 0; n < 2; ++n) {
            const int ch0 = u.pn * 128 + wc * 32 + n * 16 + 4 * fq;
            const f32x4 bx4 = *(const f32x4*)(gxb + ch0), ba4 = *(const f32x4*)(gab + ch0), lm4 = *(const f32x4*)(lam + ch0);
            f32x4 kk;
#pragma unroll
            for (int j = 0; j < 4; ++j) kk[j] = -8.0f * log1pf(expf(-lm4[j]));
#pragma unroll
            for (int ai = 0; ai < 2; ++ai)
#pragma unroll
                for (int m = 0; m < 4; ++m) { const size_t r = (size_t)u.pm * 256 + ai * 128 + wr * 64 + m * 16 + fr;
                    const u32x2 xw = *(const u32x2*)(A + r * 512 + ch0);
                    const float xc[4] = {bflo(xw.x), bfhi(xw.x), bflo(xw.y), bfhi(xw.y)};
                    f32x4 av; float bv[4];
#pragma unroll
                    for (int j = 0; j < 4; ++j) { const float gx = sigm(acc[ai][0][m][n][j] + bx4[j]), ga = sigm(acc[ai][1][m][n][j] + ba4[j]);
                        const float la = kk[j] * ga; av[j] = __expf(la); bv[j] = __builtin_amdgcn_sqrtf(fmaxf(1.0f - av[j] * av[j], 0.f)) * gx * xc[j]; }
                    *(f32x4*)(aout + r * 512 + ch0) = av;
                    u32x2 w; w.x = cvt_pk_bf16(bv[0], bv[1]); w.y = cvt_pk_bf16(bv[2], bv[3]);
                    *(u32x2*)(bxout + r * 512 + ch0) = w; }
        }
        return true;
    }
};

struct PY {
    __device__ __forceinline__ int nt(const Unit&) const { return K / BK; }
    static constexpr bool PERM = true;
    int K, lda, ldb, G, c;
    const bf16_t* apack; const bf16_t* wyt; const float* dvec; bf16_t* zc;
    __device__ __forceinline__ bool next(int i, Unit& u) const { const long L = (long)i * G + c; if (L >= 128) return false; u.pm = (int)L; u.pn = (int)L >> 2; u.z = 0; return true; }
    __device__ __forceinline__ const char* aptr(const Unit& u) const { return (const char*)apack + (size_t)u.pm * 256 * 384 * 2; }
    __device__ __forceinline__ const char* bptr(const Unit& u) const { return (const char*)wyt + (size_t)u.pn * 256 * 384 * 2; }
    __device__ __forceinline__ bool epi(Acc& acc, const Unit& u, int wr, int wc, int fr, int fq) const {
        const int g = u.pn;
#pragma unroll
        for (int bj = 0; bj < 2; ++bj) {
            const int n0 = bj * 128 + wc * 32 + 8 * fq, ti = n0 >> 4, c0 = n0 & 15;
            const f32x4 d0 = *(const f32x4*)(dvec + g * 16 + c0), d1 = *(const f32x4*)(dvec + g * 16 + c0 + 4);
#pragma unroll
            for (int ai = 0; ai < 2; ++ai)
#pragma unroll
                for (int m = 0; m < 4; ++m) { const int rr = (u.pm & 3) * 256 + ai * 128 + wr * 64 + m * 16 + fr;
                    const u32x4 uw = *(const u32x4*)(apack + ((size_t)(g * 1024 + rr) * 384 + 128 + n0));
                    float uf[8]; unpack8(uw, uf);
                    f32x4 y0, y1;
#pragma unroll
                    for (int j = 0; j < 4; ++j) { y0[j] = gelu_t(acc[ai][bj][m][0][j] + d0[j] * uf[j]); y1[j] = gelu_t(acc[ai][bj][m][1][j] + d1[j] * uf[4 + j]); }
                    const size_t tok = (size_t)(rr >> 7) * 2048 + (rr & 127) * 16 + ti;
                    *(u32x4*)(zc + tok * 512 + g * 16 + c0) = pack8(y0, y1); }
        }
        return true;
    }
};

struct PGlu {
    __device__ __forceinline__ int nt(const Unit&) const { return K / BK; }
    static constexpr bool PERM = true;
    int K, lda, ldb, G, c;
    const bf16_t* A; const bf16_t* Bt; const float* bias; bf16_t* out;
    __device__ __forceinline__ bool next(int i, Unit& u) const { const long L = (long)i * G + c; if (L >= 66 * 2) return false; tile_map((int)L, 66, 2, u.pm, u.pn); u.z = 0; return true; }
    __device__ __forceinline__ const char* aptr(const Unit& u) const { return (const char*)A + (size_t)u.pm * 256 * 512 * 2; }
    __device__ __forceinline__ const char* bptr(const Unit& u) const { return (const char*)Bt + (size_t)u.pn * 256 * 512 * 2; }
    __device__ __forceinline__ bool epi(Acc& acc, const Unit& u, int wr, int wc, int fr, int fq) const {
#pragma unroll
        for (int bj = 0; bj < 2; ++bj) {
            const int col = u.pn * 256 + bj * 128 + wc * 32 + 8 * fq;
            const f32x4 b0 = *(const f32x4*)(bias + col), b1 = *(const f32x4*)(bias + col + 4);
#pragma unroll
            for (int ai = 0; ai < 2; ++ai)
#pragma unroll
                for (int m = 0; m < 4; ++m) { const size_t r = (size_t)u.pm * 256 + ai * 128 + wr * 64 + m * 16 + fr;
                    const u32x4 zw = *(const u32x4*)(A + r * 512 + col); float zf[8]; unpack8(zw, zf);
                    f32x4 y0, y1;
#pragma unroll
                    for (int j = 0; j < 4; ++j) { y0[j] = zf[j] * sigm(acc[ai][bj][m][0][j] + b0[j]); y1[j] = zf[4 + j] * sigm(acc[ai][bj][m][1][j] + b1[j]); }
                    *(u32x4*)(out + r * 512 + col) = pack8(y0, y1); }
        }
        return true;
    }
};

struct PMerge {
    __device__ __forceinline__ int nt(const Unit&) const { return K / BK; }
    static constexpr bool PERM = true;
    int K, lda, ldb, G, c;
    const bf16_t* a0; const bf16_t* wp; const unsigned char* gl8; bf16_t* mb;
    __device__ __forceinline__ bool next(int i, Unit& u) const { const int ti = i / 3; const long L = (long)ti * G + c; if (L >= 66 * 4) return false; tile_map((int)L, 66, 4, u.pm, u.pn); u.z = i - ti * 3; return true; }
    __device__ __forceinline__ const char* aptr(const Unit& u) const { const size_t off = (u.z == 2) ? (OFF_XB + S17 - OFF_R) : (size_t)u.z * S17; return (const char*)a0 + off + (size_t)u.pm * 256 * 512 * 2; }
    __device__ __forceinline__ const char* bptr(const Unit& u) const { return (const char*)wp + ((size_t)u.z * 1024 + (size_t)u.pn * 256) * 512 * 2; }
    __device__ __forceinline__ bool epi(Acc& acc, const Unit& u, int wr, int wc, int fr, int fq) const {
        const int br = u.z;
#pragma unroll
        for (int ai = 0; ai < 2; ++ai)
#pragma unroll
            for (int m = 0; m < 4; ++m) { const size_t r = (size_t)u.pm * 256 + ai * 128 + wr * 64 + m * 16 + fr;
#pragma unroll
                for (int bj = 0; bj < 2; ++bj) { const int col = u.pn * 256 + bj * 128 + wc * 32 + 8 * fq;
                    const u32x2 qc = *(const u32x2*)(gl8 + r * 3072 + br * 1024 + col);
                    if (br < 2) {
                        const u32x2 qn = *(const u32x2*)(gl8 + r * 3072 + (br + 1) * 1024 + col);
#pragma unroll
                        for (int j = 0; j < 4; ++j) {
                            const float gc0 = (float)((qc.x >> (8 * j)) & 255u) + 0.5f, gn0 = (float)((qn.x >> (8 * j)) & 255u) + 0.5f;
                            const float gc1 = (float)((qc.y >> (8 * j)) & 255u) + 0.5f, gn1 = (float)((qn.y >> (8 * j)) & 255u) + 0.5f;
                            acc[ai][bj][m][0][j] *= gc0 / gn0; acc[ai][bj][m][1][j] *= gc1 / gn1; }
                    } else {
                        f32x4 y0, y1;
#pragma unroll
                        for (int j = 0; j < 4; ++j) {
                            y0[j] = acc[ai][bj][m][0][j] * (((float)((qc.x >> (8 * j)) & 255u) + 0.5f) * (1.0f / 256.0f));
                            y1[j] = acc[ai][bj][m][1][j] * (((float)((qc.y >> (8 * j)) & 255u) + 0.5f) * (1.0f / 256.0f)); }
                        *(u32x4*)(mb + r * 1024 + col) = pack8(y0, y1);
                    } } }
        return br == 2;
    }
};

struct PWout {
    static constexpr bool PERM = false;
    int K, lda, ldb, G, c;
    const bf16_t* A; const bf16_t* Bt; const float* xp; const float* xs; float* R; float* part;
    __device__ __forceinline__ int nt(const Unit& u) const { return u.z < 0 ? 16 : 4; }
    __device__ __forceinline__ bool next(int i, Unit& u) const {
        const int nP = c < 256 ? (256 - c + G - 1) / G : 0;
        if (i < nP) { tile_map(i * G + c, 64, 4, u.pm, u.pn); u.z = -1; return true; }
        const int j = (i - nP) * G + c; if (j >= 32) return false;
        u.pm = 64 + (j >> 4); u.pn = (j >> 2) & 3; u.z = j & 3; return true; }
    __device__ __forceinline__ const char* aptr(const Unit& u) const { return (const char*)A + (size_t)u.pm * 256 * 1024 * 2 + (u.z < 0 ? 0 : u.z * 512); }
    __device__ __forceinline__ const char* bptr(const Unit& u) const { return (const char*)Bt + (size_t)u.pn * 256 * 1024 * 2 + (u.z < 0 ? 0 : u.z * 512); }
    __device__ __forceinline__ bool epi(Acc& acc, const Unit& u, int wr, int wc, int fr, int fq) const {
        const float* xsrc = (u.pm < 64) ? xp + (size_t)u.pm * 256 * 1024 : xs + (size_t)(u.pm - 64) * 256 * 1024;
#pragma unroll
        for (int ai = 0; ai < 2; ++ai)
#pragma unroll
            for (int m = 0; m < 4; ++m) { const int rl = ai * 128 + wr * 64 + m * 16 + fr; const size_t r = (size_t)u.pm * 256 + rl;
#pragma unroll
                for (int bj = 0; bj < 2; ++bj)
#pragma unroll
                    for (int n = 0; n < 2; ++n) { const int col = u.pn * 256 + bj * 128 + wc * 32 + n * 16 + 4 * fq;
                        float* pp = R + r * 1024 + col;
                        if (u.z <= 0) { const f32x4 xv = *(const f32x4*)(xsrc + (size_t)rl * 1024 + col); *(f32x4*)pp = xv * ALPHA + acc[ai][bj][m][n]; }
                        else *(f32x4*)(part + (size_t)(u.z - 1) * PART_STRIDE + (r - MP) * 1024 + col) = acc[ai][bj][m][n]; } }
        return true;
    }
};

struct PUp {
    __device__ __forceinline__ int nt(const Unit&) const { return K / BK; }
    static constexpr bool PERM = true;
    int K, lda, ldb, G, c;
    const bf16_t* A; const bf16_t* Bt; bf16_t* h;
    __device__ __forceinline__ bool next(int i, Unit& u) const { const long L = (long)i * G + c; if (L >= 66 * 16) return false; tile_map((int)L, 66, 16, u.pm, u.pn); u.z = 0; return true; }
    __device__ __forceinline__ const char* aptr(const Unit& u) const { return (const char*)A + (size_t)u.pm * 256 * 1024 * 2; }
    __device__ __forceinline__ const char* bptr(const Unit& u) const { return (const char*)Bt + (size_t)u.pn * 256 * 1024 * 2; }
    __device__ __forceinline__ bool epi(Acc& acc, const Unit& u, int wr, int wc, int fr, int fq) const {
#pragma unroll
        for (int ai = 0; ai < 2; ++ai)
#pragma unroll
            for (int m = 0; m < 4; ++m) { const size_t r = (size_t)u.pm * 256 + ai * 128 + wr * 64 + m * 16 + fr;
#pragma unroll
                for (int bj = 0; bj < 2; ++bj) { const int col = u.pn * 256 + bj * 128 + wc * 32 + 8 * fq;
                    f32x4 y0, y1;
#pragma unroll
                    for (int j = 0; j < 4; ++j) { const float v0 = fmaxf(acc[ai][bj][m][0][j], 0.f), v1 = fmaxf(acc[ai][bj][m][1][j], 0.f); y0[j] = v0 * v0; y1[j] = v1 * v1; }
                    *(u32x4*)(h + r * 4096 + col) = pack8(y0, y1); } }
        return true;
    }
};

struct PDown {
    static constexpr bool PERM = false;
    int K, lda, ldb, G, c;
    const bf16_t* A; const bf16_t* Bt; float* R; float* part;
    __device__ __forceinline__ int nt(const Unit& u) const { return u.z < 0 ? 64 : 16; }
    __device__ __forceinline__ bool next(int i, Unit& u) const {
        const int nP = c < 256 ? (256 - c + G - 1) / G : 0;
        if (i < nP) { tile_map(i * G + c, 64, 4, u.pm, u.pn); u.z = -1; return true; }
        const int j = (i - nP) * G + c; if (j >= 32) return false;
        u.pm = 64 + (j >> 4); u.pn = (j >> 2) & 3; u.z = j & 3; return true; }
    __device__ __forceinline__ const char* aptr(const Unit& u) const { return (const char*)A + (size_t)u.pm * 256 * 4096 * 2 + (u.z < 0 ? 0 : u.z * 2048); }
    __device__ __forceinline__ const char* bptr(const Unit& u) const { return (const char*)Bt + (size_t)u.pn * 256 * 4096 * 2 + (u.z < 0 ? 0 : u.z * 2048); }
    __device__ __forceinline__ bool epi(Acc& acc, const Unit& u, int wr, int wc, int fr, int fq) const {
#pragma unroll
        for (int ai = 0; ai < 2; ++ai)
#pragma unroll
            for (int m = 0; m < 4; ++m) { const size_t r = (size_t)u.pm * 256 + ai * 128 + wr * 64 + m * 16 + fr;
#pragma unroll
                for (int bj = 0; bj < 2; ++bj)
#pragma unroll
                    for (int n = 0; n < 2; ++n) { const int col = u.pn * 256 + bj * 128 + wc * 32 + n * 16 + 4 * fq;
                        float* pp = R + r * 1024 + col;
                        if (u.z <= 0) { const f32x4 xv = *(const f32x4*)pp; *(f32x4*)pp = xv + acc[ai][bj][m][n]; }
                        else *(f32x4*)(part + (size_t)(u.z - 1) * PART_STRIDE + (r - MP) * 1024 + col) = acc[ai][bj][m][n]; } }
        return true;
    }
};

__device__ __forceinline__ void tconv_tile4(const float* W, bf16_t* Wt, int K, int N, int tk, int tn4, float* sm) {
    const int tid = otid(), r = tid >> 3, c8 = (tid & 7) * 8;
    const float* src = W + (size_t)(tk * 64 + r) * N + tn4 * 256 + c8;
    f32x4 v[4][2];
#pragma unroll
    for (int q = 0; q < 4; ++q) { v[q][0] = *(const f32x4*)(src + q * 64); v[q][1] = *(const f32x4*)(src + q * 64 + 4); }
#pragma unroll
    for (int q = 0; q < 4; ++q)
#pragma unroll
        for (int j = 0; j < 4; ++j) { sm[q * 4160 + r * 65 + c8 + j] = v[q][0][j]; sm[q * 4160 + r * 65 + c8 + 4 + j] = v[q][1][j]; }
    __syncthreads();
    const int n = tid >> 3, k8 = (tid & 7) * 8;
#pragma unroll
    for (int q = 0; q < 4; ++q) { const float* t = sm + q * 4160;
        u32x4 w;
        w.x = cvt_pk_bf16(t[(k8 + 0) * 65 + n], t[(k8 + 1) * 65 + n]); w.y = cvt_pk_bf16(t[(k8 + 2) * 65 + n], t[(k8 + 3) * 65 + n]);
        w.z = cvt_pk_bf16(t[(k8 + 4) * 65 + n], t[(k8 + 5) * 65 + n]); w.w = cvt_pk_bf16(t[(k8 + 6) * 65 + n], t[(k8 + 7) * 65 + n]);
        *(u32x4*)(Wt + (size_t)(tn4 * 256 + q * 64 + n) * K + tk * 64 + k8) = w; }
    __syncthreads();
}

__device__ __forceinline__ void abar_pow(const float* are, const float* aim, const float* ldt, int sp, float e, float& pr, float& pi) {
    const float step = expf(ldt[sp]); const float x = e * step * are[sp], th = e * step * aim[sp];
    float s, c; sincosf(th, &s, &c); const float mg = expf(x); pr = mg * c; pi = mg * s;
}
__device__ __forceinline__ void ssm_coef(const float* are, const float* aim, const float* ldt, int sp, float& cr, float& ci) {
    const float step = expf(ldt[sp]); const float ar = are[sp], ai = aim[sp];
    const float x = step * ar, th = step * ai;
    float s, c; sincosf(th, &s, &c); const float em1 = expm1f(x); const float sh = sinf(0.5f * th);
    const float nr = em1 * c - 2.0f * sh * sh, ni = (em1 + 1.0f) * s;
    const float den = ar * ar + ai * ai;
    cr = (nr * ar + ni * ai) / den; ci = (ni * ar - nr * ai) / den;
}

__device__ __forceinline__ void prep_layer(AP a, int layer, float* sm) {
    unsigned char* ws = a->ws;
    const int G = gridDim.x;
    for (int t = blockIdx.x; t < 1072; t += G) {
        const float* W; bf16_t* Wt; int K, N, tt;
        if (t < 384) { tt = t; W = a->in[I_WIN] + (size_t)layer * 1024 * 6144; Wt = (bf16_t*)(ws + OFF_WIN); K = 1024; N = 6144; }
        else if (t < 480) { const int j = (t - 384) / 32; tt = (t - 384) % 32; W = a->in[I_PA + j] + (size_t)layer * 512 * 1024; Wt = (bf16_t*)(ws + OFF_WP) + (size_t)j * 1024 * 512; K = 512; N = 1024; }
        else if (t < 496) { tt = t - 480; W = a->in[I_GLW] + (size_t)layer * 512 * 512; Wt = (bf16_t*)(ws + OFF_WGLU); K = 512; N = 512; }
        else if (t < 560) { tt = t - 496; W = a->in[I_WO] + (size_t)layer * 1024 * 1024; Wt = (bf16_t*)(ws + OFF_WOUT); K = 1024; N = 1024; }
        else if (t < 816) { tt = t - 560; W = a->in[I_UP] + (size_t)layer * 1024 * 4096; Wt = (bf16_t*)(ws + OFF_WUP); K = 1024; N = 4096; }
        else { tt = t - 816; W = a->in[I_DN] + (size_t)layer * 4096 * 1024; Wt = (bf16_t*)(ws + OFF_WDOWN); K = 4096; N = 1024; }
        const int ntn = N / 256; tconv_tile4(W, Wt, K, N, tt / ntn, tt % ntn, sm);
    }
    const int gt = blockIdx.x * NTHR + otid(), GT = G * NTHR;
    {
        bf16_t* wg = (bf16_t*)(ws + OFF_WGATE);
        for (int idx = gt; idx < 1024 * 64; idx += GT) {
            const int n = idx >> 6, k0 = (idx & 63) * 8; const int pn = n >> 8, bj = (n >> 7) & 1, ch = pn * 128 + (n & 127), hd = ch >> 6, j = ch & 63;
            u32x4 w = (u32x4){0u, 0u, 0u, 0u};
            if ((k0 >> 6) == hd) { const float* src = a->in[bj ? I_GAW : I_GXW] + (size_t)layer * 8 * 64 * 64 + (size_t)hd * 4096 + (size_t)(k0 & 63) * 64 + j;
                w.x = cvt_pk_bf16(src[0], src[64]); w.y = cvt_pk_bf16(src[128], src[192]); w.z = cvt_pk_bf16(src[256], src[320]); w.w = cvt_pk_bf16(src[384], src[448]); }
            *(u32x4*)(wg + (size_t)n * 512 + k0) = w;
        }
    }
    const float* are = a->in[I_SAR] + layer * 2048; const float* aim = a->in[I_SAI] + layer * 2048; const float* ldt = a->in[I_SDT] + layer * 2048;
    const float* bre = a->in[I_SBR] + layer * 32768; const float* bim = a->in[I_SBI] + layer * 32768;
    const float* cre = a->in[I_SCR] + layer * 32768; const float* cim = a->in[I_SCI] + layer * 32768;
    {
        bf16_t* w1 = (bf16_t*)(ws + OFF_W1T);
        for (int idx = gt; idx < 32 * 128 * 32; idx += GT) {
            const int g = idx >> 12, n = (idx >> 5) & 127, k0 = (idx & 31) * 8, j = k0 >> 4, c0 = k0 & 15, p = n & 63, part = n >> 6, sp = g * 64 + p;
            float pr, pi, cr, ci; abar_pow(are, aim, ldt, sp, (float)(15 - j), pr, pi); ssm_coef(are, aim, ldt, sp, cr, ci);
            const float qr = pr * cr - pi * ci, qi = pr * ci + pi * cr;
            float o[8];
#pragma unroll
            for (int q = 0; q < 8; ++q) { const float br = bre[sp * 16 + c0 + q], bi = bim[sp * 16 + c0 + q]; o[q] = part ? (qr * bi + qi * br) : (qr * br - qi * bi); }
            u32x4 w; w.x = cvt_pk_bf16(o[0], o[1]); w.y = cvt_pk_bf16(o[2], o[3]); w.z = cvt_pk_bf16(o[4], o[5]); w.w = cvt_pk_bf16(o[6], o[7]);
            *(u32x4*)(w1 + ((size_t)(g * 128 + n) * 256 + k0)) = w;
        }
    }
    {
        bf16_t* wy = (bf16_t*)(ws + OFF_WYT);
        for (int idx = gt; idx < 32 * 256 * 16; idx += GT) {
            const int g = idx >> 12, n = (idx >> 4) & 255, k0 = (idx & 15) * 8, i = n >> 4, c = n & 15, part = k0 >> 6, p0 = k0 & 63;
            float o[8];
#pragma unroll
            for (int q = 0; q < 8; ++q) { const int p = p0 + q, sp = g * 64 + p; float pr, pi; abar_pow(are, aim, ldt, sp, (float)(i + 1), pr, pi);
                const float xr = cre[(g * 16 + c) * 64 + p], xi = cim[(g * 16 + c) * 64 + p];
                o[q] = part ? -(xr * pi + xi * pr) : (xr * pr - xi * pi); }
            u32x4 w; w.x = cvt_pk_bf16(o[0], o[1]); w.y = cvt_pk_bf16(o[2], o[3]); w.z = cvt_pk_bf16(o[4], o[5]); w.w = cvt_pk_bf16(o[6], o[7]);
            *(u32x4*)(wy + ((size_t)(g * 256 + n) * 384 + k0)) = w;
        }
        for (int idx = gt; idx < 32 * 256 * 4; idx += GT) {
            const int pq = idx & 3, c2 = (idx >> 2) & 15, c = (idx >> 6) & 15, g = idx >> 10;
            float km[16];
#pragma unroll
            for (int d = 0; d < 16; ++d) km[d] = 0.f;
            for (int pp = 0; pp < 16; ++pp) { const int p = pq * 16 + pp, sp = g * 64 + p; float ar, ai, cr, ci; abar_pow(are, aim, ldt, sp, 1.0f, ar, ai); ssm_coef(are, aim, ldt, sp, cr, ci);
                const float br = bre[sp * 16 + c2], bi = bim[sp * 16 + c2];
                const float bbr = cr * br - ci * bi, bbi = cr * bi + ci * br;
                const float xr = cre[(g * 16 + c) * 64 + p], xi = cim[(g * 16 + c) * 64 + p];
                float tr = xr * bbr - xi * bbi, ti = xr * bbi + xi * bbr;
#pragma unroll
                for (int d = 0; d < 16; ++d) { km[d] += tr; const float nr = tr * ar - ti * ai, ni = tr * ai + ti * ar; tr = nr; ti = ni; } }
#pragma unroll
            for (int d = 0; d < 16; ++d) { km[d] += __shfl_xor(km[d], 1); km[d] += __shfl_xor(km[d], 2); }
#pragma unroll
            for (int d = 0; d < 16; ++d) if ((d & 3) == pq) { const bf16_t kb = f2bf(km[d]);
                for (int i = d; i < 16; ++i) wy[(size_t)(g * 256 + i * 16 + c) * 384 + 128 + (i - d) * 16 + c2] = kb;
                if (d > 0) for (int i = 0; i < 16 - d; ++i) wy[(size_t)(g * 256 + i * 16 + c) * 384 + 128 + (i + d) * 16 + c2] = (bf16_t)0; }
        }
    }
}

__device__ __forceinline__ void prep_x(AP a) {
    bf16_t* xb = (bf16_t*)(a->ws + OFF_XB);
    const int gt = blockIdx.x * NTHR + otid(), GT = gridDim.x * NTHR;
    for (int idx = gt; idx < M * 128; idx += GT) {
        const size_t e = (size_t)idx * 8; const float* src = e < (size_t)MP * 1024 ? a->in[I_XP] + e : a->in[I_XS] + (e - (size_t)MP * 1024);
        const f32x4 v0 = *(const f32x4*)src, v1 = *(const f32x4*)(src + 4);
        *(u32x4*)(xb + e) = pack8(v0, v1);
    }
}

__device__ __forceinline__ void conv_phase(AP a, int layer) {
    unsigned char* ws = a->ws;
    const bf16_t* xa = (const bf16_t*)(ws + OFF_R); bf16_t* sb = (bf16_t*)(ws + OFF_R + S17);
    const bf16_t* sc = (const bf16_t*)(ws + OFF_R + 2 * S17); const bf16_t* sh = (const bf16_t*)(ws + OFF_R + 3 * S17);
    bf16_t* xac = (bf16_t*)(ws + OFF_XB);
    const float* caw = a->in[I_CAW] + layer * 4 * 512; const float* cab = a->in[I_CAB] + layer * 512; const float* cbw = a->in[I_CBW] + layer * 3 * 512;
    const int gt = blockIdx.x * NTHR + otid(), GT = gridDim.x * NTHR;
    for (int idx = gt; idx < (2048 + 128) * 64; idx += GT) {
        const int seg = idx >> 6, c0 = (idx & 63) * 8;
        const bool prompt = seg < 2048;
        int row0, nrows;
        float x0[8], x1[8], x2[8], u1[8], u2[8];
        if (prompt) { row0 = seg * 8; nrows = 8; const bool first = (seg & 255) == 0;
            if (first) {
#pragma unroll
                for (int j = 0; j < 8; ++j) { x0[j] = 0.f; x1[j] = 0.f; x2[j] = 0.f; u1[j] = 0.f; u2[j] = 0.f; }
            } else {
                unpack8(*(const u32x4*)(xa + (size_t)(row0 - 3) * 512 + c0), x0); unpack8(*(const u32x4*)(xa + (size_t)(row0 - 2) * 512 + c0), x1); unpack8(*(const u32x4*)(xa + (size_t)(row0 - 1) * 512 + c0), x2);
                float s1[8], s2[8];
                unpack8(*(const u32x4*)(sc + (size_t)(row0 - 2) * 512 + c0), u1); unpack8(*(const u32x4*)(sh + (size_t)(row0 - 2) * 512 + c0), s1);
                unpack8(*(const u32x4*)(sc + (size_t)(row0 - 1) * 512 + c0), u2); unpack8(*(const u32x4*)(sh + (size_t)(row0 - 1) * 512 + c0), s2);
#pragma unroll
                for (int j = 0; j < 8; ++j) { u1[j] *= s1[j]; u2[j] *= s2[j]; }
            }
        } else { const int b = seg - 2048; row0 = MP + b * 4; nrows = 4;
            const float* lc = a->in[I_SLC] + ((size_t)(layer * 128 + b) * 3) * 512 + c0; const float* scs = a->in[I_SSC] + ((size_t)(layer * 128 + b) * 2) * 512 + c0;
#pragma unroll
            for (int j = 0; j < 8; ++j) { x0[j] = lc[j]; x1[j] = lc[512 + j]; x2[j] = lc[1024 + j]; u1[j] = scs[j]; u2[j] = scs[512 + j]; }
        }
        float w0[8], w1[8], w2[8], w3[8], wb[8], v0[8], v1[8], v2[8];
#pragma unroll
        for (int j = 0; j < 8; ++j) { w0[j] = caw[c0 + j]; w1[j] = caw[512 + c0 + j]; w2[j] = caw[1024 + c0 + j]; w3[j] = caw[1536 + c0 + j]; wb[j] = cab[c0 + j];
            v0[j] = cbw[c0 + j]; v1[j] = cbw[512 + c0 + j]; v2[j] = cbw[1024 + c0 + j]; }
        for (int t0 = 0; t0 < nrows; t0 += 2) {
            u32x4 lx[2], lc[2], lh[2], lb[2];
#pragma unroll
            for (int k = 0; k < 2; ++k) { const size_t off = (size_t)(row0 + t0 + k) * 512 + c0;
                lx[k] = *(const u32x4*)(xa + off); lc[k] = *(const u32x4*)(sc + off); lh[k] = *(const u32x4*)(sh + off); lb[k] = *(const u32x4*)(sb + off); }
#pragma unroll
            for (int k = 0; k < 2; ++k) { const size_t off = (size_t)(row0 + t0 + k) * 512 + c0;
                float xv[8], scv[8], shv[8], sbv[8];
                unpack8(lx[k], xv); unpack8(lc[k], scv); unpack8(lh[k], shv); unpack8(lb[k], sbv);
                f32x4 o0, o1, q0, q1;
#pragma unroll
                for (int j = 0; j < 8; ++j) {
                    const float o = w0[j] * x0[j] + w1[j] * x1[j] + w2[j] * x2[j] + w3[j] * xv[j] + wb[j];
                    const float uu = scv[j] * shv[j]; const float cu = v0[j] * u1[j] + v1[j] * u2[j] + v2[j] * uu; const float bi = sbv[j] * cu;
                    if (j < 4) { o0[j] = o; q0[j] = bi; } else { o1[j - 4] = o; q1[j - 4] = bi; }
                    x0[j] = x1[j]; x1[j] = x2[j]; x2[j] = xv[j]; u1[j] = u2[j]; u2[j] = uu;
                }
                *(u32x4*)(xac + off) = pack8(o0, o1);
                *(u32x4*)(sb + off) = pack8(q0, q1); }
        }
        if (prompt) { if ((seg & 255) == 255) { const int b = seg >> 8;
                float* o1 = a->out + O_LCP + ((size_t)(layer * 8 + b) * 3) * 512 + c0; float* o2 = a->out + O_SCP + ((size_t)(layer * 8 + b) * 2) * 512 + c0;
#pragma unroll
                for (int j = 0; j < 8; ++j) { o1[j] = x0[j]; o1[512 + j] = x1[j]; o1[1024 + j] = x2[j]; o2[j] = u1[j]; o2[512 + j] = u2[j]; } }
        } else { const int b = seg - 2048;
            float* o1 = a->out + O_LCS + ((size_t)(layer * 128 + b) * 3) * 512 + c0; float* o2 = a->out + O_SCS + ((size_t)(layer * 128 + b) * 2) * 512 + c0;
#pragma unroll
            for (int j = 0; j < 8; ++j) { o1[j] = x0[j]; o1[512 + j] = x1[j]; o1[1024 + j] = x2[j]; o2[j] = u1[j]; o2[512 + j] = u2[j]; }
        }
    }
}

__device__ __forceinline__ void ssm_s_gemm(AP a) {
    const bf16_t* apack = (const bf16_t*)(a->ws + OFF_APACK); const bf16_t* w1 = (const bf16_t*)(a->ws + OFF_W1T); float* S = (float*)(a->ws + OFF_S);
    const int tid_ = otid(); const int lane = tid_ & 63, wv = blockIdx.x * 8 + (tid_ >> 6), NW = gridDim.x * 8;
    const int lr = lane & 15, kq = lane >> 4;
    for (int t = wv; t < 1024; t += NW) {
        const int g = t >> 5, rt = (t >> 1) & 15, ct = t & 1;
        f32x4 acc[4][4];
#pragma unroll
        for (int i = 0; i < 4; ++i)
#pragma unroll
            for (int j = 0; j < 4; ++j) acc[i][j] = (f32x4){0.f, 0.f, 0.f, 0.f};
        const bf16_t* ab = apack + ((size_t)(g * 1024 + rt * 64 + lr) * 384 + 128 + kq * 8);
        const bf16_t* bb = w1 + ((size_t)(g * 128 + ct * 64 + lr) * 256 + kq * 8);
#pragma unroll 2
        for (int ks = 0; ks < 8; ++ks) {
            bf16x8 af[4], bf[4];
#pragma unroll
            for (int i = 0; i < 4; ++i) { af[i] = *(const bf16x8*)(ab + (size_t)i * 16 * 384 + ks * 32); bf[i] = *(const bf16x8*)(bb + (size_t)i * 16 * 256 + ks * 32); }
#pragma unroll
            for (int i = 0; i < 4; ++i)
#pragma unroll
                for (int j = 0; j < 4; ++j) acc[i][j] = __builtin_amdgcn_mfma_f32_16x16x32_bf16(af[i], bf[j], acc[i][j], 0, 0, 0);
        }
#pragma unroll
        for (int i = 0; i < 4; ++i)
#pragma unroll
            for (int j = 0; j < 4; ++j)
#pragma unroll
                for (int q = 0; q < 4; ++q) S[(size_t)(g * 1024 + rt * 64 + i * 16 + kq * 4 + q) * 128 + ct * 64 + j * 16 + lr] = acc[i][j][q];
    }
}

__device__ __forceinline__ void ssm_carry(AP a, int layer, float* sm) {
    bf16_t* apack = (bf16_t*)(a->ws + OFF_APACK); const float* S = (const float*)(a->ws + OFF_S);
    const int tid = otid(), p = tid & 63, seg = tid >> 6;
    for (int pair = blockIdx.x; pair < 256; pair += gridDim.x) {
        const int b = pair >> 5, g = pair & 31, sp = g * 64 + p;
        float ar, ai, Ar, Ai;
        abar_pow(a->in[I_SAR] + layer * 2048, a->in[I_SAI] + layer * 2048, a->in[I_SDT] + layer * 2048, sp, 16.0f, ar, ai);
        abar_pow(a->in[I_SAR] + layer * 2048, a->in[I_SAI] + layer * 2048, a->in[I_SDT] + layer * 2048, sp, 256.0f, Ar, Ai);
        const size_t rbase = (size_t)g * 1024 + b * 128 + seg * 16;
        float sr[16], si[16];
#pragma unroll
        for (int j = 0; j < 16; ++j) { sr[j] = S[(rbase + j) * 128 + p]; si[j] = S[(rbase + j) * 128 + 64 + p]; }
        float hr = 0.f, hi = 0.f;
#pragma unroll
        for (int j = 0; j < 16; ++j) { const float nr = ar * hr - ai * hi + sr[j], ni = ar * hi + ai * hr + si[j]; sr[j] = hr; si[j] = hi; hr = nr; hi = ni; }
        sm[seg * 128 + p] = hr; sm[seg * 128 + 64 + p] = hi;
        __syncthreads();
        float cr = 0.f, ci = 0.f;
        for (int s2 = 0; s2 < seg; ++s2) { const float er = sm[s2 * 128 + p], ei = sm[s2 * 128 + 64 + p]; const float nr = Ar * cr - Ai * ci + er, ni = Ar * ci + Ai * cr + ei; cr = nr; ci = ni; }
        if (seg == 7) { const float fr_ = Ar * cr - Ai * ci + hr, fi_ = Ar * ci + Ai * cr + hi;
            a->out[O_SRP + (size_t)(layer * 8 + b) * 2048 + sp] = fr_; a->out[O_SIP + (size_t)(layer * 8 + b) * 2048 + sp] = fi_; }
#pragma unroll
        for (int j = 0; j < 16; ++j) { apack[(rbase + j) * 384 + p] = f2bf(sr[j] + cr); apack[(rbase + j) * 384 + 64 + p] = f2bf(si[j] + ci);
            const float nr = ar * cr - ai * ci, ni = ar * ci + ai * cr; cr = nr; ci = ni; }
        __syncthreads();
    }
}

__device__ __forceinline__ void ssm_sample(AP a, int layer, int wv, int NW) {
    const bf16_t* uss = (const bf16_t*)(a->ws + OFF_USS); bf16_t* zc = (bf16_t*)(a->ws + OFF_XB);
    const float* are = a->in[I_SAR] + layer * 2048; const float* aim = a->in[I_SAI] + layer * 2048; const float* ldt = a->in[I_SDT] + layer * 2048;
    const float* bre = a->in[I_SBR] + layer * 32768; const float* bim = a->in[I_SBI] + layer * 32768;
    const float* cre = a->in[I_SCR] + layer * 32768; const float* cim = a->in[I_SCI] + layer * 32768; const float* dv = a->in[I_SD] + layer * 512;
    const int lane = otid() & 63;
    for (int t = wv; t < 128 * 32; t += NW) {
        const int b = t >> 5, g = t & 31, sp = g * 64 + lane;
        float ar, ai, cr, ci; abar_pow(are, aim, ldt, sp, 1.0f, ar, ai); ssm_coef(are, aim, ldt, sp, cr, ci);
        float bbr[16], bbi[16], xr[16], xi[16];
#pragma unroll
        for (int c = 0; c < 16; ++c) { const float br = bre[sp * 16 + c], bi = bim[sp * 16 + c]; bbr[c] = cr * br - ci * bi; bbi[c] = cr * bi + ci * br;
            xr[c] = cre[(g * 16 + c) * 64 + lane]; xi[c] = cim[(g * 16 + c) * 64 + lane]; }
        float hr = a->in[I_SSR][(size_t)(layer * 128 + b) * 2048 + sp], hi = a->in[I_SSI][(size_t)(layer * 128 + b) * 2048 + sp];
        const float dme = lane < 16 ? dv[g * 16 + lane] : 0.f;
        for (int tt = 0; tt < 4; ++tt) {
            const bf16_t* up = uss + (size_t)(b * 4 + tt) * 512 + g * 16;
            const u32x4 w0 = *(const u32x4*)up, w1 = *(const u32x4*)(up + 8);
            float u[16]; { float t0[8], t1[8]; unpack8(w0, t0); unpack8(w1, t1);
#pragma unroll
                for (int c = 0; c < 8; ++c) { u[c] = t0[c]; u[8 + c] = t1[c]; } }
            float br_ = 0.f, bi_ = 0.f;
#pragma unroll
            for (int c = 0; c < 16; ++c) { br_ += bbr[c] * u[c]; bi_ += bbi[c] * u[c]; }
            const float nr = ar * hr - ai * hi + br_, ni = ar * hi + ai * hr + bi_; hr = nr; hi = ni;
            float mine = 0.f, ume = 0.f;
#pragma unroll
            for (int c = 0; c < 16; ++c) { float y = xr[c] * hr - xi[c] * hi;
#pragma unroll
                for (int o = 32; o >= 1; o >>= 1) y += __shfl_xor(y, o);
                if (lane == c) { mine = y; ume = u[c]; } }
            if (lane < 16) zc[(size_t)(MP + b * 4 + tt) * 512 + g * 16 + lane] = f2bf(gelu_t(mine + dme * ume));
        }
        a->out[O_SRS + (size_t)(layer * 128 + b) * 2048 + sp] = hr; a->out[O_SIS + (size_t)(layer * 128 + b) * 2048 + sp] = hi;
    }
}

__device__ __forceinline__ void lru_local(AP a) {
    const float* av = (const float*)(a->ws + OFF_R + 2 * S17); const bf16_t* bx = (const bf16_t*)(a->ws + OFF_R); f32x2* car = (f32x2*)(a->ws + OFF_CAR);
    const int gt = blockIdx.x * NTHR + otid(), GT = gridDim.x * NTHR;
    for (int idx = gt; idx < 8 * 32 * 512; idx += GT) {
        const int c = idx & 511, sc = idx >> 9;
        const size_t base = (size_t)sc * 64 * 512 + c;
        float P = 1.f, h = 0.f;
        for (int t0 = 0; t0 < 64; t0 += 16) {
            float aa[16]; bf16_t bb[16];
#pragma unroll
            for (int j = 0; j < 16; ++j) { aa[j] = av[base + (size_t)(t0 + j) * 512]; bb[j] = bx[base + (size_t)(t0 + j) * 512]; }
#pragma unroll
            for (int j = 0; j < 16; ++j) { h = aa[j] * h + bf2f(bb[j]); P *= aa[j]; }
        }
        car[idx] = (f32x2){P, h};
    }
}
template <int B>
__device__ __forceinline__ float lru_run(const float* av, bf16_t* bx, const bf16_t* ya, size_t base, int n, float h) {
    for (int t0 = 0; t0 < n; t0 += B) {
        float aa[B]; bf16_t bb[B], yy[B];
#pragma unroll
        for (int j = 0; j < B; ++j) { const size_t o = base + (size_t)(t0 + j) * 512; aa[j] = av[o]; bb[j] = bx[o]; yy[j] = ya[o]; }
        bf16_t oo[B];
#pragma unroll
        for (int j = 0; j < B; ++j) { h = aa[j] * h + bf2f(bb[j]); oo[j] = f2bf(h * gelu_t(bf2f(yy[j]))); }
#pragma unroll
        for (int j = 0; j < B; ++j) bx[base + (size_t)(t0 + j) * 512] = oo[j];
    }
    return h;
}
__device__ __forceinline__ void lru_apply(AP a, int layer) {
    const float* av = (const float*)(a->ws + OFF_R + 2 * S17); bf16_t* bx = (bf16_t*)(a->ws + OFF_R); const f32x2* car = (const f32x2*)(a->ws + OFF_CAR);
    const bf16_t* ya = (const bf16_t*)(a->ws + OFF_YA);
    const int gt = blockIdx.x * NTHR + otid(), GT = gridDim.x * NTHR;
    for (int idx = gt; idx < 8 * 32 * 512 + 128 * 512; idx += GT) {
        if (idx < 8 * 32 * 512) {
            const int c = idx & 511, sc = idx >> 9, seq = sc >> 5, chunk = sc & 31;
            float h = 0.f;
            f32x2 ph[31];
#pragma unroll
            for (int k = 0; k < 31; ++k) ph[k] = car[(seq * 32 + (k < chunk ? k : 0)) * 512 + c];
#pragma unroll
            for (int k = 0; k < 31; ++k) if (k < chunk) h = ph[k].x * h + ph[k].y;
            h = lru_run<8>(av, bx, ya, (size_t)sc * 64 * 512 + c, 64, h);
            if (chunk == 31) a->out[O_LHP + (size_t)(layer * 8 + seq) * 512 + c] = h;
        } else {
            const int j = idx - 8 * 32 * 512, c = j & 511, b = j >> 9;
            float h = a->in[I_SLH][(size_t)(layer * 128 + b) * 512 + c];
            h = lru_run<4>(av, bx, ya, (size_t)(MP + b * 4) * 512 + c, 4, h);
            a->out[O_LHS + (size_t)(layer * 128 + b) * 512 + c] = h;
        }
    }
}

__device__ __forceinline__ void ln_phase(const float* src, float* dst32, bf16_t* dst16, const float* gam, const float* bet, const float scale32, const float* part) {
    const int tid_ = otid(); const int lane = tid_ & 63, wv = blockIdx.x * 8 + (tid_ >> 6), NW = gridDim.x * 8;
    for (int r0 = wv; r0 < M; r0 += 3 * NW) {
        f32x4 v[3][4];
#pragma unroll
        for (int k = 0; k < 3; ++k) { const int r = r0 + k * NW; const float* row = src + (size_t)(r < M ? r : r0) * 1024;
#pragma unroll
            for (int i = 0; i < 4; ++i) v[k][i] = *(const f32x4*)(row + i * 256 + lane * 4);
            if (r >= MP && r < M) {
#pragma unroll
                for (int q = 0; q < 3; ++q)
#pragma unroll
                    for (int i = 0; i < 4; ++i) v[k][i] += *(const f32x4*)(part + (size_t)q * PART_STRIDE + (size_t)(r - MP) * 1024 + i * 256 + lane * 4); } }
#pragma unroll
        for (int k = 0; k < 3; ++k) { const int r = r0 + k * NW;
            float s = 0.f;
#pragma unroll
            for (int i = 0; i < 4; ++i) s += (v[k][i][0] + v[k][i][1]) + (v[k][i][2] + v[k][i][3]);
#pragma unroll
            for (int o = 32; o >= 1; o >>= 1) s += __shfl_xor(s, o);
            const float mu = s * (1.0f / 1024.0f); float q = 0.f;
#pragma unroll
            for (int i = 0; i < 4; ++i) { const f32x4 d = v[k][i] - mu; q += (d[0] * d[0] + d[1] * d[1]) + (d[2] * d[2] + d[3] * d[3]); }
#pragma unroll
            for (int o = 32; o >= 1; o >>= 1) q += __shfl_xor(q, o);
            const float rs = rsqrtf(q * (1.0f / 1024.0f) + LN_EPS);
            if (r < M) {
#pragma unroll
                for (int i = 0; i < 4; ++i) { const int col = i * 256 + lane * 4; const f32x4 gg = *(const f32x4*)(gam + col), bb = *(const f32x4*)(bet + col);
                    const f32x4 y = (v[k][i] - mu) * rs * gg + bb;
                    *(f32x4*)(dst32 + (size_t)r * 1024 + col) = y * scale32;
                    u32x2 w; w.x = cvt_pk_bf16(y[0], y[1]); w.y = cvt_pk_bf16(y[2], y[3]);
                    *(u32x2*)(dst16 + (size_t)r * 1024 + col) = w; }
            }
        }
    }
}

__global__ void __launch_bounds__(NTHR, 2) fwd_megakernel(Args a_unused) {
    extern __shared__ __attribute__((aligned(16))) unsigned char lds_raw[];
    cg::grid_group grid = cg::this_grid();
    LAS unsigned char* lds = (LAS unsigned char*)lds_raw;
    const int G = gridDim.x, bid = blockIdx.x;

    for (int rep = 0; rep < REP_ELEM; ++rep) { const AP a = ld_args(); prep_layer(a, 0, (float*)lds_raw); prep_x(a); }
    grid.sync();
    unsigned bar_n = 0; unsigned* bar_ctr; { const AP a = ld_args(); bar_ctr = (unsigned*)(a->ws + OFF_BAR); }

#pragma unroll 1
    for (int layer = 0; layer < 2; ++layer) {
        { const AP a = ld_args(); unsigned char* ws = a->ws;
          PG1 p; p.K = 1024; p.lda = 1024; p.ldb = 1024; p.G = G; p.c = bid; p.A = (const bf16_t*)(ws + OFF_XB); p.Bt = (const bf16_t*)(ws + OFF_WIN);
          p.xa = (bf16_t*)(ws + OFF_R); p.ya = (bf16_t*)(ws + OFF_YA); p.sb = (bf16_t*)(ws + OFF_R + S17); p.sc = (bf16_t*)(ws + OFF_R + 2 * S17); p.sh = (bf16_t*)(ws + OFF_R + 3 * S17);
          p.apack = (bf16_t*)(ws + OFF_APACK); p.uss = (bf16_t*)(ws + OFF_USS); p.gl8 = ws + OFF_GL8;
          for (int rep = 0; rep < REP_GEMM; ++rep) gemm_phase(lds, p); }
        GSYNC();
        { const AP a = ld_args(); conv_phase(a, layer); }
        for (int rep = 0; rep < REP_ELEM; ++rep) { const AP a = ld_args(); ssm_s_gemm(a); }
        GSYNC();
        for (int rep = 0; rep < REP_ELEM; ++rep) { const AP a = ld_args(); ssm_carry(a, layer, (float*)lds_raw); }
        { const AP a = ld_args(); unsigned char* ws = a->ws;
          PGate p; p.K = 512; p.lda = 512; p.ldb = 512; p.G = G; p.c = bid; p.A = (const bf16_t*)(ws + OFF_XB); p.Bt = (const bf16_t*)(ws + OFF_WGATE);
          p.gxb = a->in[I_GXB] + layer * 512; p.gab = a->in[I_GAB] + layer * 512; p.lam = a->in[I_LAM] + layer * 512;
          p.aout = (float*)(ws + OFF_R + 2 * S17); p.bxout = (bf16_t*)(ws + OFF_R);
          for (int rep = 0; rep < REP_GEMM; ++rep) gemm_phase(lds, p); }
        GSYNC();
        { const AP a = ld_args(); unsigned char* ws = a->ws;
          PY p; p.K = 384; p.lda = 384; p.ldb = 384; p.G = G; p.c = bid; p.apack = (const bf16_t*)(ws + OFF_APACK); p.wyt = (const bf16_t*)(ws + OFF_WYT);
          p.dvec = a->in[I_SD] + layer * 512; p.zc = (bf16_t*)(ws + OFF_XB);
          for (int rep = 0; rep < REP_GEMM; ++rep) gemm_phase(lds, p); }
        for (int rep = 0; rep < REP_ELEM; ++rep) { const AP a = ld_args(); ssm_sample(a, layer, (G - 1 - bid) * 8 + (otid() >> 6), G * 8); }
        for (int rep = 0; rep < REP_ELEM; ++rep) { const AP a = ld_args(); lru_local(a); }
        GSYNC();
        { const AP a = ld_args(); unsigned char* ws = a->ws;
          PGlu p; p.K = 512; p.lda = 512; p.ldb = 512; p.G = G; p.c = bid; p.A = (const bf16_t*)(ws + OFF_XB); p.Bt = (const bf16_t*)(ws + OFF_WGLU);
          p.bias = a->in[I_GLB] + layer * 512; p.out = (bf16_t*)(ws + OFF_XB + S17);
          for (int rep = 0; rep < REP_GEMM; ++rep) gemm_phase(lds, p); }
        { const AP a = ld_args(); lru_apply(a, layer); }
        GSYNC();
        { const AP a = ld_args(); unsigned char* ws = a->ws;
          PMerge p; p.K = 512; p.lda = 512; p.ldb = 512; p.G = G; p.c = bid; p.a0 = (const bf16_t*)(ws + OFF_R);
          p.wp = (const bf16_t*)(ws + OFF_WP); p.gl8 = ws + OFF_GL8; p.mb = (bf16_t*)(ws + OFF_MB);
          for (int rep = 0; rep < REP_GEMM; ++rep) gemm_phase(lds, p); }
        GSYNC();
        { const AP a = ld_args(); unsigned char* ws = a->ws;
          PWout p; p.K = 1024; p.lda = 1024; p.ldb = 1024; p.G = G; p.c = bid; p.A = (const bf16_t*)(ws + OFF_MB); p.Bt = (const bf16_t*)(ws + OFF_WOUT);
          p.xp = layer == 0 ? a->in[I_XP] : a->out; p.xs = layer == 0 ? a->in[I_XS] : a->out + (size_t)MP * 1024; p.R = (float*)(ws + OFF_R); p.part = (float*)(ws + OFF_PW);
          gemm_phase(lds, p); }
        GSYNC();
        { const AP a = ld_args(); unsigned char* ws = a->ws;
          ln_phase((const float*)(ws + OFF_R), (float*)(ws + OFF_R), (bf16_t*)(ws + OFF_XB), a->in[I_L1G] + layer * 1024, a->in[I_L1B] + layer * 1024, ALPHA, (const float*)(ws + OFF_PW)); }
        GSYNC();
        { const AP a = ld_args(); unsigned char* ws = a->ws;
          PUp p; p.K = 1024; p.lda = 1024; p.ldb = 1024; p.G = G; p.c = bid; p.A = (const bf16_t*)(ws + OFF_XB); p.Bt = (const bf16_t*)(ws + OFF_WUP); p.h = (bf16_t*)(ws + OFF_H);
          for (int rep = 0; rep < REP_GEMM; ++rep) gemm_phase(lds, p); }
        GSYNC();
        { const AP a = ld_args(); unsigned char* ws = a->ws;
          PDown p; p.K = 4096; p.lda = 4096; p.ldb = 4096; p.G = G; p.c = bid; p.A = (const bf16_t*)(ws + OFF_H); p.Bt = (const bf16_t*)(ws + OFF_WDOWN); p.R = (float*)(ws + OFF_R); p.part = (float*)(ws + OFF_PD);
          gemm_phase(lds, p); }
        GSYNC();
        for (int rep = 0; rep < REP_ELEM; ++rep) { const AP a = ld_args(); unsigned char* ws = a->ws;
          ln_phase((const float*)(ws + OFF_R), a->out, (bf16_t*)(ws + OFF_XB), a->in[I_L2G] + layer * 1024, a->in[I_L2B] + layer * 1024, 1.0f, (const float*)(ws + OFF_PD)); }
        if (layer == 0) { __syncthreads(); for (int rep = 0; rep < REP_ELEM; ++rep) { const AP a = ld_args(); prep_layer(a, 1, (float*)lds_raw); } GSYNC(); }
    }
}

extern "C" void kernel_launch(void* const* d_in, const int* in_sizes, int n_in, void* d_out, int out_size, void* d_ws, size_t ws_size, hipStream_t stream) {
    constexpr size_t kDynLds = STAGE_BYTES;
    static int grid_blocks = 0;
    if (!grid_blocks) {
        int dev = 0, cus = 0, per_cu = 0;
        hipGetDevice(&dev);
        hipDeviceGetAttribute(&cus, hipDeviceAttributeMultiprocessorCount, dev);
        hipFuncSetAttribute((const void*)fwd_megakernel, hipFuncAttributeMaxDynamicSharedMemorySize, (int)kDynLds);
        hipOccupancyMaxActiveBlocksPerMultiprocessor(&per_cu, (const void*)fwd_megakernel, NTHR, kDynLds);
        if (per_cu < 1) per_cu = 1;
        grid_blocks = cus * per_cu;
        if (grid_blocks > 256) grid_blocks = 256;
        if (ws_size < WS_END || n_in != 36) fprintf(stderr, "kernel_launch: unexpected ws_size %zu (need %zu) or n_in %d\n", ws_size, (size_t)WS_END, n_in);
    }
    (void)hipMemsetAsync((char*)d_ws + OFF_BAR, 0, 256, stream);
    Args a{};
    for (int i = 0; i < 36; ++i) a.in[i] = (const float*)d_in[i];
    a.out = (float*)d_out; a.ws = (unsigned char*)d_ws;
    void* args[] = {&a};
    hipError_t e = hipLaunchCooperativeKernel((const void*)fwd_megakernel, dim3(grid_blocks), dim3(NTHR), args, kDynLds, stream);
    if (e != hipSuccess) fprintf(stderr, "cooperative launch failed: %s (grid %d)\n", hipGetErrorString(e), grid_blocks);
}
```

```cpp
#include <hip/hip_runtime.h>
#include <hip/hip_cooperative_groups.h>
#include <cstdio>
namespace cg = cooperative_groups;
#define REP_GEMM 1
#define REP_G1 REP_GEMM
#define REP_GATE REP_GEMM
#define REP_Y REP_GEMM
#define REP_GLU REP_GEMM
#define REP_MERGE REP_GEMM
#define REP_UP REP_GEMM
#define REP_ELEM 1
#define REP_PREP REP_ELEM
#define REP_SG REP_ELEM
#define REP_CARRY REP_ELEM
#define REP_SAMPLE REP_ELEM
#define REP_LOCAL REP_ELEM
#define REP_LN2 REP_ELEM
#define DRY_CONV 0
#define DRY_APPLY 0
#define DRY_LN1 0
#define REP_SYNC 1
#define GSYNC() do { for (int _s = 0; _s < REP_SYNC; ++_s) { bar_n += (unsigned)G; gbar(bar_ctr, bar_n, wv_); } } while (0)

#define LAS __attribute__((address_space(3)))
typedef unsigned short bf16_t;
typedef short bf16x8 __attribute__((ext_vector_type(8)));
typedef float f32x4 __attribute__((ext_vector_type(4)));
typedef float f32x2 __attribute__((ext_vector_type(2)));
typedef unsigned u32x4 __attribute__((ext_vector_type(4)));
typedef unsigned u32x2 __attribute__((ext_vector_type(2)));

constexpr int MP = 16384, MS = 512, M = MP + MS, D = 1024, NIN = 6144, BW = 512, DFF = 4096;
constexpr int NTHR = 512;
constexpr float ALPHA = 1.41421356237f;
constexpr float LN_EPS = 1e-5f;

constexpr size_t S17 = (size_t)M * 512 * 2;
constexpr size_t OFF_WUP = 0;
constexpr size_t OFF_WDOWN = OFF_WUP + (size_t)4096 * 1024 * 2;
constexpr size_t OFF_R = OFF_WDOWN + (size_t)4096 * 1024 * 2;
constexpr size_t OFF_XB = OFF_R + 4 * S17;
constexpr size_t OFF_BIG = OFF_XB + 2 * S17;
constexpr size_t OFF_H = OFF_BIG;
constexpr size_t OFF_WIN = OFF_BIG;
constexpr size_t OFF_WP = OFF_WIN + (size_t)6144 * 1024 * 2;
constexpr size_t OFF_WGLU = OFF_WP + (size_t)3 * 1024 * 512 * 2;
constexpr size_t OFF_WOUT = OFF_WGLU + (size_t)512 * 512 * 2;
constexpr size_t OFF_WGATE = OFF_WOUT + (size_t)1024 * 1024 * 2;
constexpr size_t OFF_W1T = OFF_WGATE + (size_t)1024 * 512 * 2;
constexpr size_t OFF_WYT = OFF_W1T + (size_t)32 * 128 * 256 * 2;
constexpr size_t OFF_GL8 = OFF_WYT + (size_t)32 * 256 * 384 * 2;
constexpr size_t OFF_YA = OFF_GL8 + (size_t)M * 3072;
constexpr size_t OFF_APACK = OFF_YA + S17;
constexpr size_t OFF_S = OFF_APACK + (size_t)32 * 1024 * 384 * 2;
constexpr size_t OFF_MB = OFF_APACK;
constexpr size_t OFF_USS = OFF_S + (size_t)32 * 1024 * 128 * 4;
constexpr size_t OFF_CAR = OFF_USS + (size_t)512 * 512 * 2;
constexpr size_t OFF_BAR = OFF_CAR + (size_t)8 * 32 * 512 * 8;
constexpr size_t OFF_PD = OFF_BAR + 256;
constexpr size_t OFF_PW = OFF_GL8;
constexpr size_t PART_STRIDE = (size_t)MS * 1024;
constexpr size_t OFF_ZCS = OFF_PD + 3 * PART_STRIDE * 4;
constexpr size_t WS_END = OFF_ZCS + (size_t)MS * 512 * 2;
static_assert(OFF_PD >= OFF_H + (size_t)M * 4096 * 2, "down partials must not overlap h");
static_assert(WS_END <= (size_t)268435456, "workspace map exceeds 256 MiB");
static_assert(OFF_MB + (size_t)M * 1024 * 2 <= OFF_USS, "m overlay");
static_assert(OFF_H + (size_t)M * 4096 * 2 <= (size_t)268435456, "h overlay");

constexpr size_t O_Y = 0;
constexpr size_t O_LCP = (size_t)M * 1024;
constexpr size_t O_LHP = O_LCP + 2 * 8 * 3 * 512;
constexpr size_t O_SCP = O_LHP + 2 * 8 * 512;
constexpr size_t O_SRP = O_SCP + 2 * 8 * 2 * 512;
constexpr size_t O_SIP = O_SRP + 2 * 8 * 2048;
constexpr size_t O_LCS = O_SIP + 2 * 8 * 2048;
constexpr size_t O_LHS = O_LCS + 2 * 128 * 3 * 512;
constexpr size_t O_SCS = O_LHS + 2 * 128 * 512;
constexpr size_t O_SRS = O_SCS + 2 * 128 * 2 * 512;
constexpr size_t O_SIS = O_SRS + 2 * 128 * 2048;

struct Args { const float* in[36]; float* out; unsigned char* ws; };
typedef const __attribute__((address_space(4))) Args* AP;
__device__ __forceinline__ AP ld_args() {
#if defined(__HIP_DEVICE_COMPILE__)
    auto p = __builtin_amdgcn_kernarg_segment_ptr();
    asm volatile("" : "+s"(p));
    return (AP)p;
#else
    return nullptr;
#endif
}
enum { I_XP = 0, I_XS, I_SLC, I_SLH, I_SSC, I_SSR, I_SSI, I_WIN, I_CAW, I_CAB, I_GXW, I_GXB, I_GAW, I_GAB, I_LAM, I_CBW, I_SAR, I_SAI, I_SDT,
       I_SBR, I_SBI, I_SCR, I_SCI, I_SD, I_GLW, I_GLB, I_PA, I_PB, I_PC, I_WO, I_L1G, I_L1B, I_UP, I_DN, I_L2G, I_L2B };

__device__ __forceinline__ unsigned cvt_pk_bf16(float lo, float hi) { unsigned r; asm volatile("v_cvt_pk_bf16_f32 %0, %1, %2" : "=v"(r) : "v"(lo), "v"(hi)); return r; }
__device__ __forceinline__ bf16_t f2bf(float f) { return (bf16_t)(cvt_pk_bf16(f, 0.f) & 0xffffu); }
__device__ __forceinline__ float bf2f(unsigned short b) { return __uint_as_float(((unsigned)b) << 16); }
__device__ __forceinline__ float bflo(unsigned w) { return __uint_as_float(w << 16); }
__device__ __forceinline__ float bfhi(unsigned w) { return __uint_as_float(w & 0xffff0000u); }
__device__ __forceinline__ float sigm(float x) { return 1.0f / (1.0f + __expf(-x)); }
__device__ __forceinline__ float gelu_t(float x) { const float u = 0.7978845608f * (x + 0.044715f * x * x * x); return x / (1.0f + __expf(-2.0f * u)); }
__device__ __forceinline__ u32x4 pack8(const f32x4 a, const f32x4 b) { u32x4 w; w.x = cvt_pk_bf16(a[0], a[1]); w.y = cvt_pk_bf16(a[2], a[3]); w.z = cvt_pk_bf16(b[0], b[1]); w.w = cvt_pk_bf16(b[2], b[3]); return w; }
__device__ __forceinline__ void unpack8(const u32x4 w, float (&f)[8]) { f[0] = bflo(w.x); f[1] = bfhi(w.x); f[2] = bflo(w.y); f[3] = bfhi(w.y); f[4] = bflo(w.z); f[5] = bfhi(w.z); f[6] = bflo(w.w); f[7] = bfhi(w.w); }

__device__ __forceinline__ int otid(const int wv_) { int t = wv_ * 64 + (int)__builtin_amdgcn_mbcnt_hi(~0u, __builtin_amdgcn_mbcnt_lo(~0u, 0u)); asm volatile("" : "+v"(t)); return t; }

__device__ __forceinline__ void gbar(unsigned* ctr, unsigned target, const int wv_) {
    asm volatile("s_waitcnt vmcnt(0)" ::: "memory");
    __syncthreads();
    if (otid(wv_) == 0) {
        __builtin_amdgcn_fence(__ATOMIC_RELEASE, "agent");
        asm volatile("s_waitcnt vmcnt(0)" ::: "memory");
        __hip_atomic_fetch_add(ctr, 1u, __ATOMIC_RELAXED, __HIP_MEMORY_SCOPE_AGENT);
        while (__hip_atomic_load(ctr, __ATOMIC_RELAXED, __HIP_MEMORY_SCOPE_AGENT) < target) __builtin_amdgcn_s_sleep(1);
        __builtin_amdgcn_fence(__ATOMIC_ACQUIRE, "agent");
        asm volatile("s_waitcnt vmcnt(0)" ::: "memory");
    }
    __syncthreads();
}

constexpr int BM = 256, BK = 64, HALF = 128, HTB = HALF * BK * 2, STAGE_BYTES = 8 * HTB;
__device__ __forceinline__ int lds_byte(int r, int c) { const int st = (r >> 4) * 2 + (c >> 5), rr = r & 15, cc = c & 31, ob = rr * 64 + cc * 2; return st * 1024 + (ob ^ (((ob >> 9) & 1) << 5)); }
__device__ __forceinline__ void stage_rc(int b, int& R, int& C) { const int st = b / 1024, sb = b % 1024, swz = sb ^ (((sb >> 9) & 1) << 5); R = (st >> 1) * 16 + swz / 64; C = (st & 1) * 32 + (swz % 64) / 2; }
__device__ __forceinline__ int perm32(int rho) { const int n = rho >> 4, i = rho & 15; return 8 * (i >> 2) + 4 * n + (i & 3); }
struct Unit { int pm, pn, z; };
__device__ __forceinline__ void tile_map(int L, int nM, int nN, int& pm, int& pn) {
    const int nwg = nM * nN; int wgid = L;
    { const int q = nwg / 8, r = nwg % 8, xcd = wgid % 8, off = wgid / 8; wgid = (xcd < r ? xcd * (q + 1) : r * (q + 1) + (xcd - r) * q) + off; }
    const int nig = 8 * nN, gid = wgid / nig, fm = gid * 8, gsz = (nM - fm) < 8 ? (nM - fm) : 8;
    pm = fm + ((wgid % nig) % gsz); pn = (wgid % nig) / gsz;
}

template <class P>
__device__ __forceinline__ void gemm_phase(LAS unsigned char* lds, const P& p, const int wv_) {
    const int tid = otid(wv_), wid = __builtin_amdgcn_readfirstlane(tid >> 6), lane = tid & 63, wr = wid >> 2, wc = wid & 3, fr = lane & 15, fq = lane >> 4;
    unsigned voffA[2], voffB[2];
#pragma unroll
    for (int i = 0; i < 2; ++i) { int R, C; stage_rc(tid * 16 + i * 8192, R, C); const int Rb = P::PERM ? ((R & ~31) + perm32(R & 31)) : R;
        voffA[i] = (unsigned)(R * p.lda + C) * 2u; voffB[i] = (unsigned)(Rb * p.ldb + C) * 2u; }
    const size_t kstep = (size_t)(BK * 2);
    const size_t hA = (size_t)HALF * p.lda * 2, hB = (size_t)HALF * p.ldb * 2;
    const unsigned ldsw = (unsigned)wid * 1024u;
    const int aoff = lds_byte(wr * 64 + fr, fq * 8), boff = lds_byte(wc * 32 + fr, fq * 8);
#define PG8_SA(b, h) (((b) * 2 + (h)) * HTB)
#define PG8_SB(b, h) ((4 + (b) * 2 + (h)) * HTB)
#define PG8_STAGE(bufoff, gbase, voff) do { _Pragma("unroll") for (int _i = 0; _i < 2; ++_i) \
        __builtin_amdgcn_global_load_lds((const unsigned*)((const char*)(gbase) + (voff)[_i]), (LAS unsigned*)(lds + (bufoff) + ldsw + _i * 8192), 16, 0, 0); } while (0)
#define PG8_LDA(dst, b, h) do { _Pragma("unroll") for (int m = 0; m < 4; ++m) _Pragma("unroll") for (int k = 0; k < 2; ++k) dst[m][k] = *(const LAS bf16x8*)(lds + PG8_SA(b, h) + aoff + m * 2048 + k * 1024); } while (0)
#define PG8_LDB(dst, b, h) do { _Pragma("unroll") for (int n = 0; n < 2; ++n) _Pragma("unroll") for (int k = 0; k < 2; ++k) dst[n][k] = *(const LAS bf16x8*)(lds + PG8_SB(b, h) + boff + n * 2048 + k * 1024); } while (0)
#define PG8_MMA(ai, bj, At, Bt) do { __builtin_amdgcn_s_setprio(1); _Pragma("unroll") for (int m = 0; m < 4; ++m) _Pragma("unroll") for (int n = 0; n < 2; ++n) _Pragma("unroll") for (int k = 0; k < 2; ++k) \
        acc[ai][bj][m][n] = __builtin_amdgcn_mfma_f32_16x16x32_bf16(Bt[n][k], At[m][k], acc[ai][bj][m][n], 0, 0, 0); __builtin_amdgcn_s_setprio(0); } while (0)
#define PG8_WAIT_V(n) asm volatile("s_waitcnt vmcnt(" #n ")" ::: "memory")
#define PG8_WAIT_L(n) asm volatile("s_waitcnt lgkmcnt(" #n ")" ::: "memory")
#define PG8_BAR __builtin_amdgcn_s_barrier()
#define PG8_SCHED __builtin_amdgcn_sched_barrier(0)
    Unit cur, nxt; int ui = 0;
    if (!p.next(0, cur)) return;
    f32x4 acc[2][2][4][2];
#pragma unroll
    for (int a = 0; a < 2; ++a)
#pragma unroll
        for (int b = 0; b < 2; ++b)
#pragma unroll
            for (int m = 0; m < 4; ++m)
#pragma unroll
                for (int n = 0; n < 2; ++n) acc[a][b][m][n] = (f32x4){0.f, 0.f, 0.f, 0.f};
    bf16x8 At[4][2], B0[2][2], B1[2][2];
    const char* cA = p.aptr(cur); const char* cB = p.bptr(cur);
    PG8_STAGE(PG8_SB(0, 0), cB, voffB); PG8_STAGE(PG8_SA(0, 0), cA, voffA); PG8_STAGE(PG8_SB(0, 1), cB + hB, voffB); PG8_STAGE(PG8_SA(0, 1), cA + hA, voffA);
    if (wr == 1) PG8_BAR;
    PG8_WAIT_V(4); PG8_BAR;
    PG8_STAGE(PG8_SB(1, 0), cB + kstep, voffB); PG8_STAGE(PG8_SA(1, 0), cA + kstep, voffA); PG8_STAGE(PG8_SB(1, 1), cB + hB + kstep, voffB);
    PG8_WAIT_V(6); PG8_BAR;
    for (;;) {
        const bool has_next = p.next(ui + 1, nxt);
        const int nt = p.nt(cur);
        const char* nA = has_next ? p.aptr(nxt) : cA; const char* nB = has_next ? p.bptr(nxt) : cB;
        for (int t = 0; t < nt; t += 2) {
            const bool last = (t == nt - 2);
            const char* a1 = cA + (size_t)(t + 1) * kstep;
            const char* a2 = last ? nA : cA + (size_t)(t + 2) * kstep; const char* b2 = last ? nB : cB + (size_t)(t + 2) * kstep;
            const char* a3 = a2 + kstep; const char* b3 = b2 + kstep;
            PG8_LDB(B0, 0, 0); PG8_SCHED; PG8_LDA(At, 0, 0); PG8_STAGE(PG8_SA(1, 1), a1 + hA, voffA);
            PG8_WAIT_L(8); PG8_BAR; PG8_WAIT_L(0); PG8_MMA(0, 0, At, B0); PG8_BAR; PG8_SCHED;
            PG8_LDB(B1, 0, 1); PG8_STAGE(PG8_SB(0, 0), b2, voffB);
            PG8_BAR; PG8_WAIT_L(0); PG8_MMA(0, 1, At, B1); PG8_BAR;
            PG8_LDA(At, 0, 1); PG8_STAGE(PG8_SA(0, 0), a2, voffA);
            PG8_BAR; PG8_WAIT_L(0); PG8_MMA(1, 0, At, B0); PG8_BAR; PG8_SCHED;
            PG8_STAGE(PG8_SB(0, 1), b2 + hB, voffB);
            PG8_WAIT_V(6); PG8_BAR; PG8_MMA(1, 1, At, B1); PG8_BAR;
            PG8_LDB(B0, 1, 0); PG8_SCHED; PG8_LDA(At, 1, 0); PG8_STAGE(PG8_SA(0, 1), a2 + hA, voffA);
            PG8_WAIT_L(8); PG8_BAR; PG8_WAIT_L(0); PG8_MMA(0, 0, At, B0); PG8_BAR; PG8_SCHED;
            PG8_LDB(B1, 1, 1); PG8_STAGE(PG8_SB(1, 0), b3, voffB);
            PG8_BAR; PG8_WAIT_L(0); PG8_MMA(0, 1, At, B1); PG8_BAR;
            PG8_LDA(At, 1, 1); PG8_STAGE(PG8_SA(1, 0), a3, voffA);
            PG8_BAR; PG8_WAIT_L(0); PG8_MMA(1, 0, At, B0); PG8_BAR; PG8_SCHED;
            PG8_STAGE(PG8_SB(1, 1), b3 + hB, voffB);
            PG8_WAIT_V(6); PG8_BAR; PG8_MMA(1, 1, At, B1); PG8_BAR;
        }
        Unit eu = cur;
        asm volatile("" : "+s"(eu.pm), "+s"(eu.pn), "+s"(eu.z));
        const bool rst = p.epi(acc, eu, wr, wc, fr, fq);
        if (!has_next) break;
        if (rst) {
#pragma unroll
            for (int a = 0; a < 2; ++a)
#pragma unroll
                for (int b = 0; b < 2; ++b)
#pragma unroll
                    for (int m = 0; m < 4; ++m)
#pragma unroll
                        for (int n = 0; n < 2; ++n) acc[a][b][m][n] = (f32x4){0.f, 0.f, 0.f, 0.f};
        }
        cur = nxt; cA = nA; cB = nB; ++ui;
    }
    PG8_WAIT_V(0);
    if (wr == 0) PG8_BAR;
    PG8_BAR;
#undef PG8_SA
#undef PG8_SB
#undef PG8_STAGE
#undef PG8_LDA
#undef PG8_LDB
#undef PG8_MMA
#undef PG8_WAIT_V
#undef PG8_WAIT_L
#undef PG8_BAR
#undef PG8_SCHED
}
typedef f32x4 Acc[2][2][4][2];

struct PG1 {
    __device__ __forceinline__ int nt(const Unit&) const { return K / BK; }
    static constexpr bool PERM = true;
    int K, lda, ldb, G, c;
    const bf16_t* A; const bf16_t* Bt;
    bf16_t *xa, *ya, *sb, *sc, *sh, *apack, *uss; unsigned char* gl8;
    __device__ __forceinline__ bool next(int i, Unit& u) const { const long L = (long)i * G + c; if (L >= 66 * 24) return false; tile_map((int)L, 66, 24, u.pm, u.pn); u.z = 0; return true; }
    __device__ __forceinline__ const char* aptr(const Unit& u) const { return (const char*)A + (size_t)u.pm * 256 * 1024 * 2; }
    __device__ __forceinline__ const char* bptr(const Unit& u) const { return (const char*)Bt + (size_t)u.pn * 256 * 1024 * 2; }
    __device__ __forceinline__ bool epi(Acc& acc, const Unit& u, int wr, int wc, int fr, int fq) const {
        const int pn = u.pn;
        if (pn < 10) {
            const int b = pn >> 1; bf16_t* base = b == 0 ? xa : b == 1 ? ya : b == 2 ? sb : b == 3 ? sc : sh;
#pragma unroll
            for (int ai = 0; ai < 2; ++ai)
#pragma unroll
                for (int m = 0; m < 4; ++m) { const size_t r = (size_t)u.pm * 256 + ai * 128 + wr * 64 + m * 16 + fr;
#pragma unroll
                    for (int bj = 0; bj < 2; ++bj) { const int col = (pn & 1) * 256 + bj * 128 + wc * 32 + 8 * fq;
                        *(u32x4*)(base + r * 512 + col) = pack8(acc[ai][bj][m][0], acc[ai][bj][m][1]); } }
        } else if (pn < 12) {
#pragma unroll
            for (int ai = 0; ai < 2; ++ai)
#pragma unroll
                for (int m = 0; m < 4; ++m) { const int r = u.pm * 256 + ai * 128 + wr * 64 + m * 16 + fr;
#pragma unroll
                    for (int bj = 0; bj < 2; ++bj) { const int cc = (pn - 10) * 256 + bj * 128 + wc * 32 + 8 * fq;
                        bf16_t* dst = (u.pm < 64) ? apack + ((size_t)((cc >> 4) * 1024 + (r >> 4)) * 384 + 128 + (r & 15) * 16 + (cc & 15)) : uss + (size_t)(r - MP) * 512 + cc;
                        *(u32x4*)dst = pack8(acc[ai][bj][m][0], acc[ai][bj][m][1]); } }
        } else {
#pragma unroll
            for (int ai = 0; ai < 2; ++ai)
#pragma unroll
                for (int m = 0; m < 4; ++m) { const size_t r = (size_t)u.pm * 256 + ai * 128 + wr * 64 + m * 16 + fr;
#pragma unroll
                    for (int bj = 0; bj < 2; ++bj) { const int col = (pn - 12) * 256 + bj * 128 + wc * 32 + 8 * fq;
                        unsigned q[8];
#pragma unroll
                        for (int n = 0; n < 2; ++n)
#pragma unroll
                            for (int j = 0; j < 4; ++j) { int v = (int)(sigm(acc[ai][bj][m][n][j]) * 256.0f); v = v < 0 ? 0 : (v > 255 ? 255 : v); q[n * 4 + j] = (unsigned)v; }
                        u32x2 w; w.x = q[0] | (q[1] << 8) | (q[2] << 16) | (q[3] << 24); w.y = q[4] | (q[5] << 8) | (q[6] << 16) | (q[7] << 24);
                        *(u32x2*)(gl8 + r * 3072 + col) = w; } }
        }
        return true;
    }
};

struct PGate {
    __device__ __forceinline__ int nt(const Unit&) const { return K / BK; }
    static constexpr bool PERM = false;
    int K, lda, ldb, G, c;
    const bf16_t* A; const bf16_t* Bt;
    const float *gxb, *gab, *lam; float* aout; bf16_t* bxout;
    __device__ __forceinline__ bool next(int i, Unit& u) const { const long L = (long)i * G + c; if (L >= 66 * 4) return false; tile_map((int)L, 66, 4, u.pm, u.pn); u.z = 0; return true; }
    __device__ __forceinline__ const char* aptr(const Unit& u) const { return (const char*)A + (size_t)u.pm * 256 * 512 * 2; }
    __device__ __forceinline__ const char* bptr(const Unit& u) const { return (const char*)Bt + (size_t)u.pn * 256 * 512 * 2; }
    __device__ __forceinline__ bool epi(Acc& acc, const Unit& u, int wr, int wc, int fr, int fq) const {
#pragma unroll
        for (int n = 0; n < 2; ++n) {
            const int ch0 = u.pn * 128 + wc * 32 + n * 16 + 4 * fq;
            const f32x4 bx4 = *(const f32x4*)(gxb + ch0), ba4 = *(const f32x4*)(gab + ch0), lm4 = *(const f32x4*)(lam + ch0);
            f32x4 kk;
#pragma unroll
            for (int j = 0; j < 4; ++j) kk[j] = -8.0f * log1pf(expf(-lm4[j]));
#pragma unroll
            for (int ai = 0; ai < 2; ++ai)
#pragma unroll
                for (int m = 0; m < 4; ++m) { const size_t r = (size_t)u.pm * 256 + ai * 128 + wr * 64 + m * 16 + fr;
                    const u32x2 xw = *(const u32x2*)(A + r * 512 + ch0);
                    const float xc[4] = {bflo(xw.x), bfhi(xw.x), bflo(xw.y), bfhi(xw.y)};
                    f32x4 av; float bv[4];
#pragma unroll
                    for (int j = 0; j < 4; ++j) { const float gx = sigm(acc[ai][0][m][n][j] + bx4[j]), ga = sigm(acc[ai][1][m][n][j] + ba4[j]);
                        const float la = kk[j] * ga; av[j] = __expf(la); bv[j] = __builtin_amdgcn_sqrtf(fmaxf(1.0f - av[j] * av[j], 0.f)) * gx * xc[j]; }
                    *(f32x4*)(aout + r * 512 + ch0) = av;
                    u32x2 w; w.x = cvt_pk_bf16(bv[0], bv[1]); w.y = cvt_pk_bf16(bv[2], bv[3]);
                    *(u32x2*)(bxout + r * 512 + ch0) = w; }
        }
        return true;
    }
};

struct PY {
    __device__ __forceinline__ int nt(const Unit&) const { return K / BK; }
    static constexpr bool PERM = true;
    int K, lda, ldb, G, c;
    const bf16_t* apack; const bf16_t* wyt; const float* dvec; bf16_t* zc;
    __device__ __forceinline__ bool next(int i, Unit& u) const { const long L = (long)i * G + c; if (L >= 128) return false; u.pm = (int)L; u.pn = (int)L >> 2; u.z = 0; return true; }
    __device__ __forceinline__ const char* aptr(const Unit& u) const { return (const char*)apack + (size_t)u.pm * 256 * 384 * 2; }
    __device__ __forceinline__ const char* bptr(const Unit& u) const { return (const char*)wyt + (size_t)u.pn * 256 * 384 * 2; }
    __device__ __forceinline__ bool epi(Acc& acc, const Unit& u, int wr, int wc, int fr, int fq) const {
        const int g = u.pn;
#pragma unroll
        for (int bj = 0; bj < 2; ++bj) {
            const int n0 = bj * 128 + wc * 32 + 8 * fq, ti = n0 >> 4, c0 = n0 & 15;
            const f32x4 d0 = *(const f32x4*)(dvec + g * 16 + c0), d1 = *(const f32x4*)(dvec + g * 16 + c0 + 4);
#pragma unroll
            for (int ai = 0; ai < 2; ++ai)
#pragma unroll
                for (int m = 0; m < 4; ++m) { const int rr = (u.pm & 3) * 256 + ai * 128 + wr * 64 + m * 16 + fr;
                    const u32x4 uw = *(const u32x4*)(apack + ((size_t)(g * 1024 + rr) * 384 + 128 + n0));
                    float uf[8]; unpack8(uw, uf);
                    f32x4 y0, y1;
#pragma unroll
                    for (int j = 0; j < 4; ++j) { y0[j] = gelu_t(acc[ai][bj][m][0][j] + d0[j] * uf[j]); y1[j] = gelu_t(acc[ai][bj][m][1][j] + d1[j] * uf[4 + j]); }
                    const size_t tok = (size_t)(rr >> 7) * 2048 + (rr & 127) * 16 + ti;
                    *(u32x4*)(zc + tok * 512 + g * 16 + c0) = pack8(y0, y1); }
        }
        return true;
    }
};

struct PGlu {
    __device__ __forceinline__ int nt(const Unit&) const { return K / BK; }
    static constexpr bool PERM = true;
    int K, lda, ldb, G, c, sample;
    const bf16_t* A; const bf16_t* As; const bf16_t* Bt; const float* bias; bf16_t* out;
    __device__ __forceinline__ bool next(int i, Unit& u) const {
        if (sample) { const int j = c - 128; if (i != 0 || j < 0 || j >= 4) return false; u.pm = 64 + (j >> 1); u.pn = j & 1; u.z = 0; return true; }
        const long L = (long)i * G + c; if (L >= 64 * 2) return false; tile_map((int)L, 64, 2, u.pm, u.pn); u.z = 0; return true; }
    __device__ __forceinline__ const bf16_t* arow0(const Unit& u) const { return u.pm < 64 ? A + (size_t)u.pm * 256 * 512 : As + (size_t)(u.pm - 64) * 256 * 512; }
    __device__ __forceinline__ const char* aptr(const Unit& u) const { return (const char*)arow0(u); }
    __device__ __forceinline__ const char* bptr(const Unit& u) const { return (const char*)Bt + (size_t)u.pn * 256 * 512 * 2; }
    __device__ __forceinline__ bool epi(Acc& acc, const Unit& u, int wr, int wc, int fr, int fq) const {
        const bf16_t* zsrc = arow0(u);
#pragma unroll
        for (int bj = 0; bj < 2; ++bj) {
            const int col = u.pn * 256 + bj * 128 + wc * 32 + 8 * fq;
            const f32x4 b0 = *(const f32x4*)(bias + col), b1 = *(const f32x4*)(bias + col + 4);
#pragma unroll
            for (int ai = 0; ai < 2; ++ai)
#pragma unroll
                for (int m = 0; m < 4; ++m) { const int rl = ai * 128 + wr * 64 + m * 16 + fr; const size_t r = (size_t)u.pm * 256 + rl;
                    const u32x4 zw = *(const u32x4*)(zsrc + (size_t)rl * 512 + col); float zf[8]; unpack8(zw, zf);
                    f32x4 y0, y1;
#pragma unroll
                    for (int j = 0; j < 4; ++j) { y0[j] = zf[j] * sigm(acc[ai][bj][m][0][j] + b0[j]); y1[j] = zf[4 + j] * sigm(acc[ai][bj][m][1][j] + b1[j]); }
                    *(u32x4*)(out + r * 512 + col) = pack8(y0, y1); }
        }
        return true;
    }
};

struct PMerge {
    __device__ __forceinline__ int nt(const Unit&) const { return K / BK; }
    static constexpr bool PERM = true;
    int K, lda, ldb, G, c, sample;
    const bf16_t* a0; const bf16_t* wp; const unsigned char* gl8; bf16_t* mb;
    __device__ __forceinline__ bool next(int i, Unit& u) const { const int ti = i / 3;
        if (sample) { const int j = c - (G - 8); if (ti != 0 || j < 0) return false; u.pm = 64 + (j >> 2); u.pn = j & 3; u.z = i; return true; }
        const long L = (long)ti * G + c; if (L >= 64 * 4) return false; tile_map((int)L, 64, 4, u.pm, u.pn); u.z = i - ti * 3; return true; }
    __device__ __forceinline__ const char* aptr(const Unit& u) const { const size_t off = (u.z == 2) ? (OFF_XB + S17 - OFF_R) : (size_t)u.z * S17; return (const char*)a0 + off + (size_t)u.pm * 256 * 512 * 2; }
    __device__ __forceinline__ const char* bptr(const Unit& u) const { return (const char*)wp + ((size_t)u.z * 1024 + (size_t)u.pn * 256) * 512 * 2; }
    __device__ __forceinline__ bool epi(Acc& acc, const Unit& u, int wr, int wc, int fr, int fq) const {
        const int br = u.z;
#pragma unroll
        for (int ai = 0; ai < 2; ++ai)
#pragma unroll
            for (int m = 0; m < 4; ++m) { const size_t r = (size_t)u.pm * 256 + ai * 128 + wr * 64 + m * 16 + fr;
#pragma unroll
                for (int bj = 0; bj < 2; ++bj) { const int col = u.pn * 256 + bj * 128 + wc * 32 + 8 * fq;
                    const u32x2 qc = *(const u32x2*)(gl8 + r * 3072 + br * 1024 + col);
                    if (br < 2) {
                        const u32x2 qn = *(const u32x2*)(gl8 + r * 3072 + (br + 1) * 1024 + col);
#pragma unroll
                        for (int j = 0; j < 4; ++j) {
                            const float gc0 = (float)((qc.x >> (8 * j)) & 255u) + 0.5f, gn0 = (float)((qn.x >> (8 * j)) & 255u) + 0.5f;
                            const float gc1 = (float)((qc.y >> (8 * j)) & 255u) + 0.5f, gn1 = (float)((qn.y >> (8 * j)) & 255u) + 0.5f;
                            acc[ai][bj][m][0][j] *= gc0 / gn0; acc[ai][bj][m][1][j] *= gc1 / gn1; }
                    } else {
                        f32x4 y0, y1;
#pragma unroll
                        for (int j = 0; j < 4; ++j) {
                            y0[j] = acc[ai][bj][m][0][j] * (((float)((qc.x >> (8 * j)) & 255u) + 0.5f) * (1.0f / 256.0f));
                            y1[j] = acc[ai][bj][m][1][j] * (((float)((qc.y >> (8 * j)) & 255u) + 0.5f) * (1.0f / 256.0f)); }
                        *(u32x4*)(mb + r * 1024 + col) = pack8(y0, y1);
                    } } }
        return br == 2;
    }
};

struct PWout {
    static constexpr bool PERM = false;
    int K, lda, ldb, G, c;
    const bf16_t* A; const bf16_t* Bt; const float* xp; const float* xs; float* R; float* part;
    __device__ __forceinline__ int nt(const Unit& u) const { return u.z < 0 ? 16 : 4; }
    __device__ __forceinline__ bool next(int i, Unit& u) const {
        const int nP = c < 256 ? (256 - c + G - 1) / G : 0;
        if (i < nP) { tile_map(i * G + c, 64, 4, u.pm, u.pn); u.z = -1; return true; }
        const int j = (i - nP) * G + c; if (j >= 32) return false;
        u.pm = 64 + (j >> 4); u.pn = (j >> 2) & 3; u.z = j & 3; return true; }
    __device__ __forceinline__ const char* aptr(const Unit& u) const { return (const char*)A + (size_t)u.pm * 256 * 1024 * 2 + (u.z < 0 ? 0 : u.z * 512); }
    __device__ __forceinline__ const char* bptr(const Unit& u) const { return (const char*)Bt + (size_t)u.pn * 256 * 1024 * 2 + (u.z < 0 ? 0 : u.z * 512); }
    __device__ __forceinline__ bool epi(Acc& acc, const Unit& u, int wr, int wc, int fr, int fq) const {
        const float* xsrc = (u.pm < 64) ? xp + (size_t)u.pm * 256 * 1024 : xs + (size_t)(u.pm - 64) * 256 * 1024;
#pragma unroll
        for (int ai = 0; ai < 2; ++ai)
#pragma unroll
            for (int m = 0; m < 4; ++m) { const int rl = ai * 128 + wr * 64 + m * 16 + fr; const size_t r = (size_t)u.pm * 256 + rl;
#pragma unroll
                for (int bj = 0; bj < 2; ++bj)
#pragma unroll
                    for (int n = 0; n < 2; ++n) { const int col = u.pn * 256 + bj * 128 + wc * 32 + n * 16 + 4 * fq;
                        float* pp = R + r * 1024 + col;
                        if (u.z <= 0) { const f32x4 xv = *(const f32x4*)(xsrc + (size_t)rl * 1024 + col); *(f32x4*)pp = xv * ALPHA + acc[ai][bj][m][n]; }
                        else *(f32x4*)(part + (size_t)(u.z - 1) * PART_STRIDE + (r - MP) * 1024 + col) = acc[ai][bj][m][n]; } }
        return true;
    }
};

struct PUp {
    __device__ __forceinline__ int nt(const Unit&) const { return K / BK; }
    static constexpr bool PERM = true;
    int K, lda, ldb, G, c;
    const bf16_t* A; const bf16_t* Bt; bf16_t* h;
    __device__ __forceinline__ bool next(int i, Unit& u) const { const long L = (long)i * G + c; if (L >= 66 * 16) return false; tile_map((int)L, 66, 16, u.pm, u.pn); u.z = 0; return true; }
    __device__ __forceinline__ const char* aptr(const Unit& u) const { return (const char*)A + (size_t)u.pm * 256 * 1024 * 2; }
    __device__ __forceinline__ const char* bptr(const Unit& u) const { return (const char*)Bt + (size_t)u.pn * 256 * 1024 * 2; }
    __device__ __forceinline__ bool epi(Acc& acc, const Unit& u, int wr, int wc, int fr, int fq) const {
#pragma unroll
        for (int ai = 0; ai < 2; ++ai)
#pragma unroll
            for (int m = 0; m < 4; ++m) { const size_t r = (size_t)u.pm * 256 + ai * 128 + wr * 64 + m * 16 + fr;
#pragma unroll
                for (int bj = 0; bj < 2; ++bj) { const int col = u.pn * 256 + bj * 128 + wc * 32 + 8 * fq;
                    f32x4 y0, y1;
#pragma unroll
                    for (int j = 0; j < 4; ++j) { const float v0 = fmaxf(acc[ai][bj][m][0][j], 0.f), v1 = fmaxf(acc[ai][bj][m][1][j], 0.f); y0[j] = v0 * v0; y1[j] = v1 * v1; }
                    *(u32x4*)(h + r * 4096 + col) = pack8(y0, y1); } }
        return true;
    }
};

struct PDown {
    static constexpr bool PERM = false;
    int K, lda, ldb, G, c;
    const bf16_t* A; const bf16_t* Bt; float* R; float* part;
    __device__ __forceinline__ int nt(const Unit& u) const { return u.z < 0 ? 64 : 16; }
    __device__ __forceinline__ bool next(int i, Unit& u) const {
        const int nP = c < 256 ? (256 - c + G - 1) / G : 0;
        if (i < nP) { tile_map(i * G + c, 64, 4, u.pm, u.pn); u.z = -1; return true; }
        const int j = (i - nP) * G + c; if (j >= 32) return false;
        u.pm = 64 + (j >> 4); u.pn = (j >> 2) & 3; u.z = j & 3; return true; }
    __device__ __forceinline__ const char* aptr(const Unit& u) const { return (const char*)A + (size_t)u.pm * 256 * 4096 * 2 + (u.z < 0 ? 0 : u.z * 2048); }
    __device__ __forceinline__ const char* bptr(const Unit& u) const { return (const char*)Bt + (size_t)u.pn * 256 * 4096 * 2 + (u.z < 0 ? 0 : u.z * 2048); }
    __device__ __forceinline__ bool epi(Acc& acc, const Unit& u, int wr, int wc, int fr, int fq) const {
#pragma unroll
        for (int ai = 0; ai < 2; ++ai)
#pragma unroll
            for (int m = 0; m < 4; ++m) { const size_t r = (size_t)u.pm * 256 + ai * 128 + wr * 64 + m * 16 + fr;
#pragma unroll
                for (int bj = 0; bj < 2; ++bj)
#pragma unroll
                    for (int n = 0; n < 2; ++n) { const int col = u.pn * 256 + bj * 128 + wc * 32 + n * 16 + 4 * fq;
                        float* pp = R + r * 1024 + col;
                        if (u.z <= 0) { const f32x4 xv = *(const f32x4*)pp; *(f32x4*)pp = xv + acc[ai][bj][m][n]; }
                        else *(f32x4*)(part + (size_t)(u.z - 1) * PART_STRIDE + (r - MP) * 1024 + col) = acc[ai][bj][m][n]; } }
        return true;
    }
};

__device__ __forceinline__ void tconv_tile4(const float* W, bf16_t* Wt, int K, int N, int tk, int tn4, float* sm, const int wv_) {
    const int tid = otid(wv_), r = tid >> 3, c8 = (tid & 7) * 8;
    const float* src = W + (size_t)(tk * 64 + r) * N + tn4 * 256 + c8;
    f32x4 v[4][2];
#pragma unroll
    for (int q = 0; q < 4; ++q) { v[q][0] = *(const f32x4*)(src + q * 64); v[q][1] = *(const f32x4*)(src + q * 64 + 4); }
#pragma unroll
    for (int q = 0; q < 4; ++q)
#pragma unroll
        for (int j = 0; j < 4; ++j) { sm[q * 4160 + r * 65 + c8 + j] = v[q][0][j]; sm[q * 4160 + r * 65 + c8 + 4 + j] = v[q][1][j]; }
    __syncthreads();
    const int n = tid >> 3, k8 = (tid & 7) * 8;
#pragma unroll
    for (int q = 0; q < 4; ++q) { const float* t = sm + q * 4160;
        u32x4 w;
        w.x = cvt_pk_bf16(t[(k8 + 0) * 65 + n], t[(k8 + 1) * 65 + n]); w.y = cvt_pk_bf16(t[(k8 + 2) * 65 + n], t[(k8 + 3) * 65 + n]);
        w.z = cvt_pk_bf16(t[(k8 + 4) * 65 + n], t[(k8 + 5) * 65 + n]); w.w = cvt_pk_bf16(t[(k8 + 6) * 65 + n], t[(k8 + 7) * 65 + n]);
        *(u32x4*)(Wt + (size_t)(tn4 * 256 + q * 64 + n) * K + tk * 64 + k8) = w; }
    __syncthreads();
}

__device__ __forceinline__ void abar_pow(const float* are, const float* aim, const float* ldt, int sp, float e, float& pr, float& pi) {
    const float step = expf(ldt[sp]); const float x = e * step * are[sp], th = e * step * aim[sp];
    float s, c; sincosf(th, &s, &c); const float mg = expf(x); pr = mg * c; pi = mg * s;
}
__device__ __forceinline__ void ssm_coef(const float* are, const float* aim, const float* ldt, int sp, float& cr, float& ci) {
    const float step = expf(ldt[sp]); const float ar = are[sp], ai = aim[sp];
    const float x = step * ar, th = step * ai;
    float s, c; sincosf(th, &s, &c); const float em1 = expm1f(x); const float sh = sinf(0.5f * th);
    const float nr = em1 * c - 2.0f * sh * sh, ni = (em1 + 1.0f) * s;
    const float den = ar * ar + ai * ai;
    cr = (nr * ar + ni * ai) / den; ci = (ni * ar - nr * ai) / den;
}

__device__ __forceinline__ void prep_layer(AP a, int layer, float* sm, const int wv_) {
    unsigned char* ws = a->ws;
    const int G = gridDim.x;
    for (int t = blockIdx.x; t < 1072; t += G) {
        const float* W; bf16_t* Wt; int K, N, tt;
        if (t < 384) { tt = t; W = a->in[I_WIN] + (size_t)layer * 1024 * 6144; Wt = (bf16_t*)(ws + OFF_WIN); K = 1024; N = 6144; }
        else if (t < 480) { const int j = (t - 384) / 32; tt = (t - 384) % 32; W = a->in[I_PA + j] + (size_t)layer * 512 * 1024; Wt = (bf16_t*)(ws + OFF_WP) + (size_t)j * 1024 * 512; K = 512; N = 1024; }
        else if (t < 496) { tt = t - 480; W = a->in[I_GLW] + (size_t)layer * 512 * 512; Wt = (bf16_t*)(ws + OFF_WGLU); K = 512; N = 512; }
        else if (t < 560) { tt = t - 496; W = a->in[I_WO] + (size_t)layer * 1024 * 1024; Wt = (bf16_t*)(ws + OFF_WOUT); K = 1024; N = 1024; }
        else if (t < 816) { tt = t - 560; W = a->in[I_UP] + (size_t)layer * 1024 * 4096; Wt = (bf16_t*)(ws + OFF_WUP); K = 1024; N = 4096; }
        else { tt = t - 816; W = a->in[I_DN] + (size_t)layer * 4096 * 1024; Wt = (bf16_t*)(ws + OFF_WDOWN); K = 4096; N = 1024; }
        const int ntn = N / 256; tconv_tile4(W, Wt, K, N, tt / ntn, tt % ntn, sm, wv_);
    }
    const int gt = blockIdx.x * NTHR + otid(wv_), GT = G * NTHR;
    {
        bf16_t* wg = (bf16_t*)(ws + OFF_WGATE);
        for (int idx = gt; idx < 1024 * 64; idx += GT) {
            const int n = idx >> 6, k0 = (idx & 63) * 8; const int pn = n >> 8, bj = (n >> 7) & 1, ch = pn * 128 + (n & 127), hd = ch >> 6, j = ch & 63;
            u32x4 w = (u32x4){0u, 0u, 0u, 0u};
            if ((k0 >> 6) == hd) { const float* src = a->in[bj ? I_GAW : I_GXW] + (size_t)layer * 8 * 64 * 64 + (size_t)hd * 4096 + (size_t)(k0 & 63) * 64 + j;
                w.x = cvt_pk_bf16(src[0], src[64]); w.y = cvt_pk_bf16(src[128], src[192]); w.z = cvt_pk_bf16(src[256], src[320]); w.w = cvt_pk_bf16(src[384], src[448]); }
            *(u32x4*)(wg + (size_t)n * 512 + k0) = w;
        }
    }
    const float* are = a->in[I_SAR] + layer * 2048; const float* aim = a->in[I_SAI] + layer * 2048; const float* ldt = a->in[I_SDT] + layer * 2048;
    const float* bre = a->in[I_SBR] + layer * 32768; const float* bim = a->in[I_SBI] + layer * 32768;
    const float* cre = a->in[I_SCR] + layer * 32768; const float* cim = a->in[I_SCI] + layer * 32768;
    {
        bf16_t* w1 = (bf16_t*)(ws + OFF_W1T);
        for (int idx = gt; idx < 32 * 128 * 32; idx += GT) {
            const int g = idx >> 12, n = (idx >> 5) & 127, k0 = (idx & 31) * 8, j = k0 >> 4, c0 = k0 & 15, p = n & 63, part = n >> 6, sp = g * 64 + p;
            float pr, pi, cr, ci; abar_pow(are, aim, ldt, sp, (float)(15 - j), pr, pi); ssm_coef(are, aim, ldt, sp, cr, ci);
            const float qr = pr * cr - pi * ci, qi = pr * ci + pi * cr;
            float o[8];
#pragma unroll
            for (int q = 0; q < 8; ++q) { const float br = bre[sp * 16 + c0 + q], bi = bim[sp * 16 + c0 + q]; o[q] = part ? (qr * bi + qi * br) : (qr * br - qi * bi); }
            u32x4 w; w.x = cvt_pk_bf16(o[0], o[1]); w.y = cvt_pk_bf16(o[2], o[3]); w.z = cvt_pk_bf16(o[4], o[5]); w.w = cvt_pk_bf16(o[6], o[7]);
            *(u32x4*)(w1 + ((size_t)(g * 128 + n) * 256 + k0)) = w;
        }
    }
    {
        bf16_t* wy = (bf16_t*)(ws + OFF_WYT);
        for (int idx = gt; idx < 32 * 256 * 16; idx += GT) {
            const int g = idx >> 12, n = (idx >> 4) & 255, k0 = (idx & 15) * 8, i = n >> 4, c = n & 15, part = k0 >> 6, p0 = k0 & 63;
            float o[8];
#pragma unroll
            for (int q = 0; q < 8; ++q) { const int p = p0 + q, sp = g * 64 + p; float pr, pi; abar_pow(are, aim, ldt, sp, (float)(i + 1), pr, pi);
                const float xr = cre[(g * 16 + c) * 64 + p], xi = cim[(g * 16 + c) * 64 + p];
                o[q] = part ? -(xr * pi + xi * pr) : (xr * pr - xi * pi); }
            u32x4 w; w.x = cvt_pk_bf16(o[0], o[1]); w.y = cvt_pk_bf16(o[2], o[3]); w.z = cvt_pk_bf16(o[4], o[5]); w.w = cvt_pk_bf16(o[6], o[7]);
            *(u32x4*)(wy + ((size_t)(g * 256 + n) * 384 + k0)) = w;
        }
        for (int idx = gt; idx < 32 * 256 * 4; idx += GT) {
            const int pq = idx & 3, c2 = (idx >> 2) & 15, c = (idx >> 6) & 15, g = idx >> 10;
            float km[16];
#pragma unroll
            for (int d = 0; d < 16; ++d) km[d] = 0.f;
            for (int pp = 0; pp < 16; ++pp) { const int p = pq * 16 + pp, sp = g * 64 + p; float ar, ai, cr, ci; abar_pow(are, aim, ldt, sp, 1.0f, ar, ai); ssm_coef(are, aim, ldt, sp, cr, ci);
                const float br = bre[sp * 16 + c2], bi = bim[sp * 16 + c2];
                const float bbr = cr * br - ci * bi, bbi = cr * bi + ci * br;
                const float xr = cre[(g * 16 + c) * 64 + p], xi = cim[(g * 16 + c) * 64 + p];
                float tr = xr * bbr - xi * bbi, ti = xr * bbi + xi * bbr;
#pragma unroll
                for (int d = 0; d < 16; ++d) { km[d] += tr; const float nr = tr * ar - ti * ai, ni = tr * ai + ti * ar; tr = nr; ti = ni; } }
#pragma unroll
            for (int d = 0; d < 16; ++d) { km[d] += __shfl_xor(km[d], 1); km[d] += __shfl_xor(km[d], 2); }
#pragma unroll
            for (int d = 0; d < 16; ++d) if ((d & 3) == pq) { const bf16_t kb = f2bf(km[d]);
                for (int i = d; i < 16; ++i) wy[(size_t)(g * 256 + i * 16 + c) * 384 + 128 + (i - d) * 16 + c2] = kb;
                if (d > 0) for (int i = 0; i < 16 - d; ++i) wy[(size_t)(g * 256 + i * 16 + c) * 384 + 128 + (i + d) * 16 + c2] = (bf16_t)0; }
        }
    }
}

__device__ __forceinline__ void prep_x(AP a, const int wv_) {
    bf16_t* xb = (bf16_t*)(a->ws + OFF_XB);
    const int gt = blockIdx.x * NTHR + otid(wv_), GT = gridDim.x * NTHR;
    for (int idx = gt; idx < M * 128; idx += GT) {
        const size_t e = (size_t)idx * 8; const float* src = e < (size_t)MP * 1024 ? a->in[I_XP] + e : a->in[I_XS] + (e - (size_t)MP * 1024);
        const f32x4 v0 = *(const f32x4*)src, v1 = *(const f32x4*)(src + 4);
        *(u32x4*)(xb + e) = pack8(v0, v1);
    }
}

__device__ __forceinline__ void conv_phase(AP a, int layer, bf16_t* bin_out, const int wv_) {
    unsigned char* ws = a->ws;
    const bf16_t* xa = (const bf16_t*)(ws + OFF_R); bf16_t* sb = (bf16_t*)(ws + OFF_R + S17);
    const bf16_t* sc = (const bf16_t*)(ws + OFF_R + 2 * S17); const bf16_t* sh = (const bf16_t*)(ws + OFF_R + 3 * S17);
    bf16_t* xac = (bf16_t*)(ws + OFF_XB);
    const float* caw = a->in[I_CAW] + layer * 4 * 512; const float* cab = a->in[I_CAB] + layer * 512; const float* cbw = a->in[I_CBW] + layer * 3 * 512;
    const int gt = blockIdx.x * NTHR + otid(wv_), GT = gridDim.x * NTHR;
    for (int idx = gt; idx < (2048 + 128) * 64; idx += GT) {
        const int seg = idx >> 6, c0 = (idx & 63) * 8;
        const bool prompt = seg < 2048;
        int row0, nrows;
        float x0[8], x1[8], x2[8], u1[8], u2[8];
        if (prompt) { row0 = seg * 8; nrows = 8; const bool first = (seg & 255) == 0;
            if (first) {
#pragma unroll
                for (int j = 0; j < 8; ++j) { x0[j] = 0.f; x1[j] = 0.f; x2[j] = 0.f; u1[j] = 0.f; u2[j] = 0.f; }
            } else {
                unpack8(*(const u32x4*)(xa + (size_t)(row0 - 3) * 512 + c0), x0); unpack8(*(const u32x4*)(xa + (size_t)(row0 - 2) * 512 + c0), x1); unpack8(*(const u32x4*)(xa + (size_t)(row0 - 1) * 512 + c0), x2);
                float s1[8], s2[8];
                unpack8(*(const u32x4*)(sc + (size_t)(row0 - 2) * 512 + c0), u1); unpack8(*(const u32x4*)(sh + (size_t)(row0 - 2) * 512 + c0), s1);
                unpack8(*(const u32x4*)(sc + (size_t)(row0 - 1) * 512 + c0), u2); unpack8(*(const u32x4*)(sh + (size_t)(row0 - 1) * 512 + c0), s2);
#pragma unroll
                for (int j = 0; j < 8; ++j) { u1[j] *= s1[j]; u2[j] *= s2[j]; }
            }
        } else { const int b = seg - 2048; row0 = MP + b * 4; nrows = 4;
            const float* lc = a->in[I_SLC] + ((size_t)(layer * 128 + b) * 3) * 512 + c0; const float* scs = a->in[I_SSC] + ((size_t)(layer * 128 + b) * 2) * 512 + c0;
#pragma unroll
            for (int j = 0; j < 8; ++j) { x0[j] = lc[j]; x1[j] = lc[512 + j]; x2[j] = lc[1024 + j]; u1[j] = scs[j]; u2[j] = scs[512 + j]; }
        }
        float w0[8], w1[8], w2[8], w3[8], wb[8], v0[8], v1[8], v2[8];
#pragma unroll
        for (int j = 0; j < 8; ++j) { w0[j] = caw[c0 + j]; w1[j] = caw[512 + c0 + j]; w2[j] = caw[1024 + c0 + j]; w3[j] = caw[1536 + c0 + j]; wb[j] = cab[c0 + j];
            v0[j] = cbw[c0 + j]; v1[j] = cbw[512 + c0 + j]; v2[j] = cbw[1024 + c0 + j]; }
        for (int t0 = 0; t0 < nrows; t0 += 2) {
            u32x4 lx[2], lc[2], lh[2], lb[2];
#pragma unroll
            for (int k = 0; k < 2; ++k) { const size_t off = (size_t)(row0 + t0 + k) * 512 + c0;
                lx[k] = *(const u32x4*)(xa + off); lc[k] = *(const u32x4*)(sc + off); lh[k] = *(const u32x4*)(sh + off); lb[k] = *(const u32x4*)(sb + off); }
#pragma unroll
            for (int k = 0; k < 2; ++k) { const size_t off = (size_t)(row0 + t0 + k) * 512 + c0;
                float xv[8], scv[8], shv[8], sbv[8];
                unpack8(lx[k], xv); unpack8(lc[k], scv); unpack8(lh[k], shv); unpack8(lb[k], sbv);
                f32x4 o0, o1, q0, q1;
#pragma unroll
                for (int j = 0; j < 8; ++j) {
                    const float o = w0[j] * x0[j] + w1[j] * x1[j] + w2[j] * x2[j] + w3[j] * xv[j] + wb[j];
                    const float uu = scv[j] * shv[j]; const float cu = v0[j] * u1[j] + v1[j] * u2[j] + v2[j] * uu; const float bi = sbv[j] * cu;
                    if (j < 4) { o0[j] = o; q0[j] = bi; } else { o1[j - 4] = o; q1[j - 4] = bi; }
                    x0[j] = x1[j]; x1[j] = x2[j]; x2[j] = xv[j]; u1[j] = u2[j]; u2[j] = uu;
                }
                *(u32x4*)(xac + off) = pack8(o0, o1);
                *(u32x4*)(bin_out + off) = pack8(q0, q1); }
        }
        if (prompt) { if ((seg & 255) == 255) { const int b = seg >> 8;
                float* o1 = a->out + O_LCP + ((size_t)(layer * 8 + b) * 3) * 512 + c0; float* o2 = a->out + O_SCP + ((size_t)(layer * 8 + b) * 2) * 512 + c0;
#pragma unroll
                for (int j = 0; j < 8; ++j) { o1[j] = x0[j]; o1[512 + j] = x1[j]; o1[1024 + j] = x2[j]; o2[j] = u1[j]; o2[512 + j] = u2[j]; } }
        } else { const int b = seg - 2048;
            float* o1 = a->out + O_LCS + ((size_t)(layer * 128 + b) * 3) * 512 + c0; float* o2 = a->out + O_SCS + ((size_t)(layer * 128 + b) * 2) * 512 + c0;
#pragma unroll
            for (int j = 0; j < 8; ++j) { o1[j] = x0[j]; o1[512 + j] = x1[j]; o1[1024 + j] = x2[j]; o2[j] = u1[j]; o2[512 + j] = u2[j]; }
        }
    }
}

__device__ __forceinline__ void ssm_s_gemm(AP a, const int wv_) {
    const bf16_t* apack = (const bf16_t*)(a->ws + OFF_APACK); const bf16_t* w1 = (const bf16_t*)(a->ws + OFF_W1T); float* S = (float*)(a->ws + OFF_S);
    const int tid_ = otid(wv_); const int lane = tid_ & 63, wv = blockIdx.x * 8 + (tid_ >> 6), NW = gridDim.x * 8;
    const int lr = lane & 15, kq = lane >> 4;
    for (int t = wv; t < 1024; t += NW) {
        const int g = t >> 5, rt = (t >> 1) & 15, ct = t & 1;
        f32x4 acc[4][4];
#pragma unroll
        for (int i = 0; i < 4; ++i)
#pragma unroll
            for (int j = 0; j < 4; ++j) acc[i][j] = (f32x4){0.f, 0.f, 0.f, 0.f};
        const bf16_t* ab = apack + ((size_t)(g * 1024 + rt * 64 + lr) * 384 + 128 + kq * 8);
        const bf16_t* bb = w1 + ((size_t)(g * 128 + ct * 64 + lr) * 256 + kq * 8);
#pragma unroll 2
        for (int ks = 0; ks < 8; ++ks) {
            bf16x8 af[4], bf[4];
#pragma unroll
            for (int i = 0; i < 4; ++i) { af[i] = *(const bf16x8*)(ab + (size_t)i * 16 * 384 + ks * 32); bf[i] = *(const bf16x8*)(bb + (size_t)i * 16 * 256 + ks * 32); }
#pragma unroll
            for (int i = 0; i < 4; ++i)
#pragma unroll
                for (int j = 0; j < 4; ++j) acc[i][j] = __builtin_amdgcn_mfma_f32_16x16x32_bf16(af[i], bf[j], acc[i][j], 0, 0, 0);
        }
#pragma unroll
        for (int i = 0; i < 4; ++i)
#pragma unroll
            for (int j = 0; j < 4; ++j)
#pragma unroll
                for (int q = 0; q < 4; ++q) S[(size_t)(g * 1024 + rt * 64 + i * 16 + kq * 4 + q) * 128 + ct * 64 + j * 16 + lr] = acc[i][j][q];
    }
}

__device__ __forceinline__ void ssm_carry(AP a, int layer, float* sm, const int wv_) {
    bf16_t* apack = (bf16_t*)(a->ws + OFF_APACK); const float* S = (const float*)(a->ws + OFF_S);
    const int tid = otid(wv_), p = tid & 63, seg = tid >> 6;
    for (int pair = blockIdx.x; pair < 256; pair += gridDim.x) {
        const int b = pair >> 5, g = pair & 31, sp = g * 64 + p;
        float ar, ai, Ar, Ai;
        abar_pow(a->in[I_SAR] + layer * 2048, a->in[I_SAI] + layer * 2048, a->in[I_SDT] + layer * 2048, sp, 16.0f, ar, ai);
        abar_pow(a->in[I_SAR] + layer * 2048, a->in[I_SAI] + layer * 2048, a->in[I_SDT] + layer * 2048, sp, 256.0f, Ar, Ai);
        const size_t rbase = (size_t)g * 1024 + b * 128 + seg * 16;
        float sr[16], si[16];
#pragma unroll
        for (int j = 0; j < 16; ++j) { sr[j] = S[(rbase + j) * 128 + p]; si[j] = S[(rbase + j) * 128 + 64 + p]; }
        float hr = 0.f, hi = 0.f;
#pragma unroll
        for (int j = 0; j < 16; ++j) { const float nr = ar * hr - ai * hi + sr[j], ni = ar * hi + ai * hr + si[j]; sr[j] = hr; si[j] = hi; hr = nr; hi = ni; }
        sm[seg * 128 + p] = hr; sm[seg * 128 + 64 + p] = hi;
        __syncthreads();
        float cr = 0.f, ci = 0.f;
        for (int s2 = 0; s2 < seg; ++s2) { const float er = sm[s2 * 128 + p], ei = sm[s2 * 128 + 64 + p]; const float nr = Ar * cr - Ai * ci + er, ni = Ar * ci + Ai * cr + ei; cr = nr; ci = ni; }
        if (seg == 7) { const float fr_ = Ar * cr - Ai * ci + hr, fi_ = Ar * ci + Ai * cr + hi;
            a->out[O_SRP + (size_t)(layer * 8 + b) * 2048 + sp] = fr_; a->out[O_SIP + (size_t)(layer * 8 + b) * 2048 + sp] = fi_; }
#pragma unroll
        for (int j = 0; j < 16; ++j) { apack[(rbase + j) * 384 + p] = f2bf(sr[j] + cr); apack[(rbase + j) * 384 + 64 + p] = f2bf(si[j] + ci);
            const float nr = ar * cr - ai * ci, ni = ar * ci + ai * cr; cr = nr; ci = ni; }
        __syncthreads();
    }
}

__device__ __forceinline__ void ssm_sample(AP a, int layer, int wv, int NW, const int wv_) {
    const bf16_t* uss = (const bf16_t*)(a->ws + OFF_USS); bf16_t* zc = (bf16_t*)(a->ws + OFF_ZCS);
    const float* are = a->in[I_SAR] + layer * 2048; const float* aim = a->in[I_SAI] + layer * 2048; const float* ldt = a->in[I_SDT] + layer * 2048;
    const float* bre = a->in[I_SBR] + layer * 32768; const float* bim = a->in[I_SBI] + layer * 32768;
    const float* cre = a->in[I_SCR] + layer * 32768; const float* cim = a->in[I_SCI] + layer * 32768; const float* dv = a->in[I_SD] + layer * 512;
    const int lane = otid(wv_) & 63;
    for (int t = wv; t < 128 * 32; t += NW) {
        const int b = t >> 5, g = t & 31, sp = g * 64 + lane;
        float ar, ai, cr, ci; abar_pow(are, aim, ldt, sp, 1.0f, ar, ai); ssm_coef(are, aim, ldt, sp, cr, ci);
        float bbr[16], bbi[16], xr[16], xi[16];
#pragma unroll
        for (int c = 0; c < 16; ++c) { const float br = bre[sp * 16 + c], bi = bim[sp * 16 + c]; bbr[c] = cr * br - ci * bi; bbi[c] = cr * bi + ci * br;
            xr[c] = cre[(g * 16 + c) * 64 + lane]; xi[c] = cim[(g * 16 + c) * 64 + lane]; }
        float hr = a->in[I_SSR][(size_t)(layer * 128 + b) * 2048 + sp], hi = a->in[I_SSI][(size_t)(layer * 128 + b) * 2048 + sp];
        const float dme = lane < 16 ? dv[g * 16 + lane] : 0.f;
        for (int tt = 0; tt < 4; ++tt) {
            const bf16_t* up = uss + (size_t)(b * 4 + tt) * 512 + g * 16;
            const u32x4 w0 = *(const u32x4*)up, w1 = *(const u32x4*)(up + 8);
            float u[16]; { float t0[8], t1[8]; unpack8(w0, t0); unpack8(w1, t1);
#pragma unroll
                for (int c = 0; c < 8; ++c) { u[c] = t0[c]; u[8 + c] = t1[c]; } }
            float br_ = 0.f, bi_ = 0.f;
#pragma unroll
            for (int c = 0; c < 16; ++c) { br_ += bbr[c] * u[c]; bi_ += bbi[c] * u[c]; }
            const float nr = ar * hr - ai * hi + br_, ni = ar * hi + ai * hr + bi_; hr = nr; hi = ni;
            float mine = 0.f, ume = 0.f;
#pragma unroll
            for (int c = 0; c < 16; ++c) { float y = xr[c] * hr - xi[c] * hi;
#pragma unroll
                for (int o = 32; o >= 1; o >>= 1) y += __shfl_xor(y, o);
                if (lane == c) { mine = y; ume = u[c]; } }
            if (lane < 16) zc[(size_t)(b * 4 + tt) * 512 + g * 16 + lane] = f2bf(gelu_t(mine + dme * ume));
        }
        a->out[O_SRS + (size_t)(layer * 128 + b) * 2048 + sp] = hr; a->out[O_SIS + (size_t)(layer * 128 + b) * 2048 + sp] = hi;
    }
}

__device__ __forceinline__ void lru_local(AP a, const int wv_) {
    const float* av = (const float*)(a->ws + OFF_R + 2 * S17); const bf16_t* bx = (const bf16_t*)(a->ws + OFF_R); f32x2* car = (f32x2*)(a->ws + OFF_CAR);
    const int gt = blockIdx.x * NTHR + otid(wv_), GT = gridDim.x * NTHR;
    for (int idx = gt; idx < 8 * 32 * 512; idx += GT) {
        const int c = idx & 511, sc = idx >> 9;
        const size_t base = (size_t)sc * 64 * 512 + c;
        float P = 1.f, h = 0.f;
        for (int t0 = 0; t0 < 64; t0 += 16) {
            float aa[16]; bf16_t bb[16];
#pragma unroll
            for (int j = 0; j < 16; ++j) { aa[j] = av[base + (size_t)(t0 + j) * 512]; bb[j] = bx[base + (size_t)(t0 + j) * 512]; }
#pragma unroll
            for (int j = 0; j < 16; ++j) { h = aa[j] * h + bf2f(bb[j]); P *= aa[j]; }
        }
        car[idx] = (f32x2){P, h};
    }
}
template <int B>
__device__ __forceinline__ float lru_run(const float* av, const bf16_t* bx, bf16_t* ao, const bf16_t* ya, size_t base, int n, float h) {
    for (int t0 = 0; t0 < n; t0 += B) {
        float aa[B]; bf16_t bb[B], yy[B];
#pragma unroll
        for (int j = 0; j < B; ++j) { const size_t o = base + (size_t)(t0 + j) * 512; aa[j] = av[o]; bb[j] = bx[o]; yy[j] = ya[o]; }
        bf16_t oo[B];
#pragma unroll
        for (int j = 0; j < B; ++j) { h = aa[j] * h + bf2f(bb[j]); oo[j] = f2bf(h * gelu_t(bf2f(yy[j]))); }
#pragma unroll
        for (int j = 0; j < B; ++j) ao[base + (size_t)(t0 + j) * 512] = oo[j];
    }
    return h;
}
__device__ __forceinline__ void lru_apply(AP a, int layer, bf16_t* ao, int mode, const int wv_) {
    const float* av = (const float*)(a->ws + OFF_R + 2 * S17); const bf16_t* bx = (const bf16_t*)(a->ws + OFF_R); const f32x2* car = (const f32x2*)(a->ws + OFF_CAR);
    const bf16_t* ya = (const bf16_t*)(a->ws + OFF_YA);
    const int G = gridDim.x, bid = blockIdx.x;
    if (mode == 0) {
        if (bid >= G - 8) return;
        const int GP = G - 8; int v = bid - 128; if (v < 0) v += GP;
        for (int idx = v * NTHR + otid(wv_); idx < 8 * 32 * 512; idx += GP * NTHR) {
            const int c = idx & 511, sc = idx >> 9, seq = sc >> 5, chunk = sc & 31;
            float h = 0.f;
            f32x2 ph[31];
#pragma unroll
            for (int k = 0; k < 31; ++k) ph[k] = car[(seq * 32 + (k < chunk ? k : 0)) * 512 + c];
#pragma unroll
            for (int k = 0; k < 31; ++k) if (k < chunk) h = ph[k].x * h + ph[k].y;
            h = lru_run<8>(av, bx, ao, ya, (size_t)sc * 64 * 512 + c, 64, h);
            if (chunk == 31) a->out[O_LHP + (size_t)(layer * 8 + seq) * 512 + c] = h;
        }
    } else {
        for (int j = bid * NTHR + otid(wv_); j < 128 * 512; j += G * NTHR) {
            const int c = j & 511, b = j >> 9;
            float h = a->in[I_SLH][(size_t)(layer * 128 + b) * 512 + c];
            h = lru_run<4>(av, bx, ao, ya, (size_t)(MP + b * 4) * 512 + c, 4, h);
            a->out[O_LHS + (size_t)(layer * 128 + b) * 512 + c] = h;
        }
    }
}

__device__ __forceinline__ void ln_phase(const float* src, float* dst32, bf16_t* dst16, const float* gam, const float* bet, const float scale32, const float* part, const int wv_) {
    const int tid_ = otid(wv_); const int lane = tid_ & 63, wv = blockIdx.x * 8 + (tid_ >> 6), NW = gridDim.x * 8;
    for (int r0 = wv; r0 < M; r0 += 3 * NW) {
        f32x4 v[3][4];
#pragma unroll
        for (int k = 0; k < 3; ++k) { const int r = r0 + k * NW; const float* row = src + (size_t)(r < M ? r : r0) * 1024;
#pragma unroll
            for (int i = 0; i < 4; ++i) v[k][i] = *(const f32x4*)(row + i * 256 + lane * 4);
            if (r >= MP && r < M) {
#pragma unroll
                for (int q = 0; q < 3; ++q)
#pragma unroll
                    for (int i = 0; i < 4; ++i) v[k][i] += *(const f32x4*)(part + (size_t)q * PART_STRIDE + (size_t)(r - MP) * 1024 + i * 256 + lane * 4); } }
#pragma unroll
        for (int k = 0; k < 3; ++k) { const int r = r0 + k * NW;
            float s = 0.f;
#pragma unroll
            for (int i = 0; i < 4; ++i) s += (v[k][i][0] + v[k][i][1]) + (v[k][i][2] + v[k][i][3]);
#pragma unroll
            for (int o = 32; o >= 1; o >>= 1) s += __shfl_xor(s, o);
            const float mu = s * (1.0f / 1024.0f); float q = 0.f;
#pragma unroll
            for (int i = 0; i < 4; ++i) { const f32x4 d = v[k][i] - mu; q += (d[0] * d[0] + d[1] * d[1]) + (d[2] * d[2] + d[3] * d[3]); }
#pragma unroll
            for (int o = 32; o >= 1; o >>= 1) q += __shfl_xor(q, o);
            const float rs = rsqrtf(q * (1.0f / 1024.0f) + LN_EPS);
            if (r < M) {
#pragma unroll
                for (int i = 0; i < 4; ++i) { const int col = i * 256 + lane * 4; const f32x4 gg = *(const f32x4*)(gam + col), bb = *(const f32x4*)(bet + col);
                    const f32x4 y = (v[k][i] - mu) * rs * gg + bb;
                    *(f32x4*)(dst32 + (size_t)r * 1024 + col) = y * scale32;
                    u32x2 w; w.x = cvt_pk_bf16(y[0], y[1]); w.y = cvt_pk_bf16(y[2], y[3]);
                    *(u32x2*)(dst16 + (size_t)r * 1024 + col) = w; }
            }
        }
    }
}

__global__ void __launch_bounds__(NTHR, 2) fwd_megakernel(Args a_unused) {
    extern __shared__ __attribute__((aligned(16))) unsigned char lds_raw[];
    cg::grid_group grid = cg::this_grid();
    LAS unsigned char* lds = (LAS unsigned char*)lds_raw;
    const int G = gridDim.x, bid = blockIdx.x;
    const int wv_ = __builtin_amdgcn_readfirstlane((int)threadIdx.x >> 6);

    for (int rep = 0; rep < REP_PREP; ++rep) { const AP a = ld_args(); prep_layer(a, 0, (float*)lds_raw, wv_); prep_x(a, wv_); }
    grid.sync();
    unsigned bar_n = 0; unsigned* bar_ctr; { const AP a = ld_args(); bar_ctr = (unsigned*)(a->ws + OFF_BAR); }

#pragma unroll 1
    for (int layer = 0; layer < 2; ++layer) {
        { const AP a = ld_args(); unsigned char* ws = a->ws;
          PG1 p; p.K = 1024; p.lda = 1024; p.ldb = 1024; p.G = G; p.c = bid; p.A = (const bf16_t*)(ws + OFF_XB); p.Bt = (const bf16_t*)(ws + OFF_WIN);
          p.xa = (bf16_t*)(ws + OFF_R); p.ya = (bf16_t*)(ws + OFF_YA); p.sb = (bf16_t*)(ws + OFF_R + S17); p.sc = (bf16_t*)(ws + OFF_R + 2 * S17); p.sh = (bf16_t*)(ws + OFF_R + 3 * S17);
          p.apack = (bf16_t*)(ws + OFF_APACK); p.uss = (bf16_t*)(ws + OFF_USS); p.gl8 = ws + OFF_GL8;
          for (int rep = 0; rep < REP_G1; ++rep) gemm_phase(lds, p, wv_); }
        GSYNC();
        if (DRY_CONV) { const AP a = ld_args(); conv_phase(a, layer, (bf16_t*)(a->ws + OFF_XB + S17), wv_); }
        { const AP a = ld_args(); conv_phase(a, layer, (bf16_t*)(a->ws + OFF_R + S17), wv_); }
        for (int rep = 0; rep < REP_SG; ++rep) { const AP a = ld_args(); ssm_s_gemm(a, wv_); }
        GSYNC();
        for (int rep = 0; rep < REP_CARRY; ++rep) { const AP a = ld_args(); ssm_carry(a, layer, (float*)lds_raw, wv_); }
        { const AP a = ld_args(); unsigned char* ws = a->ws;
          PGate p; p.K = 512; p.lda = 512; p.ldb = 512; p.G = G; p.c = bid; p.A = (const bf16_t*)(ws + OFF_XB); p.Bt = (const bf16_t*)(ws + OFF_WGATE);
          p.gxb = a->in[I_GXB] + layer * 512; p.gab = a->in[I_GAB] + layer * 512; p.lam = a->in[I_LAM] + layer * 512;
          p.aout = (float*)(ws + OFF_R + 2 * S17); p.bxout = (bf16_t*)(ws + OFF_R);
          for (int rep = 0; rep < REP_GATE; ++rep) gemm_phase(lds, p, wv_); }
        for (int rep = 0; rep < REP_SAMPLE; ++rep) if (bid >= 8) { const AP a = ld_args(); ssm_sample(a, layer, (bid - 8) * 8 + wv_, (G - 8) * 8, wv_); }
        GSYNC();
        { const AP a = ld_args(); unsigned char* ws = a->ws;
          PY p; p.K = 384; p.lda = 384; p.ldb = 384; p.G = G; p.c = bid; p.apack = (const bf16_t*)(ws + OFF_APACK); p.wyt = (const bf16_t*)(ws + OFF_WYT);
          p.dvec = a->in[I_SD] + layer * 512; p.zc = (bf16_t*)(ws + OFF_XB);
          for (int rep = 0; rep < REP_Y; ++rep) gemm_phase(lds, p, wv_); }
        { const AP a = ld_args(); unsigned char* ws = a->ws;
          PGlu p; p.K = 512; p.lda = 512; p.ldb = 512; p.G = G; p.c = bid; p.sample = 1; p.A = (const bf16_t*)(ws + OFF_XB); p.As = (const bf16_t*)(ws + OFF_ZCS); p.Bt = (const bf16_t*)(ws + OFF_WGLU);
          p.bias = a->in[I_GLB] + layer * 512; p.out = (bf16_t*)(ws + OFF_XB + S17);
          gemm_phase(lds, p, wv_); }
        { const AP a = ld_args(); lru_apply(a, layer, (bf16_t*)(a->ws + OFF_R), 1, wv_); }
        for (int rep = 0; rep < REP_LOCAL; ++rep) { const AP a = ld_args(); lru_local(a, wv_); }
        GSYNC();
        { const AP a = ld_args(); unsigned char* ws = a->ws;
          PGlu p; p.K = 512; p.lda = 512; p.ldb = 512; p.G = G; p.c = bid; p.sample = 0; p.A = (const bf16_t*)(ws + OFF_XB); p.As = (const bf16_t*)(ws + OFF_ZCS); p.Bt = (const bf16_t*)(ws + OFF_WGLU);
          p.bias = a->in[I_GLB] + layer * 512; p.out = (bf16_t*)(ws + OFF_XB + S17);
          for (int rep = 0; rep < REP_GLU; ++rep) gemm_phase(lds, p, wv_); }
        { const AP a = ld_args(); unsigned char* ws = a->ws;
          PMerge p; p.K = 512; p.lda = 512; p.ldb = 512; p.G = G; p.c = bid; p.sample = 1; p.a0 = (const bf16_t*)(ws + OFF_R);
          p.wp = (const bf16_t*)(ws + OFF_WP); p.gl8 = ws + OFF_GL8; p.mb = (bf16_t*)(ws + OFF_MB);
          gemm_phase(lds, p, wv_); }
        if (DRY_APPLY) { const AP a = ld_args(); lru_apply(a, layer, (bf16_t*)(a->ws + OFF_S), 0, wv_); }
        { const AP a = ld_args(); lru_apply(a, layer, (bf16_t*)(a->ws + OFF_R), 0, wv_); }
        GSYNC();
        { const AP a = ld_args(); unsigned char* ws = a->ws;
          PMerge p; p.K = 512; p.lda = 512; p.ldb = 512; p.G = G; p.c = bid; p.sample = 0; p.a0 = (const bf16_t*)(ws + OFF_R);
          p.wp = (const bf16_t*)(ws + OFF_WP); p.gl8 = ws + OFF_GL8; p.mb = (bf16_t*)(ws + OFF_MB);
          for (int rep = 0; rep < REP_MERGE; ++rep) gemm_phase(lds, p, wv_); }
        GSYNC();
        { const AP a = ld_args(); unsigned char* ws = a->ws;
          PWout p; p.K = 1024; p.lda = 1024; p.ldb = 1024; p.G = G; p.c = bid; p.A = (const bf16_t*)(ws + OFF_MB); p.Bt = (const bf16_t*)(ws + OFF_WOUT);
          p.xp = layer == 0 ? a->in[I_XP] : a->out; p.xs = layer == 0 ? a->in[I_XS] : a->out + (size_t)MP * 1024; p.R = (float*)(ws + OFF_R); p.part = (float*)(ws + OFF_PW);
          gemm_phase(lds, p, wv_); }
        GSYNC();
        if (DRY_LN1) { const AP a = ld_args(); unsigned char* ws = a->ws;
          ln_phase((const float*)(ws + OFF_R), a->out, (bf16_t*)(ws + OFF_XB), a->in[I_L1G] + layer * 1024, a->in[I_L1B] + layer * 1024, ALPHA, (const float*)(ws + OFF_PW), wv_); }
        { const AP a = ld_args(); unsigned char* ws = a->ws;
          ln_phase((const float*)(ws + OFF_R), (float*)(ws + OFF_R), (bf16_t*)(ws + OFF_XB), a->in[I_L1G] + layer * 1024, a->in[I_L1B] + layer * 1024, ALPHA, (const float*)(ws + OFF_PW), wv_); }
        GSYNC();
        { const AP a = ld_args(); unsigned char* ws = a->ws;
          PUp p; p.K = 1024; p.lda = 1024; p.ldb = 1024; p.G = G; p.c = bid; p.A = (const bf16_t*)(ws + OFF_XB); p.Bt = (const bf16_t*)(ws + OFF_WUP); p.h = (bf16_t*)(ws + OFF_H);
          for (int rep = 0; rep < REP_UP; ++rep) gemm_phase(lds, p, wv_); }
        GSYNC();
        { const AP a = ld_args(); unsigned char* ws = a->ws;
          PDown p; p.K = 4096; p.lda = 4096; p.ldb = 4096; p.G = G; p.c = bid; p.A = (const bf16_t*)(ws + OFF_H); p.Bt = (const bf16_t*)(ws + OFF_WDOWN); p.R = (float*)(ws + OFF_R); p.part = (float*)(ws + OFF_PD);
          gemm_phase(lds, p, wv_); }
        GSYNC();
        for (int rep = 0; rep < REP_LN2; ++rep) { const AP a = ld_args(); unsigned char* ws = a->ws;
          ln_phase((const float*)(ws + OFF_R), a->out, (bf16_t*)(ws + OFF_XB), a->in[I_L2G] + layer * 1024, a->in[I_L2B] + layer * 1024, 1.0f, (const float*)(ws + OFF_PD), wv_); }
        if (layer == 0) { __syncthreads(); for (int rep = 0; rep < REP_PREP; ++rep) { const AP a = ld_args(); prep_layer(a, 1, (float*)lds_raw, wv_); } GSYNC(); }
    }
}

extern "C" void kernel_launch(void* const* d_in, const int* in_sizes, int n_in, void* d_out, int out_size, void* d_ws, size_t ws_size, hipStream_t stream) {
    constexpr size_t kDynLds = STAGE_BYTES;
    static int grid_blocks = 0;
    if (!grid_blocks) {
        int dev = 0, cus = 0, per_cu = 0;
        hipGetDevice(&dev);
        hipDeviceGetAttribute(&cus, hipDeviceAttributeMultiprocessorCount, dev);
        hipFuncSetAttribute((const void*)fwd_megakernel, hipFuncAttributeMaxDynamicSharedMemorySize, (int)kDynLds);
        hipOccupancyMaxActiveBlocksPerMultiprocessor(&per_cu, (const void*)fwd_megakernel, NTHR, kDynLds);
        if (per_cu < 1) per_cu = 1;
        grid_blocks = cus * per_cu;
        if (grid_blocks > 256) grid_blocks = 256;
        if (ws_size < WS_END || n_in != 36) fprintf(stderr, "kernel_launch: unexpected ws_size %zu (need %zu) or n_in %d\n", ws_size, (size_t)WS_END, n_in);
    }
    (void)hipMemsetAsync((char*)d_ws + OFF_BAR, 0, 256, stream);
    Args a{};
    for (int i = 0; i < 36; ++i) a.in[i] = (const float*)d_in[i];
    a.out = (float*)d_out; a.ws = (unsigned char*)d_ws;
    void* args[] = {&a};
    hipError_t e = hipLaunchCooperativeKernel((const void*)fwd_megakernel, dim3(grid_blocks), dim3(NTHR), args, kDynLds, stream);
    if (e != hipSuccess) fprintf(stderr, "cooperative launch failed: %s (grid %d)\n", hipGetErrorString(e), grid_blocks);
}
```

```cpp
#include <hip/hip_runtime.h>
#include <hip/hip_cooperative_groups.h>
#include <cstdio>
namespace cg = cooperative_groups;
#define REP_GEMM 1
#define REP_G1 REP_GEMM
#define REP_GATE REP_GEMM
#define REP_Y REP_GEMM
#define REP_GLU REP_GEMM
#define REP_MERGE REP_GEMM
#define REP_UP REP_GEMM
#define REP_ELEM 1
#define REP_PREP REP_ELEM
#define REP_SG REP_ELEM
#define REP_CARRY REP_ELEM
#define REP_SAMPLE REP_ELEM
#define REP_LOCAL REP_ELEM
#define REP_LN2 REP_ELEM
#define DRY_CONV 0
#define DRY_APPLY 0
#define DRY_LN1 0
#define REP_SYNC 1
#define GSYNC() do { for (int _s = 0; _s < REP_SYNC; ++_s) { bar_n += (unsigned)G; gbar(bar_ctr, bar_n, wv_); } } while (0)

#define LAS __attribute__((address_space(3)))
typedef unsigned short bf16_t;
typedef short bf16x8 __attribute__((ext_vector_type(8)));
typedef float f32x4 __attribute__((ext_vector_type(4)));
typedef float f32x2 __attribute__((ext_vector_type(2)));
typedef unsigned u32x4 __attribute__((ext_vector_type(4)));
typedef unsigned u32x2 __attribute__((ext_vector_type(2)));

constexpr int MP = 16384, MS = 512, M = MP + MS, D = 1024, NIN = 6144, BW = 512, DFF = 4096;
constexpr int NTHR = 512;
constexpr float ALPHA = 1.41421356237f;
constexpr float LN_EPS = 1e-5f;

constexpr size_t S17 = (size_t)M * 512 * 2;
constexpr size_t OFF_WUP = 0;
constexpr size_t OFF_WDOWN = OFF_WUP + (size_t)4096 * 1024 * 2;
constexpr size_t OFF_R = OFF_WDOWN + (size_t)4096 * 1024 * 2;
constexpr size_t OFF_XB = OFF_R + 4 * S17;
constexpr size_t OFF_BIG = OFF_XB + 2 * S17;
constexpr size_t OFF_H = OFF_BIG;
constexpr size_t OFF_WIN = OFF_BIG;
constexpr size_t OFF_WP = OFF_WIN + (size_t)6144 * 1024 * 2;
constexpr size_t OFF_WGLU = OFF_WP + (size_t)3 * 1024 * 512 * 2;
constexpr size_t OFF_WOUT = OFF_WGLU + (size_t)512 * 512 * 2;
constexpr size_t OFF_WGATE = OFF_WOUT + (size_t)1024 * 1024 * 2;
constexpr size_t OFF_W1T = OFF_WGATE + (size_t)1024 * 512 * 2;
constexpr size_t OFF_WYT = OFF_W1T + (size_t)32 * 128 * 256 * 2;
constexpr size_t OFF_GL8 = OFF_WYT + (size_t)32 * 256 * 384 * 2;
constexpr size_t OFF_YA = OFF_GL8 + (size_t)M * 3072;
constexpr size_t OFF_APACK = OFF_YA + S17;
constexpr size_t OFF_S = OFF_APACK + (size_t)32 * 1024 * 384 * 2;
constexpr size_t OFF_MB = OFF_APACK;
constexpr size_t OFF_USS = OFF_S + (size_t)32 * 1024 * 128 * 4;
constexpr size_t OFF_CAR = OFF_USS + (size_t)512 * 512 * 2;
constexpr size_t OFF_BAR = OFF_CAR + (size_t)8 * 32 * 512 * 8;
constexpr size_t OFF_PD = OFF_BAR + 256;
constexpr size_t OFF_PW = OFF_GL8;
constexpr size_t PART_STRIDE = (size_t)MS * 1024;
constexpr size_t OFF_ZCS = OFF_PD + 3 * PART_STRIDE * 4;
constexpr size_t WS_END = OFF_ZCS + (size_t)MS * 512 * 2;
static_assert(OFF_PD >= OFF_H + (size_t)M * 4096 * 2, "down partials must not overlap h");
static_assert(WS_END <= (size_t)268435456, "workspace map exceeds 256 MiB");
static_assert(OFF_MB + (size_t)M * 1024 * 2 <= OFF_USS, "m overlay");
static_assert(OFF_H + (size_t)M * 4096 * 2 <= (size_t)268435456, "h overlay");

constexpr size_t O_Y = 0;
constexpr size_t O_LCP = (size_t)M * 1024;
constexpr size_t O_LHP = O_LCP + 2 * 8 * 3 * 512;
constexpr size_t O_SCP = O_LHP + 2 * 8 * 512;
constexpr size_t O_SRP = O_SCP + 2 * 8 * 2 * 512;
constexpr size_t O_SIP = O_SRP + 2 * 8 * 2048;
constexpr size_t O_LCS = O_SIP + 2 * 8 * 2048;
constexpr size_t O_LHS = O_LCS + 2 * 128 * 3 * 512;
constexpr size_t O_SCS = O_LHS + 2 * 128 * 512;
constexpr size_t O_SRS = O_SCS + 2 * 128 * 2 * 512;
constexpr size_t O_SIS = O_SRS + 2 * 128 * 2048;

struct Args { const float* in[36]; float* out; unsigned char* ws; };
typedef const __attribute__((address_space(4))) Args* AP;
__device__ __forceinline__ AP ld_args() {
#if defined(__HIP_DEVICE_COMPILE__)
    auto p = __builtin_amdgcn_kernarg_segment_ptr();
    asm volatile("" : "+s"(p));
    return (AP)p;
#else
    return nullptr;
#endif
}
enum { I_XP = 0, I_XS, I_SLC, I_SLH, I_SSC, I_SSR, I_SSI, I_WIN, I_CAW, I_CAB, I_GXW, I_GXB, I_GAW, I_GAB, I_LAM, I_CBW, I_SAR, I_SAI, I_SDT,
       I_SBR, I_SBI, I_SCR, I_SCI, I_SD, I_GLW, I_GLB, I_PA, I_PB, I_PC, I_WO, I_L1G, I_L1B, I_UP, I_DN, I_L2G, I_L2B };

__device__ __forceinline__ unsigned cvt_pk_bf16(float lo, float hi) { unsigned r; asm volatile("v_cvt_pk_bf16_f32 %0, %1, %2" : "=v"(r) : "v"(lo), "v"(hi)); return r; }
__device__ __forceinline__ bf16_t f2bf(float f) { return (bf16_t)(cvt_pk_bf16(f, 0.f) & 0xffffu); }
__device__ __forceinline__ float bf2f(unsigned short b) { return __uint_as_float(((unsigned)b) << 16); }
__device__ __forceinline__ float bflo(unsigned w) { return __uint_as_float(w << 16); }
__device__ __forceinline__ float bfhi(unsigned w) { return __uint_as_float(w & 0xffff0000u); }
__device__ __forceinline__ float sigm(float x) { return 1.0f / (1.0f + __expf(-x)); }
__device__ __forceinline__ float gelu_t(float x) { const float u = 0.7978845608f * (x + 0.044715f * x * x * x); return x / (1.0f + __expf(-2.0f * u)); }
__device__ __forceinline__ u32x4 pack8(const f32x4 a, const f32x4 b) { u32x4 w; w.x = cvt_pk_bf16(a[0], a[1]); w.y = cvt_pk_bf16(a[2], a[3]); w.z = cvt_pk_bf16(b[0], b[1]); w.w = cvt_pk_bf16(b[2], b[3]); return w; }
__device__ __forceinline__ void unpack8(const u32x4 w, float (&f)[8]) { f[0] = bflo(w.x); f[1] = bfhi(w.x); f[2] = bflo(w.y); f[3] = bfhi(w.y); f[4] = bflo(w.z); f[5] = bfhi(w.z); f[6] = bflo(w.w); f[7] = bfhi(w.w); }

__device__ __forceinline__ int otid(const int wv_) { int t = wv_ * 64 + (int)__builtin_amdgcn_mbcnt_hi(~0u, __builtin_amdgcn_mbcnt_lo(~0u, 0u)); asm volatile("" : "+v"(t)); return t; }

__device__ __forceinline__ int opq(int x) { asm volatile("" : "+s"(x)); return x; }

__device__ __forceinline__ void gbar(unsigned* ctr, unsigned target, const int wv_) {
    asm volatile("s_waitcnt vmcnt(0)" ::: "memory");
    __syncthreads();
    if (otid(wv_) == 0) {
        __builtin_amdgcn_fence(__ATOMIC_RELEASE, "agent");
        asm volatile("s_waitcnt vmcnt(0)" ::: "memory");
        __hip_atomic_fetch_add(ctr, 1u, __ATOMIC_RELAXED, __HIP_MEMORY_SCOPE_AGENT);
        while (__hip_atomic_load(ctr, __ATOMIC_RELAXED, __HIP_MEMORY_SCOPE_AGENT) < target) __builtin_amdgcn_s_sleep(1);
        __builtin_amdgcn_fence(__ATOMIC_ACQUIRE, "agent");
        asm volatile("s_waitcnt vmcnt(0)" ::: "memory");
    }
    __syncthreads();
}

constexpr int BM = 256, BK = 64, HALF = 128, HTB = HALF * BK * 2, STAGE_BYTES = 8 * HTB;
__device__ __forceinline__ int lds_byte(int r, int c) { const int st = (r >> 4) * 2 + (c >> 5), rr = r & 15, cc = c & 31, ob = rr * 64 + cc * 2; return st * 1024 + (ob ^ (((ob >> 9) & 1) << 5)); }
__device__ __forceinline__ void stage_rc(int b, int& R, int& C) { const int st = b / 1024, sb = b % 1024, swz = sb ^ (((sb >> 9) & 1) << 5); R = (st >> 1) * 16 + swz / 64; C = (st & 1) * 32 + (swz % 64) / 2; }
__device__ __forceinline__ int perm32(int rho) { const int n = rho >> 4, i = rho & 15; return 8 * (i >> 2) + 4 * n + (i & 3); }
struct Unit { int pm, pn, z; };
__device__ __forceinline__ void tile_map(int L, int nM, int nN, int& pm, int& pn) {
    const int nwg = nM * nN; int wgid = L;
    { const int q = nwg / 8, r = nwg % 8, xcd = wgid % 8, off = wgid / 8; wgid = (xcd < r ? xcd * (q + 1) : r * (q + 1) + (xcd - r) * q) + off; }
    const int nig = 8 * nN, gid = wgid / nig, fm = gid * 8, gsz = (nM - fm) < 8 ? (nM - fm) : 8;
    pm = fm + ((wgid % nig) % gsz); pn = (wgid % nig) / gsz;
}

template <class P>
__device__ __forceinline__ void gemm_phase(LAS unsigned char* lds, const P& p, const int wv_) {
    const int tid = otid(wv_), wid = __builtin_amdgcn_readfirstlane(tid >> 6), lane = tid & 63, wr = wid >> 2, wc = wid & 3, fr = lane & 15, fq = lane >> 4;
    unsigned voffA[2], voffB[2];
#pragma unroll
    for (int i = 0; i < 2; ++i) { int R, C; stage_rc(tid * 16 + i * 8192, R, C); const int Rb = P::PERM ? ((R & ~31) + perm32(R & 31)) : R;
        voffA[i] = (unsigned)(R * p.lda + C) * 2u; voffB[i] = (unsigned)(Rb * p.ldb + C) * 2u; }
    const size_t kstep = (size_t)(BK * 2);
    const size_t hA = (size_t)HALF * p.lda * 2, hB = (size_t)HALF * p.ldb * 2;
    const unsigned ldsw = (unsigned)wid * 1024u;
    const int aoff = lds_byte(wr * 64 + fr, fq * 8), boff = lds_byte(wc * 32 + fr, fq * 8);
#define PG8_SA(b, h) (((b) * 2 + (h)) * HTB)
#define PG8_SB(b, h) ((4 + (b) * 2 + (h)) * HTB)
#define PG8_STAGE(bufoff, gbase, voff) do { _Pragma("unroll") for (int _i = 0; _i < 2; ++_i) \
        __builtin_amdgcn_global_load_lds((const unsigned*)((const char*)(gbase) + (voff)[_i]), (LAS unsigned*)(lds + (bufoff) + ldsw + _i * 8192), 16, 0, 0); } while (0)
#define PG8_LDA(dst, b, h) do { _Pragma("unroll") for (int m = 0; m < 4; ++m) _Pragma("unroll") for (int k = 0; k < 2; ++k) dst[m][k] = *(const LAS bf16x8*)(lds + PG8_SA(b, h) + aoff + m * 2048 + k * 1024); } while (0)
#define PG8_LDB(dst, b, h) do { _Pragma("unroll") for (int n = 0; n < 2; ++n) _Pragma("unroll") for (int k = 0; k < 2; ++k) dst[n][k] = *(const LAS bf16x8*)(lds + PG8_SB(b, h) + boff + n * 2048 + k * 1024); } while (0)
#define PG8_MMA(ai, bj, At, Bt) do { __builtin_amdgcn_s_setprio(1); _Pragma("unroll") for (int m = 0; m < 4; ++m) _Pragma("unroll") for (int n = 0; n < 2; ++n) _Pragma("unroll") for (int k = 0; k < 2; ++k) \
        acc[ai][bj][m][n] = __builtin_amdgcn_mfma_f32_16x16x32_bf16(Bt[n][k], At[m][k], acc[ai][bj][m][n], 0, 0, 0); __builtin_amdgcn_s_setprio(0); } while (0)
#define PG8_WAIT_V(n) asm volatile("s_waitcnt vmcnt(" #n ")" ::: "memory")
#define PG8_WAIT_L(n) asm volatile("s_waitcnt lgkmcnt(" #n ")" ::: "memory")
#define PG8_BAR __builtin_amdgcn_s_barrier()
#define PG8_SCHED __builtin_amdgcn_sched_barrier(0)
    Unit cur, nxt; int ui = 0;
    if (!p.next(0, cur)) return;
    f32x4 acc[2][2][4][2];
#pragma unroll
    for (int a = 0; a < 2; ++a)
#pragma unroll
        for (int b = 0; b < 2; ++b)
#pragma unroll
            for (int m = 0; m < 4; ++m)
#pragma unroll
                for (int n = 0; n < 2; ++n) acc[a][b][m][n] = (f32x4){0.f, 0.f, 0.f, 0.f};
    bf16x8 At[4][2], B0[2][2], B1[2][2];
    const char* cA = p.aptr(cur); const char* cB = p.bptr(cur);
    PG8_STAGE(PG8_SB(0, 0), cB, voffB); PG8_STAGE(PG8_SA(0, 0), cA, voffA); PG8_STAGE(PG8_SB(0, 1), cB + hB, voffB); PG8_STAGE(PG8_SA(0, 1), cA + hA, voffA);
    if (wr == 1) PG8_BAR;
    PG8_WAIT_V(4); PG8_BAR;
    PG8_STAGE(PG8_SB(1, 0), cB + kstep, voffB); PG8_STAGE(PG8_SA(1, 0), cA + kstep, voffA); PG8_STAGE(PG8_SB(1, 1), cB + hB + kstep, voffB);
    PG8_WAIT_V(6); PG8_BAR;
    for (;;) {
        const bool has_next = p.next(ui + 1, nxt);
        const int nt = p.nt(cur);
        const char* nA = has_next ? p.aptr(nxt) : cA; const char* nB = has_next ? p.bptr(nxt) : cB;
        for (int t = 0; t < nt; t += 2) {
            const bool last = (t == nt - 2);
            const char* a1 = cA + (size_t)(t + 1) * kstep;
            const char* a2 = last ? nA : cA + (size_t)(t + 2) * kstep; const char* b2 = last ? nB : cB + (size_t)(t + 2) * kstep;
            const char* a3 = a2 + kstep; const char* b3 = b2 + kstep;
            PG8_LDB(B0, 0, 0); PG8_SCHED; PG8_LDA(At, 0, 0); PG8_STAGE(PG8_SA(1, 1), a1 + hA, voffA);
            PG8_WAIT_L(8); PG8_BAR; PG8_WAIT_L(0); PG8_MMA(0, 0, At, B0); PG8_BAR; PG8_SCHED;
            PG8_LDB(B1, 0, 1); PG8_STAGE(PG8_SB(0, 0), b2, voffB);
            PG8_BAR; PG8_WAIT_L(0); PG8_MMA(0, 1, At, B1); PG8_BAR;
            PG8_LDA(At, 0, 1); PG8_STAGE(PG8_SA(0, 0), a2, voffA);
            PG8_BAR; PG8_WAIT_L(0); PG8_MMA(1, 0, At, B0); PG8_BAR; PG8_SCHED;
            PG8_STAGE(PG8_SB(0, 1), b2 + hB, voffB);
            PG8_WAIT_V(6); PG8_BAR; PG8_MMA(1, 1, At, B1); PG8_BAR;
            PG8_LDB(B0, 1, 0); PG8_SCHED; PG8_LDA(At, 1, 0); PG8_STAGE(PG8_SA(0, 1), a2 + hA, voffA);
            PG8_WAIT_L(8); PG8_BAR; PG8_WAIT_L(0); PG8_MMA(0, 0, At, B0); PG8_BAR; PG8_SCHED;
            PG8_LDB(B1, 1, 1); PG8_STAGE(PG8_SB(1, 0), b3, voffB);
            PG8_BAR; PG8_WAIT_L(0); PG8_MMA(0, 1, At, B1); PG8_BAR;
            PG8_LDA(At, 1, 1); PG8_STAGE(PG8_SA(1, 0), a3, voffA);
            PG8_BAR; PG8_WAIT_L(0); PG8_MMA(1, 0, At, B0); PG8_BAR; PG8_SCHED;
            PG8_STAGE(PG8_SB(1, 1), b3 + hB, voffB);
            PG8_WAIT_V(6); PG8_BAR; PG8_MMA(1, 1, At, B1); PG8_BAR;
        }
        Unit eu = cur;
        asm volatile("" : "+s"(eu.pm), "+s"(eu.pn), "+s"(eu.z));
        const bool rst = p.epi(acc, eu, wr, wc, fr, fq);
        if (!has_next) break;
        if (rst) {
#pragma unroll
            for (int a = 0; a < 2; ++a)
#pragma unroll
                for (int b = 0; b < 2; ++b)
#pragma unroll
                    for (int m = 0; m < 4; ++m)
#pragma unroll
                        for (int n = 0; n < 2; ++n) acc[a][b][m][n] = (f32x4){0.f, 0.f, 0.f, 0.f};
        }
        cur = nxt; cA = nA; cB = nB; ++ui;
    }
    PG8_WAIT_V(0);
    if (wr == 0) PG8_BAR;
    PG8_BAR;
#undef PG8_SA
#undef PG8_SB
#undef PG8_STAGE
#undef PG8_LDA
#undef PG8_LDB
#undef PG8_MMA
#undef PG8_WAIT_V
#undef PG8_WAIT_L
#undef PG8_BAR
#undef PG8_SCHED
}
typedef f32x4 Acc[2][2][4][2];

struct PG1 {
    __device__ __forceinline__ int nt(const Unit&) const { return K / BK; }
    static constexpr bool PERM = true;
    int K, lda, ldb, G, c;
    const bf16_t* A; const bf16_t* Bt;
    bf16_t *xa, *ya, *sb, *sc, *sh, *apack, *uss; unsigned char* gl8;
    __device__ __forceinline__ bool next(int i, Unit& u) const { const long L = (long)i * G + c; if (L >= 66 * 24) return false; tile_map((int)L, 66, 24, u.pm, u.pn); u.z = 0; return true; }
    __device__ __forceinline__ const char* aptr(const Unit& u) const { return (const char*)A + (size_t)u.pm * 256 * 1024 * 2; }
    __device__ __forceinline__ const char* bptr(const Unit& u) const { return (const char*)Bt + (size_t)u.pn * 256 * 1024 * 2; }
    __device__ __forceinline__ bool epi(Acc& acc, const Unit& u, int wr, int wc, int fr, int fq) const {
        const int pn = u.pn;
        if (pn < 10) {
            const int b = pn >> 1; bf16_t* base = b == 0 ? xa : b == 1 ? ya : b == 2 ? sb : b == 3 ? sc : sh;
#pragma unroll
            for (int ai = 0; ai < 2; ++ai)
#pragma unroll
                for (int m = 0; m < 4; ++m) { const size_t r = (size_t)u.pm * 256 + ai * 128 + wr * 64 + m * 16 + fr;
#pragma unroll
                    for (int bj = 0; bj < 2; ++bj) { const int col = (pn & 1) * 256 + bj * 128 + wc * 32 + 8 * fq;
                        *(u32x4*)(base + r * 512 + col) = pack8(acc[ai][bj][m][0], acc[ai][bj][m][1]); } }
        } else if (pn < 12) {
#pragma unroll
            for (int ai = 0; ai < 2; ++ai)
#pragma unroll
                for (int m = 0; m < 4; ++m) { const int r = u.pm * 256 + ai * 128 + wr * 64 + m * 16 + fr;
#pragma unroll
                    for (int bj = 0; bj < 2; ++bj) { const int cc = (pn - 10) * 256 + bj * 128 + wc * 32 + 8 * fq;
                        bf16_t* dst = (u.pm < 64) ? apack + ((size_t)((cc >> 4) * 1024 + (r >> 4)) * 384 + 128 + (r & 15) * 16 + (cc & 15)) : uss + (size_t)(r - MP) * 512 + cc;
                        *(u32x4*)dst = pack8(acc[ai][bj][m][0], acc[ai][bj][m][1]); } }
        } else {
            unsigned char* blk = gl8 + ((size_t)(u.pm * 12 + (pn - 12)) << 16) + (size_t)(((wr * 4 + wc) * 64 + fq * 16 + fr) * 128);
#pragma unroll
            for (int ai = 0; ai < 2; ++ai)
#pragma unroll
                for (int m = 0; m < 4; ++m) { u32x4 w;
#pragma unroll
                    for (int bj = 0; bj < 2; ++bj)
#pragma unroll
                        for (int n = 0; n < 2; ++n) { unsigned pk = 0;
#pragma unroll
                            for (int j = 0; j < 4; ++j) { int v = (int)(sigm(acc[ai][bj][m][n][j]) * 256.0f); v = v < 0 ? 0 : (v > 255 ? 255 : v); pk |= (unsigned)v << (8 * j); }
                            w[bj * 2 + n] = pk; }
                    *(u32x4*)(blk + (ai * 4 + m) * 16) = w; }
        }
        return true;
    }
};

struct PGate {
    __device__ __forceinline__ int nt(const Unit&) const { return K / BK; }
    static constexpr bool PERM = false;
    int K, lda, ldb, G, c;
    const bf16_t* A; const bf16_t* Bt;
    const float *gxb, *gab, *lam; float* aout; bf16_t* bxout;
    __device__ __forceinline__ bool next(int i, Unit& u) const { const long L = (long)i * G + c; if (L >= 66 * 4) return false; tile_map((int)L, 66, 4, u.pm, u.pn); u.z = 0; return true; }
    __device__ __forceinline__ const char* aptr(const Unit& u) const { return (const char*)A + (size_t)u.pm * 256 * 512 * 2 + (size_t)(u.pn >> 1) * 512; }
    __device__ __forceinline__ const char* bptr(const Unit& u) const { return (const char*)Bt + (size_t)u.pn * 256 * 256 * 2; }
    __device__ __forceinline__ bool epi(Acc& acc, const Unit& u, int wr, int wc, int fr, int fq) const {
#pragma unroll
        for (int n = 0; n < 2; ++n) {
            const int ch0 = u.pn * 128 + wc * 32 + n * 16 + 4 * fq;
            const f32x4 bx4 = *(const f32x4*)(gxb + ch0), ba4 = *(const f32x4*)(gab + ch0), lm4 = *(const f32x4*)(lam + ch0);
            f32x4 kk;
#pragma unroll
            for (int j = 0; j < 4; ++j) kk[j] = -8.0f * log1pf(expf(-lm4[j]));
#pragma unroll
            for (int ai = 0; ai < 2; ++ai)
#pragma unroll
                for (int m = 0; m < 4; ++m) { const size_t r = (size_t)u.pm * 256 + ai * 128 + wr * 64 + m * 16 + fr;
                    const u32x2 xw = *(const u32x2*)(A + r * 512 + ch0);
                    const float xc[4] = {bflo(xw.x), bfhi(xw.x), bflo(xw.y), bfhi(xw.y)};
                    f32x4 av; float bv[4];
#pragma unroll
                    for (int j = 0; j < 4; ++j) { const float gx = sigm(acc[ai][0][m][n][j] + bx4[j]), ga = sigm(acc[ai][1][m][n][j] + ba4[j]);
                        const float la = kk[j] * ga; av[j] = __expf(la); bv[j] = __builtin_amdgcn_sqrtf(fmaxf(1.0f - av[j] * av[j], 0.f)) * gx * xc[j]; }
                    *(f32x4*)(aout + r * 512 + ch0) = av;
                    u32x2 w; w.x = cvt_pk_bf16(bv[0], bv[1]); w.y = cvt_pk_bf16(bv[2], bv[3]);
                    *(u32x2*)(bxout + r * 512 + ch0) = w; }
        }
        return true;
    }
};

struct PY {
    __device__ __forceinline__ int nt(const Unit&) const { return K / BK; }
    static constexpr bool PERM = true;
    int K, lda, ldb, G, c;
    const bf16_t* apack; const bf16_t* wyt; const float* dvec; bf16_t* zc;
    __device__ __forceinline__ bool next(int i, Unit& u) const { const long L = (long)i * G + c; if (L >= 128) return false; u.pm = (int)L; u.pn = (int)L >> 2; u.z = 0; return true; }
    __device__ __forceinline__ const char* aptr(const Unit& u) const { return (const char*)apack + (size_t)u.pm * 256 * 384 * 2; }
    __device__ __forceinline__ const char* bptr(const Unit& u) const { return (const char*)wyt + (size_t)u.pn * 256 * 384 * 2; }
    __device__ __forceinline__ bool epi(Acc& acc, const Unit& u, int wr, int wc, int fr, int fq) const {
        const int g = u.pn;
#pragma unroll
        for (int bj = 0; bj < 2; ++bj) {
            const int n0 = bj * 128 + wc * 32 + 8 * fq, ti = n0 >> 4, c0 = n0 & 15;
            const f32x4 d0 = *(const f32x4*)(dvec + g * 16 + c0), d1 = *(const f32x4*)(dvec + g * 16 + c0 + 4);
#pragma unroll
            for (int ai = 0; ai < 2; ++ai)
#pragma unroll
                for (int m = 0; m < 4; ++m) { const int rr = (u.pm & 3) * 256 + ai * 128 + wr * 64 + m * 16 + fr;
                    const u32x4 uw = *(const u32x4*)(apack + ((size_t)(g * 1024 + rr) * 384 + 128 + n0));
                    float uf[8]; unpack8(uw, uf);
                    f32x4 y0, y1;
#pragma unroll
                    for (int j = 0; j < 4; ++j) { y0[j] = gelu_t(acc[ai][bj][m][0][j] + d0[j] * uf[j]); y1[j] = gelu_t(acc[ai][bj][m][1][j] + d1[j] * uf[4 + j]); }
                    const size_t tok = (size_t)(rr >> 7) * 2048 + (rr & 127) * 16 + ti;
                    *(u32x4*)(zc + tok * 512 + g * 16 + c0) = pack8(y0, y1); }
        }
        return true;
    }
};

struct PGlu {
    __device__ __forceinline__ int nt(const Unit&) const { return K / BK; }
    static constexpr bool PERM = true;
    int K, lda, ldb, G, c, sample;
    const bf16_t* A; const bf16_t* As; const bf16_t* Bt; const float* bias; bf16_t* out;
    __device__ __forceinline__ bool next(int i, Unit& u) const {
        if (sample) { const int j = c - 128; if (i != 0 || j < 0 || j >= 4) return false; u.pm = 64 + (j >> 1); u.pn = j & 1; u.z = 0; return true; }
        const long L = (long)i * G + c; if (L >= 64 * 2) return false; tile_map((int)L, 64, 2, u.pm, u.pn); u.z = 0; return true; }
    __device__ __forceinline__ const bf16_t* arow0(const Unit& u) const { return u.pm < 64 ? A + (size_t)u.pm * 256 * 512 : As + (size_t)(u.pm - 64) * 256 * 512; }
    __device__ __forceinline__ const char* aptr(const Unit& u) const { return (const char*)arow0(u); }
    __device__ __forceinline__ const char* bptr(const Unit& u) const { return (const char*)Bt + (size_t)u.pn * 256 * 512 * 2; }
    __device__ __forceinline__ bool epi(Acc& acc, const Unit& u, int wr, int wc, int fr, int fq) const {
        const bf16_t* zsrc = arow0(u);
#pragma unroll
        for (int bj = 0; bj < 2; ++bj) {
            const int col = u.pn * 256 + bj * 128 + wc * 32 + 8 * fq;
            const f32x4 b0 = *(const f32x4*)(bias + col), b1 = *(const f32x4*)(bias + col + 4);
#pragma unroll
            for (int ai = 0; ai < 2; ++ai)
#pragma unroll
                for (int m = 0; m < 4; ++m) { const int rl = ai * 128 + wr * 64 + m * 16 + fr; const size_t r = (size_t)u.pm * 256 + rl;
                    const u32x4 zw = *(const u32x4*)(zsrc + (size_t)rl * 512 + col); float zf[8]; unpack8(zw, zf);
                    f32x4 y0, y1;
#pragma unroll
                    for (int j = 0; j < 4; ++j) { y0[j] = zf[j] * sigm(acc[ai][bj][m][0][j] + b0[j]); y1[j] = zf[4 + j] * sigm(acc[ai][bj][m][1][j] + b1[j]); }
                    *(u32x4*)(out + r * 512 + col) = pack8(y0, y1); }
        }
        return true;
    }
};

struct PMerge {
    __device__ __forceinline__ int nt(const Unit&) const { return K / BK; }
    static constexpr bool PERM = true;
    int K, lda, ldb, G, c, sample;
    const bf16_t* a0; const bf16_t* wp; const unsigned char* gl8; bf16_t* mb;
    __device__ __forceinline__ bool next(int i, Unit& u) const { const int ti = i / 3;
        if (sample) { const int j = c - (G - 8); if (ti != 0 || j < 0) return false; u.pm = 64 + (j >> 2); u.pn = j & 3; u.z = i; return true; }
        const long L = (long)ti * G + c; if (L >= 64 * 4) return false; tile_map((int)L, 64, 4, u.pm, u.pn); u.z = i - ti * 3; return true; }
    __device__ __forceinline__ const char* aptr(const Unit& u) const { const size_t off = (u.z == 2) ? (OFF_XB + S17 - OFF_R) : (size_t)u.z * S17; return (const char*)a0 + off + (size_t)u.pm * 256 * 512 * 2; }
    __device__ __forceinline__ const char* bptr(const Unit& u) const { return (const char*)wp + ((size_t)u.z * 1024 + (size_t)u.pn * 256) * 512 * 2; }
    __device__ __forceinline__ bool epi(Acc& acc, const Unit& u, int wr, int wc, int fr, int fq) const {
        const int br = u.z;
        const unsigned char* blk = gl8 + ((size_t)(u.pm * 12 + br * 4 + u.pn) << 16) + (size_t)(((wr * 4 + wc) * 64 + fq * 16 + fr) * 128);
#pragma unroll
        for (int ai = 0; ai < 2; ++ai)
#pragma unroll
            for (int m = 0; m < 4; ++m) { const size_t r = (size_t)u.pm * 256 + ai * 128 + wr * 64 + m * 16 + fr;
                const u32x4 qc = *(const u32x4*)(blk + (ai * 4 + m) * 16);
                if (br < 2) {
                    const u32x4 qn = *(const u32x4*)(blk + 4 * 65536 + (ai * 4 + m) * 16);
#pragma unroll
                    for (int bj = 0; bj < 2; ++bj)
#pragma unroll
                        for (int n = 0; n < 2; ++n)
#pragma unroll
                            for (int j = 0; j < 4; ++j) { const float gc = (float)((qc[bj * 2 + n] >> (8 * j)) & 255u) + 0.5f, gn = (float)((qn[bj * 2 + n] >> (8 * j)) & 255u) + 0.5f;
                                acc[ai][bj][m][n][j] *= gc * __builtin_amdgcn_rcpf(gn); }
                } else {
#pragma unroll
                    for (int bj = 0; bj < 2; ++bj) { const int col = u.pn * 256 + bj * 128 + wc * 32 + 8 * fq;
                        f32x4 y0, y1;
#pragma unroll
                        for (int j = 0; j < 4; ++j) {
                            y0[j] = acc[ai][bj][m][0][j] * (((float)((qc[bj * 2] >> (8 * j)) & 255u) + 0.5f) * (1.0f / 256.0f));
                            y1[j] = acc[ai][bj][m][1][j] * (((float)((qc[bj * 2 + 1] >> (8 * j)) & 255u) + 0.5f) * (1.0f / 256.0f)); }
                        *(u32x4*)(mb + r * 1024 + col) = pack8(y0, y1); }
                } }
        return br == 2;
    }
};

struct PWout {
    static constexpr bool PERM = false;
    int K, lda, ldb, G, c;
    const bf16_t* A; const bf16_t* Bt; const float* xp; const float* xs; float* R; float* part;
    __device__ __forceinline__ int nt(const Unit& u) const { return u.z < 0 ? 16 : 4; }
    __device__ __forceinline__ bool next(int i, Unit& u) const {
        const int nP = c < 256 ? (256 - c + G - 1) / G : 0;
        if (i < nP) { tile_map(i * G + c, 64, 4, u.pm, u.pn); u.z = -1; return true; }
        const int j = (i - nP) * G + c; if (j >= 32) return false;
        u.pm = 64 + (j >> 4); u.pn = (j >> 2) & 3; u.z = j & 3; return true; }
    __device__ __forceinline__ const char* aptr(const Unit& u) const { return (const char*)A + (size_t)u.pm * 256 * 1024 * 2 + (u.z < 0 ? 0 : u.z * 512); }
    __device__ __forceinline__ const char* bptr(const Unit& u) const { return (const char*)Bt + (size_t)u.pn * 256 * 1024 * 2 + (u.z < 0 ? 0 : u.z * 512); }
    __device__ __forceinline__ bool epi(Acc& acc, const Unit& u, int wr, int wc, int fr, int fq) const {
        const float* xsrc = (u.pm < 64) ? xp + (size_t)u.pm * 256 * 1024 : xs + (size_t)(u.pm - 64) * 256 * 1024;
#pragma unroll
        for (int ai = 0; ai < 2; ++ai)
#pragma unroll
            for (int m = 0; m < 4; ++m) { const int rl = ai * 128 + wr * 64 + m * 16 + fr; const size_t r = (size_t)u.pm * 256 + rl;
#pragma unroll
                for (int bj = 0; bj < 2; ++bj)
#pragma unroll
                    for (int n = 0; n < 2; ++n) { const int col = u.pn * 256 + bj * 128 + wc * 32 + n * 16 + 4 * fq;
                        float* pp = R + r * 1024 + col;
                        if (u.z <= 0) { const f32x4 xv = *(const f32x4*)(xsrc + (size_t)rl * 1024 + col); *(f32x4*)pp = xv * ALPHA + acc[ai][bj][m][n]; }
                        else *(f32x4*)(part + (size_t)(u.z - 1) * PART_STRIDE + (r - MP) * 1024 + col) = acc[ai][bj][m][n]; } }
        return true;
    }
};

struct PUp {
    __device__ __forceinline__ int nt(const Unit&) const { return K / BK; }
    static constexpr bool PERM = true;
    int K, lda, ldb, G, c;
    const bf16_t* A; const bf16_t* Bt; bf16_t* h;
    __device__ __forceinline__ bool next(int i, Unit& u) const { const long L = (long)i * G + c; if (L >= 66 * 16) return false; tile_map((int)L, 66, 16, u.pm, u.pn); u.z = 0; return true; }
    __device__ __forceinline__ const char* aptr(const Unit& u) const { return (const char*)A + (size_t)u.pm * 256 * 1024 * 2; }
    __device__ __forceinline__ const char* bptr(const Unit& u) const { return (const char*)Bt + (size_t)u.pn * 256 * 1024 * 2; }
    __device__ __forceinline__ bool epi(Acc& acc, const Unit& u, int wr, int wc, int fr, int fq) const {
#pragma unroll
        for (int ai = 0; ai < 2; ++ai)
#pragma unroll
            for (int m = 0; m < 4; ++m) { const size_t r = (size_t)u.pm * 256 + ai * 128 + wr * 64 + m * 16 + fr;
#pragma unroll
                for (int bj = 0; bj < 2; ++bj) { const int col = u.pn * 256 + bj * 128 + wc * 32 + 8 * fq;
                    f32x4 y0, y1;
#pragma unroll
                    for (int j = 0; j < 4; ++j) { const float v0 = fmaxf(acc[ai][bj][m][0][j], 0.f), v1 = fmaxf(acc[ai][bj][m][1][j], 0.f); y0[j] = v0 * v0; y1[j] = v1 * v1; }
                    *(u32x4*)(h + r * 4096 + col) = pack8(y0, y1); } }
        return true;
    }
};

struct PDown {
    static constexpr bool PERM = false;
    int K, lda, ldb, G, c;
    const bf16_t* A; const bf16_t* Bt; float* R; float* part;
    __device__ __forceinline__ int nt(const Unit& u) const { return u.z < 0 ? 64 : 16; }
    __device__ __forceinline__ bool next(int i, Unit& u) const {
        const int nP = c < 256 ? (256 - c + G - 1) / G : 0;
        if (i < nP) { tile_map(i * G + c, 64, 4, u.pm, u.pn); u.z = -1; return true; }
        const int j = (i - nP) * G + c; if (j >= 32) return false;
        u.pm = 64 + (j >> 4); u.pn = (j >> 2) & 3; u.z = j & 3; return true; }
    __device__ __forceinline__ const char* aptr(const Unit& u) const { return (const char*)A + (size_t)u.pm * 256 * 4096 * 2 + (u.z < 0 ? 0 : u.z * 2048); }
    __device__ __forceinline__ const char* bptr(const Unit& u) const { return (const char*)Bt + (size_t)u.pn * 256 * 4096 * 2 + (u.z < 0 ? 0 : u.z * 2048); }
    __device__ __forceinline__ bool epi(Acc& acc, const Unit& u, int wr, int wc, int fr, int fq) const {
#pragma unroll
        for (int ai = 0; ai < 2; ++ai)
#pragma unroll
            for (int m = 0; m < 4; ++m) { const size_t r = (size_t)u.pm * 256 + ai * 128 + wr * 64 + m * 16 + fr;
#pragma unroll
                for (int bj = 0; bj < 2; ++bj)
#pragma unroll
                    for (int n = 0; n < 2; ++n) { const int col = u.pn * 256 + bj * 128 + wc * 32 + n * 16 + 4 * fq;
                        float* pp = R + r * 1024 + col;
                        if (u.z <= 0) { const f32x4 xv = *(const f32x4*)pp; *(f32x4*)pp = xv + acc[ai][bj][m][n]; }
                        else *(f32x4*)(part + (size_t)(u.z - 1) * PART_STRIDE + (r - MP) * 1024 + col) = acc[ai][bj][m][n]; } }
        return true;
    }
};

struct TJob { const float* W; bf16_t* Wt; int K, N, tk, tn4; };
__device__ __forceinline__ TJob tjob(AP a, int layer, int t) {
    unsigned char* ws = a->ws; TJob j; int tt;
    if (t < 384) { tt = t; j.W = a->in[I_WIN] + (size_t)layer * 1024 * 6144; j.Wt = (bf16_t*)(ws + OFF_WIN); j.K = 1024; j.N = 6144; }
    else if (t < 480) { const int q = (t - 384) / 32; tt = (t - 384) % 32; j.W = a->in[I_PA + q] + (size_t)layer * 512 * 1024; j.Wt = (bf16_t*)(ws + OFF_WP) + (size_t)q * 1024 * 512; j.K = 512; j.N = 1024; }
    else if (t < 496) { tt = t - 480; j.W = a->in[I_GLW] + (size_t)layer * 512 * 512; j.Wt = (bf16_t*)(ws + OFF_WGLU); j.K = 512; j.N = 512; }
    else if (t < 560) { tt = t - 496; j.W = a->in[I_WO] + (size_t)layer * 1024 * 1024; j.Wt = (bf16_t*)(ws + OFF_WOUT); j.K = 1024; j.N = 1024; }
    else if (t < 816) { tt = t - 560; j.W = a->in[I_UP] + (size_t)layer * 1024 * 4096; j.Wt = (bf16_t*)(ws + OFF_WUP); j.K = 1024; j.N = 4096; }
    else { tt = t - 816; j.W = a->in[I_DN] + (size_t)layer * 4096 * 1024; j.Wt = (bf16_t*)(ws + OFF_WDOWN); j.K = 4096; j.N = 1024; }
    const int ntn = j.N / 256; j.tk = tt / ntn; j.tn4 = tt % ntn; return j;
}
__device__ __forceinline__ void tload(const TJob& j, int tid, f32x4 (&v)[4][2]) {
    const int r = tid >> 3, c8 = (tid & 7) * 8; const float* src = j.W + (size_t)(j.tk * 64 + r) * j.N + j.tn4 * 256 + c8;
#pragma unroll
    for (int q = 0; q < 4; ++q) { v[q][0] = *(const f32x4*)(src + q * 64); v[q][1] = *(const f32x4*)(src + q * 64 + 4); }
}

__device__ __forceinline__ void abar_pow(const float* are, const float* aim, const float* ldt, int sp, float e, float& pr, float& pi) {
    const float step = expf(ldt[sp]); const float x = e * step * are[sp], th = e * step * aim[sp];
    float s, c; sincosf(th, &s, &c); const float mg = expf(x); pr = mg * c; pi = mg * s;
}
__device__ __forceinline__ void ssm_coef(const float* are, const float* aim, const float* ldt, int sp, float& cr, float& ci) {
    const float step = expf(ldt[sp]); const float ar = are[sp], ai = aim[sp];
    const float x = step * ar, th = step * ai;
    float s, c; sincosf(th, &s, &c); const float em1 = expm1f(x); const float sh = sinf(0.5f * th);
    const float nr = em1 * c - 2.0f * sh * sh, ni = (em1 + 1.0f) * s;
    const float den = ar * ar + ai * ai;
    cr = (nr * ar + ni * ai) / den; ci = (ni * ar - nr * ai) / den;
}

__device__ __forceinline__ void prep_layer(AP a, int layer, float* sm, const int wv_) {
    unsigned char* ws = a->ws;
    const int G = gridDim.x;
    {
        const int tid = otid(wv_), r = tid >> 3, c8 = (tid & 7) * 8, n = tid >> 3, k8 = (tid & 7) * 8;
        int t = blockIdx.x; f32x4 v[4][2]; TJob j;
        if (t < 1072) { j = tjob(a, layer, t); tload(j, tid, v); }
        while (t < 1072) {
#pragma unroll
            for (int q = 0; q < 4; ++q)
#pragma unroll
                for (int e = 0; e < 4; ++e) { sm[q * 4160 + r * 65 + c8 + e] = v[q][0][e]; sm[q * 4160 + r * 65 + c8 + 4 + e] = v[q][1][e]; }
            __syncthreads();
            const TJob cj = j; const int tn = t + G;
            if (tn < 1072) { j = tjob(a, layer, tn); tload(j, tid, v); }
#pragma unroll
            for (int q = 0; q < 4; ++q) { const float* tt = sm + q * 4160;
                u32x4 w;
                w.x = cvt_pk_bf16(tt[(k8 + 0) * 65 + n], tt[(k8 + 1) * 65 + n]); w.y = cvt_pk_bf16(tt[(k8 + 2) * 65 + n], tt[(k8 + 3) * 65 + n]);
                w.z = cvt_pk_bf16(tt[(k8 + 4) * 65 + n], tt[(k8 + 5) * 65 + n]); w.w = cvt_pk_bf16(tt[(k8 + 6) * 65 + n], tt[(k8 + 7) * 65 + n]);
                *(u32x4*)(cj.Wt + (size_t)(cj.tn4 * 256 + q * 64 + n) * cj.K + cj.tk * 64 + k8) = w; }
            __syncthreads();
            t = tn;
        }
    }
    const int GT = G * NTHR;
    {
        bf16_t* wg = (bf16_t*)(ws + OFF_WGATE);
        for (int idx = blockIdx.x * NTHR + otid(wv_); idx < 1024 * 32; idx += GT) {
            const int n = idx >> 5, k0 = (idx & 31) * 8; const int pn = n >> 8, bj = (n >> 7) & 1, ch = pn * 128 + (n & 127), hd = ch >> 6, j = ch & 63;
            u32x4 w = (u32x4){0u, 0u, 0u, 0u};
            if ((pn >> 1) * 4 + (k0 >> 6) == hd) { const float* src = a->in[bj ? I_GAW : I_GXW] + (size_t)layer * 8 * 64 * 64 + (size_t)hd * 4096 + (size_t)(k0 & 63) * 64 + j;
                w.x = cvt_pk_bf16(src[0], src[64]); w.y = cvt_pk_bf16(src[128], src[192]); w.z = cvt_pk_bf16(src[256], src[320]); w.w = cvt_pk_bf16(src[384], src[448]); }
            *(u32x4*)(wg + (size_t)n * 256 + k0) = w;
        }
    }
    const float* are = a->in[I_SAR] + layer * 2048; const float* aim = a->in[I_SAI] + layer * 2048; const float* ldt = a->in[I_SDT] + layer * 2048;
    const float* bre = a->in[I_SBR] + layer * 32768; const float* bim = a->in[I_SBI] + layer * 32768;
    const float* cre = a->in[I_SCR] + layer * 32768; const float* cim = a->in[I_SCI] + layer * 32768;
    {
        bf16_t* w1 = (bf16_t*)(ws + OFF_W1T);
        for (int idx = blockIdx.x * NTHR + otid(wv_); idx < 32 * 128 * 32; idx += GT) {
            const int g = idx >> 12, n = (idx >> 5) & 127, k0 = (idx & 31) * 8, j = k0 >> 4, c0 = k0 & 15, p = n & 63, part = n >> 6, sp = g * 64 + p;
            float pr, pi, cr, ci; abar_pow(are, aim, ldt, sp, (float)(15 - j), pr, pi); ssm_coef(are, aim, ldt, sp, cr, ci);
            const float qr = pr * cr - pi * ci, qi = pr * ci + pi * cr;
            float o[8];
#pragma unroll
            for (int q = 0; q < 8; ++q) { const float br = bre[sp * 16 + c0 + q], bi = bim[sp * 16 + c0 + q]; o[q] = part ? (qr * bi + qi * br) : (qr * br - qi * bi); }
            u32x4 w; w.x = cvt_pk_bf16(o[0], o[1]); w.y = cvt_pk_bf16(o[2], o[3]); w.z = cvt_pk_bf16(o[4], o[5]); w.w = cvt_pk_bf16(o[6], o[7]);
            *(u32x4*)(w1 + ((size_t)(g * 128 + n) * 256 + k0)) = w;
        }
    }
    {
        bf16_t* wy = (bf16_t*)(ws + OFF_WYT);
        for (int idx = blockIdx.x * NTHR + otid(wv_); idx < 32 * 256 * 16; idx += GT) {
            const int g = idx >> 12, n = (idx >> 4) & 255, k0 = (idx & 15) * 8, i = n >> 4, c = n & 15, part = k0 >> 6, p0 = k0 & 63;
            float o[8];
#pragma unroll
            for (int q = 0; q < 8; ++q) { const int p = p0 + q, sp = g * 64 + p; float pr, pi; abar_pow(are, aim, ldt, sp, (float)(i + 1), pr, pi);
                const float xr = cre[(g * 16 + c) * 64 + p], xi = cim[(g * 16 + c) * 64 + p];
                o[q] = part ? -(xr * pi + xi * pr) : (xr * pr - xi * pi); }
            u32x4 w; w.x = cvt_pk_bf16(o[0], o[1]); w.y = cvt_pk_bf16(o[2], o[3]); w.z = cvt_pk_bf16(o[4], o[5]); w.w = cvt_pk_bf16(o[6], o[7]);
            *(u32x4*)(wy + ((size_t)(g * 256 + n) * 384 + k0)) = w;
        }
        for (int idx = blockIdx.x * NTHR + otid(wv_); idx < 32 * 256 * 4; idx += GT) {
            const int pq = idx & 3, c2 = (idx >> 2) & 15, c = (idx >> 6) & 15, g = idx >> 10;
            float km[16];
#pragma unroll
            for (int d = 0; d < 16; ++d) km[d] = 0.f;
            for (int pp = 0; pp < 16; ++pp) { const int p = pq * 16 + pp, sp = g * 64 + p; float ar, ai, cr, ci; abar_pow(are, aim, ldt, sp, 1.0f, ar, ai); ssm_coef(are, aim, ldt, sp, cr, ci);
                const float br = bre[sp * 16 + c2], bi = bim[sp * 16 + c2];
                const float bbr = cr * br - ci * bi, bbi = cr * bi + ci * br;
                const float xr = cre[(g * 16 + c) * 64 + p], xi = cim[(g * 16 + c) * 64 + p];
                float tr = xr * bbr - xi * bbi, ti = xr * bbi + xi * bbr;
#pragma unroll
                for (int d = 0; d < 16; ++d) { km[d] += tr; const float nr = tr * ar - ti * ai, ni = tr * ai + ti * ar; tr = nr; ti = ni; } }
#pragma unroll
            for (int d = 0; d < 16; ++d) { km[d] += __shfl_xor(km[d], 1); km[d] += __shfl_xor(km[d], 2); }
#pragma unroll
            for (int d = 0; d < 16; ++d) if ((d & 3) == pq) { const bf16_t kb = f2bf(km[d]);
                for (int i = d; i < 16; ++i) wy[(size_t)(g * 256 + i * 16 + c) * 384 + 128 + (i - d) * 16 + c2] = kb;
                if (d > 0) for (int i = 0; i < 16 - d; ++i) wy[(size_t)(g * 256 + i * 16 + c) * 384 + 128 + (i + d) * 16 + c2] = (bf16_t)0; }
        }
    }
}

__device__ __forceinline__ void prep_x(AP a, const int wv_) {
    bf16_t* xb = (bf16_t*)(a->ws + OFF_XB);
    const int gt = blockIdx.x * NTHR + otid(wv_), GT = gridDim.x * NTHR;
    for (int idx = gt; idx < M * 128; idx += GT) {
        const size_t e = (size_t)idx * 8; const float* src = e < (size_t)MP * 1024 ? a->in[I_XP] + e : a->in[I_XS] + (e - (size_t)MP * 1024);
        const f32x4 v0 = *(const f32x4*)src, v1 = *(const f32x4*)(src + 4);
        *(u32x4*)(xb + e) = pack8(v0, v1);
    }
}

__device__ __forceinline__ void conv_phase(AP a, int layer, bf16_t* bin_out, const int wv_) {
    unsigned char* ws = a->ws;
    const bf16_t* xa = (const bf16_t*)(ws + OFF_R); bf16_t* sb = (bf16_t*)(ws + OFF_R + S17);
    const bf16_t* sc = (const bf16_t*)(ws + OFF_R + 2 * S17); const bf16_t* sh = (const bf16_t*)(ws + OFF_R + 3 * S17);
    bf16_t* xac = (bf16_t*)(ws + OFF_XB);
    const float* caw = a->in[I_CAW] + layer * 4 * 512; const float* cab = a->in[I_CAB] + layer * 512; const float* cbw = a->in[I_CBW] + layer * 3 * 512;
    const int gt = blockIdx.x * NTHR + otid(wv_), GT = gridDim.x * NTHR;
    for (int idx = gt; idx < (2048 + 128) * 64; idx += GT) {
        const int seg = idx >> 6, c0 = (idx & 63) * 8;
        const bool prompt = seg < 2048;
        int row0, nrows;
        float x0[8], x1[8], x2[8], u1[8], u2[8];
        if (prompt) { row0 = seg * 8; nrows = 8; const bool first = (seg & 255) == 0;
            if (first) {
#pragma unroll
                for (int j = 0; j < 8; ++j) { x0[j] = 0.f; x1[j] = 0.f; x2[j] = 0.f; u1[j] = 0.f; u2[j] = 0.f; }
            } else {
                unpack8(*(const u32x4*)(xa + (size_t)(row0 - 3) * 512 + c0), x0); unpack8(*(const u32x4*)(xa + (size_t)(row0 - 2) * 512 + c0), x1); unpack8(*(const u32x4*)(xa + (size_t)(row0 - 1) * 512 + c0), x2);
                float s1[8], s2[8];
                unpack8(*(const u32x4*)(sc + (size_t)(row0 - 2) * 512 + c0), u1); unpack8(*(const u32x4*)(sh + (size_t)(row0 - 2) * 512 + c0), s1);
                unpack8(*(const u32x4*)(sc + (size_t)(row0 - 1) * 512 + c0), u2); unpack8(*(const u32x4*)(sh + (size_t)(row0 - 1) * 512 + c0), s2);
#pragma unroll
                for (int j = 0; j < 8; ++j) { u1[j] *= s1[j]; u2[j] *= s2[j]; }
            }
        } else { const int b = seg - 2048; row0 = MP + b * 4; nrows = 4;
            const float* lc = a->in[I_SLC] + ((size_t)(layer * 128 + b) * 3) * 512 + c0; const float* scs = a->in[I_SSC] + ((size_t)(layer * 128 + b) * 2) * 512 + c0;
#pragma unroll
            for (int j = 0; j < 8; ++j) { x0[j] = lc[j]; x1[j] = lc[512 + j]; x2[j] = lc[1024 + j]; u1[j] = scs[j]; u2[j] = scs[512 + j]; }
        }
        float w0[8], w1[8], w2[8], w3[8], wb[8], v0[8], v1[8], v2[8];
#pragma unroll
        for (int j = 0; j < 8; ++j) { w0[j] = caw[c0 + j]; w1[j] = caw[512 + c0 + j]; w2[j] = caw[1024 + c0 + j]; w3[j] = caw[1536 + c0 + j]; wb[j] = cab[c0 + j];
            v0[j] = cbw[c0 + j]; v1[j] = cbw[512 + c0 + j]; v2[j] = cbw[1024 + c0 + j]; }
        for (int t0 = 0; t0 < nrows; t0 += 2) {
            u32x4 lx[2], lc[2], lh[2], lb[2];
#pragma unroll
            for (int k = 0; k < 2; ++k) { const size_t off = (size_t)(row0 + t0 + k) * 512 + c0;
                lx[k] = *(const u32x4*)(xa + off); lc[k] = *(const u32x4*)(sc + off); lh[k] = *(const u32x4*)(sh + off); lb[k] = *(const u32x4*)(sb + off); }
#pragma unroll
            for (int k = 0; k < 2; ++k) { const size_t off = (size_t)(row0 + t0 + k) * 512 + c0;
                float xv[8], scv[8], shv[8], sbv[8];
                unpack8(lx[k], xv); unpack8(lc[k], scv); unpack8(lh[k], shv); unpack8(lb[k], sbv);
                f32x4 o0, o1, q0, q1;
#pragma unroll
                for (int j = 0; j < 8; ++j) {
                    const float o = w0[j] * x0[j] + w1[j] * x1[j] + w2[j] * x2[j] + w3[j] * xv[j] + wb[j];
                    const float uu = scv[j] * shv[j]; const float cu = v0[j] * u1[j] + v1[j] * u2[j] + v2[j] * uu; const float bi = sbv[j] * cu;
                    if (j < 4) { o0[j] = o; q0[j] = bi; } else { o1[j - 4] = o; q1[j - 4] = bi; }
                    x0[j] = x1[j]; x1[j] = x2[j]; x2[j] = xv[j]; u1[j] = u2[j]; u2[j] = uu;
                }
                *(u32x4*)(xac + off) = pack8(o0, o1);
                *(u32x4*)(bin_out + off) = pack8(q0, q1); }
        }
        if (prompt) { if ((seg & 255) == 255) { const int b = seg >> 8;
                float* o1 = a->out + O_LCP + ((size_t)(layer * 8 + b) * 3) * 512 + c0; float* o2 = a->out + O_SCP + ((size_t)(layer * 8 + b) * 2) * 512 + c0;
#pragma unroll
                for (int j = 0; j < 8; ++j) { o1[j] = x0[j]; o1[512 + j] = x1[j]; o1[1024 + j] = x2[j]; o2[j] = u1[j]; o2[512 + j] = u2[j]; } }
        } else { const int b = seg - 2048;
            float* o1 = a->out + O_LCS + ((size_t)(layer * 128 + b) * 3) * 512 + c0; float* o2 = a->out + O_SCS + ((size_t)(layer * 128 + b) * 2) * 512 + c0;
#pragma unroll
            for (int j = 0; j < 8; ++j) { o1[j] = x0[j]; o1[512 + j] = x1[j]; o1[1024 + j] = x2[j]; o2[j] = u1[j]; o2[512 + j] = u2[j]; }
        }
    }
}

__device__ __forceinline__ void ssm_s_gemm(AP a, const int wv_) {
    const bf16_t* apack = (const bf16_t*)(a->ws + OFF_APACK); const bf16_t* w1 = (const bf16_t*)(a->ws + OFF_W1T); float* S = (float*)(a->ws + OFF_S);
    const int tid_ = otid(wv_); const int lane = tid_ & 63, wv = blockIdx.x * 8 + (tid_ >> 6), NW = gridDim.x * 8;
    const int lr = lane & 15, kq = lane >> 4;
    for (int t = wv; t < 1024; t += NW) {
        const int g = t >> 5, rt = (t >> 1) & 15, ct = t & 1;
        f32x4 acc[4][4];
#pragma unroll
        for (int i = 0; i < 4; ++i)
#pragma unroll
            for (int j = 0; j < 4; ++j) acc[i][j] = (f32x4){0.f, 0.f, 0.f, 0.f};
        const bf16_t* ab = apack + ((size_t)(g * 1024 + rt * 64 + lr) * 384 + 128 + kq * 8);
        const bf16_t* bb = w1 + ((size_t)(g * 128 + ct * 64 + lr) * 256 + kq * 8);
#pragma unroll 2
        for (int ks = 0; ks < 8; ++ks) {
            bf16x8 af[4], bf[4];
#pragma unroll
            for (int i = 0; i < 4; ++i) { af[i] = *(const bf16x8*)(ab + (size_t)i * 16 * 384 + ks * 32); bf[i] = *(const bf16x8*)(bb + (size_t)i * 16 * 256 + ks * 32); }
#pragma unroll
            for (int i = 0; i < 4; ++i)
#pragma unroll
                for (int j = 0; j < 4; ++j) acc[i][j] = __builtin_amdgcn_mfma_f32_16x16x32_bf16(af[i], bf[j], acc[i][j], 0, 0, 0);
        }
#pragma unroll
        for (int i = 0; i < 4; ++i)
#pragma unroll
            for (int j = 0; j < 4; ++j)
#pragma unroll
                for (int q = 0; q < 4; ++q) S[(size_t)(g * 1024 + rt * 64 + i * 16 + kq * 4 + q) * 128 + ct * 64 + j * 16 + lr] = acc[i][j][q];
    }
}

__device__ __forceinline__ void ssm_carry(AP a, int layer, float* sm, const int wv_) {
    bf16_t* apack = (bf16_t*)(a->ws + OFF_APACK); const float* S = (const float*)(a->ws + OFF_S);
    const int tid = otid(wv_), p = tid & 63, seg = tid >> 6;
    for (int pair = blockIdx.x; pair < 256; pair += gridDim.x) {
        const int b = pair >> 5, g = pair & 31, sp = g * 64 + p;
        float ar, ai, Ar, Ai;
        abar_pow(a->in[I_SAR] + layer * 2048, a->in[I_SAI] + layer * 2048, a->in[I_SDT] + layer * 2048, sp, 16.0f, ar, ai);
        abar_pow(a->in[I_SAR] + layer * 2048, a->in[I_SAI] + layer * 2048, a->in[I_SDT] + layer * 2048, sp, 256.0f, Ar, Ai);
        const size_t rbase = (size_t)g * 1024 + b * 128 + seg * 16;
        float sr[16], si[16];
#pragma unroll
        for (int j = 0; j < 16; ++j) { sr[j] = S[(rbase + j) * 128 + p]; si[j] = S[(rbase + j) * 128 + 64 + p]; }
        float hr = 0.f, hi = 0.f;
#pragma unroll
        for (int j = 0; j < 16; ++j) { const float nr = ar * hr - ai * hi + sr[j], ni = ar * hi + ai * hr + si[j]; sr[j] = hr; si[j] = hi; hr = nr; hi = ni; }
        sm[seg * 128 + p] = hr; sm[seg * 128 + 64 + p] = hi;
        __syncthreads();
        float cr = 0.f, ci = 0.f;
        for (int s2 = 0; s2 < seg; ++s2) { const float er = sm[s2 * 128 + p], ei = sm[s2 * 128 + 64 + p]; const float nr = Ar * cr - Ai * ci + er, ni = Ar * ci + Ai * cr + ei; cr = nr; ci = ni; }
        if (seg == 7) { const float fr_ = Ar * cr - Ai * ci + hr, fi_ = Ar * ci + Ai * cr + hi;
            a->out[O_SRP + (size_t)(layer * 8 + b) * 2048 + sp] = fr_; a->out[O_SIP + (size_t)(layer * 8 + b) * 2048 + sp] = fi_; }
#pragma unroll
        for (int j = 0; j < 16; ++j) { apack[(rbase + j) * 384 + p] = f2bf(sr[j] + cr); apack[(rbase + j) * 384 + 64 + p] = f2bf(si[j] + ci);
            const float nr = ar * cr - ai * ci, ni = ar * ci + ai * cr; cr = nr; ci = ni; }
        __syncthreads();
    }
}

__device__ __forceinline__ void ssm_sample(AP a, int layer, int wv, int NW, const int wv_) {
    const bf16_t* uss = (const bf16_t*)(a->ws + OFF_USS); bf16_t* zc = (bf16_t*)(a->ws + OFF_ZCS);
    const float* are = a->in[I_SAR] + layer * 2048; const float* aim = a->in[I_SAI] + layer * 2048; const float* ldt = a->in[I_SDT] + layer * 2048;
    const float* bre = a->in[I_SBR] + layer * 32768; const float* bim = a->in[I_SBI] + layer * 32768;
    const float* cre = a->in[I_SCR] + layer * 32768; const float* cim = a->in[I_SCI] + layer * 32768; const float* dv = a->in[I_SD] + layer * 512;
    const int lane = otid(wv_) & 63;
    for (int t = wv; t < 128 * 32; t += NW) {
        const int b = t >> 5, g = t & 31, sp = g * 64 + lane;
        float ar, ai, cr, ci; abar_pow(are, aim, ldt, sp, 1.0f, ar, ai); ssm_coef(are, aim, ldt, sp, cr, ci);
        float bbr[16], bbi[16], xr[16], xi[16];
#pragma unroll
        for (int c = 0; c < 16; ++c) { const float br = bre[sp * 16 + c], bi = bim[sp * 16 + c]; bbr[c] = cr * br - ci * bi; bbi[c] = cr * bi + ci * br;
            xr[c] = cre[(g * 16 + c) * 64 + lane]; xi[c] = cim[(g * 16 + c) * 64 + lane]; }
        float hr = a->in[I_SSR][(size_t)(layer * 128 + b) * 2048 + sp], hi = a->in[I_SSI][(size_t)(layer * 128 + b) * 2048 + sp];
        const float dme = lane < 16 ? dv[g * 16 + lane] : 0.f;
        for (int tt = 0; tt < 4; ++tt) {
            const bf16_t* up = uss + (size_t)(b * 4 + tt) * 512 + g * 16;
            const u32x4 w0 = *(const u32x4*)up, w1 = *(const u32x4*)(up + 8);
            float u[16]; { float t0[8], t1[8]; unpack8(w0, t0); unpack8(w1, t1);
#pragma unroll
                for (int c = 0; c < 8; ++c) { u[c] = t0[c]; u[8 + c] = t1[c]; } }
            float br_ = 0.f, bi_ = 0.f;
#pragma unroll
            for (int c = 0; c < 16; ++c) { br_ += bbr[c] * u[c]; bi_ += bbi[c] * u[c]; }
            const float nr = ar * hr - ai * hi + br_, ni = ar * hi + ai * hr + bi_; hr = nr; hi = ni;
            float mine = 0.f, ume = 0.f;
#pragma unroll
            for (int c = 0; c < 16; ++c) { float y = xr[c] * hr - xi[c] * hi;
#pragma unroll
                for (int o = 32; o >= 1; o >>= 1) y += __shfl_xor(y, o);
                if (lane == c) { mine = y; ume = u[c]; } }
            if (lane < 16) zc[(size_t)(b * 4 + tt) * 512 + g * 16 + lane] = f2bf(gelu_t(mine + dme * ume));
        }
        a->out[O_SRS + (size_t)(layer * 128 + b) * 2048 + sp] = hr; a->out[O_SIS + (size_t)(layer * 128 + b) * 2048 + sp] = hi;
    }
}

__device__ __forceinline__ void lru_local(AP a, const int wv_) {
    const float* av = (const float*)(a->ws + OFF_R + 2 * S17); const bf16_t* bx = (const bf16_t*)(a->ws + OFF_R); f32x2* car = (f32x2*)(a->ws + OFF_CAR);
    const int gt = blockIdx.x * NTHR + otid(wv_), GT = gridDim.x * NTHR;
    for (int idx = gt; idx < 8 * 32 * 512; idx += GT) {
        const int c = idx & 511, sc = idx >> 9;
        const size_t base = (size_t)sc * 64 * 512 + c;
        float P = 1.f, h = 0.f;
        for (int t0 = 0; t0 < 64; t0 += 16) {
            float aa[16]; bf16_t bb[16];
#pragma unroll
            for (int j = 0; j < 16; ++j) { aa[j] = av[base + (size_t)(t0 + j) * 512]; bb[j] = bx[base + (size_t)(t0 + j) * 512]; }
#pragma unroll
            for (int j = 0; j < 16; ++j) { h = aa[j] * h + bf2f(bb[j]); P *= aa[j]; }
        }
        car[idx] = (f32x2){P, h};
    }
}
template <int B>
__device__ __forceinline__ float lru_run(const float* av, const bf16_t* bx, bf16_t* ao, const bf16_t* ya, size_t base, int n, float h) {
    for (int t0 = 0; t0 < n; t0 += B) {
        float aa[B]; bf16_t bb[B], yy[B];
#pragma unroll
        for (int j = 0; j < B; ++j) { const size_t o = base + (size_t)(t0 + j) * 512; aa[j] = av[o]; bb[j] = bx[o]; yy[j] = ya[o]; }
        bf16_t oo[B];
#pragma unroll
        for (int j = 0; j < B; ++j) { h = aa[j] * h + bf2f(bb[j]); oo[j] = f2bf(h * gelu_t(bf2f(yy[j]))); }
#pragma unroll
        for (int j = 0; j < B; ++j) ao[base + (size_t)(t0 + j) * 512] = oo[j];
    }
    return h;
}
__device__ __forceinline__ void lru_apply(AP a, int layer, bf16_t* ao, int mode, const int wv_) {
    const float* av = (const float*)(a->ws + OFF_R + 2 * S17); const bf16_t* bx = (const bf16_t*)(a->ws + OFF_R); const f32x2* car = (const f32x2*)(a->ws + OFF_CAR);
    const bf16_t* ya = (const bf16_t*)(a->ws + OFF_YA);
    const int G = gridDim.x, bid = blockIdx.x;
    if (mode == 0) {
        if (bid >= G - 8) return;
        const int GP = G - 8; int v = bid - 128; if (v < 0) v += GP;
        for (int idx = v * NTHR + otid(wv_); idx < 8 * 32 * 512; idx += GP * NTHR) {
            const int c = idx & 511, sc = idx >> 9, seq = sc >> 5, chunk = sc & 31;
            float h = 0.f;
            f32x2 ph[31];
#pragma unroll
            for (int k = 0; k < 31; ++k) ph[k] = car[(seq * 32 + (k < chunk ? k : 0)) * 512 + c];
#pragma unroll
            for (int k = 0; k < 31; ++k) if (k < chunk) h = ph[k].x * h + ph[k].y;
            h = lru_run<8>(av, bx, ao, ya, (size_t)sc * 64 * 512 + c, 64, h);
            if (chunk == 31) a->out[O_LHP + (size_t)(layer * 8 + seq) * 512 + c] = h;
        }
    } else {
        for (int j = bid * NTHR + otid(wv_); j < 128 * 512; j += G * NTHR) {
            const int c = j & 511, b = j >> 9;
            float h = a->in[I_SLH][(size_t)(layer * 128 + b) * 512 + c];
            h = lru_run<4>(av, bx, ao, ya, (size_t)(MP + b * 4) * 512 + c, 4, h);
            a->out[O_LHS + (size_t)(layer * 128 + b) * 512 + c] = h;
        }
    }
}

__device__ __forceinline__ void ln_phase(const float* src, float* dst32, bf16_t* dst16, const float* gam, const float* bet, const float scale32, const float* part, const int wv_) {
    const int tid_ = otid(wv_); const int lane = tid_ & 63, wv = blockIdx.x * 8 + (tid_ >> 6), NW = gridDim.x * 8;
    for (int r0 = wv; r0 < M; r0 += 3 * NW) {
        f32x4 v[3][4];
#pragma unroll
        for (int k = 0; k < 3; ++k) { const int r = r0 + k * NW; const float* row = src + (size_t)(r < M ? r : r0) * 1024;
#pragma unroll
            for (int i = 0; i < 4; ++i) v[k][i] = *(const f32x4*)(row + i * 256 + lane * 4);
            if (r >= MP && r < M) {
#pragma unroll
                for (int q = 0; q < 3; ++q)
#pragma unroll
                    for (int i = 0; i < 4; ++i) v[k][i] += *(const f32x4*)(part + (size_t)q * PART_STRIDE + (size_t)(r - MP) * 1024 + i * 256 + lane * 4); } }
#pragma unroll
        for (int k = 0; k < 3; ++k) { const int r = r0 + k * NW;
            float s = 0.f;
#pragma unroll
            for (int i = 0; i < 4; ++i) s += (v[k][i][0] + v[k][i][1]) + (v[k][i][2] + v[k][i][3]);
#pragma unroll
            for (int o = 32; o >= 1; o >>= 1) s += __shfl_xor(s, o);
            const float mu = s * (1.0f / 1024.0f); float q = 0.f;
#pragma unroll
            for (int i = 0; i < 4; ++i) { const f32x4 d = v[k][i] - mu; q += (d[0] * d[0] + d[1] * d[1]) + (d[2] * d[2] + d[3] * d[3]); }
#pragma unroll
            for (int o = 32; o >= 1; o >>= 1) q += __shfl_xor(q, o);
            const float rs = rsqrtf(q * (1.0f / 1024.0f) + LN_EPS);
            if (r < M) {
#pragma unroll
                for (int i = 0; i < 4; ++i) { const int col = i * 256 + lane * 4; const f32x4 gg = *(const f32x4*)(gam + col), bb = *(const f32x4*)(bet + col);
                    const f32x4 y = (v[k][i] - mu) * rs * gg + bb;
                    *(f32x4*)(dst32 + (size_t)r * 1024 + col) = y * scale32;
                    u32x2 w; w.x = cvt_pk_bf16(y[0], y[1]); w.y = cvt_pk_bf16(y[2], y[3]);
                    *(u32x2*)(dst16 + (size_t)r * 1024 + col) = w; }
            }
        }
    }
}

__global__ void __launch_bounds__(NTHR, 2) fwd_megakernel(Args a_unused) {
    extern __shared__ __attribute__((aligned(16))) unsigned char lds_raw[];
    cg::grid_group grid = cg::this_grid();
    LAS unsigned char* lds = (LAS unsigned char*)lds_raw;
    const int G = gridDim.x, bid = blockIdx.x;
    int wv_; { const int tw = (int)threadIdx.x >> 6; asm volatile("v_readfirstlane_b32 %0, %1" : "=s"(wv_) : "v"(tw)); }

    for (int rep = 0; rep < REP_PREP; ++rep) { const AP a = ld_args(); prep_layer(a, 0, (float*)lds_raw, wv_); prep_x(a, wv_); }
    grid.sync();
    unsigned bar_n = 0; unsigned* bar_ctr; { const AP a = ld_args(); bar_ctr = (unsigned*)(a->ws + OFF_BAR); }

#pragma unroll 1
    for (int layer = 0; layer < 2; ++layer) {
        { const AP a = ld_args(); unsigned char* ws = a->ws;
          PG1 p; p.K = 1024; p.lda = 1024; p.ldb = 1024; p.G = opq(G); p.c = opq(bid); p.A = (const bf16_t*)(ws + OFF_XB); p.Bt = (const bf16_t*)(ws + OFF_WIN);
          p.xa = (bf16_t*)(ws + OFF_R); p.ya = (bf16_t*)(ws + OFF_YA); p.sb = (bf16_t*)(ws + OFF_R + S17); p.sc = (bf16_t*)(ws + OFF_R + 2 * S17); p.sh = (bf16_t*)(ws + OFF_R + 3 * S17);
          p.apack = (bf16_t*)(ws + OFF_APACK); p.uss = (bf16_t*)(ws + OFF_USS); p.gl8 = ws + OFF_GL8;
          for (int rep = 0; rep < REP_G1; ++rep) gemm_phase(lds, p, wv_); }
        GSYNC();
        if (DRY_CONV) { const AP a = ld_args(); conv_phase(a, layer, (bf16_t*)(a->ws + OFF_XB + S17), wv_); }
        { const AP a = ld_args(); conv_phase(a, layer, (bf16_t*)(a->ws + OFF_R + S17), wv_); }
        for (int rep = 0; rep < REP_SG; ++rep) { const AP a = ld_args(); ssm_s_gemm(a, wv_); }
        GSYNC();
        for (int rep = 0; rep < REP_CARRY; ++rep) { const AP a = ld_args(); ssm_carry(a, layer, (float*)lds_raw, wv_); }
        { const AP a = ld_args(); unsigned char* ws = a->ws;
          PGate p; p.K = 256; p.lda = 512; p.ldb = 256; p.G = opq(G); p.c = opq(bid); p.A = (const bf16_t*)(ws + OFF_XB); p.Bt = (const bf16_t*)(ws + OFF_WGATE);
          p.gxb = a->in[I_GXB] + layer * 512; p.gab = a->in[I_GAB] + layer * 512; p.lam = a->in[I_LAM] + layer * 512;
          p.aout = (float*)(ws + OFF_R + 2 * S17); p.bxout = (bf16_t*)(ws + OFF_R);
          for (int rep = 0; rep < REP_GATE; ++rep) gemm_phase(lds, p, wv_); }
        for (int rep = 0; rep < REP_SAMPLE; ++rep) if (bid >= 8) { const AP a = ld_args(); ssm_sample(a, layer, (bid - 8) * 8 + wv_, (G - 8) * 8, wv_); }
        GSYNC();
        { const AP a = ld_args(); unsigned char* ws = a->ws;
          PY p; p.K = 384; p.lda = 384; p.ldb = 384; p.G = opq(G); p.c = opq(bid); p.apack = (const bf16_t*)(ws + OFF_APACK); p.wyt = (const bf16_t*)(ws + OFF_WYT);
          p.dvec = a->in[I_SD] + layer * 512; p.zc = (bf16_t*)(ws + OFF_XB);
          for (int rep = 0; rep < REP_Y; ++rep) gemm_phase(lds, p, wv_); }
        { const AP a = ld_args(); unsigned char* ws = a->ws;
          PGlu p; p.K = 512; p.lda = 512; p.ldb = 512; p.G = opq(G); p.c = opq(bid); p.sample = 1; p.A = (const bf16_t*)(ws + OFF_XB); p.As = (const bf16_t*)(ws + OFF_ZCS); p.Bt = (const bf16_t*)(ws + OFF_WGLU);
          p.bias = a->in[I_GLB] + layer * 512; p.out = (bf16_t*)(ws + OFF_XB + S17);
          gemm_phase(lds, p, wv_); }
        { const AP a = ld_args(); lru_apply(a, layer, (bf16_t*)(a->ws + OFF_R), 1, wv_); }
        for (int rep = 0; rep < REP_LOCAL; ++rep) { const AP a = ld_args(); lru_local(a, wv_); }
        GSYNC();
        { const AP a = ld_args(); unsigned char* ws = a->ws;
          PGlu p; p.K = 512; p.lda = 512; p.ldb = 512; p.G = opq(G); p.c = opq(bid); p.sample = 0; p.A = (const bf16_t*)(ws + OFF_XB); p.As = (const bf16_t*)(ws + OFF_ZCS); p.Bt = (const bf16_t*)(ws + OFF_WGLU);
          p.bias = a->in[I_GLB] + layer * 512; p.out = (bf16_t*)(ws + OFF_XB + S17);
          for (int rep = 0; rep < REP_GLU; ++rep) gemm_phase(lds, p, wv_); }
        { const AP a = ld_args(); unsigned char* ws = a->ws;
          PMerge p; p.K = 512; p.lda = 512; p.ldb = 512; p.G = opq(G); p.c = opq(bid); p.sample = 1; p.a0 = (const bf16_t*)(ws + OFF_R);
          p.wp = (const bf16_t*)(ws + OFF_WP); p.gl8 = ws + OFF_GL8; p.mb = (bf16_t*)(ws + OFF_MB);
          gemm_phase(lds, p, wv_); }
        if (DRY_APPLY) { const AP a = ld_args(); lru_apply(a, layer, (bf16_t*)(a->ws + OFF_S), 0, wv_); }
        { const AP a = ld_args(); lru_apply(a, layer, (bf16_t*)(a->ws + OFF_R), 0, wv_); }
        GSYNC();
        { const AP a = ld_args(); unsigned char* ws = a->ws;
          PMerge p; p.K = 512; p.lda = 512; p.ldb = 512; p.G = opq(G); p.c = opq(bid); p.sample = 0; p.a0 = (const bf16_t*)(ws + OFF_R);
          p.wp = (const bf16_t*)(ws + OFF_WP); p.gl8 = ws + OFF_GL8; p.mb = (bf16_t*)(ws + OFF_MB);
          for (int rep = 0; rep < REP_MERGE; ++rep) gemm_phase(lds, p, wv_); }
        GSYNC();
        { const AP a = ld_args(); unsigned char* ws = a->ws;
          PWout p; p.K = 1024; p.lda = 1024; p.ldb = 1024; p.G = opq(G); p.c = opq(bid); p.A = (const bf16_t*)(ws + OFF_MB); p.Bt = (const bf16_t*)(ws + OFF_WOUT);
          p.xp = layer == 0 ? a->in[I_XP] : a->out; p.xs = layer == 0 ? a->in[I_XS] : a->out + (size_t)MP * 1024; p.R = (float*)(ws + OFF_R); p.part = (float*)(ws + OFF_PW);
          gemm_phase(lds, p, wv_); }
        GSYNC();
        if (DRY_LN1) { const AP a = ld_args(); unsigned char* ws = a->ws;
          ln_phase((const float*)(ws + OFF_R), a->out, (bf16_t*)(ws + OFF_XB), a->in[I_L1G] + layer * 1024, a->in[I_L1B] + layer * 1024, ALPHA, (const float*)(ws + OFF_PW), wv_); }
        { const AP a = ld_args(); unsigned char* ws = a->ws;
          ln_phase((const float*)(ws + OFF_R), (float*)(ws + OFF_R), (bf16_t*)(ws + OFF_XB), a->in[I_L1G] + layer * 1024, a->in[I_L1B] + layer * 1024, ALPHA, (const float*)(ws + OFF_PW), wv_); }
        GSYNC();
        { const AP a = ld_args(); unsigned char* ws = a->ws;
          PUp p; p.K = 1024; p.lda = 1024; p.ldb = 1024; p.G = opq(G); p.c = opq(bid); p.A = (const bf16_t*)(ws + OFF_XB); p.Bt = (const bf16_t*)(ws + OFF_WUP); p.h = (bf16_t*)(ws + OFF_H);
          for (int rep = 0; rep < REP_UP; ++rep) gemm_phase(lds, p, wv_); }
        GSYNC();
        { const AP a = ld_args(); unsigned char* ws = a->ws;
          PDown p; p.K = 4096; p.lda = 4096; p.ldb = 4096; p.G = opq(G); p.c = opq(bid); p.A = (const bf16_t*)(ws + OFF_H); p.Bt = (const bf16_t*)(ws + OFF_WDOWN); p.R = (float*)(ws + OFF_R); p.part = (float*)(ws + OFF_PD);
          gemm_phase(lds, p, wv_); }
        GSYNC();
        for (int rep = 0; rep < REP_LN2; ++rep) { const AP a = ld_args(); unsigned char* ws = a->ws;
          ln_phase((const float*)(ws + OFF_R), a->out, (bf16_t*)(ws + OFF_XB), a->in[I_L2G] + layer * 1024, a->in[I_L2B] + layer * 1024, 1.0f, (const float*)(ws + OFF_PD), wv_); }
        if (layer == 0) { __syncthreads(); for (int rep = 0; rep < REP_PREP; ++rep) { const AP a = ld_args(); prep_layer(a, 1, (float*)lds_raw, wv_); } GSYNC(); }
    }
}

extern "C" void kernel_launch(void* const* d_in, const int* in_sizes, int n_in, void* d_out, int out_size, void* d_ws, size_t ws_size, hipStream_t stream) {
    constexpr size_t kDynLds = STAGE_BYTES;
    static int grid_blocks = 0;
    if (!grid_blocks) {
        int dev = 0, cus = 0, per_cu = 0;
        hipGetDevice(&dev);
        hipDeviceGetAttribute(&cus, hipDeviceAttributeMultiprocessorCount, dev);
        hipFuncSetAttribute((const void*)fwd_megakernel, hipFuncAttributeMaxDynamicSharedMemorySize, (int)kDynLds);
        hipOccupancyMaxActiveBlocksPerMultiprocessor(&per_cu, (const void*)fwd_megakernel, NTHR, kDynLds);
        if (per_cu < 1) per_cu = 1;
        grid_blocks = cus * per_cu;
        if (grid_blocks > 256) grid_blocks = 256;
        if (ws_size < WS_END || n_in != 36) fprintf(stderr, "kernel_launch: unexpected ws_size %zu (need %zu) or n_in %d\n", ws_size, (size_t)WS_END, n_in);
    }
    (void)hipMemsetAsync((char*)d_ws + OFF_BAR, 0, 256, stream);
    Args a{};
    for (int i = 0; i < 36; ++i) a.in[i] = (const float*)d_in[i];
    a.out = (float*)d_out; a.ws = (unsigned char*)d_ws;
    void* args[] = {&a};
    hipError_t e = hipLaunchCooperativeKernel((const void*)fwd_megakernel, dim3(grid_blocks), dim3(NTHR), args, kDynLds, stream);
    if (e != hipSuccess) fprintf(stderr, "cooperative launch failed: %s (grid %d)\n", hipGetErrorString(e), grid_blocks);
}
```

```cpp
#include <hip/hip_runtime.h>
#include <hip/hip_cooperative_groups.h>
#include <cstdio>
namespace cg = cooperative_groups;
#define REP_GEMM 1
#define REP_G1 REP_GEMM
#define REP_GATE REP_GEMM
#define REP_Y REP_GEMM
#define REP_GLU REP_GEMM
#define REP_MERGE REP_GEMM
#define REP_UP REP_GEMM
#define REP_ELEM 1
#define REP_PREP REP_ELEM
#define REP_SG REP_ELEM
#define REP_CARRY REP_ELEM
#define REP_SAMPLE REP_ELEM
#define REP_LOCAL REP_ELEM
#define REP_LN2 REP_ELEM
#define DRY_CONV 0
#define DRY_APPLY 0
#define DRY_LN1 0
#define REP_SYNC 1
#define PROBE_ON 0
#define PROBE_A 0
#define PROBE_B 1
#define GSYNC() do { for (int _s = 0; _s < REP_SYNC; ++_s) { bar_n += (unsigned)G; gbar(bar_ctr, bar_n, wv_); } ++pidx; if (PROBE_ON) { if (pidx == PROBE_A) tA = __builtin_amdgcn_s_memrealtime(); if (pidx == PROBE_B) tB = __builtin_amdgcn_s_memrealtime(); } } while (0)

#define LAS __attribute__((address_space(3)))
typedef unsigned short bf16_t;
typedef short bf16x8 __attribute__((ext_vector_type(8)));
typedef float f32x4 __attribute__((ext_vector_type(4)));
typedef float f32x2 __attribute__((ext_vector_type(2)));
typedef unsigned u32x4 __attribute__((ext_vector_type(4)));
typedef unsigned u32x2 __attribute__((ext_vector_type(2)));

constexpr int MP = 16384, MS = 512, M = MP + MS, D = 1024, NIN = 6144, BW = 512, DFF = 4096;
constexpr int NTHR = 512;
constexpr float ALPHA = 1.41421356237f;
constexpr float LN_EPS = 1e-5f;

constexpr size_t S17 = (size_t)M * 512 * 2;
constexpr size_t OFF_WUP = 0;
constexpr size_t OFF_WDOWN = OFF_WUP + (size_t)4096 * 1024 * 2;
constexpr size_t OFF_R = OFF_WDOWN + (size_t)4096 * 1024 * 2;
constexpr size_t OFF_XB = OFF_R + 4 * S17;
constexpr size_t OFF_BIG = OFF_XB + 2 * S17;
constexpr size_t OFF_H = OFF_BIG;
constexpr size_t OFF_WIN = OFF_BIG;
constexpr size_t OFF_WP = OFF_WIN + (size_t)6144 * 1024 * 2;
constexpr size_t OFF_WGLU = OFF_WP + (size_t)3 * 1024 * 512 * 2;
constexpr size_t OFF_WOUT = OFF_WGLU + (size_t)512 * 512 * 2;
constexpr size_t OFF_WGATE = OFF_WOUT + (size_t)1024 * 1024 * 2;
constexpr size_t OFF_W1T = OFF_WGATE + (size_t)1024 * 512 * 2;
constexpr size_t OFF_WYT = OFF_W1T + (size_t)32 * 128 * 256 * 2;
constexpr size_t OFF_GL8 = OFF_WYT + (size_t)32 * 256 * 384 * 2;
constexpr size_t OFF_YA = OFF_GL8 + (size_t)M * 3072;
constexpr size_t OFF_APACK = OFF_YA + S17;
constexpr size_t OFF_S = OFF_APACK + (size_t)32 * 1024 * 384 * 2;
constexpr size_t OFF_MB = OFF_APACK;
constexpr size_t OFF_USS = OFF_S + (size_t)32 * 1024 * 128 * 4;
constexpr size_t OFF_CAR = OFF_USS + (size_t)512 * 512 * 2;
constexpr size_t OFF_BAR = OFF_CAR + (size_t)8 * 32 * 512 * 8;
constexpr size_t OFF_PD = OFF_BAR + 256;
constexpr size_t OFF_PW = OFF_GL8;
constexpr size_t PART_STRIDE = (size_t)MS * 1024;
constexpr size_t OFF_ZCS = OFF_PD + 3 * PART_STRIDE * 4;
constexpr size_t WS_END = OFF_ZCS + (size_t)MS * 512 * 2;
static_assert(OFF_PD >= OFF_H + (size_t)M * 4096 * 2, "down partials must not overlap h");
static_assert(WS_END <= (size_t)268435456, "workspace map exceeds 256 MiB");
static_assert(OFF_MB + (size_t)M * 1024 * 2 <= OFF_USS, "m overlay");
static_assert(OFF_H + (size_t)M * 4096 * 2 <= (size_t)268435456, "h overlay");

constexpr size_t O_Y = 0;
constexpr size_t O_LCP = (size_t)M * 1024;
constexpr size_t O_LHP = O_LCP + 2 * 8 * 3 * 512;
constexpr size_t O_SCP = O_LHP + 2 * 8 * 512;
constexpr size_t O_SRP = O_SCP + 2 * 8 * 2 * 512;
constexpr size_t O_SIP = O_SRP + 2 * 8 * 2048;
constexpr size_t O_LCS = O_SIP + 2 * 8 * 2048;
constexpr size_t O_LHS = O_LCS + 2 * 128 * 3 * 512;
constexpr size_t O_SCS = O_LHS + 2 * 128 * 512;
constexpr size_t O_SRS = O_SCS + 2 * 128 * 2 * 512;
constexpr size_t O_SIS = O_SRS + 2 * 128 * 2048;

struct Args { const float* in[36]; float* out; unsigned char* ws; };
typedef const __attribute__((address_space(4))) Args* AP;
__device__ __forceinline__ AP ld_args() {
#if defined(__HIP_DEVICE_COMPILE__)
    auto p = __builtin_amdgcn_kernarg_segment_ptr();
    asm volatile("" : "+s"(p));
    return (AP)p;
#else
    return nullptr;
#endif
}
enum { I_XP = 0, I_XS, I_SLC, I_SLH, I_SSC, I_SSR, I_SSI, I_WIN, I_CAW, I_CAB, I_GXW, I_GXB, I_GAW, I_GAB, I_LAM, I_CBW, I_SAR, I_SAI, I_SDT,
       I_SBR, I_SBI, I_SCR, I_SCI, I_SD, I_GLW, I_GLB, I_PA, I_PB, I_PC, I_WO, I_L1G, I_L1B, I_UP, I_DN, I_L2G, I_L2B };

__device__ __forceinline__ unsigned cvt_pk_bf16(float lo, float hi) { unsigned r; asm volatile("v_cvt_pk_bf16_f32 %0, %1, %2" : "=v"(r) : "v"(lo), "v"(hi)); return r; }
__device__ __forceinline__ bf16_t f2bf(float f) { return (bf16_t)(cvt_pk_bf16(f, 0.f) & 0xffffu); }
__device__ __forceinline__ float bf2f(unsigned short b) { return __uint_as_float(((unsigned)b) << 16); }
__device__ __forceinline__ float bflo(unsigned w) { return __uint_as_float(w << 16); }
__device__ __forceinline__ float bfhi(unsigned w) { return __uint_as_float(w & 0xffff0000u); }
__device__ __forceinline__ float sigm(float x) { return 1.0f / (1.0f + __expf(-x)); }
__device__ __forceinline__ float gelu_t(float x) { const float u = 0.7978845608f * (x + 0.044715f * x * x * x); return x / (1.0f + __expf(-2.0f * u)); }
__device__ __forceinline__ u32x4 pack8(const f32x4 a, const f32x4 b) { u32x4 w; w.x = cvt_pk_bf16(a[0], a[1]); w.y = cvt_pk_bf16(a[2], a[3]); w.z = cvt_pk_bf16(b[0], b[1]); w.w = cvt_pk_bf16(b[2], b[3]); return w; }
__device__ __forceinline__ void unpack8(const u32x4 w, float (&f)[8]) { f[0] = bflo(w.x); f[1] = bfhi(w.x); f[2] = bflo(w.y); f[3] = bfhi(w.y); f[4] = bflo(w.z); f[5] = bfhi(w.z); f[6] = bflo(w.w); f[7] = bfhi(w.w); }

__device__ __forceinline__ int otid(const int wv_) { int t = wv_ * 64 + (int)__builtin_amdgcn_mbcnt_hi(~0u, __builtin_amdgcn_mbcnt_lo(~0u, 0u)); asm volatile("" : "+v"(t)); return t; }

__device__ __forceinline__ int opq(int x) { asm volatile("" : "+s"(x)); return x; }

__device__ __forceinline__ void gbar(unsigned* ctr, unsigned target, const int wv_) {
    asm volatile("s_waitcnt vmcnt(0)" ::: "memory");
    __syncthreads();
    if (otid(wv_) == 0) {
        __builtin_amdgcn_fence(__ATOMIC_RELEASE, "agent");
        asm volatile("s_waitcnt vmcnt(0)" ::: "memory");
        __hip_atomic_fetch_add(ctr, 1u, __ATOMIC_RELAXED, __HIP_MEMORY_SCOPE_AGENT);
        while (__hip_atomic_load(ctr, __ATOMIC_RELAXED, __HIP_MEMORY_SCOPE_AGENT) < target) __builtin_amdgcn_s_sleep(1);
        __builtin_amdgcn_fence(__ATOMIC_ACQUIRE, "agent");
        asm volatile("s_waitcnt vmcnt(0)" ::: "memory");
    }
    __syncthreads();
}

constexpr int BM = 256, BK = 64, HALF = 128, HTB = HALF * BK * 2, STAGE_BYTES = 8 * HTB;
__device__ __forceinline__ int lds_byte(int r, int c) { const int st = (r >> 4) * 2 + (c >> 5), rr = r & 15, cc = c & 31, ob = rr * 64 + cc * 2; return st * 1024 + (ob ^ (((ob >> 9) & 1) << 5)); }
__device__ __forceinline__ void stage_rc(int b, int& R, int& C) { const int st = b / 1024, sb = b % 1024, swz = sb ^ (((sb >> 9) & 1) << 5); R = (st >> 1) * 16 + swz / 64; C = (st & 1) * 32 + (swz % 64) / 2; }
__device__ __forceinline__ int perm32(int rho) { const int n = rho >> 4, i = rho & 15; return 8 * (i >> 2) + 4 * n + (i & 3); }
struct Unit { int pm, pn, z; };
__device__ __forceinline__ void tile_map(int L, int nM, int nN, int& pm, int& pn) {
    const int nwg = nM * nN; int wgid = L;
    { const int q = nwg / 8, r = nwg % 8, xcd = wgid % 8, off = wgid / 8; wgid = (xcd < r ? xcd * (q + 1) : r * (q + 1) + (xcd - r) * q) + off; }
    const int nig = 8 * nN, gid = wgid / nig, fm = gid * 8, gsz = (nM - fm) < 8 ? (nM - fm) : 8;
    pm = fm + ((wgid % nig) % gsz); pn = (wgid % nig) / gsz;
}

template <class P>
__device__ __forceinline__ void gemm_phase(LAS unsigned char* lds, const P& p, const int wv_) {
    const int tid = otid(wv_), wid = __builtin_amdgcn_readfirstlane(tid >> 6), lane = tid & 63, wr = wid >> 2, wc = wid & 3, fr = lane & 15, fq = lane >> 4;
    unsigned voffA[2], voffB[2];
#pragma unroll
    for (int i = 0; i < 2; ++i) { int R, C; stage_rc(tid * 16 + i * 8192, R, C); const int Rb = P::PERM ? ((R & ~31) + perm32(R & 31)) : R;
        voffA[i] = (unsigned)(R * p.lda + C) * 2u; voffB[i] = (unsigned)(Rb * p.ldb + C) * 2u; }
    const size_t kstep = (size_t)(BK * 2);
    const size_t hA = (size_t)HALF * p.lda * 2, hB = (size_t)HALF * p.ldb * 2;
    const unsigned ldsw = (unsigned)wid * 1024u;
    const int aoff = lds_byte(wr * 64 + fr, fq * 8), boff = lds_byte(wc * 32 + fr, fq * 8);
#define PG8_SA(b, h) (((b) * 2 + (h)) * HTB)
#define PG8_SB(b, h) ((4 + (b) * 2 + (h)) * HTB)
#define PG8_STAGE(bufoff, gbase, voff) do { _Pragma("unroll") for (int _i = 0; _i < 2; ++_i) \
        __builtin_amdgcn_global_load_lds((const unsigned*)((const char*)(gbase) + (voff)[_i]), (LAS unsigned*)(lds + (bufoff) + ldsw + _i * 8192), 16, 0, 0); } while (0)
#define PG8_LDA(dst, b, h) do { _Pragma("unroll") for (int m = 0; m < 4; ++m) _Pragma("unroll") for (int k = 0; k < 2; ++k) dst[m][k] = *(const LAS bf16x8*)(lds + PG8_SA(b, h) + aoff + m * 2048 + k * 1024); } while (0)
#define PG8_LDB(dst, b, h) do { _Pragma("unroll") for (int n = 0; n < 2; ++n) _Pragma("unroll") for (int k = 0; k < 2; ++k) dst[n][k] = *(const LAS bf16x8*)(lds + PG8_SB(b, h) + boff + n * 2048 + k * 1024); } while (0)
#define PG8_MMA(ai, bj, At, Bt) do { __builtin_amdgcn_s_setprio(1); _Pragma("unroll") for (int m = 0; m < 4; ++m) _Pragma("unroll") for (int n = 0; n < 2; ++n) _Pragma("unroll") for (int k = 0; k < 2; ++k) \
        acc[ai][bj][m][n] = __builtin_amdgcn_mfma_f32_16x16x32_bf16(Bt[n][k], At[m][k], acc[ai][bj][m][n], 0, 0, 0); __builtin_amdgcn_s_setprio(0); } while (0)
#define PG8_WAIT_V(n) asm volatile("s_waitcnt vmcnt(" #n ")" ::: "memory")
#define PG8_WAIT_L(n) asm volatile("s_waitcnt lgkmcnt(" #n ")" ::: "memory")
#define PG8_BAR __builtin_amdgcn_s_barrier()
#define PG8_SCHED __builtin_amdgcn_sched_barrier(0)
    Unit cur, nxt; int ui = 0;
    if (!p.next(0, cur)) return;
    f32x4 acc[2][2][4][2];
#pragma unroll
    for (int a = 0; a < 2; ++a)
#pragma unroll
        for (int b = 0; b < 2; ++b)
#pragma unroll
            for (int m = 0; m < 4; ++m)
#pragma unroll
                for (int n = 0; n < 2; ++n) acc[a][b][m][n] = (f32x4){0.f, 0.f, 0.f, 0.f};
    bf16x8 At[4][2], B0[2][2], B1[2][2];
    const char* cA = p.aptr(cur); const char* cB = p.bptr(cur);
    PG8_STAGE(PG8_SB(0, 0), cB, voffB); PG8_STAGE(PG8_SA(0, 0), cA, voffA); PG8_STAGE(PG8_SB(0, 1), cB + hB, voffB); PG8_STAGE(PG8_SA(0, 1), cA + hA, voffA);
    if (wr == 1) PG8_BAR;
    PG8_WAIT_V(4); PG8_BAR;
    PG8_STAGE(PG8_SB(1, 0), cB + kstep, voffB); PG8_STAGE(PG8_SA(1, 0), cA + kstep, voffA); PG8_STAGE(PG8_SB(1, 1), cB + hB + kstep, voffB);
    PG8_WAIT_V(6); PG8_BAR;
    for (;;) {
        const bool has_next = p.next(ui + 1, nxt);
        const int nt = p.nt(cur);
        const char* nA = has_next ? p.aptr(nxt) : cA; const char* nB = has_next ? p.bptr(nxt) : cB;
        for (int t = 0; t < nt; t += 2) {
            const bool last = (t == nt - 2);
            const char* a1 = cA + (size_t)(t + 1) * kstep;
            const char* a2 = last ? nA : cA + (size_t)(t + 2) * kstep; const char* b2 = last ? nB : cB + (size_t)(t + 2) * kstep;
            const char* a3 = a2 + kstep; const char* b3 = b2 + kstep;
            PG8_LDB(B0, 0, 0); PG8_SCHED; PG8_LDA(At, 0, 0); PG8_STAGE(PG8_SA(1, 1), a1 + hA, voffA);
            PG8_WAIT_L(8); PG8_BAR; PG8_WAIT_L(0); PG8_MMA(0, 0, At, B0); PG8_BAR; PG8_SCHED;
            PG8_LDB(B1, 0, 1); PG8_STAGE(PG8_SB(0, 0), b2, voffB);
            PG8_BAR; PG8_WAIT_L(0); PG8_MMA(0, 1, At, B1); PG8_BAR;
            PG8_LDA(At, 0, 1); PG8_STAGE(PG8_SA(0, 0), a2, voffA);
            PG8_BAR; PG8_WAIT_L(0); PG8_MMA(1, 0, At, B0); PG8_BAR; PG8_SCHED;
            PG8_STAGE(PG8_SB(0, 1), b2 + hB, voffB);
            PG8_WAIT_V(6); PG8_BAR; PG8_MMA(1, 1, At, B1); PG8_BAR;
            PG8_LDB(B0, 1, 0); PG8_SCHED; PG8_LDA(At, 1, 0); PG8_STAGE(PG8_SA(0, 1), a2 + hA, voffA);
            PG8_WAIT_L(8); PG8_BAR; PG8_WAIT_L(0); PG8_MMA(0, 0, At, B0); PG8_BAR; PG8_SCHED;
            PG8_LDB(B1, 1, 1); PG8_STAGE(PG8_SB(1, 0), b3, voffB);
            PG8_BAR; PG8_WAIT_L(0); PG8_MMA(0, 1, At, B1); PG8_BAR;
            PG8_LDA(At, 1, 1); PG8_STAGE(PG8_SA(1, 0), a3, voffA);
            PG8_BAR; PG8_WAIT_L(0); PG8_MMA(1, 0, At, B0); PG8_BAR; PG8_SCHED;
            PG8_STAGE(PG8_SB(1, 1), b3 + hB, voffB);
            PG8_WAIT_V(6); PG8_BAR; PG8_MMA(1, 1, At, B1); PG8_BAR;
        }
        Unit eu = cur;
        asm volatile("" : "+s"(eu.pm), "+s"(eu.pn), "+s"(eu.z));
        const bool rst = p.epi(acc, eu, wr, wc, fr, fq);
        if (!has_next) break;
        if (rst) {
#pragma unroll
            for (int a = 0; a < 2; ++a)
#pragma unroll
                for (int b = 0; b < 2; ++b)
#pragma unroll
                    for (int m = 0; m < 4; ++m)
#pragma unroll
                        for (int n = 0; n < 2; ++n) acc[a][b][m][n] = (f32x4){0.f, 0.f, 0.f, 0.f};
        }
        cur = nxt; cA = nA; cB = nB; ++ui;
    }
    PG8_WAIT_V(0);
    if (wr == 0) PG8_BAR;
    PG8_BAR;
#undef PG8_SA
#undef PG8_SB
#undef PG8_STAGE
#undef PG8_LDA
#undef PG8_LDB
#undef PG8_MMA
#undef PG8_WAIT_V
#undef PG8_WAIT_L
#undef PG8_BAR
#undef PG8_SCHED
}
typedef f32x4 Acc[2][2][4][2];

struct PG1 {
    __device__ __forceinline__ int nt(const Unit&) const { return K / BK; }
    static constexpr bool PERM = true;
    int K, lda, ldb, G, c;
    const bf16_t* A; const bf16_t* Bt;
    bf16_t *xa, *ya, *sb, *sc, *sh, *apack, *uss; unsigned char* gl8;
    __device__ __forceinline__ bool next(int i, Unit& u) const { const long L = (long)i * G + c; if (L >= 66 * 24) return false; tile_map((int)L, 66, 24, u.pm, u.pn); u.z = 0; return true; }
    __device__ __forceinline__ const char* aptr(const Unit& u) const { return (const char*)A + (size_t)u.pm * 256 * 1024 * 2; }
    __device__ __forceinline__ const char* bptr(const Unit& u) const { return (const char*)Bt + (size_t)u.pn * 256 * 1024 * 2; }
    __device__ __forceinline__ bool epi(Acc& acc, const Unit& u, int wr, int wc, int fr, int fq) const {
        const int pn = u.pn;
        if (pn < 10) {
            const int b = pn >> 1; bf16_t* base = b == 0 ? xa : b == 1 ? ya : b == 2 ? sb : b == 3 ? sc : sh;
#pragma unroll
            for (int ai = 0; ai < 2; ++ai)
#pragma unroll
                for (int m = 0; m < 4; ++m) { const size_t r = (size_t)u.pm * 256 + ai * 128 + wr * 64 + m * 16 + fr;
#pragma unroll
                    for (int bj = 0; bj < 2; ++bj) { const int col = (pn & 1) * 256 + bj * 128 + wc * 32 + 8 * fq;
                        *(u32x4*)(base + r * 512 + col) = pack8(acc[ai][bj][m][0], acc[ai][bj][m][1]); } }
        } else if (pn < 12) {
#pragma unroll
            for (int ai = 0; ai < 2; ++ai)
#pragma unroll
                for (int m = 0; m < 4; ++m) { const int r = u.pm * 256 + ai * 128 + wr * 64 + m * 16 + fr;
#pragma unroll
                    for (int bj = 0; bj < 2; ++bj) { const int cc = (pn - 10) * 256 + bj * 128 + wc * 32 + 8 * fq;
                        bf16_t* dst = (u.pm < 64) ? apack + ((size_t)((cc >> 4) * 1024 + (r >> 4)) * 384 + 128 + (r & 15) * 16 + (cc & 15)) : uss + (size_t)(r - MP) * 512 + cc;
                        *(u32x4*)dst = pack8(acc[ai][bj][m][0], acc[ai][bj][m][1]); } }
        } else {
            unsigned char* blk = gl8 + ((size_t)(u.pm * 12 + (pn - 12)) << 16) + (size_t)(((wr * 4 + wc) * 64 + fq * 16 + fr) * 128);
#pragma unroll
            for (int ai = 0; ai < 2; ++ai)
#pragma unroll
                for (int m = 0; m < 4; ++m) { u32x4 w;
#pragma unroll
                    for (int bj = 0; bj < 2; ++bj)
#pragma unroll
                        for (int n = 0; n < 2; ++n) { unsigned pk = 0;
#pragma unroll
                            for (int j = 0; j < 4; ++j) { int v = (int)(sigm(acc[ai][bj][m][n][j]) * 256.0f); v = v < 0 ? 0 : (v > 255 ? 255 : v); pk |= (unsigned)v << (8 * j); }
                            w[bj * 2 + n] = pk; }
                    *(u32x4*)(blk + (ai * 4 + m) * 16) = w; }
        }
        return true;
    }
};

struct PGate {
    __device__ __forceinline__ int nt(const Unit&) const { return K / BK; }
    static constexpr bool PERM = false;
    int K, lda, ldb, G, c;
    const bf16_t* A; const bf16_t* Bt;
    const float *gxb, *gab, *lam; _Float16* aout; bf16_t* bxout;
    __device__ __forceinline__ bool next(int i, Unit& u) const { const long L = (long)i * G + c; if (L >= 66 * 4) return false; tile_map((int)L, 66, 4, u.pm, u.pn); u.z = 0; return true; }
    __device__ __forceinline__ const char* aptr(const Unit& u) const { return (const char*)A + (size_t)u.pm * 256 * 512 * 2 + (size_t)(u.pn >> 1) * 512; }
    __device__ __forceinline__ const char* bptr(const Unit& u) const { return (const char*)Bt + (size_t)u.pn * 256 * 256 * 2; }
    __device__ __forceinline__ bool epi(Acc& acc, const Unit& u, int wr, int wc, int fr, int fq) const {
#pragma unroll
        for (int n = 0; n < 2; ++n) {
            const int ch0 = u.pn * 128 + wc * 32 + n * 16 + 4 * fq;
            const f32x4 bx4 = *(const f32x4*)(gxb + ch0), ba4 = *(const f32x4*)(gab + ch0), lm4 = *(const f32x4*)(lam + ch0);
            f32x4 kk;
#pragma unroll
            for (int j = 0; j < 4; ++j) kk[j] = -8.0f * log1pf(expf(-lm4[j]));
#pragma unroll
            for (int ai = 0; ai < 2; ++ai)
#pragma unroll
                for (int m = 0; m < 4; ++m) { const size_t r = (size_t)u.pm * 256 + ai * 128 + wr * 64 + m * 16 + fr;
                    const u32x2 xw = *(const u32x2*)(A + r * 512 + ch0);
                    const float xc[4] = {bflo(xw.x), bfhi(xw.x), bflo(xw.y), bfhi(xw.y)};
                    float av[4], la4[4]; float bv[4];
#pragma unroll
                    for (int j = 0; j < 4; ++j) { const float gx = sigm(acc[ai][0][m][n][j] + bx4[j]), ga = sigm(acc[ai][1][m][n][j] + ba4[j]);
                        const float la = kk[j] * ga; la4[j] = la; av[j] = __expf(la); bv[j] = __builtin_amdgcn_sqrtf(fmaxf(1.0f - av[j] * av[j], 0.f)) * gx * xc[j]; }
                    { typedef _Float16 h4 __attribute__((ext_vector_type(4))); h4 hv; hv[0] = (_Float16)la4[0]; hv[1] = (_Float16)la4[1]; hv[2] = (_Float16)la4[2]; hv[3] = (_Float16)la4[3]; *(h4*)(aout + r * 512 + ch0) = hv; }
                    u32x2 w; w.x = cvt_pk_bf16(bv[0], bv[1]); w.y = cvt_pk_bf16(bv[2], bv[3]);
                    *(u32x2*)(bxout + r * 512 + ch0) = w; }
        }
        return true;
    }
};

struct PY {
    __device__ __forceinline__ int nt(const Unit&) const { return K / BK; }
    static constexpr bool PERM = true;
    int K, lda, ldb, G, c;
    const bf16_t* apack; const bf16_t* wyt; const float* dvec; bf16_t* zc;
    __device__ __forceinline__ bool next(int i, Unit& u) const { const long L = (long)i * G + c; if (L >= 128) return false; u.pm = (int)L; u.pn = (int)L >> 2; u.z = 0; return true; }
    __device__ __forceinline__ const char* aptr(const Unit& u) const { return (const char*)apack + (size_t)u.pm * 256 * 384 * 2; }
    __device__ __forceinline__ const char* bptr(const Unit& u) const { return (const char*)wyt + (size_t)u.pn * 256 * 384 * 2; }
    __device__ __forceinline__ bool epi(Acc& acc, const Unit& u, int wr, int wc, int fr, int fq) const {
        const int g = u.pn;
#pragma unroll
        for (int bj = 0; bj < 2; ++bj) {
            const int n0 = bj * 128 + wc * 32 + 8 * fq, ti = n0 >> 4, c0 = n0 & 15;
            const f32x4 d0 = *(const f32x4*)(dvec + g * 16 + c0), d1 = *(const f32x4*)(dvec + g * 16 + c0 + 4);
#pragma unroll
            for (int ai = 0; ai < 2; ++ai)
#pragma unroll
                for (int m = 0; m < 4; ++m) { const int rr = (u.pm & 3) * 256 + ai * 128 + wr * 64 + m * 16 + fr;
                    const u32x4 uw = *(const u32x4*)(apack + ((size_t)(g * 1024 + rr) * 384 + 128 + n0));
                    float uf[8]; unpack8(uw, uf);
                    f32x4 y0, y1;
#pragma unroll
                    for (int j = 0; j < 4; ++j) { y0[j] = gelu_t(acc[ai][bj][m][0][j] + d0[j] * uf[j]); y1[j] = gelu_t(acc[ai][bj][m][1][j] + d1[j] * uf[4 + j]); }
                    const size_t tok = (size_t)(rr >> 7) * 2048 + (rr & 127) * 16 + ti;
                    *(u32x4*)(zc + tok * 512 + g * 16 + c0) = pack8(y0, y1); }
        }
        return true;
    }
};

struct PGlu {
    __device__ __forceinline__ int nt(const Unit&) const { return K / BK; }
    static constexpr bool PERM = true;
    int K, lda, ldb, G, c, sample;
    const bf16_t* A; const bf16_t* As; const bf16_t* Bt; const float* bias; bf16_t* out;
    __device__ __forceinline__ bool next(int i, Unit& u) const {
        if (sample) { const int j = c - 128; if (i != 0 || j < 0 || j >= 4) return false; u.pm = 64 + (j >> 1); u.pn = j & 1; u.z = 0; return true; }
        const long L = (long)i * G + c; if (L >= 64 * 2) return false; tile_map((int)L, 64, 2, u.pm, u.pn); u.z = 0; return true; }
    __device__ __forceinline__ const bf16_t* arow0(const Unit& u) const { return u.pm < 64 ? A + (size_t)u.pm * 256 * 512 : As + (size_t)(u.pm - 64) * 256 * 512; }
    __device__ __forceinline__ const char* aptr(const Unit& u) const { return (const char*)arow0(u); }
    __device__ __forceinline__ const char* bptr(const Unit& u) const { return (const char*)Bt + (size_t)u.pn * 256 * 512 * 2; }
    __device__ __forceinline__ bool epi(Acc& acc, const Unit& u, int wr, int wc, int fr, int fq) const {
        const bf16_t* zsrc = arow0(u);
#pragma unroll
        for (int bj = 0; bj < 2; ++bj) {
            const int col = u.pn * 256 + bj * 128 + wc * 32 + 8 * fq;
            const f32x4 b0 = *(const f32x4*)(bias + col), b1 = *(const f32x4*)(bias + col + 4);
#pragma unroll
            for (int ai = 0; ai < 2; ++ai)
#pragma unroll
                for (int m = 0; m < 4; ++m) { const int rl = ai * 128 + wr * 64 + m * 16 + fr; const size_t r = (size_t)u.pm * 256 + rl;
                    const u32x4 zw = *(const u32x4*)(zsrc + (size_t)rl * 512 + col); float zf[8]; unpack8(zw, zf);
                    f32x4 y0, y1;
#pragma unroll
                    for (int j = 0; j < 4; ++j) { y0[j] = zf[j] * sigm(acc[ai][bj][m][0][j] + b0[j]); y1[j] = zf[4 + j] * sigm(acc[ai][bj][m][1][j] + b1[j]); }
                    *(u32x4*)(out + r * 512 + col) = pack8(y0, y1); }
        }
        return true;
    }
};

struct PMerge {
    __device__ __forceinline__ int nt(const Unit&) const { return K / BK; }
    static constexpr bool PERM = true;
    int K, lda, ldb, G, c, sample;
    const bf16_t* a0; const bf16_t* wp; const unsigned char* gl8; bf16_t* mb;
    __device__ __forceinline__ bool next(int i, Unit& u) const { const int ti = i / 3;
        if (sample) { const int j = c - (G - 8); if (ti != 0 || j < 0) return false; u.pm = 64 + (j >> 2); u.pn = j & 3; u.z = i; return true; }
        const long L = (long)ti * G + c; if (L >= 64 * 4) return false; tile_map((int)L, 64, 4, u.pm, u.pn); u.z = i - ti * 3; return true; }
    __device__ __forceinline__ const char* aptr(const Unit& u) const { const size_t off = (u.z == 2) ? (OFF_XB + S17 - OFF_R) : (size_t)u.z * S17; return (const char*)a0 + off + (size_t)u.pm * 256 * 512 * 2; }
    __device__ __forceinline__ const char* bptr(const Unit& u) const { return (const char*)wp + ((size_t)u.z * 1024 + (size_t)u.pn * 256) * 512 * 2; }
    __device__ __forceinline__ bool epi(Acc& acc, const Unit& u, int wr, int wc, int fr, int fq) const {
        const int br = u.z;
        const unsigned char* blk = gl8 + ((size_t)(u.pm * 12 + br * 4 + u.pn) << 16) + (size_t)(((wr * 4 + wc) * 64 + fq * 16 + fr) * 128);
#pragma unroll
        for (int ai = 0; ai < 2; ++ai)
#pragma unroll
            for (int m = 0; m < 4; ++m) { const size_t r = (size_t)u.pm * 256 + ai * 128 + wr * 64 + m * 16 + fr;
                const u32x4 qc = *(const u32x4*)(blk + (ai * 4 + m) * 16);
                if (br < 2) {
                    const u32x4 qn = *(const u32x4*)(blk + 4 * 65536 + (ai * 4 + m) * 16);
#pragma unroll
                    for (int bj = 0; bj < 2; ++bj)
#pragma unroll
                        for (int n = 0; n < 2; ++n)
#pragma unroll
                            for (int j = 0; j < 4; ++j) { const float gc = (float)((qc[bj * 2 + n] >> (8 * j)) & 255u) + 0.5f, gn = (float)((qn[bj * 2 + n] >> (8 * j)) & 255u) + 0.5f;
                                acc[ai][bj][m][n][j] *= gc * __builtin_amdgcn_rcpf(gn); }
                } else {
#pragma unroll
                    for (int bj = 0; bj < 2; ++bj) { const int col = u.pn * 256 + bj * 128 + wc * 32 + 8 * fq;
                        f32x4 y0, y1;
#pragma unroll
                        for (int j = 0; j < 4; ++j) {
                            y0[j] = acc[ai][bj][m][0][j] * (((float)((qc[bj * 2] >> (8 * j)) & 255u) + 0.5f) * (1.0f / 256.0f));
                            y1[j] = acc[ai][bj][m][1][j] * (((float)((qc[bj * 2 + 1] >> (8 * j)) & 255u) + 0.5f) * (1.0f / 256.0f)); }
                        *(u32x4*)(mb + r * 1024 + col) = pack8(y0, y1); }
                } }
        return br == 2;
    }
};

struct PWout {
    static constexpr bool PERM = false;
    int K, lda, ldb, G, c;
    const bf16_t* A; const bf16_t* Bt; const float* xp; const float* xs; float* R; float* part;
    __device__ __forceinline__ int nt(const Unit& u) const { return u.z < 0 ? 16 : 4; }
    __device__ __forceinline__ bool next(int i, Unit& u) const {
        const int nP = c < 256 ? (256 - c + G - 1) / G : 0;
        if (i < nP) { tile_map(i * G + c, 64, 4, u.pm, u.pn); u.z = -1; return true; }
        const int j = (i - nP) * G + c; if (j >= 32) return false;
        u.pm = 64 + (j >> 4); u.pn = (j >> 2) & 3; u.z = j & 3; return true; }
    __device__ __forceinline__ const char* aptr(const Unit& u) const { return (const char*)A + (size_t)u.pm * 256 * 1024 * 2 + (u.z < 0 ? 0 : u.z * 512); }
    __device__ __forceinline__ const char* bptr(const Unit& u) const { return (const char*)Bt + (size_t)u.pn * 256 * 1024 * 2 + (u.z < 0 ? 0 : u.z * 512); }
    __device__ __forceinline__ bool epi(Acc& acc, const Unit& u, int wr, int wc, int fr, int fq) const {
        const float* xsrc = (u.pm < 64) ? xp + (size_t)u.pm * 256 * 1024 : xs + (size_t)(u.pm - 64) * 256 * 1024;
#pragma unroll
        for (int ai = 0; ai < 2; ++ai)
#pragma unroll
            for (int m = 0; m < 4; ++m) { const int rl = ai * 128 + wr * 64 + m * 16 + fr; const size_t r = (size_t)u.pm * 256 + rl;
#pragma unroll
                for (int bj = 0; bj < 2; ++bj)
#pragma unroll
                    for (int n = 0; n < 2; ++n) { const int col = u.pn * 256 + bj * 128 + wc * 32 + n * 16 + 4 * fq;
                        float* pp = R + r * 1024 + col;
                        if (u.z <= 0) { const f32x4 xv = *(const f32x4*)(xsrc + (size_t)rl * 1024 + col); *(f32x4*)pp = xv * ALPHA + acc[ai][bj][m][n]; }
                        else *(f32x4*)(part + (size_t)(u.z - 1) * PART_STRIDE + (r - MP) * 1024 + col) = acc[ai][bj][m][n]; } }
        return true;
    }
};

struct PUp {
    __device__ __forceinline__ int nt(const Unit&) const { return K / BK; }
    static constexpr bool PERM = true;
    int K, lda, ldb, G, c;
    const bf16_t* A; const bf16_t* Bt; bf16_t* h;
    __device__ __forceinline__ bool next(int i, Unit& u) const { const long L = (long)i * G + c; if (L >= 66 * 16) return false; tile_map((int)L, 66, 16, u.pm, u.pn); u.z = 0; return true; }
    __device__ __forceinline__ const char* aptr(const Unit& u) const { return (const char*)A + (size_t)u.pm * 256 * 1024 * 2; }
    __device__ __forceinline__ const char* bptr(const Unit& u) const { return (const char*)Bt + (size_t)u.pn * 256 * 1024 * 2; }
    __device__ __forceinline__ bool epi(Acc& acc, const Unit& u, int wr, int wc, int fr, int fq) const {
#pragma unroll
        for (int ai = 0; ai < 2; ++ai)
#pragma unroll
            for (int m = 0; m < 4; ++m) { const size_t r = (size_t)u.pm * 256 + ai * 128 + wr * 64 + m * 16 + fr;
#pragma unroll
                for (int bj = 0; bj < 2; ++bj) { const int col = u.pn * 256 + bj * 128 + wc * 32 + 8 * fq;
                    f32x4 y0, y1;
#pragma unroll
                    for (int j = 0; j < 4; ++j) { const float v0 = fmaxf(acc[ai][bj][m][0][j], 0.f), v1 = fmaxf(acc[ai][bj][m][1][j], 0.f); y0[j] = v0 * v0; y1[j] = v1 * v1; }
                    *(u32x4*)(h + r * 4096 + col) = pack8(y0, y1); } }
        return true;
    }
};

struct PDown {
    static constexpr bool PERM = false;
    int K, lda, ldb, G, c;
    const bf16_t* A; const bf16_t* Bt; float* R; float* part; const bf16_t* x1;
    __device__ __forceinline__ int nt(const Unit& u) const { return u.z < 0 ? 64 : 16; }
    __device__ __forceinline__ bool next(int i, Unit& u) const {
        const int nP = c < 256 ? (256 - c + G - 1) / G : 0;
        if (i < nP) { tile_map(i * G + c, 64, 4, u.pm, u.pn); u.z = -1; return true; }
        const int j = (i - nP) * G + c; if (j >= 32) return false;
        u.pm = 64 + (j >> 4); u.pn = (j >> 2) & 3; u.z = j & 3; return true; }
    __device__ __forceinline__ const char* aptr(const Unit& u) const { return (const char*)A + (size_t)u.pm * 256 * 4096 * 2 + (u.z < 0 ? 0 : u.z * 2048); }
    __device__ __forceinline__ const char* bptr(const Unit& u) const { return (const char*)Bt + (size_t)u.pn * 256 * 4096 * 2 + (u.z < 0 ? 0 : u.z * 2048); }
    __device__ __forceinline__ bool epi(Acc& acc, const Unit& u, int wr, int wc, int fr, int fq) const {
#pragma unroll
        for (int ai = 0; ai < 2; ++ai)
#pragma unroll
            for (int m = 0; m < 4; ++m) { const size_t r = (size_t)u.pm * 256 + ai * 128 + wr * 64 + m * 16 + fr;
#pragma unroll
                for (int bj = 0; bj < 2; ++bj)
#pragma unroll
                    for (int n = 0; n < 2; ++n) { const int col = u.pn * 256 + bj * 128 + wc * 32 + n * 16 + 4 * fq;
                        float* pp = R + r * 1024 + col;
                        if (u.z <= 0) { const u32x2 xw = *(const u32x2*)(x1 + r * 1024 + col); const f32x4 xv = (f32x4){bflo(xw.x), bfhi(xw.x), bflo(xw.y), bfhi(xw.y)};
                            *(f32x4*)pp = xv * ALPHA + acc[ai][bj][m][n]; }
                        else *(f32x4*)(part + (size_t)(u.z - 1) * PART_STRIDE + (r - MP) * 1024 + col) = acc[ai][bj][m][n]; } }
        return true;
    }
};

struct TJob { const float* W; bf16_t* Wt; int K, N, tk, tn4; };
__device__ __forceinline__ TJob tjob(AP a, int layer, int t) {
    unsigned char* ws = a->ws; TJob j; int tt;
    if (t < 384) { tt = t; j.W = a->in[I_WIN] + (size_t)layer * 1024 * 6144; j.Wt = (bf16_t*)(ws + OFF_WIN); j.K = 1024; j.N = 6144; }
    else if (t < 480) { const int q = (t - 384) / 32; tt = (t - 384) % 32; j.W = a->in[I_PA + q] + (size_t)layer * 512 * 1024; j.Wt = (bf16_t*)(ws + OFF_WP) + (size_t)q * 1024 * 512; j.K = 512; j.N = 1024; }
    else if (t < 496) { tt = t - 480; j.W = a->in[I_GLW] + (size_t)layer * 512 * 512; j.Wt = (bf16_t*)(ws + OFF_WGLU); j.K = 512; j.N = 512; }
    else if (t < 560) { tt = t - 496; j.W = a->in[I_WO] + (size_t)layer * 1024 * 1024; j.Wt = (bf16_t*)(ws + OFF_WOUT); j.K = 1024; j.N = 1024; }
    else if (t < 816) { tt = t - 560; j.W = a->in[I_UP] + (size_t)layer * 1024 * 4096; j.Wt = (bf16_t*)(ws + OFF_WUP); j.K = 1024; j.N = 4096; }
    else { tt = t - 816; j.W = a->in[I_DN] + (size_t)layer * 4096 * 1024; j.Wt = (bf16_t*)(ws + OFF_WDOWN); j.K = 4096; j.N = 1024; }
    const int ntn = j.N / 256; j.tk = tt / ntn; j.tn4 = tt % ntn; return j;
}
__device__ __forceinline__ void tload(const TJob& j, int tid, f32x4 (&v)[4][2]) {
    const int r = tid >> 3, c8 = (tid & 7) * 8; const float* src = j.W + (size_t)(j.tk * 64 + r) * j.N + j.tn4 * 256 + c8;
#pragma unroll
    for (int q = 0; q < 4; ++q) { v[q][0] = *(const f32x4*)(src + q * 64); v[q][1] = *(const f32x4*)(src + q * 64 + 4); }
}

__device__ __forceinline__ void abar_pow(const float* are, const float* aim, const float* ldt, int sp, float e, float& pr, float& pi) {
    const float step = expf(ldt[sp]); const float x = e * step * are[sp], th = e * step * aim[sp];
    float s, c; sincosf(th, &s, &c); const float mg = expf(x); pr = mg * c; pi = mg * s;
}
__device__ __forceinline__ void ssm_coef(const float* are, const float* aim, const float* ldt, int sp, float& cr, float& ci) {
    const float step = expf(ldt[sp]); const float ar = are[sp], ai = aim[sp];
    const float x = step * ar, th = step * ai;
    float s, c; sincosf(th, &s, &c); const float em1 = expm1f(x); const float sh = sinf(0.5f * th);
    const float nr = em1 * c - 2.0f * sh * sh, ni = (em1 + 1.0f) * s;
    const float den = ar * ar + ai * ai;
    cr = (nr * ar + ni * ai) / den; ci = (ni * ar - nr * ai) / den;
}

__device__ __forceinline__ void prep_layer(AP a, int layer, float* sm, const int wv_) {
    unsigned char* ws = a->ws;
    const int G = gridDim.x;
    {
        const int tid = otid(wv_), r = tid >> 3, c8 = (tid & 7) * 8, n = tid >> 3, k8 = (tid & 7) * 8;
        int t = blockIdx.x; f32x4 v[4][2]; TJob j;
        if (t < 1072) { j = tjob(a, layer, t); tload(j, tid, v); }
        while (t < 1072) {
#pragma unroll
            for (int q = 0; q < 4; ++q)
#pragma unroll
                for (int e = 0; e < 4; ++e) { sm[q * 4160 + r * 65 + c8 + e] = v[q][0][e]; sm[q * 4160 + r * 65 + c8 + 4 + e] = v[q][1][e]; }
            __syncthreads();
            const TJob cj = j; const int tn = t + G;
            if (tn < 1072) { j = tjob(a, layer, tn); tload(j, tid, v); }
#pragma unroll
            for (int q = 0; q < 4; ++q) { const float* tt = sm + q * 4160;
                u32x4 w;
                w.x = cvt_pk_bf16(tt[(k8 + 0) * 65 + n], tt[(k8 + 1) * 65 + n]); w.y = cvt_pk_bf16(tt[(k8 + 2) * 65 + n], tt[(k8 + 3) * 65 + n]);
                w.z = cvt_pk_bf16(tt[(k8 + 4) * 65 + n], tt[(k8 + 5) * 65 + n]); w.w = cvt_pk_bf16(tt[(k8 + 6) * 65 + n], tt[(k8 + 7) * 65 + n]);
                *(u32x4*)(cj.Wt + (size_t)(cj.tn4 * 256 + q * 64 + n) * cj.K + cj.tk * 64 + k8) = w; }
            __syncthreads();
            t = tn;
        }
    }
    const int GT = G * NTHR;
    {
        bf16_t* wg = (bf16_t*)(ws + OFF_WGATE);
        for (int idx = blockIdx.x * NTHR + otid(wv_); idx < 1024 * 32; idx += GT) {
            const int n = idx >> 5, k0 = (idx & 31) * 8; const int pn = n >> 8, bj = (n >> 7) & 1, ch = pn * 128 + (n & 127), hd = ch >> 6, j = ch & 63;
            u32x4 w = (u32x4){0u, 0u, 0u, 0u};
            if ((pn >> 1) * 4 + (k0 >> 6) == hd) { const float* src = a->in[bj ? I_GAW : I_GXW] + (size_t)layer * 8 * 64 * 64 + (size_t)hd * 4096 + (size_t)(k0 & 63) * 64 + j;
                w.x = cvt_pk_bf16(src[0], src[64]); w.y = cvt_pk_bf16(src[128], src[192]); w.z = cvt_pk_bf16(src[256], src[320]); w.w = cvt_pk_bf16(src[384], src[448]); }
            *(u32x4*)(wg + (size_t)n * 256 + k0) = w;
        }
    }
    const float* are = a->in[I_SAR] + layer * 2048; const float* aim = a->in[I_SAI] + layer * 2048; const float* ldt = a->in[I_SDT] + layer * 2048;
    const float* bre = a->in[I_SBR] + layer * 32768; const float* bim = a->in[I_SBI] + layer * 32768;
    const float* cre = a->in[I_SCR] + layer * 32768; const float* cim = a->in[I_SCI] + layer * 32768;
    {
        bf16_t* w1 = (bf16_t*)(ws + OFF_W1T);
        for (int idx = blockIdx.x * NTHR + otid(wv_); idx < 32 * 128 * 32; idx += GT) {
            const int g = idx >> 12, n = (idx >> 5) & 127, k0 = (idx & 31) * 8, j = k0 >> 4, c0 = k0 & 15, p = n & 63, part = n >> 6, sp = g * 64 + p;
            float pr, pi, cr, ci; abar_pow(are, aim, ldt, sp, (float)(15 - j), pr, pi); ssm_coef(are, aim, ldt, sp, cr, ci);
            const float qr = pr * cr - pi * ci, qi = pr * ci + pi * cr;
            float o[8];
#pragma unroll
            for (int q = 0; q < 8; ++q) { const float br = bre[sp * 16 + c0 + q], bi = bim[sp * 16 + c0 + q]; o[q] = part ? (qr * bi + qi * br) : (qr * br - qi * bi); }
            u32x4 w; w.x = cvt_pk_bf16(o[0], o[1]); w.y = cvt_pk_bf16(o[2], o[3]); w.z = cvt_pk_bf16(o[4], o[5]); w.w = cvt_pk_bf16(o[6], o[7]);
            *(u32x4*)(w1 + ((size_t)(g * 128 + n) * 256 + k0)) = w;
        }
    }
    {
        bf16_t* wy = (bf16_t*)(ws + OFF_WYT);
        for (int idx = blockIdx.x * NTHR + otid(wv_); idx < 32 * 256 * 16; idx += GT) {
            const int g = idx >> 12, n = (idx >> 4) & 255, k0 = (idx & 15) * 8, i = n >> 4, c = n & 15, part = k0 >> 6, p0 = k0 & 63;
            float o[8];
#pragma unroll
            for (int q = 0; q < 8; ++q) { const int p = p0 + q, sp = g * 64 + p; float pr, pi; abar_pow(are, aim, ldt, sp, (float)(i + 1), pr, pi);
                const float xr = cre[(g * 16 + c) * 64 + p], xi = cim[(g * 16 + c) * 64 + p];
                o[q] = part ? -(xr * pi + xi * pr) : (xr * pr - xi * pi); }
            u32x4 w; w.x = cvt_pk_bf16(o[0], o[1]); w.y = cvt_pk_bf16(o[2], o[3]); w.z = cvt_pk_bf16(o[4], o[5]); w.w = cvt_pk_bf16(o[6], o[7]);
            *(u32x4*)(wy + ((size_t)(g * 256 + n) * 384 + k0)) = w;
        }
        for (int idx = blockIdx.x * NTHR + otid(wv_); idx < 32 * 256 * 4; idx += GT) {
            const int pq = idx & 3, c2 = (idx >> 2) & 15, c = (idx >> 6) & 15, g = idx >> 10;
            float km[16];
#pragma unroll
            for (int d = 0; d < 16; ++d) km[d] = 0.f;
            for (int pp = 0; pp < 16; ++pp) { const int p = pq * 16 + pp, sp = g * 64 + p; float ar, ai, cr, ci; abar_pow(are, aim, ldt, sp, 1.0f, ar, ai); ssm_coef(are, aim, ldt, sp, cr, ci);
                const float br = bre[sp * 16 + c2], bi = bim[sp * 16 + c2];
                const float bbr = cr * br - ci * bi, bbi = cr * bi + ci * br;
                const float xr = cre[(g * 16 + c) * 64 + p], xi = cim[(g * 16 + c) * 64 + p];
                float tr = xr * bbr - xi * bbi, ti = xr * bbi + xi * bbr;
#pragma unroll
                for (int d = 0; d < 16; ++d) { km[d] += tr; const float nr = tr * ar - ti * ai, ni = tr * ai + ti * ar; tr = nr; ti = ni; } }
#pragma unroll
            for (int d = 0; d < 16; ++d) { km[d] += __shfl_xor(km[d], 1); km[d] += __shfl_xor(km[d], 2); }
#pragma unroll
            for (int d = 0; d < 16; ++d) if ((d & 3) == pq) { const bf16_t kb = f2bf(km[d]);
                for (int i = d; i < 16; ++i) wy[(size_t)(g * 256 + i * 16 + c) * 384 + 128 + (i - d) * 16 + c2] = kb;
                if (d > 0) for (int i = 0; i < 16 - d; ++i) wy[(size_t)(g * 256 + i * 16 + c) * 384 + 128 + (i + d) * 16 + c2] = (bf16_t)0; }
        }
    }
}

__device__ __forceinline__ void prep_x(AP a, const int wv_) {
    bf16_t* xb = (bf16_t*)(a->ws + OFF_XB);
    const int gt = blockIdx.x * NTHR + otid(wv_), GT = gridDim.x * NTHR;
    for (int idx = gt; idx < M * 128; idx += GT) {
        const size_t e = (size_t)idx * 8; const float* src = e < (size_t)MP * 1024 ? a->in[I_XP] + e : a->in[I_XS] + (e - (size_t)MP * 1024);
        const f32x4 v0 = *(const f32x4*)src, v1 = *(const f32x4*)(src + 4);
        *(u32x4*)(xb + e) = pack8(v0, v1);
    }
}

__device__ __forceinline__ void conv_phase(AP a, int layer, bf16_t* bin_out, const int wv_) {
    unsigned char* ws = a->ws;
    const bf16_t* xa = (const bf16_t*)(ws + OFF_R); bf16_t* sb = (bf16_t*)(ws + OFF_R + S17);
    const bf16_t* sc = (const bf16_t*)(ws + OFF_R + 2 * S17); const bf16_t* sh = (const bf16_t*)(ws + OFF_R + 3 * S17);
    bf16_t* xac = (bf16_t*)(ws + OFF_XB);
    const float* caw = a->in[I_CAW] + layer * 4 * 512; const float* cab = a->in[I_CAB] + layer * 512; const float* cbw = a->in[I_CBW] + layer * 3 * 512;
    const int gt = blockIdx.x * NTHR + otid(wv_), GT = gridDim.x * NTHR;
    for (int idx = gt; idx < (2048 + 128) * 64; idx += GT) {
        const int seg = idx >> 6, c0 = (idx & 63) * 8;
        const bool prompt = seg < 2048;
        int row0, nrows;
        float x0[8], x1[8], x2[8], u1[8], u2[8];
        if (prompt) { row0 = seg * 8; nrows = 8; const bool first = (seg & 255) == 0;
            if (first) {
#pragma unroll
                for (int j = 0; j < 8; ++j) { x0[j] = 0.f; x1[j] = 0.f; x2[j] = 0.f; u1[j] = 0.f; u2[j] = 0.f; }
            } else {
                unpack8(*(const u32x4*)(xa + (size_t)(row0 - 3) * 512 + c0), x0); unpack8(*(const u32x4*)(xa + (size_t)(row0 - 2) * 512 + c0), x1); unpack8(*(const u32x4*)(xa + (size_t)(row0 - 1) * 512 + c0), x2);
                float s1[8], s2[8];
                unpack8(*(const u32x4*)(sc + (size_t)(row0 - 2) * 512 + c0), u1); unpack8(*(const u32x4*)(sh + (size_t)(row0 - 2) * 512 + c0), s1);
                unpack8(*(const u32x4*)(sc + (size_t)(row0 - 1) * 512 + c0), u2); unpack8(*(const u32x4*)(sh + (size_t)(row0 - 1) * 512 + c0), s2);
#pragma unroll
                for (int j = 0; j < 8; ++j) { u1[j] *= s1[j]; u2[j] *= s2[j]; }
            }
        } else { const int b = seg - 2048; row0 = MP + b * 4; nrows = 4;
            const float* lc = a->in[I_SLC] + ((size_t)(layer * 128 + b) * 3) * 512 + c0; const float* scs = a->in[I_SSC] + ((size_t)(layer * 128 + b) * 2) * 512 + c0;
#pragma unroll
            for (int j = 0; j < 8; ++j) { x0[j] = lc[j]; x1[j] = lc[512 + j]; x2[j] = lc[1024 + j]; u1[j] = scs[j]; u2[j] = scs[512 + j]; }
        }
        float w0[8], w1[8], w2[8], w3[8], wb[8], v0[8], v1[8], v2[8];
#pragma unroll
        for (int j = 0; j < 8; ++j) { w0[j] = caw[c0 + j]; w1[j] = caw[512 + c0 + j]; w2[j] = caw[1024 + c0 + j]; w3[j] = caw[1536 + c0 + j]; wb[j] = cab[c0 + j];
            v0[j] = cbw[c0 + j]; v1[j] = cbw[512 + c0 + j]; v2[j] = cbw[1024 + c0 + j]; }
        for (int t0 = 0; t0 < nrows; t0 += 2) {
            u32x4 lx[2], lc[2], lh[2], lb[2];
#pragma unroll
            for (int k = 0; k < 2; ++k) { const size_t off = (size_t)(row0 + t0 + k) * 512 + c0;
                lx[k] = *(const u32x4*)(xa + off); lc[k] = *(const u32x4*)(sc + off); lh[k] = *(const u32x4*)(sh + off); lb[k] = *(const u32x4*)(sb + off); }
#pragma unroll
            for (int k = 0; k < 2; ++k) { const size_t off = (size_t)(row0 + t0 + k) * 512 + c0;
                float xv[8], scv[8], shv[8], sbv[8];
                unpack8(lx[k], xv); unpack8(lc[k], scv); unpack8(lh[k], shv); unpack8(lb[k], sbv);
                f32x4 o0, o1, q0, q1;
#pragma unroll
                for (int j = 0; j < 8; ++j) {
                    const float o = w0[j] * x0[j] + w1[j] * x1[j] + w2[j] * x2[j] + w3[j] * xv[j] + wb[j];
                    const float uu = scv[j] * shv[j]; const float cu = v0[j] * u1[j] + v1[j] * u2[j] + v2[j] * uu; const float bi = sbv[j] * cu;
                    if (j < 4) { o0[j] = o; q0[j] = bi; } else { o1[j - 4] = o; q1[j - 4] = bi; }
                    x0[j] = x1[j]; x1[j] = x2[j]; x2[j] = xv[j]; u1[j] = u2[j]; u2[j] = uu;
                }
                *(u32x4*)(xac + off) = pack8(o0, o1);
                *(u32x4*)(bin_out + off) = pack8(q0, q1); }
        }
        if (prompt) { if ((seg & 255) == 255) { const int b = seg >> 8;
                float* o1 = a->out + O_LCP + ((size_t)(layer * 8 + b) * 3) * 512 + c0; float* o2 = a->out + O_SCP + ((size_t)(layer * 8 + b) * 2) * 512 + c0;
#pragma unroll
                for (int j = 0; j < 8; ++j) { o1[j] = x0[j]; o1[512 + j] = x1[j]; o1[1024 + j] = x2[j]; o2[j] = u1[j]; o2[512 + j] = u2[j]; } }
        } else { const int b = seg - 2048;
            float* o1 = a->out + O_LCS + ((size_t)(layer * 128 + b) * 3) * 512 + c0; float* o2 = a->out + O_SCS + ((size_t)(layer * 128 + b) * 2) * 512 + c0;
#pragma unroll
            for (int j = 0; j < 8; ++j) { o1[j] = x0[j]; o1[512 + j] = x1[j]; o1[1024 + j] = x2[j]; o2[j] = u1[j]; o2[512 + j] = u2[j]; }
        }
    }
}

__device__ __forceinline__ void ssm_s_gemm(AP a, const int wv_) {
    const bf16_t* apack = (const bf16_t*)(a->ws + OFF_APACK); const bf16_t* w1 = (const bf16_t*)(a->ws + OFF_W1T); float* S = (float*)(a->ws + OFF_S);
    const int tid_ = otid(wv_); const int lane = tid_ & 63, wv = blockIdx.x * 8 + (tid_ >> 6), NW = gridDim.x * 8;
    const int lr = lane & 15, kq = lane >> 4;
    for (int t = wv; t < 1024; t += NW) {
        const int g = t >> 5, rt = (t >> 1) & 15, ct = t & 1;
        f32x4 acc[4][4];
#pragma unroll
        for (int i = 0; i < 4; ++i)
#pragma unroll
            for (int j = 0; j < 4; ++j) acc[i][j] = (f32x4){0.f, 0.f, 0.f, 0.f};
        const bf16_t* ab = apack + ((size_t)(g * 1024 + rt * 64 + lr) * 384 + 128 + kq * 8);
        const bf16_t* bb = w1 + ((size_t)(g * 128 + ct * 64 + lr) * 256 + kq * 8);
#pragma unroll 2
        for (int ks = 0; ks < 8; ++ks) {
            bf16x8 af[4], bf[4];
#pragma unroll
            for (int i = 0; i < 4; ++i) { af[i] = *(const bf16x8*)(ab + (size_t)i * 16 * 384 + ks * 32); bf[i] = *(const bf16x8*)(bb + (size_t)i * 16 * 256 + ks * 32); }
#pragma unroll
            for (int i = 0; i < 4; ++i)
#pragma unroll
                for (int j = 0; j < 4; ++j) acc[i][j] = __builtin_amdgcn_mfma_f32_16x16x32_bf16(af[i], bf[j], acc[i][j], 0, 0, 0);
        }
#pragma unroll
        for (int i = 0; i < 4; ++i)
#pragma unroll
            for (int j = 0; j < 4; ++j)
#pragma unroll
                for (int q = 0; q < 4; ++q) S[(size_t)(g * 1024 + rt * 64 + i * 16 + kq * 4 + q) * 128 + ct * 64 + j * 16 + lr] = acc[i][j][q];
    }
}

__device__ __forceinline__ void ssm_carry(AP a, int layer, float* sm, const int wv_) {
    bf16_t* apack = (bf16_t*)(a->ws + OFF_APACK); const float* S = (const float*)(a->ws + OFF_S);
    const int tid = otid(wv_), p = tid & 63, seg = tid >> 6;
    for (int pair = blockIdx.x; pair < 256; pair += gridDim.x) {
        const int b = pair >> 5, g = pair & 31, sp = g * 64 + p;
        float ar, ai, Ar, Ai;
        abar_pow(a->in[I_SAR] + layer * 2048, a->in[I_SAI] + layer * 2048, a->in[I_SDT] + layer * 2048, sp, 16.0f, ar, ai);
        abar_pow(a->in[I_SAR] + layer * 2048, a->in[I_SAI] + layer * 2048, a->in[I_SDT] + layer * 2048, sp, 256.0f, Ar, Ai);
        const size_t rbase = (size_t)g * 1024 + b * 128 + seg * 16;
        float sr[16], si[16];
#pragma unroll
        for (int j = 0; j < 16; ++j) { sr[j] = S[(rbase + j) * 128 + p]; si[j] = S[(rbase + j) * 128 + 64 + p]; }
        float hr = 0.f, hi = 0.f;
#pragma unroll
        for (int j = 0; j < 16; ++j) { const float nr = ar * hr - ai * hi + sr[j], ni = ar * hi + ai * hr + si[j]; sr[j] = hr; si[j] = hi; hr = nr; hi = ni; }
        sm[seg * 128 + p] = hr; sm[seg * 128 + 64 + p] = hi;
        __syncthreads();
        float cr = 0.f, ci = 0.f;
        for (int s2 = 0; s2 < seg; ++s2) { const float er = sm[s2 * 128 + p], ei = sm[s2 * 128 + 64 + p]; const float nr = Ar * cr - Ai * ci + er, ni = Ar * ci + Ai * cr + ei; cr = nr; ci = ni; }
        if (seg == 7) { const float fr_ = Ar * cr - Ai * ci + hr, fi_ = Ar * ci + Ai * cr + hi;
            a->out[O_SRP + (size_t)(layer * 8 + b) * 2048 + sp] = fr_; a->out[O_SIP + (size_t)(layer * 8 + b) * 2048 + sp] = fi_; }
#pragma unroll
        for (int j = 0; j < 16; ++j) { apack[(rbase + j) * 384 + p] = f2bf(sr[j] + cr); apack[(rbase + j) * 384 + 64 + p] = f2bf(si[j] + ci);
            const float nr = ar * cr - ai * ci, ni = ar * ci + ai * cr; cr = nr; ci = ni; }
        __syncthreads();
    }
}

__device__ __forceinline__ void ssm_sample(AP a, int layer, int wv, int NW, const int wv_) {
    const bf16_t* uss = (const bf16_t*)(a->ws + OFF_USS); bf16_t* zc = (bf16_t*)(a->ws + OFF_ZCS);
    const float* are = a->in[I_SAR] + layer * 2048; const float* aim = a->in[I_SAI] + layer * 2048; const float* ldt = a->in[I_SDT] + layer * 2048;
    const float* bre = a->in[I_SBR] + layer * 32768; const float* bim = a->in[I_SBI] + layer * 32768;
    const float* cre = a->in[I_SCR] + layer * 32768; const float* cim = a->in[I_SCI] + layer * 32768; const float* dv = a->in[I_SD] + layer * 512;
    const int lane = otid(wv_) & 63;
    for (int t = wv; t < 128 * 32; t += NW) {
        const int b = t >> 5, g = t & 31, sp = g * 64 + lane;
        float ar, ai, cr, ci; abar_pow(are, aim, ldt, sp, 1.0f, ar, ai); ssm_coef(are, aim, ldt, sp, cr, ci);
        float bbr[16], bbi[16], xr[16], xi[16];
#pragma unroll
        for (int c = 0; c < 16; ++c) { const float br = bre[sp * 16 + c], bi = bim[sp * 16 + c]; bbr[c] = cr * br - ci * bi; bbi[c] = cr * bi + ci * br;
            xr[c] = cre[(g * 16 + c) * 64 + lane]; xi[c] = cim[(g * 16 + c) * 64 + lane]; }
        float hr = a->in[I_SSR][(size_t)(layer * 128 + b) * 2048 + sp], hi = a->in[I_SSI][(size_t)(layer * 128 + b) * 2048 + sp];
        const float dme = lane < 16 ? dv[g * 16 + lane] : 0.f;
        for (int tt = 0; tt < 4; ++tt) {
            const bf16_t* up = uss + (size_t)(b * 4 + tt) * 512 + g * 16;
            const u32x4 w0 = *(const u32x4*)up, w1 = *(const u32x4*)(up + 8);
            float u[16]; { float t0[8], t1[8]; unpack8(w0, t0); unpack8(w1, t1);
#pragma unroll
                for (int c = 0; c < 8; ++c) { u[c] = t0[c]; u[8 + c] = t1[c]; } }
            float br_ = 0.f, bi_ = 0.f;
#pragma unroll
            for (int c = 0; c < 16; ++c) { br_ += bbr[c] * u[c]; bi_ += bbi[c] * u[c]; }
            const float nr = ar * hr - ai * hi + br_, ni = ar * hi + ai * hr + bi_; hr = nr; hi = ni;
            float mine = 0.f, ume = 0.f;
#pragma unroll
            for (int c = 0; c < 16; ++c) { float y = xr[c] * hr - xi[c] * hi;
#pragma unroll
                for (int o = 32; o >= 1; o >>= 1) y += __shfl_xor(y, o);
                if (lane == c) { mine = y; ume = u[c]; } }
            if (lane < 16) zc[(size_t)(b * 4 + tt) * 512 + g * 16 + lane] = f2bf(gelu_t(mine + dme * ume));
        }
        a->out[O_SRS + (size_t)(layer * 128 + b) * 2048 + sp] = hr; a->out[O_SIS + (size_t)(layer * 128 + b) * 2048 + sp] = hi;
    }
}

__device__ __forceinline__ void lru_local(AP a, const int wv_) {
    const _Float16* av = (const _Float16*)(a->ws + OFF_R + 2 * S17); const bf16_t* bx = (const bf16_t*)(a->ws + OFF_R); f32x2* car = (f32x2*)(a->ws + OFF_CAR);
    const int gt = blockIdx.x * NTHR + otid(wv_), GT = gridDim.x * NTHR;
    for (int idx = gt; idx < 8 * 32 * 512; idx += GT) {
        const int c = idx & 511, sc = idx >> 9;
        const size_t base = (size_t)sc * 64 * 512 + c;
        float P = 1.f, h = 0.f;
        for (int t0 = 0; t0 < 64; t0 += 16) {
            _Float16 al[16]; bf16_t bb[16];
#pragma unroll
            for (int j = 0; j < 16; ++j) { al[j] = av[base + (size_t)(t0 + j) * 512]; bb[j] = bx[base + (size_t)(t0 + j) * 512]; }
#pragma unroll
            for (int j = 0; j < 16; ++j) { const float aa = __expf((float)al[j]); h = aa * h + bf2f(bb[j]); P *= aa; }
        }
        car[idx] = (f32x2){P, h};
    }
}
template <int B>
__device__ __forceinline__ float lru_run(const _Float16* av, const bf16_t* bx, bf16_t* ao, const bf16_t* ya, size_t base, int n, float h) {
    for (int t0 = 0; t0 < n; t0 += B) {
        _Float16 aa[B]; bf16_t bb[B], yy[B];
#pragma unroll
        for (int j = 0; j < B; ++j) { const size_t o = base + (size_t)(t0 + j) * 512; aa[j] = av[o]; bb[j] = bx[o]; yy[j] = ya[o]; }
        bf16_t oo[B];
#pragma unroll
        for (int j = 0; j < B; ++j) { h = __expf((float)aa[j]) * h + bf2f(bb[j]); oo[j] = f2bf(h * gelu_t(bf2f(yy[j]))); }
#pragma unroll
        for (int j = 0; j < B; ++j) ao[base + (size_t)(t0 + j) * 512] = oo[j];
    }
    return h;
}
__device__ __forceinline__ void lru_apply(AP a, int layer, bf16_t* ao, int mode, const int wv_) {
    const _Float16* av = (const _Float16*)(a->ws + OFF_R + 2 * S17); const bf16_t* bx = (const bf16_t*)(a->ws + OFF_R); const f32x2* car = (const f32x2*)(a->ws + OFF_CAR);
    const bf16_t* ya = (const bf16_t*)(a->ws + OFF_YA);
    const int G = gridDim.x, bid = blockIdx.x;
    if (mode == 0) {
        if (bid >= G - 8) return;
        const int GP = G - 8; int v = bid - 128; if (v < 0) v += GP;
        for (int idx = v * NTHR + otid(wv_); idx < 8 * 32 * 512; idx += GP * NTHR) {
            const int c = idx & 511, sc = idx >> 9, seq = sc >> 5, chunk = sc & 31;
            float h = 0.f;
            f32x2 ph[31];
#pragma unroll
            for (int k = 0; k < 31; ++k) ph[k] = car[(seq * 32 + (k < chunk ? k : 0)) * 512 + c];
#pragma unroll
            for (int k = 0; k < 31; ++k) if (k < chunk) h = ph[k].x * h + ph[k].y;
            h = lru_run<8>(av, bx, ao, ya, (size_t)sc * 64 * 512 + c, 64, h);
            if (chunk == 31) a->out[O_LHP + (size_t)(layer * 8 + seq) * 512 + c] = h;
        }
    } else {
        for (int j = bid * NTHR + otid(wv_); j < 128 * 512; j += G * NTHR) {
            const int c = j & 511, b = j >> 9;
            float h = a->in[I_SLH][(size_t)(layer * 128 + b) * 512 + c];
            h = lru_run<4>(av, bx, ao, ya, (size_t)(MP + b * 4) * 512 + c, 4, h);
            a->out[O_LHS + (size_t)(layer * 128 + b) * 512 + c] = h;
        }
    }
}

__device__ __forceinline__ void ln_phase(const float* src, float* dst32, bf16_t* dst16, const float* gam, const float* bet, const float scale32, const float* part, const int wv_) {
    const int tid_ = otid(wv_); const int lane = tid_ & 63, wv = blockIdx.x * 8 + (tid_ >> 6), NW = gridDim.x * 8;
    for (int r0 = wv; r0 < M; r0 += 3 * NW) {
        f32x4 v[3][4];
#pragma unroll
        for (int k = 0; k < 3; ++k) { const int r = r0 + k * NW; const float* row = src + (size_t)(r < M ? r : r0) * 1024;
#pragma unroll
            for (int i = 0; i < 4; ++i) v[k][i] = *(const f32x4*)(row + i * 256 + lane * 4);
            if (r >= MP && r < M) {
#pragma unroll
                for (int q = 0; q < 3; ++q)
#pragma unroll
                    for (int i = 0; i < 4; ++i) v[k][i] += *(const f32x4*)(part + (size_t)q * PART_STRIDE + (size_t)(r - MP) * 1024 + i * 256 + lane * 4); } }
#pragma unroll
        for (int k = 0; k < 3; ++k) { const int r = r0 + k * NW;
            float s = 0.f;
#pragma unroll
            for (int i = 0; i < 4; ++i) s += (v[k][i][0] + v[k][i][1]) + (v[k][i][2] + v[k][i][3]);
#pragma unroll
            for (int o = 32; o >= 1; o >>= 1) s += __shfl_xor(s, o);
            const float mu = s * (1.0f / 1024.0f); float q = 0.f;
#pragma unroll
            for (int i = 0; i < 4; ++i) { const f32x4 d = v[k][i] - mu; q += (d[0] * d[0] + d[1] * d[1]) + (d[2] * d[2] + d[3] * d[3]); }
#pragma unroll
            for (int o = 32; o >= 1; o >>= 1) q += __shfl_xor(q, o);
            const float rs = rsqrtf(q * (1.0f / 1024.0f) + LN_EPS);
            if (r < M) {
#pragma unroll
                for (int i = 0; i < 4; ++i) { const int col = i * 256 + lane * 4; const f32x4 gg = *(const f32x4*)(gam + col), bb = *(const f32x4*)(bet + col);
                    const f32x4 y = (v[k][i] - mu) * rs * gg + bb;
                    if (dst32) *(f32x4*)(dst32 + (size_t)r * 1024 + col) = y * scale32;
                    u32x2 w; w.x = cvt_pk_bf16(y[0], y[1]); w.y = cvt_pk_bf16(y[2], y[3]);
                    *(u32x2*)(dst16 + (size_t)r * 1024 + col) = w; }
            }
        }
    }
}

__global__ void __launch_bounds__(NTHR, 2) fwd_megakernel(Args a_unused) {
    extern __shared__ __attribute__((aligned(16))) unsigned char lds_raw[];
    cg::grid_group grid = cg::this_grid();
    LAS unsigned char* lds = (LAS unsigned char*)lds_raw;
    const int G = gridDim.x, bid = blockIdx.x;
    int wv_; { const int tw = (int)threadIdx.x >> 6; asm volatile("v_readfirstlane_b32 %0, %1" : "=s"(wv_) : "v"(tw)); }

    const unsigned long long t_start = PROBE_ON ? __builtin_amdgcn_s_memrealtime() : 0ull;
    for (int rep = 0; rep < REP_PREP; ++rep) { const AP a = ld_args(); prep_layer(a, 0, (float*)lds_raw, wv_); prep_x(a, wv_); }
    int pidx = 1; unsigned long long tA = PROBE_A == 0 ? t_start : 0ull, tB = 0ull;
    grid.sync();
    if (PROBE_ON) { if (PROBE_A == 1) tA = __builtin_amdgcn_s_memrealtime(); if (PROBE_B == 1) tB = __builtin_amdgcn_s_memrealtime(); }
    unsigned bar_n = 0; unsigned* bar_ctr; { const AP a = ld_args(); bar_ctr = (unsigned*)(a->ws + OFF_BAR); }

#pragma unroll 1
    for (int layer = 0; layer < 2; ++layer) {
        { const AP a = ld_args(); unsigned char* ws = a->ws;
          PG1 p; p.K = 1024; p.lda = 1024; p.ldb = 1024; p.G = opq(G); p.c = opq(bid); p.A = (const bf16_t*)(ws + OFF_XB); p.Bt = (const bf16_t*)(ws + OFF_WIN);
          p.xa = (bf16_t*)(ws + OFF_R); p.ya = (bf16_t*)(ws + OFF_YA); p.sb = (bf16_t*)(ws + OFF_R + S17); p.sc = (bf16_t*)(ws + OFF_R + 2 * S17); p.sh = (bf16_t*)(ws + OFF_R + 3 * S17);
          p.apack = (bf16_t*)(ws + OFF_APACK); p.uss = (bf16_t*)(ws + OFF_USS); p.gl8 = ws + OFF_GL8;
          for (int rep = 0; rep < REP_G1; ++rep) gemm_phase(lds, p, wv_); }
        GSYNC();
        if (DRY_CONV) { const AP a = ld_args(); conv_phase(a, layer, (bf16_t*)(a->ws + OFF_XB + S17), wv_); }
        { const AP a = ld_args(); conv_phase(a, layer, (bf16_t*)(a->ws + OFF_R + S17), wv_); }
        for (int rep = 0; rep < REP_SG; ++rep) { const AP a = ld_args(); ssm_s_gemm(a, wv_); }
        GSYNC();
        for (int rep = 0; rep < REP_CARRY; ++rep) { const AP a = ld_args(); ssm_carry(a, layer, (float*)lds_raw, wv_); }
        { const AP a = ld_args(); unsigned char* ws = a->ws;
          PGate p; p.K = 256; p.lda = 512; p.ldb = 256; p.G = opq(G); p.c = opq(bid); p.A = (const bf16_t*)(ws + OFF_XB); p.Bt = (const bf16_t*)(ws + OFF_WGATE);
          p.gxb = a->in[I_GXB] + layer * 512; p.gab = a->in[I_GAB] + layer * 512; p.lam = a->in[I_LAM] + layer * 512;
          p.aout = (_Float16*)(ws + OFF_R + 2 * S17); p.bxout = (bf16_t*)(ws + OFF_R);
          for (int rep = 0; rep < REP_GATE; ++rep) gemm_phase(lds, p, wv_); }
        for (int rep = 0; rep < REP_SAMPLE; ++rep) if (bid >= 8) { const AP a = ld_args(); ssm_sample(a, layer, (bid - 8) * 8 + wv_, (G - 8) * 8, wv_); }
        GSYNC();
        { const AP a = ld_args(); unsigned char* ws = a->ws;
          PY p; p.K = 384; p.lda = 384; p.ldb = 384; p.G = opq(G); p.c = opq(bid); p.apack = (const bf16_t*)(ws + OFF_APACK); p.wyt = (const bf16_t*)(ws + OFF_WYT);
          p.dvec = a->in[I_SD] + layer * 512; p.zc = (bf16_t*)(ws + OFF_XB);
          for (int rep = 0; rep < REP_Y; ++rep) gemm_phase(lds, p, wv_); }
        { const AP a = ld_args(); unsigned char* ws = a->ws;
          PGlu p; p.K = 512; p.lda = 512; p.ldb = 512; p.G = opq(G); p.c = opq(bid); p.sample = 1; p.A = (const bf16_t*)(ws + OFF_XB); p.As = (const bf16_t*)(ws + OFF_ZCS); p.Bt = (const bf16_t*)(ws + OFF_WGLU);
          p.bias = a->in[I_GLB] + layer * 512; p.out = (bf16_t*)(ws + OFF_XB + S17);
          gemm_phase(lds, p, wv_); }
        { const AP a = ld_args(); lru_apply(a, layer, (bf16_t*)(a->ws + OFF_R), 1, wv_); }
        for (int rep = 0; rep < REP_LOCAL; ++rep) { const AP a = ld_args(); lru_local(a, wv_); }
        GSYNC();
        { const AP a = ld_args(); unsigned char* ws = a->ws;
          PGlu p; p.K = 512; p.lda = 512; p.ldb = 512; p.G = opq(G); p.c = opq(bid); p.sample = 0; p.A = (const bf16_t*)(ws + OFF_XB); p.As = (const bf16_t*)(ws + OFF_ZCS); p.Bt = (const bf16_t*)(ws + OFF_WGLU);
          p.bias = a->in[I_GLB] + layer * 512; p.out = (bf16_t*)(ws + OFF_XB + S17);
          for (int rep = 0; rep < REP_GLU; ++rep) gemm_phase(lds, p, wv_); }
        { const AP a = ld_args(); unsigned char* ws = a->ws;
          PMerge p; p.K = 512; p.lda = 512; p.ldb = 512; p.G = opq(G); p.c = opq(bid); p.sample = 1; p.a0 = (const bf16_t*)(ws + OFF_R);
          p.wp = (const bf16_t*)(ws + OFF_WP); p.gl8 = ws + OFF_GL8; p.mb = (bf16_t*)(ws + OFF_MB);
          gemm_phase(lds, p, wv_); }
        if (DRY_APPLY) { const AP a = ld_args(); lru_apply(a, layer, (bf16_t*)(a->ws + OFF_S), 0, wv_); }
        { const AP a = ld_args(); lru_apply(a, layer, (bf16_t*)(a->ws + OFF_R), 0, wv_); }
        GSYNC();
        { const AP a = ld_args(); unsigned char* ws = a->ws;
          PMerge p; p.K = 512; p.lda = 512; p.ldb = 512; p.G = opq(G); p.c = opq(bid); p.sample = 0; p.a0 = (const bf16_t*)(ws + OFF_R);
          p.wp = (const bf16_t*)(ws + OFF_WP); p.gl8 = ws + OFF_GL8; p.mb = (bf16_t*)(ws + OFF_MB);
          for (int rep = 0; rep < REP_MERGE; ++rep) gemm_phase(lds, p, wv_); }
        GSYNC();
        { const AP a = ld_args(); unsigned char* ws = a->ws;
          PWout p; p.K = 1024; p.lda = 1024; p.ldb = 1024; p.G = opq(G); p.c = opq(bid); p.A = (const bf16_t*)(ws + OFF_MB); p.Bt = (const bf16_t*)(ws + OFF_WOUT);
          p.xp = layer == 0 ? a->in[I_XP] : a->out; p.xs = layer == 0 ? a->in[I_XS] : a->out + (size_t)MP * 1024; p.R = (float*)(ws + OFF_R); p.part = (float*)(ws + OFF_PW);
          gemm_phase(lds, p, wv_); }
        GSYNC();
        if (DRY_LN1) { const AP a = ld_args(); unsigned char* ws = a->ws;
          ln_phase((const float*)(ws + OFF_R), a->out, (bf16_t*)(ws + OFF_XB), a->in[I_L1G] + layer * 1024, a->in[I_L1B] + layer * 1024, ALPHA, (const float*)(ws + OFF_PW), wv_); }
        { const AP a = ld_args(); unsigned char* ws = a->ws;
          ln_phase((const float*)(ws + OFF_R), (float*)nullptr, (bf16_t*)(ws + OFF_XB), a->in[I_L1G] + layer * 1024, a->in[I_L1B] + layer * 1024, 1.0f, (const float*)(ws + OFF_PW), wv_); }
        GSYNC();
        { const AP a = ld_args(); unsigned char* ws = a->ws;
          PUp p; p.K = 1024; p.lda = 1024; p.ldb = 1024; p.G = opq(G); p.c = opq(bid); p.A = (const bf16_t*)(ws + OFF_XB); p.Bt = (const bf16_t*)(ws + OFF_WUP); p.h = (bf16_t*)(ws + OFF_H);
          for (int rep = 0; rep < REP_UP; ++rep) gemm_phase(lds, p, wv_); }
        GSYNC();
        { const AP a = ld_args(); unsigned char* ws = a->ws;
          PDown p; p.K = 4096; p.lda = 4096; p.ldb = 4096; p.G = opq(G); p.c = opq(bid); p.A = (const bf16_t*)(ws + OFF_H); p.Bt = (const bf16_t*)(ws + OFF_WDOWN); p.R = (float*)(ws + OFF_R); p.part = (float*)(ws + OFF_PD); p.x1 = (const bf16_t*)(ws + OFF_XB);
          gemm_phase(lds, p, wv_); }
        GSYNC();
        for (int rep = 0; rep < REP_LN2; ++rep) { const AP a = ld_args(); unsigned char* ws = a->ws;
          ln_phase((const float*)(ws + OFF_R), a->out, (bf16_t*)(ws + OFF_XB), a->in[I_L2G] + layer * 1024, a->in[I_L2B] + layer * 1024, 1.0f, (const float*)(ws + OFF_PD), wv_); }
        if (layer == 0) { __syncthreads(); for (int rep = 0; rep < REP_PREP; ++rep) { const AP a = ld_args(); prep_layer(a, 1, (float*)lds_raw, wv_); } GSYNC(); }
    }
    if (PROBE_ON && bid == 0) { if (PROBE_B > 22) tB = __builtin_amdgcn_s_memrealtime(); const unsigned long long t0 = __builtin_amdgcn_s_memrealtime(); while (__builtin_amdgcn_s_memrealtime() - t0 < tB - tA) __builtin_amdgcn_s_sleep(8); }
}

extern "C" void kernel_launch(void* const* d_in, const int* in_sizes, int n_in, void* d_out, int out_size, void* d_ws, size_t ws_size, hipStream_t stream) {
    constexpr size_t kDynLds = STAGE_BYTES;
    static int grid_blocks = 0;
    if (!grid_blocks) {
        int dev = 0, cus = 0, per_cu = 0;
        hipGetDevice(&dev);
        hipDeviceGetAttribute(&cus, hipDeviceAttributeMultiprocessorCount, dev);
        hipFuncSetAttribute((const void*)fwd_megakernel, hipFuncAttributeMaxDynamicSharedMemorySize, (int)kDynLds);
        hipOccupancyMaxActiveBlocksPerMultiprocessor(&per_cu, (const void*)fwd_megakernel, NTHR, kDynLds);
        if (per_cu < 1) per_cu = 1;
        grid_blocks = cus * per_cu;
        if (grid_blocks > 256) grid_blocks = 256;
        if (ws_size < WS_END || n_in != 36) fprintf(stderr, "kernel_launch: unexpected ws_size %zu (need %zu) or n_in %d\n", ws_size, (size_t)WS_END, n_in);
    }
    (void)hipMemsetAsync((char*)d_ws + OFF_BAR, 0, 256, stream);
    Args a{};
    for (int i = 0; i < 36; ++i) a.in[i] = (const float*)d_in[i];
    a.out = (float*)d_out; a.ws = (unsigned char*)d_ws;
    void* args[] = {&a};
    hipError_t e = hipLaunchCooperativeKernel((const void*)fwd_megakernel, dim3(grid_blocks), dim3(NTHR), args, kDynLds, stream);
    if (e != hipSuccess) fprintf(stderr, "cooperative launch failed: %s (grid %d)\n", hipGetErrorString(e), grid_blocks);
}
```

```cpp
#include <hip/hip_runtime.h>
#include <hip/hip_cooperative_groups.h>
#include <cstdio>
namespace cg = cooperative_groups;
#define REP_GEMM 1
#define REP_G1 REP_GEMM
#define REP_GATE REP_GEMM
#define REP_Y REP_GEMM
#define REP_GLU REP_GEMM
#define REP_MERGE REP_GEMM
#define REP_UP REP_GEMM
#define REP_ELEM 1
#define REP_PREP REP_ELEM
#define REP_SG REP_ELEM
#define REP_CARRY REP_ELEM
#define REP_SAMPLE REP_ELEM
#define REP_LOCAL REP_ELEM
#define REP_LN2 REP_ELEM
#define DRY_CONV 0
#define DRY_APPLY 0
#define DRY_LN1 0
#define REP_SYNC 1
#define PROBE_ON 0
#define PROBE_A 0
#define PROBE_B 1
#define GSYNC() do { for (int _s = 0; _s < REP_SYNC; ++_s) { bar_n += (unsigned)G; gbar(bar_ctr, bar_n, wv_); } ++pidx; if (PROBE_ON) { if (pidx == PROBE_A) tA = __builtin_amdgcn_s_memrealtime(); if (pidx == PROBE_B) tB = __builtin_amdgcn_s_memrealtime(); } } while (0)

#define LAS __attribute__((address_space(3)))
typedef unsigned short bf16_t;
typedef short bf16x8 __attribute__((ext_vector_type(8)));
typedef float f32x4 __attribute__((ext_vector_type(4)));
typedef float f32x2 __attribute__((ext_vector_type(2)));
typedef unsigned u32x4 __attribute__((ext_vector_type(4)));
typedef unsigned u32x2 __attribute__((ext_vector_type(2)));

constexpr int MP = 16384, MS = 512, M = MP + MS, D = 1024, NIN = 6144, BW = 512, DFF = 4096;
constexpr int NTHR = 512;
constexpr float ALPHA = 1.41421356237f;
constexpr float LN_EPS = 1e-5f;

constexpr size_t S17 = (size_t)M * 512 * 2;
constexpr size_t OFF_WUP = 0;
constexpr size_t OFF_WDOWN = OFF_WUP + (size_t)4096 * 1024 * 2;
constexpr size_t OFF_R = OFF_WDOWN + (size_t)4096 * 1024 * 2;
constexpr size_t OFF_XB = OFF_R + 4 * S17;
constexpr size_t OFF_BIG = OFF_XB + 2 * S17;
constexpr size_t OFF_H = OFF_BIG;
constexpr size_t OFF_WIN = OFF_BIG;
constexpr size_t OFF_WP = OFF_WIN + (size_t)6144 * 1024 * 2;
constexpr size_t OFF_WGLU = OFF_WP + (size_t)3 * 1024 * 512 * 2;
constexpr size_t OFF_WOUT = OFF_WGLU + (size_t)512 * 512 * 2;
constexpr size_t OFF_WGATE = OFF_WOUT + (size_t)1024 * 1024 * 2;
constexpr size_t OFF_W1T = OFF_WGATE + (size_t)1024 * 512 * 2;
constexpr size_t OFF_WYT = OFF_W1T + (size_t)32 * 128 * 256 * 2;
constexpr size_t OFF_GL8 = OFF_WYT + (size_t)32 * 256 * 384 * 2;
constexpr size_t OFF_YA = OFF_GL8 + (size_t)M * 3072;
constexpr size_t OFF_APACK = OFF_YA + S17;
constexpr size_t OFF_S = OFF_APACK + (size_t)32 * 1024 * 384 * 2;
constexpr size_t OFF_MB = OFF_APACK;
constexpr size_t OFF_USS = OFF_S + (size_t)32 * 1024 * 128 * 4;
constexpr size_t OFF_CAR = OFF_USS + (size_t)512 * 512 * 2;
constexpr size_t OFF_BAR = OFF_CAR + (size_t)8 * 32 * 512 * 8;
constexpr size_t OFF_PD = OFF_BAR + 256;
constexpr size_t OFF_PW = OFF_GL8;
constexpr size_t PART_STRIDE = (size_t)MS * 1024;
constexpr size_t OFF_ZCS = OFF_PD + 3 * PART_STRIDE * 4;
constexpr size_t WS_END = OFF_ZCS + (size_t)MS * 512 * 2;
static_assert(OFF_PD >= OFF_H + (size_t)M * 4096 * 2, "down partials must not overlap h");
static_assert(WS_END <= (size_t)268435456, "workspace map exceeds 256 MiB");
static_assert(OFF_MB + (size_t)M * 1024 * 2 <= OFF_USS, "m overlay");
static_assert(OFF_H + (size_t)M * 4096 * 2 <= (size_t)268435456, "h overlay");

constexpr size_t O_Y = 0;
constexpr size_t O_LCP = (size_t)M * 1024;
constexpr size_t O_LHP = O_LCP + 2 * 8 * 3 * 512;
constexpr size_t O_SCP = O_LHP + 2 * 8 * 512;
constexpr size_t O_SRP = O_SCP + 2 * 8 * 2 * 512;
constexpr size_t O_SIP = O_SRP + 2 * 8 * 2048;
constexpr size_t O_LCS = O_SIP + 2 * 8 * 2048;
constexpr size_t O_LHS = O_LCS + 2 * 128 * 3 * 512;
constexpr size_t O_SCS = O_LHS + 2 * 128 * 512;
constexpr size_t O_SRS = O_SCS + 2 * 128 * 2 * 512;
constexpr size_t O_SIS = O_SRS + 2 * 128 * 2048;

struct Args { const float* in[36]; float* out; unsigned char* ws; };
typedef const __attribute__((address_space(4))) Args* AP;
__device__ __forceinline__ AP ld_args() {
#if defined(__HIP_DEVICE_COMPILE__)
    auto p = __builtin_amdgcn_kernarg_segment_ptr();
    asm volatile("" : "+s"(p));
    return (AP)p;
#else
    return nullptr;
#endif
}
enum { I_XP = 0, I_XS, I_SLC, I_SLH, I_SSC, I_SSR, I_SSI, I_WIN, I_CAW, I_CAB, I_GXW, I_GXB, I_GAW, I_GAB, I_LAM, I_CBW, I_SAR, I_SAI, I_SDT,
       I_SBR, I_SBI, I_SCR, I_SCI, I_SD, I_GLW, I_GLB, I_PA, I_PB, I_PC, I_WO, I_L1G, I_L1B, I_UP, I_DN, I_L2G, I_L2B };

__device__ __forceinline__ unsigned cvt_pk_bf16(float lo, float hi) { unsigned r; asm volatile("v_cvt_pk_bf16_f32 %0, %1, %2" : "=v"(r) : "v"(lo), "v"(hi)); return r; }
__device__ __forceinline__ bf16_t f2bf(float f) { return (bf16_t)(cvt_pk_bf16(f, 0.f) & 0xffffu); }
__device__ __forceinline__ float bf2f(unsigned short b) { return __uint_as_float(((unsigned)b) << 16); }
__device__ __forceinline__ float bflo(unsigned w) { return __uint_as_float(w << 16); }
__device__ __forceinline__ float bfhi(unsigned w) { return __uint_as_float(w & 0xffff0000u); }
__device__ __forceinline__ float sigm(float x) { return 1.0f / (1.0f + __expf(-x)); }
__device__ __forceinline__ float gelu_t(float x) { const float u = 0.7978845608f * (x + 0.044715f * x * x * x); return x / (1.0f + __expf(-2.0f * u)); }
__device__ __forceinline__ u32x4 pack8(const f32x4 a, const f32x4 b) { u32x4 w; w.x = cvt_pk_bf16(a[0], a[1]); w.y = cvt_pk_bf16(a[2], a[3]); w.z = cvt_pk_bf16(b[0], b[1]); w.w = cvt_pk_bf16(b[2], b[3]); return w; }
__device__ __forceinline__ void unpack8(const u32x4 w, float (&f)[8]) { f[0] = bflo(w.x); f[1] = bfhi(w.x); f[2] = bflo(w.y); f[3] = bfhi(w.y); f[4] = bflo(w.z); f[5] = bfhi(w.z); f[6] = bflo(w.w); f[7] = bfhi(w.w); }

__device__ __forceinline__ int otid(const int wv_) { int t = wv_ * 64 + (int)__builtin_amdgcn_mbcnt_hi(~0u, __builtin_amdgcn_mbcnt_lo(~0u, 0u)); asm volatile("" : "+v"(t)); return t; }

__device__ __forceinline__ int opq(int x) { asm volatile("" : "+s"(x)); return x; }

__device__ __forceinline__ void gbar(unsigned* ctr, unsigned target, const int wv_) {
    asm volatile("s_waitcnt vmcnt(0)" ::: "memory");
    __syncthreads();
    if (otid(wv_) == 0) {
        __builtin_amdgcn_fence(__ATOMIC_RELEASE, "agent");
        asm volatile("s_waitcnt vmcnt(0)" ::: "memory");
        __hip_atomic_fetch_add(ctr, 1u, __ATOMIC_RELAXED, __HIP_MEMORY_SCOPE_AGENT);
        while (__hip_atomic_load(ctr, __ATOMIC_RELAXED, __HIP_MEMORY_SCOPE_AGENT) < target) __builtin_amdgcn_s_sleep(1);
        __builtin_amdgcn_fence(__ATOMIC_ACQUIRE, "agent");
        asm volatile("s_waitcnt vmcnt(0)" ::: "memory");
    }
    __syncthreads();
}

constexpr int BM = 256, BK = 64, HALF = 128, HTB = HALF * BK * 2, STAGE_BYTES = 8 * HTB;
__device__ __forceinline__ int lds_byte(int r, int c) { const int st = (r >> 4) * 2 + (c >> 5), rr = r & 15, cc = c & 31, ob = rr * 64 + cc * 2; return st * 1024 + (ob ^ (((ob >> 9) & 1) << 5)); }
__device__ __forceinline__ void stage_rc(int b, int& R, int& C) { const int st = b / 1024, sb = b % 1024, swz = sb ^ (((sb >> 9) & 1) << 5); R = (st >> 1) * 16 + swz / 64; C = (st & 1) * 32 + (swz % 64) / 2; }
__device__ __forceinline__ int perm32(int rho) { const int n = rho >> 4, i = rho & 15; return 8 * (i >> 2) + 4 * n + (i & 3); }
struct Unit { int pm, pn, z; };
__device__ __forceinline__ void tile_map(int L, int nM, int nN, int& pm, int& pn) {
    const int nwg = nM * nN; int wgid = L;
    { const int q = nwg / 8, r = nwg % 8, xcd = wgid % 8, off = wgid / 8; wgid = (xcd < r ? xcd * (q + 1) : r * (q + 1) + (xcd - r) * q) + off; }
    const int nig = 8 * nN, gid = wgid / nig, fm = gid * 8, gsz = (nM - fm) < 8 ? (nM - fm) : 8;
    pm = fm + ((wgid % nig) % gsz); pn = (wgid % nig) / gsz;
}

template <class P>
__device__ __forceinline__ void gemm_phase(LAS unsigned char* lds, const P& p, const int wv_) {
    const int tid = otid(wv_), wid = __builtin_amdgcn_readfirstlane(tid >> 6), lane = tid & 63, wr = wid >> 2, wc = wid & 3, fr = lane & 15, fq = lane >> 4;
    unsigned voffA[2], voffB[2];
#pragma unroll
    for (int i = 0; i < 2; ++i) { int R, C; stage_rc(tid * 16 + i * 8192, R, C); const int Rb = P::PERM ? ((R & ~31) + perm32(R & 31)) : R;
        voffA[i] = (unsigned)(R * p.lda + C) * 2u; voffB[i] = (unsigned)(Rb * p.ldb + C) * 2u; }
    const size_t kstep = (size_t)(BK * 2);
    const size_t hA = (size_t)HALF * p.lda * 2, hB = (size_t)HALF * p.ldb * 2;
    const unsigned ldsw = (unsigned)wid * 1024u;
    const int aoff = lds_byte(wr * 64 + fr, fq * 8), boff = lds_byte(wc * 32 + fr, fq * 8);
#define PG8_SA(b, h) (((b) * 2 + (h)) * HTB)
#define PG8_SB(b, h) ((4 + (b) * 2 + (h)) * HTB)
#define PG8_STAGE(bufoff, gbase, voff) do { _Pragma("unroll") for (int _i = 0; _i < 2; ++_i) \
        __builtin_amdgcn_global_load_lds((const unsigned*)((const char*)(gbase) + (voff)[_i]), (LAS unsigned*)(lds + (bufoff) + ldsw + _i * 8192), 16, 0, 0); } while (0)
#define PG8_LDA(dst, b, h) do { _Pragma("unroll") for (int m = 0; m < 4; ++m) _Pragma("unroll") for (int k = 0; k < 2; ++k) dst[m][k] = *(const LAS bf16x8*)(lds + PG8_SA(b, h) + aoff + m * 2048 + k * 1024); } while (0)
#define PG8_LDB(dst, b, h) do { _Pragma("unroll") for (int n = 0; n < 2; ++n) _Pragma("unroll") for (int k = 0; k < 2; ++k) dst[n][k] = *(const LAS bf16x8*)(lds + PG8_SB(b, h) + boff + n * 2048 + k * 1024); } while (0)
#define PG8_MMA(ai, bj, At, Bt) do { __builtin_amdgcn_s_setprio(1); _Pragma("unroll") for (int m = 0; m < 4; ++m) _Pragma("unroll") for (int n = 0; n < 2; ++n) _Pragma("unroll") for (int k = 0; k < 2; ++k) \
        acc[ai][bj][m][n] = __builtin_amdgcn_mfma_f32_16x16x32_bf16(Bt[n][k], At[m][k], acc[ai][bj][m][n], 0, 0, 0); __builtin_amdgcn_s_setprio(0); } while (0)
#define PG8_WAIT_V(n) asm volatile("s_waitcnt vmcnt(" #n ")" ::: "memory")
#define PG8_WAIT_L(n) asm volatile("s_waitcnt lgkmcnt(" #n ")" ::: "memory")
#define PG8_BAR __builtin_amdgcn_s_barrier()
#define PG8_SCHED __builtin_amdgcn_sched_barrier(0)
    Unit cur, nxt; int ui = 0;
    if (!p.next(0, cur)) return;
    f32x4 acc[2][2][4][2];
#pragma unroll
    for (int a = 0; a < 2; ++a)
#pragma unroll
        for (int b = 0; b < 2; ++b)
#pragma unroll
            for (int m = 0; m < 4; ++m)
#pragma unroll
                for (int n = 0; n < 2; ++n) acc[a][b][m][n] = (f32x4){0.f, 0.f, 0.f, 0.f};
    bf16x8 At[4][2], B0[2][2], B1[2][2];
    const char* cA = p.aptr(cur); const char* cB = p.bptr(cur);
    PG8_STAGE(PG8_SB(0, 0), cB, voffB); PG8_STAGE(PG8_SA(0, 0), cA, voffA); PG8_STAGE(PG8_SB(0, 1), cB + hB, voffB); PG8_STAGE(PG8_SA(0, 1), cA + hA, voffA);
    if (wr == 1) PG8_BAR;
    PG8_WAIT_V(4); PG8_BAR;
    PG8_STAGE(PG8_SB(1, 0), cB + kstep, voffB); PG8_STAGE(PG8_SA(1, 0), cA + kstep, voffA); PG8_STAGE(PG8_SB(1, 1), cB + hB + kstep, voffB);
    PG8_WAIT_V(6); PG8_BAR;
    for (;;) {
        const bool has_next = p.next(ui + 1, nxt);
        const int nt = p.nt(cur);
        const char* nA = has_next ? p.aptr(nxt) : cA; const char* nB = has_next ? p.bptr(nxt) : cB;
        for (int t = 0; t < nt; t += 2) {
            const bool last = (t == nt - 2);
            const char* a1 = cA + (size_t)(t + 1) * kstep;
            const char* a2 = last ? nA : cA + (size_t)(t + 2) * kstep; const char* b2 = last ? nB : cB + (size_t)(t + 2) * kstep;
            const char* a3 = a2 + kstep; const char* b3 = b2 + kstep;
            PG8_LDB(B0, 0, 0); PG8_SCHED; PG8_LDA(At, 0, 0); PG8_STAGE(PG8_SA(1, 1), a1 + hA, voffA);
            PG8_WAIT_L(8); PG8_BAR; PG8_WAIT_L(0); PG8_MMA(0, 0, At, B0); PG8_BAR; PG8_SCHED;
            PG8_LDB(B1, 0, 1); PG8_STAGE(PG8_SB(0, 0), b2, voffB);
            PG8_BAR; PG8_WAIT_L(0); PG8_MMA(0, 1, At, B1); PG8_BAR;
            PG8_LDA(At, 0, 1); PG8_STAGE(PG8_SA(0, 0), a2, voffA);
            PG8_BAR; PG8_WAIT_L(0); PG8_MMA(1, 0, At, B0); PG8_BAR; PG8_SCHED;
            PG8_STAGE(PG8_SB(0, 1), b2 + hB, voffB);
            PG8_WAIT_V(6); PG8_BAR; PG8_MMA(1, 1, At, B1); PG8_BAR;
            PG8_LDB(B0, 1, 0); PG8_SCHED; PG8_LDA(At, 1, 0); PG8_STAGE(PG8_SA(0, 1), a2 + hA, voffA);
            PG8_WAIT_L(8); PG8_BAR; PG8_WAIT_L(0); PG8_MMA(0, 0, At, B0); PG8_BAR; PG8_SCHED;
            PG8_LDB(B1, 1, 1); PG8_STAGE(PG8_SB(1, 0), b3, voffB);
            PG8_BAR; PG8_WAIT_L(0); PG8_MMA(0, 1, At, B1); PG8_BAR;
            PG8_LDA(At, 1, 1); PG8_STAGE(PG8_SA(1, 0), a3, voffA);
            PG8_BAR; PG8_WAIT_L(0); PG8_MMA(1, 0, At, B0); PG8_BAR; PG8_SCHED;
            PG8_STAGE(PG8_SB(1, 1), b3 + hB, voffB);
            PG8_WAIT_V(6); PG8_BAR; PG8_MMA(1, 1, At, B1); PG8_BAR;
        }
        Unit eu = cur;
        asm volatile("" : "+s"(eu.pm), "+s"(eu.pn), "+s"(eu.z));
        const bool rst = p.epi(acc, eu, wr, wc, fr, fq);
        if (!has_next) break;
        if (rst) {
#pragma unroll
            for (int a = 0; a < 2; ++a)
#pragma unroll
                for (int b = 0; b < 2; ++b)
#pragma unroll
                    for (int m = 0; m < 4; ++m)
#pragma unroll
                        for (int n = 0; n < 2; ++n) acc[a][b][m][n] = (f32x4){0.f, 0.f, 0.f, 0.f};
        }
        cur = nxt; cA = nA; cB = nB; ++ui;
    }
    PG8_WAIT_V(0);
    if (wr == 0) PG8_BAR;
    PG8_BAR;
#undef PG8_SA
#undef PG8_SB
#undef PG8_STAGE
#undef PG8_LDA
#undef PG8_LDB
#undef PG8_MMA
#undef PG8_WAIT_V
#undef PG8_WAIT_L
#undef PG8_BAR
#undef PG8_SCHED
}
typedef f32x4 Acc[2][2][4][2];

struct PG1 {
    __device__ __forceinline__ int nt(const Unit&) const { return K / BK; }
    static constexpr bool PERM = true;
    int K, lda, ldb, G, c;
    const bf16_t* A; const bf16_t* Bt;
    bf16_t *xa, *ya, *sb, *sc, *sh, *apack, *uss; unsigned char* gl8;
    __device__ __forceinline__ bool next(int i, Unit& u) const { const long L = (long)i * G + c; if (L >= 66 * 24) return false; tile_map((int)L, 66, 24, u.pm, u.pn); u.z = 0; return true; }
    __device__ __forceinline__ const char* aptr(const Unit& u) const { return (const char*)A + (size_t)u.pm * 256 * 1024 * 2; }
    __device__ __forceinline__ const char* bptr(const Unit& u) const { return (const char*)Bt + (size_t)u.pn * 256 * 1024 * 2; }
    __device__ __forceinline__ bool epi(Acc& acc, const Unit& u, int wr, int wc, int fr, int fq) const {
        const int pn = u.pn;
        if (pn < 10) {
            const int b = pn >> 1; bf16_t* base = b == 0 ? xa : b == 1 ? ya : b == 2 ? sb : b == 3 ? sc : sh;
#pragma unroll
            for (int ai = 0; ai < 2; ++ai)
#pragma unroll
                for (int m = 0; m < 4; ++m) { const size_t r = (size_t)u.pm * 256 + ai * 128 + wr * 64 + m * 16 + fr;
#pragma unroll
                    for (int bj = 0; bj < 2; ++bj) { const int col = (pn & 1) * 256 + bj * 128 + wc * 32 + 8 * fq;
                        *(u32x4*)(base + r * 512 + col) = pack8(acc[ai][bj][m][0], acc[ai][bj][m][1]); } }
        } else if (pn < 12) {
#pragma unroll
            for (int ai = 0; ai < 2; ++ai)
#pragma unroll
                for (int m = 0; m < 4; ++m) { const int r = u.pm * 256 + ai * 128 + wr * 64 + m * 16 + fr;
#pragma unroll
                    for (int bj = 0; bj < 2; ++bj) { const int cc = (pn - 10) * 256 + bj * 128 + wc * 32 + 8 * fq;
                        bf16_t* dst = (u.pm < 64) ? apack + ((size_t)((cc >> 4) * 1024 + (r >> 4)) * 384 + 128 + (r & 15) * 16 + (cc & 15)) : uss + (size_t)(r - MP) * 512 + cc;
                        *(u32x4*)dst = pack8(acc[ai][bj][m][0], acc[ai][bj][m][1]); } }
        } else {
            unsigned char* blk = gl8 + ((size_t)(u.pm * 12 + (pn - 12)) << 16) + (size_t)(((wr * 4 + wc) * 64 + fq * 16 + fr) * 128);
#pragma unroll
            for (int ai = 0; ai < 2; ++ai)
#pragma unroll
                for (int m = 0; m < 4; ++m) { u32x4 w;
#pragma unroll
                    for (int bj = 0; bj < 2; ++bj)
#pragma unroll
                        for (int n = 0; n < 2; ++n) { unsigned pk = 0;
#pragma unroll
                            for (int j = 0; j < 4; ++j) { int v = (int)(sigm(acc[ai][bj][m][n][j]) * 256.0f); v = v < 0 ? 0 : (v > 255 ? 255 : v); pk |= (unsigned)v << (8 * j); }
                            w[bj * 2 + n] = pk; }
                    *(u32x4*)(blk + (ai * 4 + m) * 16) = w; }
        }
        return true;
    }
};

struct PGate {
    __device__ __forceinline__ int nt(const Unit&) const { return K / BK; }
    static constexpr bool PERM = false;
    int K, lda, ldb, G, c;
    const bf16_t* A; const bf16_t* Bt;
    const float *gxb, *gab, *lam; _Float16* aout; bf16_t* bxout;
    __device__ __forceinline__ bool next(int i, Unit& u) const { const long L = (long)i * G + c; if (L >= 66 * 4) return false; tile_map((int)L, 66, 4, u.pm, u.pn); u.z = 0; return true; }
    __device__ __forceinline__ const char* aptr(const Unit& u) const { return (const char*)A + (size_t)u.pm * 256 * 512 * 2 + (size_t)(u.pn >> 1) * 512; }
    __device__ __forceinline__ const char* bptr(const Unit& u) const { return (const char*)Bt + (size_t)u.pn * 256 * 256 * 2; }
    __device__ __forceinline__ bool epi(Acc& acc, const Unit& u, int wr, int wc, int fr, int fq) const {
#pragma unroll
        for (int n = 0; n < 2; ++n) {
            const int ch0 = u.pn * 128 + wc * 32 + n * 16 + 4 * fq;
            const f32x4 bx4 = *(const f32x4*)(gxb + ch0), ba4 = *(const f32x4*)(gab + ch0), lm4 = *(const f32x4*)(lam + ch0);
            f32x4 kk;
#pragma unroll
            for (int j = 0; j < 4; ++j) kk[j] = -8.0f * log1pf(expf(-lm4[j]));
#pragma unroll
            for (int ai = 0; ai < 2; ++ai)
#pragma unroll
                for (int m = 0; m < 4; ++m) { const size_t r = (size_t)u.pm * 256 + ai * 128 + wr * 64 + m * 16 + fr;
                    const u32x2 xw = *(const u32x2*)(A + r * 512 + ch0);
                    const float xc[4] = {bflo(xw.x), bfhi(xw.x), bflo(xw.y), bfhi(xw.y)};
                    float av[4], la4[4]; float bv[4];
#pragma unroll
                    for (int j = 0; j < 4; ++j) { const float gx = sigm(acc[ai][0][m][n][j] + bx4[j]), ga = sigm(acc[ai][1][m][n][j] + ba4[j]);
                        const float la = kk[j] * ga; la4[j] = la; av[j] = __expf(la); bv[j] = __builtin_amdgcn_sqrtf(fmaxf(1.0f - av[j] * av[j], 0.f)) * gx * xc[j]; }
                    { typedef _Float16 h4 __attribute__((ext_vector_type(4))); h4 hv; hv[0] = (_Float16)la4[0]; hv[1] = (_Float16)la4[1]; hv[2] = (_Float16)la4[2]; hv[3] = (_Float16)la4[3]; *(h4*)(aout + r * 512 + ch0) = hv; }
                    u32x2 w; w.x = cvt_pk_bf16(bv[0], bv[1]); w.y = cvt_pk_bf16(bv[2], bv[3]);
                    *(u32x2*)(bxout + r * 512 + ch0) = w; }
        }
        return true;
    }
};

struct PY {
    __device__ __forceinline__ int nt(const Unit&) const { return K / BK; }
    static constexpr bool PERM = true;
    int K, lda, ldb, G, c;
    const bf16_t* apack; const bf16_t* wyt; const float* dvec; bf16_t* zc;
    __device__ __forceinline__ bool next(int i, Unit& u) const { const long L = (long)i * G + c; if (L >= 128) return false; u.pm = (int)L; u.pn = (int)L >> 2; u.z = 0; return true; }
    __device__ __forceinline__ const char* aptr(const Unit& u) const { return (const char*)apack + (size_t)u.pm * 256 * 384 * 2; }
    __device__ __forceinline__ const char* bptr(const Unit& u) const { return (const char*)wyt + (size_t)u.pn * 256 * 384 * 2; }
    __device__ __forceinline__ bool epi(Acc& acc, const Unit& u, int wr, int wc, int fr, int fq) const {
        const int g = u.pn;
#pragma unroll
        for (int bj = 0; bj < 2; ++bj) {
            const int n0 = bj * 128 + wc * 32 + 8 * fq, ti = n0 >> 4, c0 = n0 & 15;
            const f32x4 d0 = *(const f32x4*)(dvec + g * 16 + c0), d1 = *(const f32x4*)(dvec + g * 16 + c0 + 4);
#pragma unroll
            for (int ai = 0; ai < 2; ++ai)
#pragma unroll
                for (int m = 0; m < 4; ++m) { const int rr = (u.pm & 3) * 256 + ai * 128 + wr * 64 + m * 16 + fr;
                    const u32x4 uw = *(const u32x4*)(apack + ((size_t)(g * 1024 + rr) * 384 + 128 + n0));
                    float uf[8]; unpack8(uw, uf);
                    f32x4 y0, y1;
#pragma unroll
                    for (int j = 0; j < 4; ++j) { y0[j] = gelu_t(acc[ai][bj][m][0][j] + d0[j] * uf[j]); y1[j] = gelu_t(acc[ai][bj][m][1][j] + d1[j] * uf[4 + j]); }
                    const size_t tok = (size_t)(rr >> 7) * 2048 + (rr & 127) * 16 + ti;
                    *(u32x4*)(zc + tok * 512 + g * 16 + c0) = pack8(y0, y1); }
        }
        return true;
    }
};

struct PGlu {
    __device__ __forceinline__ int nt(const Unit&) const { return K / BK; }
    static constexpr bool PERM = true;
    int K, lda, ldb, G, c, sample;
    const bf16_t* A; const bf16_t* As; const bf16_t* Bt; const float* bias; bf16_t* out;
    __device__ __forceinline__ bool next(int i, Unit& u) const {
        if (sample) { const int j = c - 128; if (i != 0 || j < 0 || j >= 4) return false; u.pm = 64 + (j >> 1); u.pn = j & 1; u.z = 0; return true; }
        const long L = (long)i * G + c; if (L >= 64 * 2) return false; tile_map((int)L, 64, 2, u.pm, u.pn); u.z = 0; return true; }
    __device__ __forceinline__ const bf16_t* arow0(const Unit& u) const { return u.pm < 64 ? A + (size_t)u.pm * 256 * 512 : As + (size_t)(u.pm - 64) * 256 * 512; }
    __device__ __forceinline__ const char* aptr(const Unit& u) const { return (const char*)arow0(u); }
    __device__ __forceinline__ const char* bptr(const Unit& u) const { return (const char*)Bt + (size_t)u.pn * 256 * 512 * 2; }
    __device__ __forceinline__ bool epi(Acc& acc, const Unit& u, int wr, int wc, int fr, int fq) const {
        const bf16_t* zsrc = arow0(u);
#pragma unroll
        for (int bj = 0; bj < 2; ++bj) {
            const int col = u.pn * 256 + bj * 128 + wc * 32 + 8 * fq;
            const f32x4 b0 = *(const f32x4*)(bias + col), b1 = *(const f32x4*)(bias + col + 4);
#pragma unroll
            for (int ai = 0; ai < 2; ++ai)
#pragma unroll
                for (int m = 0; m < 4; ++m) { const int rl = ai * 128 + wr * 64 + m * 16 + fr; const size_t r = (size_t)u.pm * 256 + rl;
                    const u32x4 zw = *(const u32x4*)(zsrc + (size_t)rl * 512 + col); float zf[8]; unpack8(zw, zf);
                    f32x4 y0, y1;
#pragma unroll
                    for (int j = 0; j < 4; ++j) { y0[j] = zf[j] * sigm(acc[ai][bj][m][0][j] + b0[j]); y1[j] = zf[4 + j] * sigm(acc[ai][bj][m][1][j] + b1[j]); }
                    *(u32x4*)(out + r * 512 + col) = pack8(y0, y1); }
        }
        return true;
    }
};

struct PMerge {
    __device__ __forceinline__ int nt(const Unit&) const { return K / BK; }
    static constexpr bool PERM = true;
    int K, lda, ldb, G, c, sample;
    const bf16_t* a0; const bf16_t* wp; const unsigned char* gl8; bf16_t* mb;
    __device__ __forceinline__ bool next(int i, Unit& u) const { const int ti = i / 3;
        if (sample) { const int j = c - (G - 8); if (ti != 0 || j < 0) return false; u.pm = 64 + (j >> 2); u.pn = j & 3; u.z = i; return true; }
        const long L = (long)ti * G + c; if (L >= 64 * 4) return false; tile_map((int)L, 64, 4, u.pm, u.pn); u.z = i - ti * 3; return true; }
    __device__ __forceinline__ const char* aptr(const Unit& u) const { const size_t off = (u.z == 2) ? (OFF_XB + S17 - OFF_R) : (size_t)u.z * S17; return (const char*)a0 + off + (size_t)u.pm * 256 * 512 * 2; }
    __device__ __forceinline__ const char* bptr(const Unit& u) const { return (const char*)wp + ((size_t)u.z * 1024 + (size_t)u.pn * 256) * 512 * 2; }
    __device__ __forceinline__ bool epi(Acc& acc, const Unit& u, int wr, int wc, int fr, int fq) const {
        const int br = u.z;
        const unsigned char* blk = gl8 + ((size_t)(u.pm * 12 + br * 4 + u.pn) << 16) + (size_t)(((wr * 4 + wc) * 64 + fq * 16 + fr) * 128);
#pragma unroll
        for (int ai = 0; ai < 2; ++ai)
#pragma unroll
            for (int m = 0; m < 4; ++m) { const size_t r = (size_t)u.pm * 256 + ai * 128 + wr * 64 + m * 16 + fr;
                const u32x4 qc = *(const u32x4*)(blk + (ai * 4 + m) * 16);
                if (br < 2) {
                    const u32x4 qn = *(const u32x4*)(blk + 4 * 65536 + (ai * 4 + m) * 16);
#pragma unroll
                    for (int bj = 0; bj < 2; ++bj)
#pragma unroll
                        for (int n = 0; n < 2; ++n)
#pragma unroll
                            for (int j = 0; j < 4; ++j) { const float gc = (float)((qc[bj * 2 + n] >> (8 * j)) & 255u) + 0.5f, gn = (float)((qn[bj * 2 + n] >> (8 * j)) & 255u) + 0.5f;
                                acc[ai][bj][m][n][j] *= gc * __builtin_amdgcn_rcpf(gn); }
                } else {
#pragma unroll
                    for (int bj = 0; bj < 2; ++bj) { const int col = u.pn * 256 + bj * 128 + wc * 32 + 8 * fq;
                        f32x4 y0, y1;
#pragma unroll
                        for (int j = 0; j < 4; ++j) {
                            y0[j] = acc[ai][bj][m][0][j] * (((float)((qc[bj * 2] >> (8 * j)) & 255u) + 0.5f) * (1.0f / 256.0f));
                            y1[j] = acc[ai][bj][m][1][j] * (((float)((qc[bj * 2 + 1] >> (8 * j)) & 255u) + 0.5f) * (1.0f / 256.0f)); }
                        *(u32x4*)(mb + r * 1024 + col) = pack8(y0, y1); }
                } }
        return br == 2;
    }
};

struct PWout {
    static constexpr bool PERM = true;
    int K, lda, ldb, G, c;
    const bf16_t* A; const bf16_t* Bt; bf16_t* T; float* R; float* part;
    __device__ __forceinline__ int nt(const Unit& u) const { return u.z < 0 ? 16 : 4; }
    __device__ __forceinline__ bool next(int i, Unit& u) const {
        const int nP = c < 256 ? (256 - c + G - 1) / G : 0;
        if (i < nP) { tile_map(i * G + c, 64, 4, u.pm, u.pn); u.z = -1; return true; }
        const int j = (i - nP) * G + c; if (j >= 32) return false;
        u.pm = 64 + (j >> 4); u.pn = (j >> 2) & 3; u.z = j & 3; return true; }
    __device__ __forceinline__ const char* aptr(const Unit& u) const { return (const char*)A + (size_t)u.pm * 256 * 1024 * 2 + (u.z < 0 ? 0 : u.z * 512); }
    __device__ __forceinline__ const char* bptr(const Unit& u) const { return (const char*)Bt + (size_t)u.pn * 256 * 1024 * 2 + (u.z < 0 ? 0 : u.z * 512); }
    __device__ __forceinline__ bool epi(Acc& acc, const Unit& u, int wr, int wc, int fr, int fq) const {
#pragma unroll
        for (int ai = 0; ai < 2; ++ai)
#pragma unroll
            for (int m = 0; m < 4; ++m) { const size_t r = (size_t)u.pm * 256 + ai * 128 + wr * 64 + m * 16 + fr;
#pragma unroll
                for (int bj = 0; bj < 2; ++bj) { const int col = u.pn * 256 + bj * 128 + wc * 32 + 8 * fq;
                    if (u.z < 0) *(u32x4*)(T + r * 1024 + col) = pack8(acc[ai][bj][m][0], acc[ai][bj][m][1]);
                    else { float* pp = (u.z == 0) ? R + r * 1024 + col : part + (size_t)(u.z - 1) * PART_STRIDE + (r - MP) * 1024 + col;
                        *(f32x4*)pp = acc[ai][bj][m][0]; *(f32x4*)(pp + 4) = acc[ai][bj][m][1]; } } }
        return true;
    }
};

struct PUp {
    __device__ __forceinline__ int nt(const Unit&) const { return K / BK; }
    static constexpr bool PERM = true;
    int K, lda, ldb, G, c;
    const bf16_t* A; const bf16_t* Bt; bf16_t* h;
    __device__ __forceinline__ bool next(int i, Unit& u) const { const long L = (long)i * G + c; if (L >= 66 * 16) return false; tile_map((int)L, 66, 16, u.pm, u.pn); u.z = 0; return true; }
    __device__ __forceinline__ const char* aptr(const Unit& u) const { return (const char*)A + (size_t)u.pm * 256 * 1024 * 2; }
    __device__ __forceinline__ const char* bptr(const Unit& u) const { return (const char*)Bt + (size_t)u.pn * 256 * 1024 * 2; }
    __device__ __forceinline__ bool epi(Acc& acc, const Unit& u, int wr, int wc, int fr, int fq) const {
#pragma unroll
        for (int ai = 0; ai < 2; ++ai)
#pragma unroll
            for (int m = 0; m < 4; ++m) { const size_t r = (size_t)u.pm * 256 + ai * 128 + wr * 64 + m * 16 + fr;
#pragma unroll
                for (int bj = 0; bj < 2; ++bj) { const int col = u.pn * 256 + bj * 128 + wc * 32 + 8 * fq;
                    f32x4 y0, y1;
#pragma unroll
                    for (int j = 0; j < 4; ++j) { const float v0 = fmaxf(acc[ai][bj][m][0][j], 0.f), v1 = fmaxf(acc[ai][bj][m][1][j], 0.f); y0[j] = v0 * v0; y1[j] = v1 * v1; }
                    *(u32x4*)(h + r * 4096 + col) = pack8(y0, y1); } }
        return true;
    }
};

struct PDown {
    static constexpr bool PERM = true;
    int K, lda, ldb, G, c;
    const bf16_t* A; const bf16_t* Bt; bf16_t* T; float* R; float* part;
    __device__ __forceinline__ int nt(const Unit& u) const { return u.z < 0 ? 64 : 16; }
    __device__ __forceinline__ bool next(int i, Unit& u) const {
        const int nP = c < 256 ? (256 - c + G - 1) / G : 0;
        if (i < nP) { tile_map(i * G + c, 64, 4, u.pm, u.pn); u.z = -1; return true; }
        const int j = (i - nP) * G + c; if (j >= 32) return false;
        u.pm = 64 + (j >> 4); u.pn = (j >> 2) & 3; u.z = j & 3; return true; }
    __device__ __forceinline__ const char* aptr(const Unit& u) const { return (const char*)A + (size_t)u.pm * 256 * 4096 * 2 + (u.z < 0 ? 0 : u.z * 2048); }
    __device__ __forceinline__ const char* bptr(const Unit& u) const { return (const char*)Bt + (size_t)u.pn * 256 * 4096 * 2 + (u.z < 0 ? 0 : u.z * 2048); }
    __device__ __forceinline__ bool epi(Acc& acc, const Unit& u, int wr, int wc, int fr, int fq) const {
#pragma unroll
        for (int ai = 0; ai < 2; ++ai)
#pragma unroll
            for (int m = 0; m < 4; ++m) { const size_t r = (size_t)u.pm * 256 + ai * 128 + wr * 64 + m * 16 + fr;
#pragma unroll
                for (int bj = 0; bj < 2; ++bj) { const int col = u.pn * 256 + bj * 128 + wc * 32 + 8 * fq;
                    if (u.z < 0) *(u32x4*)(T + r * 1024 + col) = pack8(acc[ai][bj][m][0], acc[ai][bj][m][1]);
                    else { float* pp = (u.z == 0) ? R + r * 1024 + col : part + (size_t)(u.z - 1) * PART_STRIDE + (r - MP) * 1024 + col;
                        *(f32x4*)pp = acc[ai][bj][m][0]; *(f32x4*)(pp + 4) = acc[ai][bj][m][1]; } } }
        return true;
    }
};

struct TJob { const float* W; bf16_t* Wt; int K, N, tk, tn4; };
__device__ __forceinline__ TJob tjob(AP a, int layer, int t) {
    unsigned char* ws = a->ws; TJob j; int tt;
    if (t < 384) { tt = t; j.W = a->in[I_WIN] + (size_t)layer * 1024 * 6144; j.Wt = (bf16_t*)(ws + OFF_WIN); j.K = 1024; j.N = 6144; }
    else if (t < 480) { const int q = (t - 384) / 32; tt = (t - 384) % 32; j.W = a->in[I_PA + q] + (size_t)layer * 512 * 1024; j.Wt = (bf16_t*)(ws + OFF_WP) + (size_t)q * 1024 * 512; j.K = 512; j.N = 1024; }
    else if (t < 496) { tt = t - 480; j.W = a->in[I_GLW] + (size_t)layer * 512 * 512; j.Wt = (bf16_t*)(ws + OFF_WGLU); j.K = 512; j.N = 512; }
    else if (t < 560) { tt = t - 496; j.W = a->in[I_WO] + (size_t)layer * 1024 * 1024; j.Wt = (bf16_t*)(ws + OFF_WOUT); j.K = 1024; j.N = 1024; }
    else if (t < 816) { tt = t - 560; j.W = a->in[I_UP] + (size_t)layer * 1024 * 4096; j.Wt = (bf16_t*)(ws + OFF_WUP); j.K = 1024; j.N = 4096; }
    else { tt = t - 816; j.W = a->in[I_DN] + (size_t)layer * 4096 * 1024; j.Wt = (bf16_t*)(ws + OFF_WDOWN); j.K = 4096; j.N = 1024; }
    const int ntn = j.N / 256; j.tk = tt / ntn; j.tn4 = tt % ntn; return j;
}
__device__ __forceinline__ void tload(const TJob& j, int tid, f32x4 (&v)[4][2]) {
    const int r = tid >> 3, c8 = (tid & 7) * 8; const float* src = j.W + (size_t)(j.tk * 64 + r) * j.N + j.tn4 * 256 + c8;
#pragma unroll
    for (int q = 0; q < 4; ++q) { v[q][0] = *(const f32x4*)(src + q * 64); v[q][1] = *(const f32x4*)(src + q * 64 + 4); }
}

__device__ __forceinline__ void abar_pow(const float* are, const float* aim, const float* ldt, int sp, float e, float& pr, float& pi) {
    const float step = expf(ldt[sp]); const float x = e * step * are[sp], th = e * step * aim[sp];
    float s, c; sincosf(th, &s, &c); const float mg = expf(x); pr = mg * c; pi = mg * s;
}
__device__ __forceinline__ void ssm_coef(const float* are, const float* aim, const float* ldt, int sp, float& cr, float& ci) {
    const float step = expf(ldt[sp]); const float ar = are[sp], ai = aim[sp];
    const float x = step * ar, th = step * ai;
    float s, c; sincosf(th, &s, &c); const float em1 = expm1f(x); const float sh = sinf(0.5f * th);
    const float nr = em1 * c - 2.0f * sh * sh, ni = (em1 + 1.0f) * s;
    const float den = ar * ar + ai * ai;
    cr = (nr * ar + ni * ai) / den; ci = (ni * ar - nr * ai) / den;
}

__device__ __forceinline__ void prep_layer(AP a, int layer, float* sm, const int wv_) {
    unsigned char* ws = a->ws;
    const int G = gridDim.x;
    {
        const int tid = otid(wv_), r = tid >> 3, c8 = (tid & 7) * 8, n = tid >> 3, k8 = (tid & 7) * 8;
        int t = blockIdx.x; f32x4 v[4][2]; TJob j;
        if (t < 1072) { j = tjob(a, layer, t); tload(j, tid, v); }
        while (t < 1072) {
#pragma unroll
            for (int q = 0; q < 4; ++q)
#pragma unroll
                for (int e = 0; e < 4; ++e) { sm[q * 4160 + r * 65 + c8 + e] = v[q][0][e]; sm[q * 4160 + r * 65 + c8 + 4 + e] = v[q][1][e]; }
            __syncthreads();
            const TJob cj = j; const int tn = t + G;
            if (tn < 1072) { j = tjob(a, layer, tn); tload(j, tid, v); }
#pragma unroll
            for (int q = 0; q < 4; ++q) { const float* tt = sm + q * 4160;
                u32x4 w;
                w.x = cvt_pk_bf16(tt[(k8 + 0) * 65 + n], tt[(k8 + 1) * 65 + n]); w.y = cvt_pk_bf16(tt[(k8 + 2) * 65 + n], tt[(k8 + 3) * 65 + n]);
                w.z = cvt_pk_bf16(tt[(k8 + 4) * 65 + n], tt[(k8 + 5) * 65 + n]); w.w = cvt_pk_bf16(tt[(k8 + 6) * 65 + n], tt[(k8 + 7) * 65 + n]);
                *(u32x4*)(cj.Wt + (size_t)(cj.tn4 * 256 + q * 64 + n) * cj.K + cj.tk * 64 + k8) = w; }
            __syncthreads();
            t = tn;
        }
    }
    const int GT = G * NTHR;
    {
        bf16_t* wg = (bf16_t*)(ws + OFF_WGATE);
        for (int idx = blockIdx.x * NTHR + otid(wv_); idx < 1024 * 32; idx += GT) {
            const int n = idx >> 5, k0 = (idx & 31) * 8; const int pn = n >> 8, bj = (n >> 7) & 1, ch = pn * 128 + (n & 127), hd = ch >> 6, j = ch & 63;
            u32x4 w = (u32x4){0u, 0u, 0u, 0u};
            if ((pn >> 1) * 4 + (k0 >> 6) == hd) { const float* src = a->in[bj ? I_GAW : I_GXW] + (size_t)layer * 8 * 64 * 64 + (size_t)hd * 4096 + (size_t)(k0 & 63) * 64 + j;
                w.x = cvt_pk_bf16(src[0], src[64]); w.y = cvt_pk_bf16(src[128], src[192]); w.z = cvt_pk_bf16(src[256], src[320]); w.w = cvt_pk_bf16(src[384], src[448]); }
            *(u32x4*)(wg + (size_t)n * 256 + k0) = w;
        }
    }
    const float* are = a->in[I_SAR] + layer * 2048; const float* aim = a->in[I_SAI] + layer * 2048; const float* ldt = a->in[I_SDT] + layer * 2048;
    const float* bre = a->in[I_SBR] + layer * 32768; const float* bim = a->in[I_SBI] + layer * 32768;
    const float* cre = a->in[I_SCR] + layer * 32768; const float* cim = a->in[I_SCI] + layer * 32768;
    {
        bf16_t* w1 = (bf16_t*)(ws + OFF_W1T);
        for (int idx = blockIdx.x * NTHR + otid(wv_); idx < 32 * 128 * 32; idx += GT) {
            const int g = idx >> 12, n = (idx >> 5) & 127, k0 = (idx & 31) * 8, j = k0 >> 4, c0 = k0 & 15, p = n & 63, part = n >> 6, sp = g * 64 + p;
            float pr, pi, cr, ci; abar_pow(are, aim, ldt, sp, (float)(15 - j), pr, pi); ssm_coef(are, aim, ldt, sp, cr, ci);
            const float qr = pr * cr - pi * ci, qi = pr * ci + pi * cr;
            float o[8];
#pragma unroll
            for (int q = 0; q < 8; ++q) { const float br = bre[sp * 16 + c0 + q], bi = bim[sp * 16 + c0 + q]; o[q] = part ? (qr * bi + qi * br) : (qr * br - qi * bi); }
            u32x4 w; w.x = cvt_pk_bf16(o[0], o[1]); w.y = cvt_pk_bf16(o[2], o[3]); w.z = cvt_pk_bf16(o[4], o[5]); w.w = cvt_pk_bf16(o[6], o[7]);
            *(u32x4*)(w1 + ((size_t)(g * 128 + n) * 256 + k0)) = w;
        }
    }
    {
        bf16_t* wy = (bf16_t*)(ws + OFF_WYT);
        for (int idx = blockIdx.x * NTHR + otid(wv_); idx < 32 * 256 * 16; idx += GT) {
            const int g = idx >> 12, n = (idx >> 4) & 255, k0 = (idx & 15) * 8, i = n >> 4, c = n & 15, part = k0 >> 6, p0 = k0 & 63;
            float o[8];
#pragma unroll
            for (int q = 0; q < 8; ++q) { const int p = p0 + q, sp = g * 64 + p; float pr, pi; abar_pow(are, aim, ldt, sp, (float)(i + 1), pr, pi);
                const float xr = cre[(g * 16 + c) * 64 + p], xi = cim[(g * 16 + c) * 64 + p];
                o[q] = part ? -(xr * pi + xi * pr) : (xr * pr - xi * pi); }
            u32x4 w; w.x = cvt_pk_bf16(o[0], o[1]); w.y = cvt_pk_bf16(o[2], o[3]); w.z = cvt_pk_bf16(o[4], o[5]); w.w = cvt_pk_bf16(o[6], o[7]);
            *(u32x4*)(wy + ((size_t)(g * 256 + n) * 384 + k0)) = w;
        }
        for (int idx = blockIdx.x * NTHR + otid(wv_); idx < 32 * 256 * 4; idx += GT) {
            const int pq = idx & 3, c2 = (idx >> 2) & 15, c = (idx >> 6) & 15, g = idx >> 10;
            float km[16];
#pragma unroll
            for (int d = 0; d < 16; ++d) km[d] = 0.f;
            for (int pp = 0; pp < 16; ++pp) { const int p = pq * 16 + pp, sp = g * 64 + p; float ar, ai, cr, ci; abar_pow(are, aim, ldt, sp, 1.0f, ar, ai); ssm_coef(are, aim, ldt, sp, cr, ci);
                const float br = bre[sp * 16 + c2], bi = bim[sp * 16 + c2];
                const float bbr = cr * br - ci * bi, bbi = cr * bi + ci * br;
                const float xr = cre[(g * 16 + c) * 64 + p], xi = cim[(g * 16 + c) * 64 + p];
                float tr = xr * bbr - xi * bbi, ti = xr * bbi + xi * bbr;
#pragma unroll
                for (int d = 0; d < 16; ++d) { km[d] += tr; const float nr = tr * ar - ti * ai, ni = tr * ai + ti * ar; tr = nr; ti = ni; } }
#pragma unroll
            for (int d = 0; d < 16; ++d) { km[d] += __shfl_xor(km[d], 1); km[d] += __shfl_xor(km[d], 2); }
#pragma unroll
            for (int d = 0; d < 16; ++d) if ((d & 3) == pq) { const bf16_t kb = f2bf(km[d]);
                for (int i = d; i < 16; ++i) wy[(size_t)(g * 256 + i * 16 + c) * 384 + 128 + (i - d) * 16 + c2] = kb;
                if (d > 0) for (int i = 0; i < 16 - d; ++i) wy[(size_t)(g * 256 + i * 16 + c) * 384 + 128 + (i + d) * 16 + c2] = (bf16_t)0; }
        }
    }
}

__device__ __forceinline__ void prep_x(AP a, const int wv_) {
    bf16_t* xb = (bf16_t*)(a->ws + OFF_XB);
    const int gt = blockIdx.x * NTHR + otid(wv_), GT = gridDim.x * NTHR;
    for (int idx = gt; idx < M * 128; idx += GT) {
        const size_t e = (size_t)idx * 8; const float* src = e < (size_t)MP * 1024 ? a->in[I_XP] + e : a->in[I_XS] + (e - (size_t)MP * 1024);
        const f32x4 v0 = *(const f32x4*)src, v1 = *(const f32x4*)(src + 4);
        *(u32x4*)(xb + e) = pack8(v0, v1);
    }
}

__device__ __forceinline__ void conv_phase(AP a, int layer, bf16_t* bin_out, const int wv_) {
    unsigned char* ws = a->ws;
    const bf16_t* xa = (const bf16_t*)(ws + OFF_R); bf16_t* sb = (bf16_t*)(ws + OFF_R + S17);
    const bf16_t* sc = (const bf16_t*)(ws + OFF_R + 2 * S17); const bf16_t* sh = (const bf16_t*)(ws + OFF_R + 3 * S17);
    bf16_t* xac = (bf16_t*)(ws + OFF_XB);
    const float* caw = a->in[I_CAW] + layer * 4 * 512; const float* cab = a->in[I_CAB] + layer * 512; const float* cbw = a->in[I_CBW] + layer * 3 * 512;
    const int gt = blockIdx.x * NTHR + otid(wv_), GT = gridDim.x * NTHR;
    for (int idx = gt; idx < (2048 + 128) * 64; idx += GT) {
        const int seg = idx >> 6, c0 = (idx & 63) * 8;
        const bool prompt = seg < 2048;
        int row0, nrows;
        float x0[8], x1[8], x2[8], u1[8], u2[8];
        if (prompt) { row0 = seg * 8; nrows = 8; const bool first = (seg & 255) == 0;
            if (first) {
#pragma unroll
                for (int j = 0; j < 8; ++j) { x0[j] = 0.f; x1[j] = 0.f; x2[j] = 0.f; u1[j] = 0.f; u2[j] = 0.f; }
            } else {
                unpack8(*(const u32x4*)(xa + (size_t)(row0 - 3) * 512 + c0), x0); unpack8(*(const u32x4*)(xa + (size_t)(row0 - 2) * 512 + c0), x1); unpack8(*(const u32x4*)(xa + (size_t)(row0 - 1) * 512 + c0), x2);
                float s1[8], s2[8];
                unpack8(*(const u32x4*)(sc + (size_t)(row0 - 2) * 512 + c0), u1); unpack8(*(const u32x4*)(sh + (size_t)(row0 - 2) * 512 + c0), s1);
                unpack8(*(const u32x4*)(sc + (size_t)(row0 - 1) * 512 + c0), u2); unpack8(*(const u32x4*)(sh + (size_t)(row0 - 1) * 512 + c0), s2);
#pragma unroll
                for (int j = 0; j < 8; ++j) { u1[j] *= s1[j]; u2[j] *= s2[j]; }
            }
        } else { const int b = seg - 2048; row0 = MP + b * 4; nrows = 4;
            const float* lc = a->in[I_SLC] + ((size_t)(layer * 128 + b) * 3) * 512 + c0; const float* scs = a->in[I_SSC] + ((size_t)(layer * 128 + b) * 2) * 512 + c0;
#pragma unroll
            for (int j = 0; j < 8; ++j) { x0[j] = lc[j]; x1[j] = lc[512 + j]; x2[j] = lc[1024 + j]; u1[j] = scs[j]; u2[j] = scs[512 + j]; }
        }
        float w0[8], w1[8], w2[8], w3[8], wb[8], v0[8], v1[8], v2[8];
#pragma unroll
        for (int j = 0; j < 8; ++j) { w0[j] = caw[c0 + j]; w1[j] = caw[512 + c0 + j]; w2[j] = caw[1024 + c0 + j]; w3[j] = caw[1536 + c0 + j]; wb[j] = cab[c0 + j];
            v0[j] = cbw[c0 + j]; v1[j] = cbw[512 + c0 + j]; v2[j] = cbw[1024 + c0 + j]; }
        for (int t0 = 0; t0 < nrows; t0 += 2) {
            u32x4 lx[2], lc[2], lh[2], lb[2];
#pragma unroll
            for (int k = 0; k < 2; ++k) { const size_t off = (size_t)(row0 + t0 + k) * 512 + c0;
                lx[k] = *(const u32x4*)(xa + off); lc[k] = *(const u32x4*)(sc + off); lh[k] = *(const u32x4*)(sh + off); lb[k] = *(const u32x4*)(sb + off); }
#pragma unroll
            for (int k = 0; k < 2; ++k) { const size_t off = (size_t)(row0 + t0 + k) * 512 + c0;
                float xv[8], scv[8], shv[8], sbv[8];
                unpack8(lx[k], xv); unpack8(lc[k], scv); unpack8(lh[k], shv); unpack8(lb[k], sbv);
                f32x4 o0, o1, q0, q1;
#pragma unroll
                for (int j = 0; j < 8; ++j) {
                    const float o = w0[j] * x0[j] + w1[j] * x1[j] + w2[j] * x2[j] + w3[j] * xv[j] + wb[j];
                    const float uu = scv[j] * shv[j]; const float cu = v0[j] * u1[j] + v1[j] * u2[j] + v2[j] * uu; const float bi = sbv[j] * cu;
                    if (j < 4) { o0[j] = o; q0[j] = bi; } else { o1[j - 4] = o; q1[j - 4] = bi; }
                    x0[j] = x1[j]; x1[j] = x2[j]; x2[j] = xv[j]; u1[j] = u2[j]; u2[j] = uu;
                }
                *(u32x4*)(xac + off) = pack8(o0, o1);
                *(u32x4*)(bin_out + off) = pack8(q0, q1); }
        }
        if (prompt) { if ((seg & 255) == 255) { const int b = seg >> 8;
                float* o1 = a->out + O_LCP + ((size_t)(layer * 8 + b) * 3) * 512 + c0; float* o2 = a->out + O_SCP + ((size_t)(layer * 8 + b) * 2) * 512 + c0;
#pragma unroll
                for (int j = 0; j < 8; ++j) { o1[j] = x0[j]; o1[512 + j] = x1[j]; o1[1024 + j] = x2[j]; o2[j] = u1[j]; o2[512 + j] = u2[j]; } }
        } else { const int b = seg - 2048;
            float* o1 = a->out + O_LCS + ((size_t)(layer * 128 + b) * 3) * 512 + c0; float* o2 = a->out + O_SCS + ((size_t)(layer * 128 + b) * 2) * 512 + c0;
#pragma unroll
            for (int j = 0; j < 8; ++j) { o1[j] = x0[j]; o1[512 + j] = x1[j]; o1[1024 + j] = x2[j]; o2[j] = u1[j]; o2[512 + j] = u2[j]; }
        }
    }
}

__device__ __forceinline__ void ssm_s_gemm(AP a, const int wv_) {
    const bf16_t* apack = (const bf16_t*)(a->ws + OFF_APACK); const bf16_t* w1 = (const bf16_t*)(a->ws + OFF_W1T); float* S = (float*)(a->ws + OFF_S);
    const int tid_ = otid(wv_); const int lane = tid_ & 63, wv = blockIdx.x * 8 + (tid_ >> 6), NW = gridDim.x * 8;
    const int lr = lane & 15, kq = lane >> 4;
    for (int t = wv; t < 1024; t += NW) {
        const int g = t >> 5, rt = (t >> 1) & 15, ct = t & 1;
        f32x4 acc[4][4];
#pragma unroll
        for (int i = 0; i < 4; ++i)
#pragma unroll
            for (int j = 0; j < 4; ++j) acc[i][j] = (f32x4){0.f, 0.f, 0.f, 0.f};
        const bf16_t* ab = apack + ((size_t)(g * 1024 + rt * 64 + lr) * 384 + 128 + kq * 8);
        const bf16_t* bb = w1 + ((size_t)(g * 128 + ct * 64 + lr) * 256 + kq * 8);
#pragma unroll 2
        for (int ks = 0; ks < 8; ++ks) {
            bf16x8 af[4], bf[4];
#pragma unroll
            for (int i = 0; i < 4; ++i) { af[i] = *(const bf16x8*)(ab + (size_t)i * 16 * 384 + ks * 32); bf[i] = *(const bf16x8*)(bb + (size_t)i * 16 * 256 + ks * 32); }
#pragma unroll
            for (int i = 0; i < 4; ++i)
#pragma unroll
                for (int j = 0; j < 4; ++j) acc[i][j] = __builtin_amdgcn_mfma_f32_16x16x32_bf16(af[i], bf[j], acc[i][j], 0, 0, 0);
        }
#pragma unroll
        for (int i = 0; i < 4; ++i)
#pragma unroll
            for (int j = 0; j < 4; ++j)
#pragma unroll
                for (int q = 0; q < 4; ++q) S[(size_t)(g * 1024 + rt * 64 + i * 16 + kq * 4 + q) * 128 + ct * 64 + j * 16 + lr] = acc[i][j][q];
    }
}

__device__ __forceinline__ void ssm_carry(AP a, int layer, float* sm, const int wv_) {
    bf16_t* apack = (bf16_t*)(a->ws + OFF_APACK); const float* S = (const float*)(a->ws + OFF_S);
    const int tid = otid(wv_), p = tid & 63, seg = tid >> 6;
    for (int pair = blockIdx.x; pair < 256; pair += gridDim.x) {
        const int b = pair >> 5, g = pair & 31, sp = g * 64 + p;
        float ar, ai, Ar, Ai;
        abar_pow(a->in[I_SAR] + layer * 2048, a->in[I_SAI] + layer * 2048, a->in[I_SDT] + layer * 2048, sp, 16.0f, ar, ai);
        abar_pow(a->in[I_SAR] + layer * 2048, a->in[I_SAI] + layer * 2048, a->in[I_SDT] + layer * 2048, sp, 256.0f, Ar, Ai);
        const size_t rbase = (size_t)g * 1024 + b * 128 + seg * 16;
        float sr[16], si[16];
#pragma unroll
        for (int j = 0; j < 16; ++j) { sr[j] = S[(rbase + j) * 128 + p]; si[j] = S[(rbase + j) * 128 + 64 + p]; }
        float hr = 0.f, hi = 0.f;
#pragma unroll
        for (int j = 0; j < 16; ++j) { const float nr = ar * hr - ai * hi + sr[j], ni = ar * hi + ai * hr + si[j]; sr[j] = hr; si[j] = hi; hr = nr; hi = ni; }
        sm[seg * 128 + p] = hr; sm[seg * 128 + 64 + p] = hi;
        __syncthreads();
        float cr = 0.f, ci = 0.f;
        for (int s2 = 0; s2 < seg; ++s2) { const float er = sm[s2 * 128 + p], ei = sm[s2 * 128 + 64 + p]; const float nr = Ar * cr - Ai * ci + er, ni = Ar * ci + Ai * cr + ei; cr = nr; ci = ni; }
        if (seg == 7) { const float fr_ = Ar * cr - Ai * ci + hr, fi_ = Ar * ci + Ai * cr + hi;
            a->out[O_SRP + (size_t)(layer * 8 + b) * 2048 + sp] = fr_; a->out[O_SIP + (size_t)(layer * 8 + b) * 2048 + sp] = fi_; }
#pragma unroll
        for (int j = 0; j < 16; ++j) { apack[(rbase + j) * 384 + p] = f2bf(sr[j] + cr); apack[(rbase + j) * 384 + 64 + p] = f2bf(si[j] + ci);
            const float nr = ar * cr - ai * ci, ni = ar * ci + ai * cr; cr = nr; ci = ni; }
        __syncthreads();
    }
}

__device__ __forceinline__ void ssm_sample(AP a, int layer, int wv, int NW, const int wv_) {
    const bf16_t* uss = (const bf16_t*)(a->ws + OFF_USS); bf16_t* zc = (bf16_t*)(a->ws + OFF_ZCS);
    const float* are = a->in[I_SAR] + layer * 2048; const float* aim = a->in[I_SAI] + layer * 2048; const float* ldt = a->in[I_SDT] + layer * 2048;
    const float* bre = a->in[I_SBR] + layer * 32768; const float* bim = a->in[I_SBI] + layer * 32768;
    const float* cre = a->in[I_SCR] + layer * 32768; const float* cim = a->in[I_SCI] + layer * 32768; const float* dv = a->in[I_SD] + layer * 512;
    const int lane = otid(wv_) & 63;
    for (int t = wv; t < 128 * 32; t += NW) {
        const int b = t >> 5, g = t & 31, sp = g * 64 + lane;
        float ar, ai, cr, ci; abar_pow(are, aim, ldt, sp, 1.0f, ar, ai); ssm_coef(are, aim, ldt, sp, cr, ci);
        float bbr[16], bbi[16], xr[16], xi[16];
#pragma unroll
        for (int c = 0; c < 16; ++c) { const float br = bre[sp * 16 + c], bi = bim[sp * 16 + c]; bbr[c] = cr * br - ci * bi; bbi[c] = cr * bi + ci * br;
            xr[c] = cre[(g * 16 + c) * 64 + lane]; xi[c] = cim[(g * 16 + c) * 64 + lane]; }
        float hr = a->in[I_SSR][(size_t)(layer * 128 + b) * 2048 + sp], hi = a->in[I_SSI][(size_t)(layer * 128 + b) * 2048 + sp];
        const float dme = lane < 16 ? dv[g * 16 + lane] : 0.f;
        for (int tt = 0; tt < 4; ++tt) {
            const bf16_t* up = uss + (size_t)(b * 4 + tt) * 512 + g * 16;
            const u32x4 w0 = *(const u32x4*)up, w1 = *(const u32x4*)(up + 8);
            float u[16]; { float t0[8], t1[8]; unpack8(w0, t0); unpack8(w1, t1);
#pragma unroll
                for (int c = 0; c < 8; ++c) { u[c] = t0[c]; u[8 + c] = t1[c]; } }
            float br_ = 0.f, bi_ = 0.f;
#pragma unroll
            for (int c = 0; c < 16; ++c) { br_ += bbr[c] * u[c]; bi_ += bbi[c] * u[c]; }
            const float nr = ar * hr - ai * hi + br_, ni = ar * hi + ai * hr + bi_; hr = nr; hi = ni;
            float mine = 0.f, ume = 0.f;
#pragma unroll
            for (int c = 0; c < 16; ++c) { float y = xr[c] * hr - xi[c] * hi;
#pragma unroll
                for (int o = 32; o >= 1; o >>= 1) y += __shfl_xor(y, o);
                if (lane == c) { mine = y; ume = u[c]; } }
            if (lane < 16) zc[(size_t)(b * 4 + tt) * 512 + g * 16 + lane] = f2bf(gelu_t(mine + dme * ume));
        }
        a->out[O_SRS + (size_t)(layer * 128 + b) * 2048 + sp] = hr; a->out[O_SIS + (size_t)(layer * 128 + b) * 2048 + sp] = hi;
    }
}

__device__ __forceinline__ void lru_local(AP a, const int wv_) {
    const _Float16* av = (const _Float16*)(a->ws + OFF_R + 2 * S17); const bf16_t* bx = (const bf16_t*)(a->ws + OFF_R); f32x2* car = (f32x2*)(a->ws + OFF_CAR);
    const int gt = blockIdx.x * NTHR + otid(wv_), GT = gridDim.x * NTHR;
    for (int idx = gt; idx < 8 * 32 * 512; idx += GT) {
        const int c = idx & 511, sc = idx >> 9;
        const size_t base = (size_t)sc * 64 * 512 + c;
        float P = 1.f, h = 0.f;
        for (int t0 = 0; t0 < 64; t0 += 16) {
            _Float16 al[16]; bf16_t bb[16];
#pragma unroll
            for (int j = 0; j < 16; ++j) { al[j] = av[base + (size_t)(t0 + j) * 512]; bb[j] = bx[base + (size_t)(t0 + j) * 512]; }
#pragma unroll
            for (int j = 0; j < 16; ++j) { const float aa = __expf((float)al[j]); h = aa * h + bf2f(bb[j]); P *= aa; }
        }
        car[idx] = (f32x2){P, h};
    }
}
template <int B>
__device__ __forceinline__ float lru_run(const _Float16* av, const bf16_t* bx, bf16_t* ao, const bf16_t* ya, size_t base, int n, float h) {
    for (int t0 = 0; t0 < n; t0 += B) {
        _Float16 aa[B]; bf16_t bb[B], yy[B];
#pragma unroll
        for (int j = 0; j < B; ++j) { const size_t o = base + (size_t)(t0 + j) * 512; aa[j] = av[o]; bb[j] = bx[o]; yy[j] = ya[o]; }
        bf16_t oo[B];
#pragma unroll
        for (int j = 0; j < B; ++j) { h = __expf((float)aa[j]) * h + bf2f(bb[j]); oo[j] = f2bf(h * gelu_t(bf2f(yy[j]))); }
#pragma unroll
        for (int j = 0; j < B; ++j) ao[base + (size_t)(t0 + j) * 512] = oo[j];
    }
    return h;
}
__device__ __forceinline__ void lru_apply(AP a, int layer, bf16_t* ao, int mode, const int wv_) {
    const _Float16* av = (const _Float16*)(a->ws + OFF_R + 2 * S17); const bf16_t* bx = (const bf16_t*)(a->ws + OFF_R); const f32x2* car = (const f32x2*)(a->ws + OFF_CAR);
    const bf16_t* ya = (const bf16_t*)(a->ws + OFF_YA);
    const int G = gridDim.x, bid = blockIdx.x;
    if (mode == 0) {
        if (bid >= G - 8) return;
        const int GP = G - 8; int v = bid - 128; if (v < 0) v += GP;
        for (int idx = v * NTHR + otid(wv_); idx < 8 * 32 * 512; idx += GP * NTHR) {
            const int c = idx & 511, sc = idx >> 9, seq = sc >> 5, chunk = sc & 31;
            float h = 0.f;
            f32x2 ph[31];
#pragma unroll
            for (int k = 0; k < 31; ++k) ph[k] = car[(seq * 32 + (k < chunk ? k : 0)) * 512 + c];
#pragma unroll
            for (int k = 0; k < 31; ++k) if (k < chunk) h = ph[k].x * h + ph[k].y;
            h = lru_run<8>(av, bx, ao, ya, (size_t)sc * 64 * 512 + c, 64, h);
            if (chunk == 31) a->out[O_LHP + (size_t)(layer * 8 + seq) * 512 + c] = h;
        }
    } else {
        for (int j = bid * NTHR + otid(wv_); j < 128 * 512; j += G * NTHR) {
            const int c = j & 511, b = j >> 9;
            float h = a->in[I_SLH][(size_t)(layer * 128 + b) * 512 + c];
            h = lru_run<4>(av, bx, ao, ya, (size_t)(MP + b * 4) * 512 + c, 4, h);
            a->out[O_LHS + (size_t)(layer * 128 + b) * 512 + c] = h;
        }
    }
}

template <bool RES16>
__device__ __forceinline__ void ln_phase(const bf16_t* T, const float* Rs, const float* part, const float* resp, const float* ress, const bf16_t* res16,
                                         float* dst32, bf16_t* dst16, const float* gam, const float* bet, const int wv_) {
    const int tid_ = otid(wv_); const int lane = tid_ & 63, wv = blockIdx.x * 8 + (tid_ >> 6), NW = gridDim.x * 8;
    for (int r0 = wv; r0 < M; r0 += 3 * NW) {
        f32x4 v[3][4];
#pragma unroll
        for (int k = 0; k < 3; ++k) { const int rr = r0 + k * NW; const int r = rr < M ? rr : r0;
            if (r < MP) {
#pragma unroll
                for (int i = 0; i < 4; ++i) { const u32x2 w = *(const u32x2*)(T + (size_t)r * 1024 + i * 256 + lane * 4); v[k][i] = (f32x4){bflo(w.x), bfhi(w.x), bflo(w.y), bfhi(w.y)}; }
            } else {
#pragma unroll
                for (int i = 0; i < 4; ++i) v[k][i] = *(const f32x4*)(Rs + (size_t)r * 1024 + i * 256 + lane * 4);
#pragma unroll
                for (int q = 0; q < 3; ++q)
#pragma unroll
                    for (int i = 0; i < 4; ++i) v[k][i] += *(const f32x4*)(part + (size_t)q * PART_STRIDE + (size_t)(r - MP) * 1024 + i * 256 + lane * 4);
            }
            if (RES16) {
#pragma unroll
                for (int i = 0; i < 4; ++i) { const u32x2 w = *(const u32x2*)(res16 + (size_t)r * 1024 + i * 256 + lane * 4); v[k][i] += (f32x4){bflo(w.x), bfhi(w.x), bflo(w.y), bfhi(w.y)} * ALPHA; }
            } else { const float* rp = r < MP ? resp + (size_t)r * 1024 : ress + (size_t)(r - MP) * 1024;
#pragma unroll
                for (int i = 0; i < 4; ++i) v[k][i] += *(const f32x4*)(rp + i * 256 + lane * 4) * ALPHA;
            } }
#pragma unroll
        for (int k = 0; k < 3; ++k) { const int r = r0 + k * NW;
            float s = 0.f;
#pragma unroll
            for (int i = 0; i < 4; ++i) s += (v[k][i][0] + v[k][i][1]) + (v[k][i][2] + v[k][i][3]);
#pragma unroll
            for (int o = 32; o >= 1; o >>= 1) s += __shfl_xor(s, o);
            const float mu = s * (1.0f / 1024.0f); float q = 0.f;
#pragma unroll
            for (int i = 0; i < 4; ++i) { const f32x4 d = v[k][i] - mu; q += (d[0] * d[0] + d[1] * d[1]) + (d[2] * d[2] + d[3] * d[3]); }
#pragma unroll
            for (int o = 32; o >= 1; o >>= 1) q += __shfl_xor(q, o);
            const float rs = rsqrtf(q * (1.0f / 1024.0f) + LN_EPS);
            if (r < M) {
#pragma unroll
                for (int i = 0; i < 4; ++i) { const int col = i * 256 + lane * 4; const f32x4 gg = *(const f32x4*)(gam + col), bb = *(const f32x4*)(bet + col);
                    const f32x4 y = (v[k][i] - mu) * rs * gg + bb;
                    if (dst32) *(f32x4*)(dst32 + (size_t)r * 1024 + col) = y;
                    u32x2 w; w.x = cvt_pk_bf16(y[0], y[1]); w.y = cvt_pk_bf16(y[2], y[3]);
                    *(u32x2*)(dst16 + (size_t)r * 1024 + col) = w; }
            }
        }
    }
}

__global__ void __launch_bounds__(NTHR, 2) fwd_megakernel(Args a_unused) {
    extern __shared__ __attribute__((aligned(16))) unsigned char lds_raw[];
    cg::grid_group grid = cg::this_grid();
    LAS unsigned char* lds = (LAS unsigned char*)lds_raw;
    const int G = gridDim.x, bid = blockIdx.x;
    int wv_; { const int tw = (int)threadIdx.x >> 6; asm volatile("v_readfirstlane_b32 %0, %1" : "=s"(wv_) : "v"(tw)); }

    const unsigned long long t_start = PROBE_ON ? __builtin_amdgcn_s_memrealtime() : 0ull;
    for (int rep = 0; rep < REP_PREP; ++rep) { const AP a = ld_args(); prep_layer(a, 0, (float*)lds_raw, wv_); prep_x(a, wv_); }
    int pidx = 1; unsigned long long tA = PROBE_A == 0 ? t_start : 0ull, tB = 0ull;
    grid.sync();
    if (PROBE_ON) { if (PROBE_A == 1) tA = __builtin_amdgcn_s_memrealtime(); if (PROBE_B == 1) tB = __builtin_amdgcn_s_memrealtime(); }
    unsigned bar_n = 0; unsigned* bar_ctr; { const AP a = ld_args(); bar_ctr = (unsigned*)(a->ws + OFF_BAR); }

#pragma unroll 1
    for (int layer = 0; layer < 2; ++layer) {
        { const AP a = ld_args(); unsigned char* ws = a->ws;
          PG1 p; p.K = 1024; p.lda = 1024; p.ldb = 1024; p.G = opq(G); p.c = opq(bid); p.A = (const bf16_t*)(ws + OFF_XB); p.Bt = (const bf16_t*)(ws + OFF_WIN);
          p.xa = (bf16_t*)(ws + OFF_R); p.ya = (bf16_t*)(ws + OFF_YA); p.sb = (bf16_t*)(ws + OFF_R + S17); p.sc = (bf16_t*)(ws + OFF_R + 2 * S17); p.sh = (bf16_t*)(ws + OFF_R + 3 * S17);
          p.apack = (bf16_t*)(ws + OFF_APACK); p.uss = (bf16_t*)(ws + OFF_USS); p.gl8 = ws + OFF_GL8;
          for (int rep = 0; rep < REP_G1; ++rep) gemm_phase(lds, p, wv_); }
        GSYNC();
        if (DRY_CONV) { const AP a = ld_args(); conv_phase(a, layer, (bf16_t*)(a->ws + OFF_XB + S17), wv_); }
        { const AP a = ld_args(); conv_phase(a, layer, (bf16_t*)(a->ws + OFF_R + S17), wv_); }
        for (int rep = 0; rep < REP_SG; ++rep) { const AP a = ld_args(); ssm_s_gemm(a, wv_); }
        GSYNC();
        for (int rep = 0; rep < REP_CARRY; ++rep) { const AP a = ld_args(); ssm_carry(a, layer, (float*)lds_raw, wv_); }
        { const AP a = ld_args(); unsigned char* ws = a->ws;
          PGate p; p.K = 256; p.lda = 512; p.ldb = 256; p.G = opq(G); p.c = opq(bid); p.A = (const bf16_t*)(ws + OFF_XB); p.Bt = (const bf16_t*)(ws + OFF_WGATE);
          p.gxb = a->in[I_GXB] + layer * 512; p.gab = a->in[I_GAB] + layer * 512; p.lam = a->in[I_LAM] + layer * 512;
          p.aout = (_Float16*)(ws + OFF_R + 2 * S17); p.bxout = (bf16_t*)(ws + OFF_R);
          for (int rep = 0; rep < REP_GATE; ++rep) gemm_phase(lds, p, wv_); }
        for (int rep = 0; rep < REP_SAMPLE; ++rep) if (bid >= 8) { const AP a = ld_args(); ssm_sample(a, layer, (bid - 8) * 8 + wv_, (G - 8) * 8, wv_); }
        GSYNC();
        { const AP a = ld_args(); unsigned char* ws = a->ws;
          PY p; p.K = 384; p.lda = 384; p.ldb = 384; p.G = opq(G); p.c = opq(bid); p.apack = (const bf16_t*)(ws + OFF_APACK); p.wyt = (const bf16_t*)(ws + OFF_WYT);
          p.dvec = a->in[I_SD] + layer * 512; p.zc = (bf16_t*)(ws + OFF_XB);
          for (int rep = 0; rep < REP_Y; ++rep) gemm_phase(lds, p, wv_); }
        { const AP a = ld_args(); unsigned char* ws = a->ws;
          PGlu p; p.K = 512; p.lda = 512; p.ldb = 512; p.G = opq(G); p.c = opq(bid); p.sample = 1; p.A = (const bf16_t*)(ws + OFF_XB); p.As = (const bf16_t*)(ws + OFF_ZCS); p.Bt = (const bf16_t*)(ws + OFF_WGLU);
          p.bias = a->in[I_GLB] + layer * 512; p.out = (bf16_t*)(ws + OFF_XB + S17);
          gemm_phase(lds, p, wv_); }
        { const AP a = ld_args(); lru_apply(a, layer, (bf16_t*)(a->ws + OFF_R), 1, wv_); }
        for (int rep = 0; rep < REP_LOCAL; ++rep) { const AP a = ld_args(); lru_local(a, wv_); }
        GSYNC();
        { const AP a = ld_args(); unsigned char* ws = a->ws;
          PGlu p; p.K = 512; p.lda = 512; p.ldb = 512; p.G = opq(G); p.c = opq(bid); p.sample = 0; p.A = (const bf16_t*)(ws + OFF_XB); p.As = (const bf16_t*)(ws + OFF_ZCS); p.Bt = (const bf16_t*)(ws + OFF_WGLU);
          p.bias = a->in[I_GLB] + layer * 512; p.out = (bf16_t*)(ws + OFF_XB + S17);
          for (int rep = 0; rep < REP_GLU; ++rep) gemm_phase(lds, p, wv_); }
        { const AP a = ld_args(); unsigned char* ws = a->ws;
          PMerge p; p.K = 512; p.lda = 512; p.ldb = 512; p.G = opq(G); p.c = opq(bid); p.sample = 1; p.a0 = (const bf16_t*)(ws + OFF_R);
          p.wp = (const bf16_t*)(ws + OFF_WP); p.gl8 = ws + OFF_GL8; p.mb = (bf16_t*)(ws + OFF_MB);
          gemm_phase(lds, p, wv_); }
        if (DRY_APPLY) { const AP a = ld_args(); lru_apply(a, layer, (bf16_t*)(a->ws + OFF_S), 0, wv_); }
        { const AP a = ld_args(); lru_apply(a, layer, (bf16_t*)(a->ws + OFF_R), 0, wv_); }
        GSYNC();
        { const AP a = ld_args(); unsigned char* ws = a->ws;
          PMerge p; p.K = 512; p.lda = 512; p.ldb = 512; p.G = opq(G); p.c = opq(bid); p.sample = 0; p.a0 = (const bf16_t*)(ws + OFF_R);
          p.wp = (const bf16_t*)(ws + OFF_WP); p.gl8 = ws + OFF_GL8; p.mb = (bf16_t*)(ws + OFF_MB);
          for (int rep = 0; rep < REP_MERGE; ++rep) gemm_phase(lds, p, wv_); }
        GSYNC();
        { const AP a = ld_args(); unsigned char* ws = a->ws;
          PWout p; p.K = 1024; p.lda = 1024; p.ldb = 1024; p.G = opq(G); p.c = opq(bid); p.A = (const bf16_t*)(ws + OFF_MB); p.Bt = (const bf16_t*)(ws + OFF_WOUT);
          p.T = (bf16_t*)(ws + OFF_R); p.R = (float*)(ws + OFF_R); p.part = (float*)(ws + OFF_PW);
          gemm_phase(lds, p, wv_); }
        GSYNC();
        { const AP a = ld_args(); unsigned char* ws = a->ws;
          ln_phase<false>((const bf16_t*)(ws + OFF_R), (const float*)(ws + OFF_R), (const float*)(ws + OFF_PW), layer == 0 ? a->in[I_XP] : a->out, layer == 0 ? a->in[I_XS] : a->out + (size_t)MP * 1024, (const bf16_t*)nullptr,
                          (float*)nullptr, (bf16_t*)(ws + OFF_XB), a->in[I_L1G] + layer * 1024, a->in[I_L1B] + layer * 1024, wv_); }
        GSYNC();
        { const AP a = ld_args(); unsigned char* ws = a->ws;
          PUp p; p.K = 1024; p.lda = 1024; p.ldb = 1024; p.G = opq(G); p.c = opq(bid); p.A = (const bf16_t*)(ws + OFF_XB); p.Bt = (const bf16_t*)(ws + OFF_WUP); p.h = (bf16_t*)(ws + OFF_H);
          for (int rep = 0; rep < REP_UP; ++rep) gemm_phase(lds, p, wv_); }
        GSYNC();
        { const AP a = ld_args(); unsigned char* ws = a->ws;
          PDown p; p.K = 4096; p.lda = 4096; p.ldb = 4096; p.G = opq(G); p.c = opq(bid); p.A = (const bf16_t*)(ws + OFF_H); p.Bt = (const bf16_t*)(ws + OFF_WDOWN);
          p.T = (bf16_t*)(ws + OFF_R); p.R = (float*)(ws + OFF_R); p.part = (float*)(ws + OFF_PD);
          gemm_phase(lds, p, wv_); }
        GSYNC();
        { const AP a = ld_args(); unsigned char* ws = a->ws;
          ln_phase<true>((const bf16_t*)(ws + OFF_R), (const float*)(ws + OFF_R), (const float*)(ws + OFF_PD), (const float*)nullptr, (const float*)nullptr, (const bf16_t*)(ws + OFF_XB),
                         a->out, (bf16_t*)(ws + OFF_XB), a->in[I_L2G] + layer * 1024, a->in[I_L2B] + layer * 1024, wv_); }
        if (layer == 0) { __syncthreads(); for (int rep = 0; rep < REP_PREP; ++rep) { const AP a = ld_args(); prep_layer(a, 1, (float*)lds_raw, wv_); } GSYNC(); }
    }
    if (PROBE_ON && bid == 0) { if (PROBE_B > 22) tB = __builtin_amdgcn_s_memrealtime(); const unsigned long long t0 = __builtin_amdgcn_s_memrealtime(); while (__builtin_amdgcn_s_memrealtime() - t0 < tB - tA) __builtin_amdgcn_s_sleep(8); }
}

extern "C" void kernel_launch(void* const* d_in, const int* in_sizes, int n_in, void* d_out, int out_size, void* d_ws, size_t ws_size, hipStream_t stream) {
    constexpr size_t kDynLds = STAGE_BYTES;
    static int grid_blocks = 0;
    if (!grid_blocks) {
        int dev = 0, cus = 0, per_cu = 0;
        hipGetDevice(&dev);
        hipDeviceGetAttribute(&cus, hipDeviceAttributeMultiprocessorCount, dev);
        hipFuncSetAttribute((const void*)fwd_megakernel, hipFuncAttributeMaxDynamicSharedMemorySize, (int)kDynLds);
        hipOccupancyMaxActiveBlocksPerMultiprocessor(&per_cu, (const void*)fwd_megakernel, NTHR, kDynLds);
        if (per_cu < 1) per_cu = 1;
        grid_blocks = cus * per_cu;
        if (grid_blocks > 256) grid_blocks = 256;
        if (ws_size < WS_END || n_in != 36) fprintf(stderr, "kernel_launch: unexpected ws_size %zu (need %zu) or n_in %d\n", ws_size, (size_t)WS_END, n_in);
    }
    (void)hipMemsetAsync((char*)d_ws + OFF_BAR, 0, 256, stream);
    Args a{};
    for (int i = 0; i < 36; ++i) a.in[i] = (const float*)d_in[i];
    a.out = (float*)d_out; a.ws = (unsigned char*)d_ws;
    void* args[] = {&a};
    hipError_t e = hipLaunchCooperativeKernel((const void*)fwd_megakernel, dim3(grid_blocks), dim3(NTHR), args, kDynLds, stream);
    if (e != hipSuccess) fprintf(stderr, "cooperative launch failed: %s (grid %d)\n", hipGetErrorString(e), grid_blocks);
}
```

```cpp
#include <hip/hip_runtime.h>
#include <hip/hip_cooperative_groups.h>
#include <cstdio>
namespace cg = cooperative_groups;
#define REP_GEMM 1
#define REP_G1 REP_GEMM
#define REP_GATE REP_GEMM
#define REP_Y REP_GEMM
#define REP_GLU REP_GEMM
#define REP_MERGE REP_GEMM
#define REP_UP REP_GEMM
#define REP_ELEM 1
#define REP_PREP REP_ELEM
#define REP_SG REP_ELEM
#define REP_CARRY REP_ELEM
#define REP_SAMPLE REP_ELEM
#define REP_LOCAL REP_ELEM
#define REP_LN2 REP_ELEM
#define DRY_CONV 0
#define DRY_APPLY 0
#define DRY_LN1 0
#define REP_SYNC 1
#define PROBE_ON 0
#define PROBE_A 0
#define PROBE_B 1
#define GSYNC() do { for (int _s = 0; _s < REP_SYNC; ++_s) { bar_n += (unsigned)G; gbar(bar_ctr, bar_n, wv_); } ++pidx; if (PROBE_ON) { if (pidx == PROBE_A) tA = __builtin_amdgcn_s_memrealtime(); if (pidx == PROBE_B) tB = __builtin_amdgcn_s_memrealtime(); } } while (0)

#define LAS __attribute__((address_space(3)))
typedef unsigned short bf16_t;
typedef short bf16x8 __attribute__((ext_vector_type(8)));
typedef float f32x4 __attribute__((ext_vector_type(4)));
typedef float f32x2 __attribute__((ext_vector_type(2)));
typedef unsigned u32x4 __attribute__((ext_vector_type(4)));
typedef unsigned u32x2 __attribute__((ext_vector_type(2)));

constexpr int MP = 16384, MS = 512, M = MP + MS, D = 1024, NIN = 6144, BW = 512, DFF = 4096;
constexpr int NTHR = 512;
constexpr float ALPHA = 1.41421356237f;
constexpr float LN_EPS = 1e-5f;

constexpr size_t S17 = (size_t)M * 512 * 2;
constexpr size_t OFF_WUP = 0;
constexpr size_t OFF_WDOWN = OFF_WUP + (size_t)4096 * 1024 * 2;
constexpr size_t OFF_R = OFF_WDOWN + (size_t)4096 * 1024 * 2;
constexpr size_t OFF_XB = OFF_R + 4 * S17;
constexpr size_t OFF_BIG = OFF_XB + 2 * S17;
constexpr size_t OFF_H = OFF_BIG;
constexpr size_t OFF_WIN = OFF_BIG;
constexpr size_t OFF_WP = OFF_WIN + (size_t)6144 * 1024 * 2;
constexpr size_t OFF_WGLU = OFF_WP + (size_t)3 * 1024 * 512 * 2;
constexpr size_t OFF_WOUT = OFF_WGLU + (size_t)512 * 512 * 2;
constexpr size_t OFF_WGATE = OFF_WOUT + (size_t)1024 * 1024 * 2;
constexpr size_t OFF_W1T = OFF_WGATE + (size_t)1024 * 512 * 2;
constexpr size_t OFF_WYT = OFF_W1T + (size_t)32 * 128 * 256 * 2;
constexpr size_t OFF_GL8 = OFF_WYT + (size_t)32 * 256 * 384 * 2;
constexpr size_t OFF_YA = OFF_GL8 + (size_t)M * 3072;
constexpr size_t OFF_APACK = OFF_YA + S17;
constexpr size_t OFF_S = OFF_APACK + (size_t)32 * 1024 * 384 * 2;
constexpr size_t OFF_MB = OFF_APACK;
constexpr size_t OFF_USS = OFF_S + (size_t)32 * 1024 * 128 * 4;
constexpr size_t OFF_CAR = OFF_USS + (size_t)512 * 512 * 2;
constexpr size_t OFF_BAR = OFF_CAR + (size_t)8 * 32 * 512 * 8;
constexpr size_t OFF_PD = OFF_BAR + 256;
constexpr size_t OFF_PW = OFF_GL8;
constexpr size_t PART_STRIDE = (size_t)MS * 1024;
constexpr size_t OFF_ZCS = OFF_PD + 3 * PART_STRIDE * 4;
constexpr size_t WS_END = OFF_ZCS + (size_t)MS * 512 * 2;
static_assert(OFF_PD >= OFF_H + (size_t)M * 4096 * 2, "down partials must not overlap h");
static_assert(WS_END <= (size_t)268435456, "workspace map exceeds 256 MiB");
static_assert(OFF_MB + (size_t)M * 1024 * 2 <= OFF_USS, "m overlay");
static_assert(OFF_H + (size_t)M * 4096 * 2 <= (size_t)268435456, "h overlay");

constexpr size_t O_Y = 0;
constexpr size_t O_LCP = (size_t)M * 1024;
constexpr size_t O_LHP = O_LCP + 2 * 8 * 3 * 512;
constexpr size_t O_SCP = O_LHP + 2 * 8 * 512;
constexpr size_t O_SRP = O_SCP + 2 * 8 * 2 * 512;
constexpr size_t O_SIP = O_SRP + 2 * 8 * 2048;
constexpr size_t O_LCS = O_SIP + 2 * 8 * 2048;
constexpr size_t O_LHS = O_LCS + 2 * 128 * 3 * 512;
constexpr size_t O_SCS = O_LHS + 2 * 128 * 512;
constexpr size_t O_SRS = O_SCS + 2 * 128 * 2 * 512;
constexpr size_t O_SIS = O_SRS + 2 * 128 * 2048;

struct Args { const float* in[36]; float* out; unsigned char* ws; };
typedef const __attribute__((address_space(4))) Args* AP;
__device__ __forceinline__ AP ld_args() {
#if defined(__HIP_DEVICE_COMPILE__)
    auto p = __builtin_amdgcn_kernarg_segment_ptr();
    asm volatile("" : "+s"(p));
    return (AP)p;
#else
    return nullptr;
#endif
}
enum { I_XP = 0, I_XS, I_SLC, I_SLH, I_SSC, I_SSR, I_SSI, I_WIN, I_CAW, I_CAB, I_GXW, I_GXB, I_GAW, I_GAB, I_LAM, I_CBW, I_SAR, I_SAI, I_SDT,
       I_SBR, I_SBI, I_SCR, I_SCI, I_SD, I_GLW, I_GLB, I_PA, I_PB, I_PC, I_WO, I_L1G, I_L1B, I_UP, I_DN, I_L2G, I_L2B };

__device__ __forceinline__ unsigned cvt_pk_bf16(float lo, float hi) { unsigned r; asm volatile("v_cvt_pk_bf16_f32 %0, %1, %2" : "=v"(r) : "v"(lo), "v"(hi)); return r; }
__device__ __forceinline__ bf16_t f2bf(float f) { return (bf16_t)(cvt_pk_bf16(f, 0.f) & 0xffffu); }
__device__ __forceinline__ float bf2f(unsigned short b) { return __uint_as_float(((unsigned)b) << 16); }
__device__ __forceinline__ float bflo(unsigned w) { return __uint_as_float(w << 16); }
__device__ __forceinline__ float bfhi(unsigned w) { return __uint_as_float(w & 0xffff0000u); }
__device__ __forceinline__ float sigm(float x) { return 1.0f / (1.0f + __expf(-x)); }
__device__ __forceinline__ float gelu_t(float x) { const float u = 0.7978845608f * (x + 0.044715f * x * x * x); return x / (1.0f + __expf(-2.0f * u)); }
__device__ __forceinline__ u32x4 pack8(const f32x4 a, const f32x4 b) { u32x4 w; w.x = cvt_pk_bf16(a[0], a[1]); w.y = cvt_pk_bf16(a[2], a[3]); w.z = cvt_pk_bf16(b[0], b[1]); w.w = cvt_pk_bf16(b[2], b[3]); return w; }
__device__ __forceinline__ void unpack8(const u32x4 w, float (&f)[8]) { f[0] = bflo(w.x); f[1] = bfhi(w.x); f[2] = bflo(w.y); f[3] = bfhi(w.y); f[4] = bflo(w.z); f[5] = bfhi(w.z); f[6] = bflo(w.w); f[7] = bfhi(w.w); }

__device__ __forceinline__ int otid(const int wv_) { int t = wv_ * 64 + (int)__builtin_amdgcn_mbcnt_hi(~0u, __builtin_amdgcn_mbcnt_lo(~0u, 0u)); asm volatile("" : "+v"(t)); return t; }

__device__ __forceinline__ int opq(int x) { asm volatile("" : "+s"(x)); return x; }

__device__ __forceinline__ void gbar(unsigned* ctr, unsigned target, const int wv_) {
    asm volatile("s_waitcnt vmcnt(0)" ::: "memory");
    __syncthreads();
    if (otid(wv_) == 0) {
        __builtin_amdgcn_fence(__ATOMIC_RELEASE, "agent");
        asm volatile("s_waitcnt vmcnt(0)" ::: "memory");
        __hip_atomic_fetch_add(ctr, 1u, __ATOMIC_RELAXED, __HIP_MEMORY_SCOPE_AGENT);
        while (__hip_atomic_load(ctr, __ATOMIC_RELAXED, __HIP_MEMORY_SCOPE_AGENT) < target) __builtin_amdgcn_s_sleep(1);
        __builtin_amdgcn_fence(__ATOMIC_ACQUIRE, "agent");
        asm volatile("s_waitcnt vmcnt(0)" ::: "memory");
    }
    __syncthreads();
}

constexpr int BM = 256, BK = 64, HALF = 128, HTB = HALF * BK * 2, STAGE_BYTES = 8 * HTB;
__device__ __forceinline__ int lds_byte(int r, int c) { const int st = (r >> 4) * 2 + (c >> 5), rr = r & 15, cc = c & 31, ob = rr * 64 + cc * 2; return st * 1024 + (ob ^ (((ob >> 9) & 1) << 5)); }
__device__ __forceinline__ void stage_rc(int b, int& R, int& C) { const int st = b / 1024, sb = b % 1024, swz = sb ^ (((sb >> 9) & 1) << 5); R = (st >> 1) * 16 + swz / 64; C = (st & 1) * 32 + (swz % 64) / 2; }
__device__ __forceinline__ int perm32(int rho) { const int n = rho >> 4, i = rho & 15; return 8 * (i >> 2) + 4 * n + (i & 3); }
struct Unit { int pm, pn, z; };
__device__ __forceinline__ void tile_map(int L, int nM, int nN, int& pm, int& pn) {
    const int nwg = nM * nN; int wgid = L;
    { const int q = nwg / 8, r = nwg % 8, xcd = wgid % 8, off = wgid / 8; wgid = (xcd < r ? xcd * (q + 1) : r * (q + 1) + (xcd - r) * q) + off; }
    const int nig = 8 * nN, gid = wgid / nig, fm = gid * 8, gsz = (nM - fm) < 8 ? (nM - fm) : 8;
    pm = fm + ((wgid % nig) % gsz); pn = (wgid % nig) / gsz;
}

template <class P>
__device__ __forceinline__ void gemm_phase(LAS unsigned char* lds, const P& p, const int wv_) {
    const int tid = otid(wv_), wid = __builtin_amdgcn_readfirstlane(tid >> 6), lane = tid & 63, wr = wid >> 2, wc = wid & 3, fr = lane & 15, fq = lane >> 4;
    unsigned voffA[2], voffB[2];
#pragma unroll
    for (int i = 0; i < 2; ++i) { int R, C; stage_rc(tid * 16 + i * 8192, R, C); const int Rb = P::PERM ? ((R & ~31) + perm32(R & 31)) : R;
        voffA[i] = (unsigned)(R * p.lda + C) * 2u; voffB[i] = (unsigned)(Rb * p.ldb + C) * 2u; }
    const size_t kstep = (size_t)(BK * 2);
    const size_t hA = (size_t)HALF * p.lda * 2, hB = (size_t)HALF * p.ldb * 2;
    const unsigned ldsw = (unsigned)wid * 1024u;
    const int aoff = lds_byte(wr * 64 + fr, fq * 8), boff = lds_byte(wc * 32 + fr, fq * 8);
#define PG8_SA(b, h) (((b) * 2 + (h)) * HTB)
#define PG8_SB(b, h) ((4 + (b) * 2 + (h)) * HTB)
#define PG8_STAGE(bufoff, gbase, voff) do { _Pragma("unroll") for (int _i = 0; _i < 2; ++_i) \
        __builtin_amdgcn_global_load_lds((const unsigned*)((const char*)(gbase) + (voff)[_i]), (LAS unsigned*)(lds + (bufoff) + ldsw + _i * 8192), 16, 0, 0); } while (0)
#define PG8_LDA(dst, b, h) do { _Pragma("unroll") for (int m = 0; m < 4; ++m) _Pragma("unroll") for (int k = 0; k < 2; ++k) dst[m][k] = *(const LAS bf16x8*)(lds + PG8_SA(b, h) + aoff + m * 2048 + k * 1024); } while (0)
#define PG8_LDB(dst, b, h) do { _Pragma("unroll") for (int n = 0; n < 2; ++n) _Pragma("unroll") for (int k = 0; k < 2; ++k) dst[n][k] = *(const LAS bf16x8*)(lds + PG8_SB(b, h) + boff + n * 2048 + k * 1024); } while (0)
#define PG8_MMA(ai, bj, At, Bt) do { __builtin_amdgcn_s_setprio(1); _Pragma("unroll") for (int m = 0; m < 4; ++m) _Pragma("unroll") for (int n = 0; n < 2; ++n) _Pragma("unroll") for (int k = 0; k < 2; ++k) \
        acc[ai][bj][m][n] = __builtin_amdgcn_mfma_f32_16x16x32_bf16(Bt[n][k], At[m][k], acc[ai][bj][m][n], 0, 0, 0); __builtin_amdgcn_s_setprio(0); } while (0)
#define PG8_WAIT_V(n) asm volatile("s_waitcnt vmcnt(" #n ")" ::: "memory")
#define PG8_WAIT_L(n) asm volatile("s_waitcnt lgkmcnt(" #n ")" ::: "memory")
#define PG8_BAR __builtin_amdgcn_s_barrier()
#define PG8_SCHED __builtin_amdgcn_sched_barrier(0)
    Unit cur, nxt; int ui = 0;
    if (!p.next(0, cur)) return;
    f32x4 acc[2][2][4][2];
#pragma unroll
    for (int a = 0; a < 2; ++a)
#pragma unroll
        for (int b = 0; b < 2; ++b)
#pragma unroll
            for (int m = 0; m < 4; ++m)
#pragma unroll
                for (int n = 0; n < 2; ++n) acc[a][b][m][n] = (f32x4){0.f, 0.f, 0.f, 0.f};
    bf16x8 At[4][2], B0[2][2], B1[2][2];
    const char* cA = p.aptr(cur); const char* cB = p.bptr(cur);
    PG8_STAGE(PG8_SB(0, 0), cB, voffB); PG8_STAGE(PG8_SA(0, 0), cA, voffA); PG8_STAGE(PG8_SB(0, 1), cB + hB, voffB); PG8_STAGE(PG8_SA(0, 1), cA + hA, voffA);
    if (wr == 1) PG8_BAR;
    PG8_WAIT_V(4); PG8_BAR;
    PG8_STAGE(PG8_SB(1, 0), cB + kstep, voffB); PG8_STAGE(PG8_SA(1, 0), cA + kstep, voffA); PG8_STAGE(PG8_SB(1, 1), cB + hB + kstep, voffB);
    PG8_WAIT_V(6); PG8_BAR;
    for (;;) {
        const bool has_next = p.next(ui + 1, nxt);
        const int nt = p.nt(cur);
        const char* nA = has_next ? p.aptr(nxt) : cA; const char* nB = has_next ? p.bptr(nxt) : cB;
        for (int t = 0; t < nt; t += 2) {
            const bool last = (t == nt - 2);
            const char* a1 = cA + (size_t)(t + 1) * kstep;
            const char* a2 = last ? nA : cA + (size_t)(t + 2) * kstep; const char* b2 = last ? nB : cB + (size_t)(t + 2) * kstep;
            const char* a3 = a2 + kstep; const char* b3 = b2 + kstep;
            PG8_LDB(B0, 0, 0); PG8_SCHED; PG8_LDA(At, 0, 0); PG8_STAGE(PG8_SA(1, 1), a1 + hA, voffA);
            PG8_WAIT_L(8); PG8_BAR; PG8_WAIT_L(0); PG8_MMA(0, 0, At, B0); PG8_BAR; PG8_SCHED;
            PG8_LDB(B1, 0, 1); PG8_STAGE(PG8_SB(0, 0), b2, voffB);
            PG8_BAR; PG8_WAIT_L(0); PG8_MMA(0, 1, At, B1); PG8_BAR;
            PG8_LDA(At, 0, 1); PG8_STAGE(PG8_SA(0, 0), a2, voffA);
            PG8_BAR; PG8_WAIT_L(0); PG8_MMA(1, 0, At, B0); PG8_BAR; PG8_SCHED;
            PG8_STAGE(PG8_SB(0, 1), b2 + hB, voffB);
            PG8_WAIT_V(6); PG8_BAR; PG8_MMA(1, 1, At, B1); PG8_BAR;
            PG8_LDB(B0, 1, 0); PG8_SCHED; PG8_LDA(At, 1, 0); PG8_STAGE(PG8_SA(0, 1), a2 + hA, voffA);
            PG8_WAIT_L(8); PG8_BAR; PG8_WAIT_L(0); PG8_MMA(0, 0, At, B0); PG8_BAR; PG8_SCHED;
            PG8_LDB(B1, 1, 1); PG8_STAGE(PG8_SB(1, 0), b3, voffB);
            PG8_BAR; PG8_WAIT_L(0); PG8_MMA(0, 1, At, B1); PG8_BAR;
            PG8_LDA(At, 1, 1); PG8_STAGE(PG8_SA(1, 0), a3, voffA);
            PG8_BAR; PG8_WAIT_L(0); PG8_MMA(1, 0, At, B0); PG8_BAR; PG8_SCHED;
            PG8_STAGE(PG8_SB(1, 1), b3 + hB, voffB);
            PG8_WAIT_V(6); PG8_BAR; PG8_MMA(1, 1, At, B1); PG8_BAR;
        }
        Unit eu = cur;
        asm volatile("" : "+s"(eu.pm), "+s"(eu.pn), "+s"(eu.z));
        const bool rst = p.epi(acc, eu, wr, wc, fr, fq);
        if (!has_next) break;
        if (rst) {
#pragma unroll
            for (int a = 0; a < 2; ++a)
#pragma unroll
                for (int b = 0; b < 2; ++b)
#pragma unroll
                    for (int m = 0; m < 4; ++m)
#pragma unroll
                        for (int n = 0; n < 2; ++n) acc[a][b][m][n] = (f32x4){0.f, 0.f, 0.f, 0.f};
        }
        cur = nxt; cA = nA; cB = nB; ++ui;
    }
    PG8_WAIT_V(0);
    if (wr == 0) PG8_BAR;
    PG8_BAR;
#undef PG8_SA
#undef PG8_SB
#undef PG8_STAGE
#undef PG8_LDA
#undef PG8_LDB
#undef PG8_MMA
#undef PG8_WAIT_V
#undef PG8_WAIT_L
#undef PG8_BAR
#undef PG8_SCHED
}
typedef f32x4 Acc[2][2][4][2];

struct PG1 {
    __device__ __forceinline__ int nt(const Unit&) const { return K / BK; }
    static constexpr bool PERM = true;
    int K, lda, ldb, G, c;
    const bf16_t* A; const bf16_t* Bt;
    bf16_t *xa, *ya, *sb, *sc, *sh, *apack, *uss; unsigned char* gl8;
    __device__ __forceinline__ bool next(int i, Unit& u) const { const long L = (long)i * G + c; if (L >= 66 * 24) return false; tile_map((int)L, 66, 24, u.pm, u.pn); u.z = 0; return true; }
    __device__ __forceinline__ const char* aptr(const Unit& u) const { return (const char*)A + (size_t)u.pm * 256 * 1024 * 2; }
    __device__ __forceinline__ const char* bptr(const Unit& u) const { return (const char*)Bt + (size_t)u.pn * 256 * 1024 * 2; }
    __device__ __forceinline__ bool epi(Acc& acc, const Unit& u, int wr, int wc, int fr, int fq) const {
        const int pn = u.pn;
        if (pn < 10) {
            const int b = pn >> 1; bf16_t* base = b == 0 ? xa : b == 1 ? ya : b == 2 ? sb : b == 3 ? sc : sh;
#pragma unroll
            for (int ai = 0; ai < 2; ++ai)
#pragma unroll
                for (int m = 0; m < 4; ++m) { const size_t r = (size_t)u.pm * 256 + ai * 128 + wr * 64 + m * 16 + fr;
#pragma unroll
                    for (int bj = 0; bj < 2; ++bj) { const int col = (pn & 1) * 256 + bj * 128 + wc * 32 + 8 * fq;
                        *(u32x4*)(base + r * 512 + col) = pack8(acc[ai][bj][m][0], acc[ai][bj][m][1]); } }
        } else if (pn < 12) {
#pragma unroll
            for (int ai = 0; ai < 2; ++ai)
#pragma unroll
                for (int m = 0; m < 4; ++m) { const int r = u.pm * 256 + ai * 128 + wr * 64 + m * 16 + fr;
#pragma unroll
                    for (int bj = 0; bj < 2; ++bj) { const int cc = (pn - 10) * 256 + bj * 128 + wc * 32 + 8 * fq;
                        bf16_t* dst = (u.pm < 64) ? apack + ((size_t)((cc >> 4) * 1024 + (r >> 4)) * 384 + 128 + (r & 15) * 16 + (cc & 15)) : uss + (size_t)(r - MP) * 512 + cc;
                        *(u32x4*)dst = pack8(acc[ai][bj][m][0], acc[ai][bj][m][1]); } }
        } else {
            unsigned char* blk = gl8 + ((size_t)(u.pm * 12 + (pn - 12)) << 16) + (size_t)(((wr * 4 + wc) * 64 + fq * 16 + fr) * 128);
#pragma unroll
            for (int ai = 0; ai < 2; ++ai)
#pragma unroll
                for (int m = 0; m < 4; ++m) { u32x4 w;
#pragma unroll
                    for (int bj = 0; bj < 2; ++bj)
#pragma unroll
                        for (int n = 0; n < 2; ++n) { unsigned pk = 0;
#pragma unroll
                            for (int j = 0; j < 4; ++j) { int v = (int)(sigm(acc[ai][bj][m][n][j]) * 256.0f); v = v < 0 ? 0 : (v > 255 ? 255 : v); pk |= (unsigned)v << (8 * j); }
                            w[bj * 2 + n] = pk; }
                    *(u32x4*)(blk + (ai * 4 + m) * 16) = w; }
        }
        return true;
    }
};

struct PGate {
    __device__ __forceinline__ int nt(const Unit&) const { return K / BK; }
    static constexpr bool PERM = true;
    int K, lda, ldb, G, c;
    const bf16_t* A; const bf16_t* Bt;
    const float *gxb, *gab, *lam; _Float16* aout; bf16_t* bxout;
    __device__ __forceinline__ bool next(int i, Unit& u) const { const long L = (long)i * G + c; if (L >= 66 * 4) return false; tile_map((int)L, 66, 4, u.pm, u.pn); u.z = 0; return true; }
    __device__ __forceinline__ const char* aptr(const Unit& u) const { return (const char*)A + (size_t)u.pm * 256 * 512 * 2 + (size_t)(u.pn >> 1) * 512; }
    __device__ __forceinline__ const char* bptr(const Unit& u) const { return (const char*)Bt + (size_t)u.pn * 256 * 256 * 2; }
    __device__ __forceinline__ bool epi(Acc& acc, const Unit& u, int wr, int wc, int fr, int fq) const {
        typedef _Float16 h8 __attribute__((ext_vector_type(8)));
        const int ch0 = u.pn * 128 + wc * 32 + 8 * fq;
        float bxv[8], bav[8], kk[8];
#pragma unroll
        for (int j = 0; j < 8; ++j) { bxv[j] = gxb[ch0 + j]; bav[j] = gab[ch0 + j]; kk[j] = -8.0f * log1pf(expf(-lam[ch0 + j])); }
#pragma unroll
        for (int ai = 0; ai < 2; ++ai)
#pragma unroll
            for (int m = 0; m < 4; ++m) { const size_t r = (size_t)u.pm * 256 + ai * 128 + wr * 64 + m * 16 + fr;
                float xc[8]; unpack8(*(const u32x4*)(A + r * 512 + ch0), xc);
                h8 lav; f32x4 b0, b1;
#pragma unroll
                for (int j = 0; j < 8; ++j) { const float px = acc[ai][0][m][j >> 2][j & 3], pa = acc[ai][1][m][j >> 2][j & 3];
                    const float gx = sigm(px + bxv[j]), ga = sigm(pa + bav[j]);
                    const float la = kk[j] * ga, av = __expf(la); lav[j] = (_Float16)la;
                    const float bv = __builtin_amdgcn_sqrtf(fmaxf(1.0f - av * av, 0.f)) * gx * xc[j];
                    if (j < 4) b0[j] = bv; else b1[j - 4] = bv; }
                *(h8*)(aout + r * 512 + ch0) = lav;
                *(u32x4*)(bxout + r * 512 + ch0) = pack8(b0, b1); }
        return true;
    }
};

struct PY {
    __device__ __forceinline__ int nt(const Unit&) const { return K / BK; }
    static constexpr bool PERM = true;
    int K, lda, ldb, G, c;
    const bf16_t* apack; const bf16_t* wyt; const float* dvec; bf16_t* zc;
    __device__ __forceinline__ bool next(int i, Unit& u) const { const long L = (long)i * G + c; if (L >= 128) return false; u.pm = (int)L; u.pn = (int)L >> 2; u.z = 0; return true; }
    __device__ __forceinline__ const char* aptr(const Unit& u) const { return (const char*)apack + (size_t)u.pm * 256 * 384 * 2; }
    __device__ __forceinline__ const char* bptr(const Unit& u) const { return (const char*)wyt + (size_t)u.pn * 256 * 384 * 2; }
    __device__ __forceinline__ bool epi(Acc& acc, const Unit& u, int wr, int wc, int fr, int fq) const {
        const int g = u.pn;
#pragma unroll
        for (int bj = 0; bj < 2; ++bj) {
            const int n0 = bj * 128 + wc * 32 + 8 * fq, ti = n0 >> 4, c0 = n0 & 15;
            const f32x4 d0 = *(const f32x4*)(dvec + g * 16 + c0), d1 = *(const f32x4*)(dvec + g * 16 + c0 + 4);
#pragma unroll
            for (int ai = 0; ai < 2; ++ai)
#pragma unroll
                for (int m = 0; m < 4; ++m) { const int rr = (u.pm & 3) * 256 + ai * 128 + wr * 64 + m * 16 + fr;
                    const u32x4 uw = *(const u32x4*)(apack + ((size_t)(g * 1024 + rr) * 384 + 128 + n0));
                    float uf[8]; unpack8(uw, uf);
                    f32x4 y0, y1;
#pragma unroll
                    for (int j = 0; j < 4; ++j) { y0[j] = gelu_t(acc[ai][bj][m][0][j] + d0[j] * uf[j]); y1[j] = gelu_t(acc[ai][bj][m][1][j] + d1[j] * uf[4 + j]); }
                    const size_t tok = (size_t)(rr >> 7) * 2048 + (rr & 127) * 16 + ti;
                    *(u32x4*)(zc + tok * 512 + g * 16 + c0) = pack8(y0, y1); }
        }
        return true;
    }
};

struct PGlu {
    __device__ __forceinline__ int nt(const Unit&) const { return K / BK; }
    static constexpr bool PERM = true;
    int K, lda, ldb, G, c, sample;
    const bf16_t* A; const bf16_t* As; const bf16_t* Bt; const float* bias; bf16_t* out;
    __device__ __forceinline__ bool next(int i, Unit& u) const {
        if (sample) { const int j = c - 128; if (i != 0 || j < 0 || j >= 4) return false; u.pm = 64 + (j >> 1); u.pn = j & 1; u.z = 0; return true; }
        const long L = (long)i * G + c; if (L >= 64 * 2) return false; tile_map((int)L, 64, 2, u.pm, u.pn); u.z = 0; return true; }
    __device__ __forceinline__ const bf16_t* arow0(const Unit& u) const { return u.pm < 64 ? A + (size_t)u.pm * 256 * 512 : As + (size_t)(u.pm - 64) * 256 * 512; }
    __device__ __forceinline__ const char* aptr(const Unit& u) const { return (const char*)arow0(u); }
    __device__ __forceinline__ const char* bptr(const Unit& u) const { return (const char*)Bt + (size_t)u.pn * 256 * 512 * 2; }
    __device__ __forceinline__ bool epi(Acc& acc, const Unit& u, int wr, int wc, int fr, int fq) const {
        const bf16_t* zsrc = arow0(u);
#pragma unroll
        for (int bj = 0; bj < 2; ++bj) {
            const int col = u.pn * 256 + bj * 128 + wc * 32 + 8 * fq;
            const f32x4 b0 = *(const f32x4*)(bias + col), b1 = *(const f32x4*)(bias + col + 4);
#pragma unroll
            for (int ai = 0; ai < 2; ++ai)
#pragma unroll
                for (int m = 0; m < 4; ++m) { const int rl = ai * 128 + wr * 64 + m * 16 + fr; const size_t r = (size_t)u.pm * 256 + rl;
                    const u32x4 zw = *(const u32x4*)(zsrc + (size_t)rl * 512 + col); float zf[8]; unpack8(zw, zf);
                    f32x4 y0, y1;
#pragma unroll
                    for (int j = 0; j < 4; ++j) { y0[j] = zf[j] * sigm(acc[ai][bj][m][0][j] + b0[j]); y1[j] = zf[4 + j] * sigm(acc[ai][bj][m][1][j] + b1[j]); }
                    *(u32x4*)(out + r * 512 + col) = pack8(y0, y1); }
        }
        return true;
    }
};

struct PMerge {
    __device__ __forceinline__ int nt(const Unit&) const { return K / BK; }
    static constexpr bool PERM = true;
    int K, lda, ldb, G, c, sample;
    const bf16_t* a0; const bf16_t* wp; const unsigned char* gl8; bf16_t* mb;
    __device__ __forceinline__ bool next(int i, Unit& u) const { const int ti = i / 3;
        if (sample) { const int j = c - (G - 8); if (ti != 0 || j < 0) return false; u.pm = 64 + (j >> 2); u.pn = j & 3; u.z = i; return true; }
        const long L = (long)ti * G + c; if (L >= 64 * 4) return false; tile_map((int)L, 64, 4, u.pm, u.pn); u.z = i - ti * 3; return true; }
    __device__ __forceinline__ const char* aptr(const Unit& u) const { const size_t off = (u.z == 2) ? (OFF_XB + S17 - OFF_R) : (size_t)u.z * S17; return (const char*)a0 + off + (size_t)u.pm * 256 * 512 * 2; }
    __device__ __forceinline__ const char* bptr(const Unit& u) const { return (const char*)wp + ((size_t)u.z * 1024 + (size_t)u.pn * 256) * 512 * 2; }
    __device__ __forceinline__ bool epi(Acc& acc, const Unit& u, int wr, int wc, int fr, int fq) const {
        const int br = u.z;
        const unsigned char* blk = gl8 + ((size_t)(u.pm * 12 + br * 4 + u.pn) << 16) + (size_t)(((wr * 4 + wc) * 64 + fq * 16 + fr) * 128);
#pragma unroll
        for (int ai = 0; ai < 2; ++ai)
#pragma unroll
            for (int m = 0; m < 4; ++m) { const size_t r = (size_t)u.pm * 256 + ai * 128 + wr * 64 + m * 16 + fr;
                const u32x4 qc = *(const u32x4*)(blk + (ai * 4 + m) * 16);
                if (br < 2) {
                    const u32x4 qn = *(const u32x4*)(blk + 4 * 65536 + (ai * 4 + m) * 16);
#pragma unroll
                    for (int bj = 0; bj < 2; ++bj)
#pragma unroll
                        for (int n = 0; n < 2; ++n)
#pragma unroll
                            for (int j = 0; j < 4; ++j) { const float gc = (float)((qc[bj * 2 + n] >> (8 * j)) & 255u) + 0.5f, gn = (float)((qn[bj * 2 + n] >> (8 * j)) & 255u) + 0.5f;
                                acc[ai][bj][m][n][j] *= gc * __builtin_amdgcn_rcpf(gn); }
                } else {
#pragma unroll
                    for (int bj = 0; bj < 2; ++bj) { const int col = u.pn * 256 + bj * 128 + wc * 32 + 8 * fq;
                        f32x4 y0, y1;
#pragma unroll
                        for (int j = 0; j < 4; ++j) {
                            y0[j] = acc[ai][bj][m][0][j] * (((float)((qc[bj * 2] >> (8 * j)) & 255u) + 0.5f) * (1.0f / 256.0f));
                            y1[j] = acc[ai][bj][m][1][j] * (((float)((qc[bj * 2 + 1] >> (8 * j)) & 255u) + 0.5f) * (1.0f / 256.0f)); }
                        *(u32x4*)(mb + r * 1024 + col) = pack8(y0, y1); }
                } }
        return br == 2;
    }
};

struct PWout {
    static constexpr bool PERM = true;
    int K, lda, ldb, G, c;
    const bf16_t* A; const bf16_t* Bt; bf16_t* T; float* R; float* part;
    __device__ __forceinline__ int nt(const Unit& u) const { return u.z < 0 ? 16 : 4; }
    __device__ __forceinline__ bool next(int i, Unit& u) const {
        const int nP = c < 256 ? (256 - c + G - 1) / G : 0;
        if (i < nP) { tile_map(i * G + c, 64, 4, u.pm, u.pn); u.z = -1; return true; }
        const int j = (i - nP) * G + c; if (j >= 32) return false;
        u.pm = 64 + (j >> 4); u.pn = (j >> 2) & 3; u.z = j & 3; return true; }
    __device__ __forceinline__ const char* aptr(const Unit& u) const { return (const char*)A + (size_t)u.pm * 256 * 1024 * 2 + (u.z < 0 ? 0 : u.z * 512); }
    __device__ __forceinline__ const char* bptr(const Unit& u) const { return (const char*)Bt + (size_t)u.pn * 256 * 1024 * 2 + (u.z < 0 ? 0 : u.z * 512); }
    __device__ __forceinline__ bool epi(Acc& acc, const Unit& u, int wr, int wc, int fr, int fq) const {
#pragma unroll
        for (int ai = 0; ai < 2; ++ai)
#pragma unroll
            for (int m = 0; m < 4; ++m) { const size_t r = (size_t)u.pm * 256 + ai * 128 + wr * 64 + m * 16 + fr;
#pragma unroll
                for (int bj = 0; bj < 2; ++bj) { const int col = u.pn * 256 + bj * 128 + wc * 32 + 8 * fq;
                    if (u.z < 0) *(u32x4*)(T + r * 1024 + col) = pack8(acc[ai][bj][m][0], acc[ai][bj][m][1]);
                    else { float* pp = (u.z == 0) ? R + r * 1024 + col : part + (size_t)(u.z - 1) * PART_STRIDE + (r - MP) * 1024 + col;
                        *(f32x4*)pp = acc[ai][bj][m][0]; *(f32x4*)(pp + 4) = acc[ai][bj][m][1]; } } }
        return true;
    }
};

struct PUp {
    __device__ __forceinline__ int nt(const Unit&) const { return K / BK; }
    static constexpr bool PERM = true;
    int K, lda, ldb, G, c;
    const bf16_t* A; const bf16_t* Bt; bf16_t* h;
    __device__ __forceinline__ bool next(int i, Unit& u) const { const long L = (long)i * G + c; if (L >= 66 * 16) return false; tile_map((int)L, 66, 16, u.pm, u.pn); u.z = 0; return true; }
    __device__ __forceinline__ const char* aptr(const Unit& u) const { return (const char*)A + (size_t)u.pm * 256 * 1024 * 2; }
    __device__ __forceinline__ const char* bptr(const Unit& u) const { return (const char*)Bt + (size_t)u.pn * 256 * 1024 * 2; }
    __device__ __forceinline__ bool epi(Acc& acc, const Unit& u, int wr, int wc, int fr, int fq) const {
#pragma unroll
        for (int ai = 0; ai < 2; ++ai)
#pragma unroll
            for (int m = 0; m < 4; ++m) { const size_t r = (size_t)u.pm * 256 + ai * 128 + wr * 64 + m * 16 + fr;
#pragma unroll
                for (int bj = 0; bj < 2; ++bj) { const int col = u.pn * 256 + bj * 128 + wc * 32 + 8 * fq;
                    f32x4 y0, y1;
#pragma unroll
                    for (int j = 0; j < 4; ++j) { const float v0 = fmaxf(acc[ai][bj][m][0][j], 0.f), v1 = fmaxf(acc[ai][bj][m][1][j], 0.f); y0[j] = v0 * v0; y1[j] = v1 * v1; }
                    *(u32x4*)(h + r * 4096 + col) = pack8(y0, y1); } }
        return true;
    }
};

struct PDown {
    static constexpr bool PERM = true;
    int K, lda, ldb, G, c;
    const bf16_t* A; const bf16_t* Bt; bf16_t* T; float* R; float* part;
    __device__ __forceinline__ int nt(const Unit& u) const { return u.z < 0 ? 64 : 16; }
    __device__ __forceinline__ bool next(int i, Unit& u) const {
        const int nP = c < 256 ? (256 - c + G - 1) / G : 0;
        if (i < nP) { tile_map(i * G + c, 64, 4, u.pm, u.pn); u.z = -1; return true; }
        const int j = (i - nP) * G + c; if (j >= 32) return false;
        u.pm = 64 + (j >> 4); u.pn = (j >> 2) & 3; u.z = j & 3; return true; }
    __device__ __forceinline__ const char* aptr(const Unit& u) const { return (const char*)A + (size_t)u.pm * 256 * 4096 * 2 + (u.z < 0 ? 0 : u.z * 2048); }
    __device__ __forceinline__ const char* bptr(const Unit& u) const { return (const char*)Bt + (size_t)u.pn * 256 * 4096 * 2 + (u.z < 0 ? 0 : u.z * 2048); }
    __device__ __forceinline__ bool epi(Acc& acc, const Unit& u, int wr, int wc, int fr, int fq) const {
#pragma unroll
        for (int ai = 0; ai < 2; ++ai)
#pragma unroll
            for (int m = 0; m < 4; ++m) { const size_t r = (size_t)u.pm * 256 + ai * 128 + wr * 64 + m * 16 + fr;
#pragma unroll
                for (int bj = 0; bj < 2; ++bj) { const int col = u.pn * 256 + bj * 128 + wc * 32 + 8 * fq;
                    if (u.z < 0) *(u32x4*)(T + r * 1024 + col) = pack8(acc[ai][bj][m][0], acc[ai][bj][m][1]);
                    else { float* pp = (u.z == 0) ? R + r * 1024 + col : part + (size_t)(u.z - 1) * PART_STRIDE + (r - MP) * 1024 + col;
                        *(f32x4*)pp = acc[ai][bj][m][0]; *(f32x4*)(pp + 4) = acc[ai][bj][m][1]; } } }
        return true;
    }
};

struct TJob { const float* W; bf16_t* Wt; int K, N, tk, tn4; };
__device__ __forceinline__ TJob tjob(AP a, int layer, int t) {
    unsigned char* ws = a->ws; TJob j; int tt;
    if (t < 384) { tt = t; j.W = a->in[I_WIN] + (size_t)layer * 1024 * 6144; j.Wt = (bf16_t*)(ws + OFF_WIN); j.K = 1024; j.N = 6144; }
    else if (t < 480) { const int q = (t - 384) / 32; tt = (t - 384) % 32; j.W = a->in[I_PA + q] + (size_t)layer * 512 * 1024; j.Wt = (bf16_t*)(ws + OFF_WP) + (size_t)q * 1024 * 512; j.K = 512; j.N = 1024; }
    else if (t < 496) { tt = t - 480; j.W = a->in[I_GLW] + (size_t)layer * 512 * 512; j.Wt = (bf16_t*)(ws + OFF_WGLU); j.K = 512; j.N = 512; }
    else if (t < 560) { tt = t - 496; j.W = a->in[I_WO] + (size_t)layer * 1024 * 1024; j.Wt = (bf16_t*)(ws + OFF_WOUT); j.K = 1024; j.N = 1024; }
    else if (t < 816) { tt = t - 560; j.W = a->in[I_UP] + (size_t)layer * 1024 * 4096; j.Wt = (bf16_t*)(ws + OFF_WUP); j.K = 1024; j.N = 4096; }
    else { tt = t - 816; j.W = a->in[I_DN] + (size_t)layer * 4096 * 1024; j.Wt = (bf16_t*)(ws + OFF_WDOWN); j.K = 4096; j.N = 1024; }
    const int ntn = j.N / 256; j.tk = tt / ntn; j.tn4 = tt % ntn; return j;
}
__device__ __forceinline__ void tload(const TJob& j, int tid, f32x4 (&v)[4][2]) {
    const int r = tid >> 3, c8 = (tid & 7) * 8; const float* src = j.W + (size_t)(j.tk * 64 + r) * j.N + j.tn4 * 256 + c8;
#pragma unroll
    for (int q = 0; q < 4; ++q) { v[q][0] = *(const f32x4*)(src + q * 64); v[q][1] = *(const f32x4*)(src + q * 64 + 4); }
}

__device__ __forceinline__ void abar_pow(const float* are, const float* aim, const float* ldt, int sp, float e, float& pr, float& pi) {
    const float step = expf(ldt[sp]); const float x = e * step * are[sp], th = e * step * aim[sp];
    float s, c; sincosf(th, &s, &c); const float mg = expf(x); pr = mg * c; pi = mg * s;
}
__device__ __forceinline__ void ssm_coef(const float* are, const float* aim, const float* ldt, int sp, float& cr, float& ci) {
    const float step = expf(ldt[sp]); const float ar = are[sp], ai = aim[sp];
    const float x = step * ar, th = step * ai;
    float s, c; sincosf(th, &s, &c); const float em1 = expm1f(x); const float sh = sinf(0.5f * th);
    const float nr = em1 * c - 2.0f * sh * sh, ni = (em1 + 1.0f) * s;
    const float den = ar * ar + ai * ai;
    cr = (nr * ar + ni * ai) / den; ci = (ni * ar - nr * ai) / den;
}

__device__ __forceinline__ void prep_layer(AP a, int layer, float* sm, const int wv_) {
    unsigned char* ws = a->ws;
    const int G = gridDim.x;
    {
        const int tid = otid(wv_), r = tid >> 3, c8 = (tid & 7) * 8, n = tid >> 3, k8 = (tid & 7) * 8;
        int t = blockIdx.x; f32x4 v[4][2]; TJob j;
        if (t < 1072) { j = tjob(a, layer, t); tload(j, tid, v); }
        while (t < 1072) {
#pragma unroll
            for (int q = 0; q < 4; ++q)
#pragma unroll
                for (int e = 0; e < 4; ++e) { sm[q * 4160 + r * 65 + c8 + e] = v[q][0][e]; sm[q * 4160 + r * 65 + c8 + 4 + e] = v[q][1][e]; }
            __syncthreads();
            const TJob cj = j; const int tn = t + G;
            if (tn < 1072) { j = tjob(a, layer, tn); tload(j, tid, v); }
#pragma unroll
            for (int q = 0; q < 4; ++q) { const float* tt = sm + q * 4160;
                u32x4 w;
                w.x = cvt_pk_bf16(tt[(k8 + 0) * 65 + n], tt[(k8 + 1) * 65 + n]); w.y = cvt_pk_bf16(tt[(k8 + 2) * 65 + n], tt[(k8 + 3) * 65 + n]);
                w.z = cvt_pk_bf16(tt[(k8 + 4) * 65 + n], tt[(k8 + 5) * 65 + n]); w.w = cvt_pk_bf16(tt[(k8 + 6) * 65 + n], tt[(k8 + 7) * 65 + n]);
                *(u32x4*)(cj.Wt + (size_t)(cj.tn4 * 256 + q * 64 + n) * cj.K + cj.tk * 64 + k8) = w; }
            __syncthreads();
            t = tn;
        }
    }
    const int GT = G * NTHR;
    {
        bf16_t* wg = (bf16_t*)(ws + OFF_WGATE);
        for (int idx = blockIdx.x * NTHR + otid(wv_); idx < 1024 * 32; idx += GT) {
            const int n = idx >> 5, k0 = (idx & 31) * 8; const int pn = n >> 8, bj = (n >> 7) & 1, ch = pn * 128 + (n & 127), hd = ch >> 6, j = ch & 63;
            u32x4 w = (u32x4){0u, 0u, 0u, 0u};
            if ((pn >> 1) * 4 + (k0 >> 6) == hd) { const float* src = a->in[bj ? I_GAW : I_GXW] + (size_t)layer * 8 * 64 * 64 + (size_t)hd * 4096 + (size_t)(k0 & 63) * 64 + j;
                w.x = cvt_pk_bf16(src[0], src[64]); w.y = cvt_pk_bf16(src[128], src[192]); w.z = cvt_pk_bf16(src[256], src[320]); w.w = cvt_pk_bf16(src[384], src[448]); }
            *(u32x4*)(wg + (size_t)n * 256 + k0) = w;
        }
    }
    const float* are = a->in[I_SAR] + layer * 2048; const float* aim = a->in[I_SAI] + layer * 2048; const float* ldt = a->in[I_SDT] + layer * 2048;
    const float* bre = a->in[I_SBR] + layer * 32768; const float* bim = a->in[I_SBI] + layer * 32768;
    const float* cre = a->in[I_SCR] + layer * 32768; const float* cim = a->in[I_SCI] + layer * 32768;
    {
        bf16_t* w1 = (bf16_t*)(ws + OFF_W1T);
        for (int idx = blockIdx.x * NTHR + otid(wv_); idx < 32 * 128 * 32; idx += GT) {
            const int g = idx >> 12, n = (idx >> 5) & 127, k0 = (idx & 31) * 8, j = k0 >> 4, c0 = k0 & 15, p = n & 63, part = n >> 6, sp = g * 64 + p;
            float pr, pi, cr, ci; abar_pow(are, aim, ldt, sp, (float)(15 - j), pr, pi); ssm_coef(are, aim, ldt, sp, cr, ci);
            const float qr = pr * cr - pi * ci, qi = pr * ci + pi * cr;
            float o[8];
#pragma unroll
            for (int q = 0; q < 8; ++q) { const float br = bre[sp * 16 + c0 + q], bi = bim[sp * 16 + c0 + q]; o[q] = part ? (qr * bi + qi * br) : (qr * br - qi * bi); }
            u32x4 w; w.x = cvt_pk_bf16(o[0], o[1]); w.y = cvt_pk_bf16(o[2], o[3]); w.z = cvt_pk_bf16(o[4], o[5]); w.w = cvt_pk_bf16(o[6], o[7]);
            *(u32x4*)(w1 + ((size_t)(g * 128 + n) * 256 + k0)) = w;
        }
    }
    {
        bf16_t* wy = (bf16_t*)(ws + OFF_WYT);
        for (int idx = blockIdx.x * NTHR + otid(wv_); idx < 32 * 256 * 16; idx += GT) {
            const int g = idx >> 12, n = (idx >> 4) & 255, k0 = (idx & 15) * 8, i = n >> 4, c = n & 15, part = k0 >> 6, p0 = k0 & 63;
            float o[8];
#pragma unroll
            for (int q = 0; q < 8; ++q) { const int p = p0 + q, sp = g * 64 + p; float pr, pi; abar_pow(are, aim, ldt, sp, (float)(i + 1), pr, pi);
                const float xr = cre[(g * 16 + c) * 64 + p], xi = cim[(g * 16 + c) * 64 + p];
                o[q] = part ? -(xr * pi + xi * pr) : (xr * pr - xi * pi); }
            u32x4 w; w.x = cvt_pk_bf16(o[0], o[1]); w.y = cvt_pk_bf16(o[2], o[3]); w.z = cvt_pk_bf16(o[4], o[5]); w.w = cvt_pk_bf16(o[6], o[7]);
            *(u32x4*)(wy + ((size_t)(g * 256 + n) * 384 + k0)) = w;
        }
        for (int idx = blockIdx.x * NTHR + otid(wv_); idx < 32 * 256 * 4; idx += GT) {
            const int pq = idx & 3, c2 = (idx >> 2) & 15, c = (idx >> 6) & 15, g = idx >> 10;
            float km[16];
#pragma unroll
            for (int d = 0; d < 16; ++d) km[d] = 0.f;
            for (int pp = 0; pp < 16; ++pp) { const int p = pq * 16 + pp, sp = g * 64 + p; float ar, ai, cr, ci; abar_pow(are, aim, ldt, sp, 1.0f, ar, ai); ssm_coef(are, aim, ldt, sp, cr, ci);
                const float br = bre[sp * 16 + c2], bi = bim[sp * 16 + c2];
                const float bbr = cr * br - ci * bi, bbi = cr * bi + ci * br;
                const float xr = cre[(g * 16 + c) * 64 + p], xi = cim[(g * 16 + c) * 64 + p];
                float tr = xr * bbr - xi * bbi, ti = xr * bbi + xi * bbr;
#pragma unroll
                for (int d = 0; d < 16; ++d) { km[d] += tr; const float nr = tr * ar - ti * ai, ni = tr * ai + ti * ar; tr = nr; ti = ni; } }
#pragma unroll
            for (int d = 0; d < 16; ++d) { km[d] += __shfl_xor(km[d], 1); km[d] += __shfl_xor(km[d], 2); }
#pragma unroll
            for (int d = 0; d < 16; ++d) if ((d & 3) == pq) { const bf16_t kb = f2bf(km[d]);
                for (int i = d; i < 16; ++i) wy[(size_t)(g * 256 + i * 16 + c) * 384 + 128 + (i - d) * 16 + c2] = kb;
                if (d > 0) for (int i = 0; i < 16 - d; ++i) wy[(size_t)(g * 256 + i * 16 + c) * 384 + 128 + (i + d) * 16 + c2] = (bf16_t)0; }
        }
    }
}

__device__ __forceinline__ void prep_x(AP a, const int wv_) {
    bf16_t* xb = (bf16_t*)(a->ws + OFF_XB);
    const int gt = blockIdx.x * NTHR + otid(wv_), GT = gridDim.x * NTHR;
    for (int idx = gt; idx < M * 128; idx += GT) {
        const size_t e = (size_t)idx * 8; const float* src = e < (size_t)MP * 1024 ? a->in[I_XP] + e : a->in[I_XS] + (e - (size_t)MP * 1024);
        const f32x4 v0 = *(const f32x4*)src, v1 = *(const f32x4*)(src + 4);
        *(u32x4*)(xb + e) = pack8(v0, v1);
    }
}

__device__ __forceinline__ void conv_phase(AP a, int layer, bf16_t* bin_out, const int wv_) {
    unsigned char* ws = a->ws;
    const bf16_t* xa = (const bf16_t*)(ws + OFF_R); bf16_t* sb = (bf16_t*)(ws + OFF_R + S17);
    const bf16_t* sc = (const bf16_t*)(ws + OFF_R + 2 * S17); const bf16_t* sh = (const bf16_t*)(ws + OFF_R + 3 * S17);
    bf16_t* xac = (bf16_t*)(ws + OFF_XB);
    const float* caw = a->in[I_CAW] + layer * 4 * 512; const float* cab = a->in[I_CAB] + layer * 512; const float* cbw = a->in[I_CBW] + layer * 3 * 512;
    const int gt = blockIdx.x * NTHR + otid(wv_), GT = gridDim.x * NTHR;
    for (int idx = gt; idx < (2048 + 128) * 64; idx += GT) {
        const int seg = idx >> 6, c0 = (idx & 63) * 8;
        const bool prompt = seg < 2048;
        int row0, nrows;
        float x0[8], x1[8], x2[8], u1[8], u2[8];
        if (prompt) { row0 = seg * 8; nrows = 8; const bool first = (seg & 255) == 0;
            if (first) {
#pragma unroll
                for (int j = 0; j < 8; ++j) { x0[j] = 0.f; x1[j] = 0.f; x2[j] = 0.f; u1[j] = 0.f; u2[j] = 0.f; }
            } else {
                unpack8(*(const u32x4*)(xa + (size_t)(row0 - 3) * 512 + c0), x0); unpack8(*(const u32x4*)(xa + (size_t)(row0 - 2) * 512 + c0), x1); unpack8(*(const u32x4*)(xa + (size_t)(row0 - 1) * 512 + c0), x2);
                float s1[8], s2[8];
                unpack8(*(const u32x4*)(sc + (size_t)(row0 - 2) * 512 + c0), u1); unpack8(*(const u32x4*)(sh + (size_t)(row0 - 2) * 512 + c0), s1);
                unpack8(*(const u32x4*)(sc + (size_t)(row0 - 1) * 512 + c0), u2); unpack8(*(const u32x4*)(sh + (size_t)(row0 - 1) * 512 + c0), s2);
#pragma unroll
                for (int j = 0; j < 8; ++j) { u1[j] *= s1[j]; u2[j] *= s2[j]; }
            }
        } else { const int b = seg - 2048; row0 = MP + b * 4; nrows = 4;
            const float* lc = a->in[I_SLC] + ((size_t)(layer * 128 + b) * 3) * 512 + c0; const float* scs = a->in[I_SSC] + ((size_t)(layer * 128 + b) * 2) * 512 + c0;
#pragma unroll
            for (int j = 0; j < 8; ++j) { x0[j] = lc[j]; x1[j] = lc[512 + j]; x2[j] = lc[1024 + j]; u1[j] = scs[j]; u2[j] = scs[512 + j]; }
        }
        float w0[8], w1[8], w2[8], w3[8], wb[8], v0[8], v1[8], v2[8];
#pragma unroll
        for (int j = 0; j < 8; ++j) { w0[j] = caw[c0 + j]; w1[j] = caw[512 + c0 + j]; w2[j] = caw[1024 + c0 + j]; w3[j] = caw[1536 + c0 + j]; wb[j] = cab[c0 + j];
            v0[j] = cbw[c0 + j]; v1[j] = cbw[512 + c0 + j]; v2[j] = cbw[1024 + c0 + j]; }
        for (int t0 = 0; t0 < nrows; t0 += 2) {
            u32x4 lx[2], lc[2], lh[2], lb[2];
#pragma unroll
            for (int k = 0; k < 2; ++k) { const size_t off = (size_t)(row0 + t0 + k) * 512 + c0;
                lx[k] = *(const u32x4*)(xa + off); lc[k] = *(const u32x4*)(sc + off); lh[k] = *(const u32x4*)(sh + off); lb[k] = *(const u32x4*)(sb + off); }
#pragma unroll
            for (int k = 0; k < 2; ++k) { const size_t off = (size_t)(row0 + t0 + k) * 512 + c0;
                float xv[8], scv[8], shv[8], sbv[8];
                unpack8(lx[k], xv); unpack8(lc[k], scv); unpack8(lh[k], shv); unpack8(lb[k], sbv);
                f32x4 o0, o1, q0, q1;
#pragma unroll
                for (int j = 0; j < 8; ++j) {
                    const float o = w0[j] * x0[j] + w1[j] * x1[j] + w2[j] * x2[j] + w3[j] * xv[j] + wb[j];
                    const float uu = scv[j] * shv[j]; const float cu = v0[j] * u1[j] + v1[j] * u2[j] + v2[j] * uu; const float bi = sbv[j] * cu;
                    if (j < 4) { o0[j] = o; q0[j] = bi; } else { o1[j - 4] = o; q1[j - 4] = bi; }
                    x0[j] = x1[j]; x1[j] = x2[j]; x2[j] = xv[j]; u1[j] = u2[j]; u2[j] = uu;
                }
                *(u32x4*)(xac + off) = pack8(o0, o1);
                *(u32x4*)(bin_out + off) = pack8(q0, q1); }
        }
        if (prompt) { if ((seg & 255) == 255) { const int b = seg >> 8;
                float* o1 = a->out + O_LCP + ((size_t)(layer * 8 + b) * 3) * 512 + c0; float* o2 = a->out + O_SCP + ((size_t)(layer * 8 + b) * 2) * 512 + c0;
#pragma unroll
                for (int j = 0; j < 8; ++j) { o1[j] = x0[j]; o1[512 + j] = x1[j]; o1[1024 + j] = x2[j]; o2[j] = u1[j]; o2[512 + j] = u2[j]; } }
        } else { const int b = seg - 2048;
            float* o1 = a->out + O_LCS + ((size_t)(layer * 128 + b) * 3) * 512 + c0; float* o2 = a->out + O_SCS + ((size_t)(layer * 128 + b) * 2) * 512 + c0;
#pragma unroll
            for (int j = 0; j < 8; ++j) { o1[j] = x0[j]; o1[512 + j] = x1[j]; o1[1024 + j] = x2[j]; o2[j] = u1[j]; o2[512 + j] = u2[j]; }
        }
    }
}

__device__ __forceinline__ void ssm_s_gemm(AP a, const int wv_) {
    const bf16_t* apack = (const bf16_t*)(a->ws + OFF_APACK); const bf16_t* w1 = (const bf16_t*)(a->ws + OFF_W1T); float* S = (float*)(a->ws + OFF_S);
    const int tid_ = otid(wv_); const int lane = tid_ & 63, wv = blockIdx.x * 8 + (tid_ >> 6), NW = gridDim.x * 8;
    const int lr = lane & 15, kq = lane >> 4;
    for (int t = wv; t < 1024; t += NW) {
        const int g = t >> 5, rt = (t >> 1) & 15, ct = t & 1;
        f32x4 acc[4][4];
#pragma unroll
        for (int i = 0; i < 4; ++i)
#pragma unroll
            for (int j = 0; j < 4; ++j) acc[i][j] = (f32x4){0.f, 0.f, 0.f, 0.f};
        const bf16_t* ab = apack + ((size_t)(g * 1024 + rt * 64 + lr) * 384 + 128 + kq * 8);
        const bf16_t* bb = w1 + ((size_t)(g * 128 + ct * 64 + lr) * 256 + kq * 8);
#pragma unroll 2
        for (int ks = 0; ks < 8; ++ks) {
            bf16x8 af[4], bf[4];
#pragma unroll
            for (int i = 0; i < 4; ++i) { af[i] = *(const bf16x8*)(ab + (size_t)i * 16 * 384 + ks * 32); bf[i] = *(const bf16x8*)(bb + (size_t)i * 16 * 256 + ks * 32); }
#pragma unroll
            for (int i = 0; i < 4; ++i)
#pragma unroll
                for (int j = 0; j < 4; ++j) acc[i][j] = __builtin_amdgcn_mfma_f32_16x16x32_bf16(af[i], bf[j], acc[i][j], 0, 0, 0);
        }
#pragma unroll
        for (int i = 0; i < 4; ++i)
#pragma unroll
            for (int j = 0; j < 4; ++j)
#pragma unroll
                for (int q = 0; q < 4; ++q) S[(size_t)(g * 1024 + rt * 64 + i * 16 + kq * 4 + q) * 128 + ct * 64 + j * 16 + lr] = acc[i][j][q];
    }
}

__device__ __forceinline__ void ssm_carry(AP a, int layer, float* sm, const int wv_) {
    bf16_t* apack = (bf16_t*)(a->ws + OFF_APACK); const float* S = (const float*)(a->ws + OFF_S);
    const int tid = otid(wv_), p = tid & 63, seg = tid >> 6;
    for (int pair = blockIdx.x; pair < 256; pair += gridDim.x) {
        const int b = pair >> 5, g = pair & 31, sp = g * 64 + p;
        float ar, ai, Ar, Ai;
        abar_pow(a->in[I_SAR] + layer * 2048, a->in[I_SAI] + layer * 2048, a->in[I_SDT] + layer * 2048, sp, 16.0f, ar, ai);
        abar_pow(a->in[I_SAR] + layer * 2048, a->in[I_SAI] + layer * 2048, a->in[I_SDT] + layer * 2048, sp, 256.0f, Ar, Ai);
        const size_t rbase = (size_t)g * 1024 + b * 128 + seg * 16;
        float sr[16], si[16];
#pragma unroll
        for (int j = 0; j < 16; ++j) { sr[j] = S[(rbase + j) * 128 + p]; si[j] = S[(rbase + j) * 128 + 64 + p]; }
        float hr = 0.f, hi = 0.f;
#pragma unroll
        for (int j = 0; j < 16; ++j) { const float nr = ar * hr - ai * hi + sr[j], ni = ar * hi + ai * hr + si[j]; sr[j] = hr; si[j] = hi; hr = nr; hi = ni; }
        sm[seg * 128 + p] = hr; sm[seg * 128 + 64 + p] = hi;
        __syncthreads();
        float cr = 0.f, ci = 0.f;
        for (int s2 = 0; s2 < seg; ++s2) { const float er = sm[s2 * 128 + p], ei = sm[s2 * 128 + 64 + p]; const float nr = Ar * cr - Ai * ci + er, ni = Ar * ci + Ai * cr + ei; cr = nr; ci = ni; }
        if (seg == 7) { const float fr_ = Ar * cr - Ai * ci + hr, fi_ = Ar * ci + Ai * cr + hi;
            a->out[O_SRP + (size_t)(layer * 8 + b) * 2048 + sp] = fr_; a->out[O_SIP + (size_t)(layer * 8 + b) * 2048 + sp] = fi_; }
#pragma unroll
        for (int j = 0; j < 16; ++j) { apack[(rbase + j) * 384 + p] = f2bf(sr[j] + cr); apack[(rbase + j) * 384 + 64 + p] = f2bf(si[j] + ci);
            const float nr = ar * cr - ai * ci, ni = ar * ci + ai * cr; cr = nr; ci = ni; }
        __syncthreads();
    }
}

__device__ __forceinline__ void ssm_sample(AP a, int layer, int wv, int NW, const int wv_) {
    const bf16_t* uss = (const bf16_t*)(a->ws + OFF_USS); bf16_t* zc = (bf16_t*)(a->ws + OFF_ZCS);
    const float* are = a->in[I_SAR] + layer * 2048; const float* aim = a->in[I_SAI] + layer * 2048; const float* ldt = a->in[I_SDT] + layer * 2048;
    const float* bre = a->in[I_SBR] + layer * 32768; const float* bim = a->in[I_SBI] + layer * 32768;
    const float* cre = a->in[I_SCR] + layer * 32768; const float* cim = a->in[I_SCI] + layer * 32768; const float* dv = a->in[I_SD] + layer * 512;
    const int lane = otid(wv_) & 63;
    for (int t = wv; t < 128 * 32; t += NW) {
        const int b = t >> 5, g = t & 31, sp = g * 64 + lane;
        float ar, ai, cr, ci; abar_pow(are, aim, ldt, sp, 1.0f, ar, ai); ssm_coef(are, aim, ldt, sp, cr, ci);
        float bbr[16], bbi[16], xr[16], xi[16];
#pragma unroll
        for (int c = 0; c < 16; ++c) { const float br = bre[sp * 16 + c], bi = bim[sp * 16 + c]; bbr[c] = cr * br - ci * bi; bbi[c] = cr * bi + ci * br;
            xr[c] = cre[(g * 16 + c) * 64 + lane]; xi[c] = cim[(g * 16 + c) * 64 + lane]; }
        float hr = a->in[I_SSR][(size_t)(layer * 128 + b) * 2048 + sp], hi = a->in[I_SSI][(size_t)(layer * 128 + b) * 2048 + sp];
        const float dme = lane < 16 ? dv[g * 16 + lane] : 0.f;
        for (int tt = 0; tt < 4; ++tt) {
            const bf16_t* up = uss + (size_t)(b * 4 + tt) * 512 + g * 16;
            const u32x4 w0 = *(const u32x4*)up, w1 = *(const u32x4*)(up + 8);
            float u[16]; { float t0[8], t1[8]; unpack8(w0, t0); unpack8(w1, t1);
#pragma unroll
                for (int c = 0; c < 8; ++c) { u[c] = t0[c]; u[8 + c] = t1[c]; } }
            float br_ = 0.f, bi_ = 0.f;
#pragma unroll
            for (int c = 0; c < 16; ++c) { br_ += bbr[c] * u[c]; bi_ += bbi[c] * u[c]; }
            const float nr = ar * hr - ai * hi + br_, ni = ar * hi + ai * hr + bi_; hr = nr; hi = ni;
            float mine = 0.f, ume = 0.f;
#pragma unroll
            for (int c = 0; c < 16; ++c) { float y = xr[c] * hr - xi[c] * hi;
#pragma unroll
                for (int o = 32; o >= 1; o >>= 1) y += __shfl_xor(y, o);
                if (lane == c) { mine = y; ume = u[c]; } }
            if (lane < 16) zc[(size_t)(b * 4 + tt) * 512 + g * 16 + lane] = f2bf(gelu_t(mine + dme * ume));
        }
        a->out[O_SRS + (size_t)(layer * 128 + b) * 2048 + sp] = hr; a->out[O_SIS + (size_t)(layer * 128 + b) * 2048 + sp] = hi;
    }
}

__device__ __forceinline__ void lru_local(AP a, const int wv_) {
    const _Float16* av = (const _Float16*)(a->ws + OFF_R + 2 * S17); const bf16_t* bx = (const bf16_t*)(a->ws + OFF_R); f32x2* car = (f32x2*)(a->ws + OFF_CAR);
    const int gt = blockIdx.x * NTHR + otid(wv_), GT = gridDim.x * NTHR;
    for (int idx = gt; idx < 8 * 32 * 512; idx += GT) {
        const int c = idx & 511, sc = idx >> 9;
        const size_t base = (size_t)sc * 64 * 512 + c;
        float P = 1.f, h = 0.f;
        for (int t0 = 0; t0 < 64; t0 += 16) {
            _Float16 al[16]; bf16_t bb[16];
#pragma unroll
            for (int j = 0; j < 16; ++j) { al[j] = av[base + (size_t)(t0 + j) * 512]; bb[j] = bx[base + (size_t)(t0 + j) * 512]; }
#pragma unroll
            for (int j = 0; j < 16; ++j) { const float aa = __expf((float)al[j]); h = aa * h + bf2f(bb[j]); P *= aa; }
        }
        car[idx] = (f32x2){P, h};
    }
}
template <int B>
__device__ __forceinline__ float lru_run(const _Float16* av, const bf16_t* bx, bf16_t* ao, const bf16_t* ya, size_t base, int n, float h) {
    for (int t0 = 0; t0 < n; t0 += B) {
        _Float16 aa[B]; bf16_t bb[B], yy[B];
#pragma unroll
        for (int j = 0; j < B; ++j) { const size_t o = base + (size_t)(t0 + j) * 512; aa[j] = av[o]; bb[j] = bx[o]; yy[j] = ya[o]; }
        bf16_t oo[B];
#pragma unroll
        for (int j = 0; j < B; ++j) { h = __expf((float)aa[j]) * h + bf2f(bb[j]); oo[j] = f2bf(h * gelu_t(bf2f(yy[j]))); }
#pragma unroll
        for (int j = 0; j < B; ++j) ao[base + (size_t)(t0 + j) * 512] = oo[j];
    }
    return h;
}
__device__ __forceinline__ void lru_apply(AP a, int layer, bf16_t* ao, int mode, const int wv_) {
    const _Float16* av = (const _Float16*)(a->ws + OFF_R + 2 * S17); const bf16_t* bx = (const bf16_t*)(a->ws + OFF_R); const f32x2* car = (const f32x2*)(a->ws + OFF_CAR);
    const bf16_t* ya = (const bf16_t*)(a->ws + OFF_YA);
    const int G = gridDim.x, bid = blockIdx.x;
    if (mode == 0) {
        if (bid >= G - 8) return;
        const int GP = G - 8; int v = bid - 128; if (v < 0) v += GP;
        for (int idx = v * NTHR + otid(wv_); idx < 8 * 32 * 512; idx += GP * NTHR) {
            const int c = idx & 511, sc = idx >> 9, seq = sc >> 5, chunk = sc & 31;
            float h = 0.f;
            f32x2 ph[31];
#pragma unroll
            for (int k = 0; k < 31; ++k) ph[k] = car[(seq * 32 + (k < chunk ? k : 0)) * 512 + c];
#pragma unroll
            for (int k = 0; k < 31; ++k) if (k < chunk) h = ph[k].x * h + ph[k].y;
            h = lru_run<8>(av, bx, ao, ya, (size_t)sc * 64 * 512 + c, 64, h);
            if (chunk == 31) a->out[O_LHP + (size_t)(layer * 8 + seq) * 512 + c] = h;
        }
    } else {
        for (int j = bid * NTHR + otid(wv_); j < 128 * 512; j += G * NTHR) {
            const int c = j & 511, b = j >> 9;
            float h = a->in[I_SLH][(size_t)(layer * 128 + b) * 512 + c];
            h = lru_run<4>(av, bx, ao, ya, (size_t)(MP + b * 4) * 512 + c, 4, h);
            a->out[O_LHS + (size_t)(layer * 128 + b) * 512 + c] = h;
        }
    }
}

template <bool RES16>
__device__ __forceinline__ void ln_phase(const bf16_t* T, const float* Rs, const float* part, const float* resp, const float* ress, const bf16_t* res16,
                                         float* dst32, bf16_t* dst16, const float* gam, const float* bet, const int wv_) {
    const int tid_ = otid(wv_); const int lane = tid_ & 63, wv = blockIdx.x * 8 + (tid_ >> 6), NW = gridDim.x * 8;
    for (int r0 = wv; r0 < M; r0 += 3 * NW) {
        f32x4 v[3][4];
#pragma unroll
        for (int k = 0; k < 3; ++k) { const int rr = r0 + k * NW; const int r = rr < M ? rr : r0;
            if (r < MP) {
#pragma unroll
                for (int i = 0; i < 4; ++i) { const u32x2 w = *(const u32x2*)(T + (size_t)r * 1024 + i * 256 + lane * 4); v[k][i] = (f32x4){bflo(w.x), bfhi(w.x), bflo(w.y), bfhi(w.y)}; }
            } else {
#pragma unroll
                for (int i = 0; i < 4; ++i) v[k][i] = *(const f32x4*)(Rs + (size_t)r * 1024 + i * 256 + lane * 4);
#pragma unroll
                for (int q = 0; q < 3; ++q)
#pragma unroll
                    for (int i = 0; i < 4; ++i) v[k][i] += *(const f32x4*)(part + (size_t)q * PART_STRIDE + (size_t)(r - MP) * 1024 + i * 256 + lane * 4);
            }
            if (RES16) {
#pragma unroll
                for (int i = 0; i < 4; ++i) { const u32x2 w = *(const u32x2*)(res16 + (size_t)r * 1024 + i * 256 + lane * 4); v[k][i] += (f32x4){bflo(w.x), bfhi(w.x), bflo(w.y), bfhi(w.y)} * ALPHA; }
            } else { const float* rp = r < MP ? resp + (size_t)r * 1024 : ress + (size_t)(r - MP) * 1024;
#pragma unroll
                for (int i = 0; i < 4; ++i) v[k][i] += *(const f32x4*)(rp + i * 256 + lane * 4) * ALPHA;
            } }
#pragma unroll
        for (int k = 0; k < 3; ++k) { const int r = r0 + k * NW;
            float s = 0.f;
#pragma unroll
            for (int i = 0; i < 4; ++i) s += (v[k][i][0] + v[k][i][1]) + (v[k][i][2] + v[k][i][3]);
#pragma unroll
            for (int o = 32; o >= 1; o >>= 1) s += __shfl_xor(s, o);
            const float mu = s * (1.0f / 1024.0f); float q = 0.f;
#pragma unroll
            for (int i = 0; i < 4; ++i) { const f32x4 d = v[k][i] - mu; q += (d[0] * d[0] + d[1] * d[1]) + (d[2] * d[2] + d[3] * d[3]); }
#pragma unroll
            for (int o = 32; o >= 1; o >>= 1) q += __shfl_xor(q, o);
            const float rs = rsqrtf(q * (1.0f / 1024.0f) + LN_EPS);
            if (r < M) {
#pragma unroll
                for (int i = 0; i < 4; ++i) { const int col = i * 256 + lane * 4; const f32x4 gg = *(const f32x4*)(gam + col), bb = *(const f32x4*)(bet + col);
                    const f32x4 y = (v[k][i] - mu) * rs * gg + bb;
                    if (dst32) *(f32x4*)(dst32 + (size_t)r * 1024 + col) = y;
                    if (dst16) { u32x2 w; w.x = cvt_pk_bf16(y[0], y[1]); w.y = cvt_pk_bf16(y[2], y[3]);
                        *(u32x2*)(dst16 + (size_t)r * 1024 + col) = w; } }
            }
        }
    }
}

__global__ void __launch_bounds__(NTHR, 2) fwd_megakernel(Args a_unused) {
    extern __shared__ __attribute__((aligned(16))) unsigned char lds_raw[];
    cg::grid_group grid = cg::this_grid();
    LAS unsigned char* lds = (LAS unsigned char*)lds_raw;
    const int G = gridDim.x, bid = blockIdx.x;
    int wv_; { const int tw = (int)threadIdx.x >> 6; asm volatile("v_readfirstlane_b32 %0, %1" : "=s"(wv_) : "v"(tw)); }

    const unsigned long long t_start = PROBE_ON ? __builtin_amdgcn_s_memrealtime() : 0ull;
    for (int rep = 0; rep < REP_PREP; ++rep) { const AP a = ld_args(); prep_layer(a, 0, (float*)lds_raw, wv_); prep_x(a, wv_); }
    int pidx = 1; unsigned long long tA = PROBE_A == 0 ? t_start : 0ull, tB = 0ull;
    if (PROBE_ON) { if (PROBE_A == 1) tA = __builtin_amdgcn_s_memrealtime(); if (PROBE_B == 1) tB = __builtin_amdgcn_s_memrealtime(); }
    unsigned bar_n = 0; unsigned* bar_ctr; { const AP a = ld_args(); bar_ctr = (unsigned*)(a->ws + OFF_BAR); if (a->ws == nullptr) grid.sync(); }
    bar_n += (unsigned)G; gbar(bar_ctr, bar_n, wv_);

#pragma unroll 1
    for (int layer = 0; layer < 2; ++layer) {
        { const AP a = ld_args(); unsigned char* ws = a->ws;
          PG1 p; p.K = 1024; p.lda = 1024; p.ldb = 1024; p.G = opq(G); p.c = opq(bid); p.A = layer == 0 ? (const bf16_t*)(ws + OFF_XB) : (const bf16_t*)a->out; p.Bt = (const bf16_t*)(ws + OFF_WIN);
          p.xa = (bf16_t*)(ws + OFF_R); p.ya = (bf16_t*)(ws + OFF_YA); p.sb = (bf16_t*)(ws + OFF_R + S17); p.sc = (bf16_t*)(ws + OFF_R + 2 * S17); p.sh = (bf16_t*)(ws + OFF_R + 3 * S17);
          p.apack = (bf16_t*)(ws + OFF_APACK); p.uss = (bf16_t*)(ws + OFF_USS); p.gl8 = ws + OFF_GL8;
          for (int rep = 0; rep < REP_G1; ++rep) gemm_phase(lds, p, wv_); }
        GSYNC();
        if (DRY_CONV) { const AP a = ld_args(); conv_phase(a, layer, (bf16_t*)(a->ws + OFF_XB + S17), wv_); }
        { const AP a = ld_args(); conv_phase(a, layer, (bf16_t*)(a->ws + OFF_R + S17), wv_); }
        for (int rep = 0; rep < REP_SG; ++rep) { const AP a = ld_args(); ssm_s_gemm(a, wv_); }
        GSYNC();
        for (int rep = 0; rep < REP_CARRY; ++rep) { const AP a = ld_args(); ssm_carry(a, layer, (float*)lds_raw, wv_); }
        { const AP a = ld_args(); unsigned char* ws = a->ws;
          PGate p; p.K = 256; p.lda = 512; p.ldb = 256; p.G = opq(G); p.c = opq(bid); p.A = (const bf16_t*)(ws + OFF_XB); p.Bt = (const bf16_t*)(ws + OFF_WGATE);
          p.gxb = a->in[I_GXB] + layer * 512; p.gab = a->in[I_GAB] + layer * 512; p.lam = a->in[I_LAM] + layer * 512;
          p.aout = (_Float16*)(ws + OFF_R + 2 * S17); p.bxout = (bf16_t*)(ws + OFF_R);
          for (int rep = 0; rep < REP_GATE; ++rep) gemm_phase(lds, p, wv_); }
        for (int rep = 0; rep < REP_SAMPLE; ++rep) if (bid >= 8) { const AP a = ld_args(); ssm_sample(a, layer, (bid - 8) * 8 + wv_, (G - 8) * 8, wv_); }
        GSYNC();
        { const AP a = ld_args(); unsigned char* ws = a->ws;
          PY p; p.K = 384; p.lda = 384; p.ldb = 384; p.G = opq(G); p.c = opq(bid); p.apack = (const bf16_t*)(ws + OFF_APACK); p.wyt = (const bf16_t*)(ws + OFF_WYT);
          p.dvec = a->in[I_SD] + layer * 512; p.zc = (bf16_t*)(ws + OFF_XB);
          for (int rep = 0; rep < REP_Y; ++rep) gemm_phase(lds, p, wv_); }
        { const AP a = ld_args(); unsigned char* ws = a->ws;
          PGlu p; p.K = 512; p.lda = 512; p.ldb = 512; p.G = opq(G); p.c = opq(bid); p.sample = 1; p.A = (const bf16_t*)(ws + OFF_XB); p.As = (const bf16_t*)(ws + OFF_ZCS); p.Bt = (const bf16_t*)(ws + OFF_WGLU);
          p.bias = a->in[I_GLB] + layer * 512; p.out = (bf16_t*)(ws + OFF_XB + S17);
          gemm_phase(lds, p, wv_); }
        { const AP a = ld_args(); lru_apply(a, layer, (bf16_t*)(a->ws + OFF_R), 1, wv_); }
        for (int rep = 0; rep < REP_LOCAL; ++rep) { const AP a = ld_args(); lru_local(a, wv_); }
        GSYNC();
        { const AP a = ld_args(); unsigned char* ws = a->ws;
          PGlu p; p.K = 512; p.lda = 512; p.ldb = 512; p.G = opq(G); p.c = opq(bid); p.sample = 0; p.A = (const bf16_t*)(ws + OFF_XB); p.As = (const bf16_t*)(ws + OFF_ZCS); p.Bt = (const bf16_t*)(ws + OFF_WGLU);
          p.bias = a->in[I_GLB] + layer * 512; p.out = (bf16_t*)(ws + OFF_XB + S17);
          for (int rep = 0; rep < REP_GLU; ++rep) gemm_phase(lds, p, wv_); }
        { const AP a = ld_args(); unsigned char* ws = a->ws;
          PMerge p; p.K = 512; p.lda = 512; p.ldb = 512; p.G = opq(G); p.c = opq(bid); p.sample = 1; p.a0 = (const bf16_t*)(ws + OFF_R);
          p.wp = (const bf16_t*)(ws + OFF_WP); p.gl8 = ws + OFF_GL8; p.mb = (bf16_t*)(ws + OFF_MB);
          gemm_phase(lds, p, wv_); }
        if (DRY_APPLY) { const AP a = ld_args(); lru_apply(a, layer, (bf16_t*)(a->ws + OFF_S), 0, wv_); }
        { const AP a = ld_args(); lru_apply(a, layer, (bf16_t*)(a->ws + OFF_R), 0, wv_); }
        GSYNC();
        { const AP a = ld_args(); unsigned char* ws = a->ws;
          PMerge p; p.K = 512; p.lda = 512; p.ldb = 512; p.G = opq(G); p.c = opq(bid); p.sample = 0; p.a0 = (const bf16_t*)(ws + OFF_R);
          p.wp = (const bf16_t*)(ws + OFF_WP); p.gl8 = ws + OFF_GL8; p.mb = (bf16_t*)(ws + OFF_MB);
          for (int rep = 0; rep < REP_MERGE; ++rep) gemm_phase(lds, p, wv_); }
        GSYNC();
        { const AP a = ld_args(); unsigned char* ws = a->ws;
          PWout p; p.K = 1024; p.lda = 1024; p.ldb = 1024; p.G = opq(G); p.c = opq(bid); p.A = (const bf16_t*)(ws + OFF_MB); p.Bt = (const bf16_t*)(ws + OFF_WOUT);
          p.T = (bf16_t*)(ws + OFF_R); p.R = (float*)(ws + OFF_R); p.part = (float*)(ws + OFF_PW);
          gemm_phase(lds, p, wv_); }
        GSYNC();
        { const AP a = ld_args(); unsigned char* ws = a->ws;
          if (layer == 0) ln_phase<false>((const bf16_t*)(ws + OFF_R), (const float*)(ws + OFF_R), (const float*)(ws + OFF_PW), a->in[I_XP], a->in[I_XS], (const bf16_t*)nullptr,
                          (float*)nullptr, (bf16_t*)(ws + OFF_XB), a->in[I_L1G] + layer * 1024, a->in[I_L1B] + layer * 1024, wv_);
          else ln_phase<true>((const bf16_t*)(ws + OFF_R), (const float*)(ws + OFF_R), (const float*)(ws + OFF_PW), (const float*)nullptr, (const float*)nullptr, (const bf16_t*)a->out,
                          (float*)nullptr, (bf16_t*)(ws + OFF_XB), a->in[I_L1G] + layer * 1024, a->in[I_L1B] + layer * 1024, wv_); }
        GSYNC();
        { const AP a = ld_args(); unsigned char* ws = a->ws;
          PUp p; p.K = 1024; p.lda = 1024; p.ldb = 1024; p.G = opq(G); p.c = opq(bid); p.A = (const bf16_t*)(ws + OFF_XB); p.Bt = (const bf16_t*)(ws + OFF_WUP); p.h = (bf16_t*)(ws + OFF_H);
          for (int rep = 0; rep < REP_UP; ++rep) gemm_phase(lds, p, wv_); }
        GSYNC();
        { const AP a = ld_args(); unsigned char* ws = a->ws;
          PDown p; p.K = 4096; p.lda = 4096; p.ldb = 4096; p.G = opq(G); p.c = opq(bid); p.A = (const bf16_t*)(ws + OFF_H); p.Bt = (const bf16_t*)(ws + OFF_WDOWN);
          p.T = (bf16_t*)(ws + OFF_R); p.R = (float*)(ws + OFF_R); p.part = (float*)(ws + OFF_PD);
          gemm_phase(lds, p, wv_); }
        GSYNC();
        { const AP a = ld_args(); unsigned char* ws = a->ws;
          ln_phase<true>((const bf16_t*)(ws + OFF_R), (const float*)(ws + OFF_R), (const float*)(ws + OFF_PD), (const float*)nullptr, (const float*)nullptr, (const bf16_t*)(ws + OFF_XB),
                         layer == 0 ? (float*)nullptr : a->out, layer == 0 ? (bf16_t*)a->out : (bf16_t*)nullptr, a->in[I_L2G] + layer * 1024, a->in[I_L2B] + layer * 1024, wv_); }
        if (layer == 0) { __syncthreads(); for (int rep = 0; rep < REP_PREP; ++rep) { const AP a = ld_args(); prep_layer(a, 1, (float*)lds_raw, wv_); } GSYNC(); }
    }
    if (PROBE_ON && bid == 0) { if (PROBE_B > 22) tB = __builtin_amdgcn_s_memrealtime(); const unsigned long long t0 = __builtin_amdgcn_s_memrealtime(); while (__builtin_amdgcn_s_memrealtime() - t0 < tB - tA) __builtin_amdgcn_s_sleep(8); }
}

extern "C" void kernel_launch(void* const* d_in, const int* in_sizes, int n_in, void* d_out, int out_size, void* d_ws, size_t ws_size, hipStream_t stream) {
    constexpr size_t kDynLds = STAGE_BYTES;
    static int grid_blocks = 0;
    if (!grid_blocks) {
        int dev = 0, cus = 0, per_cu = 0;
        hipGetDevice(&dev);
        hipDeviceGetAttribute(&cus, hipDeviceAttributeMultiprocessorCount, dev);
        hipFuncSetAttribute((const void*)fwd_megakernel, hipFuncAttributeMaxDynamicSharedMemorySize, (int)kDynLds);
        hipOccupancyMaxActiveBlocksPerMultiprocessor(&per_cu, (const void*)fwd_megakernel, NTHR, kDynLds);
        if (per_cu < 1) per_cu = 1;
        grid_blocks = cus * per_cu;
        if (grid_blocks > 256) grid_blocks = 256;
        if (ws_size < WS_END || n_in != 36) fprintf(stderr, "kernel_launch: unexpected ws_size %zu (need %zu) or n_in %d\n", ws_size, (size_t)WS_END, n_in);
    }
    (void)hipMemsetAsync((char*)d_ws + OFF_BAR, 0, 256, stream);
    Args a{};
    for (int i = 0; i < 36; ++i) a.in[i] = (const float*)d_in[i];
    a.out = (float*)d_out; a.ws = (unsigned char*)d_ws;
    void* args[] = {&a};
    hipError_t e = hipLaunchCooperativeKernel((const void*)fwd_megakernel, dim3(grid_blocks), dim3(NTHR), args, kDynLds, stream);
    if (e != hipSuccess) fprintf(stderr, "cooperative launch failed: %s (grid %d)\n", hipGetErrorString(e), grid_blocks);
}
```

```cpp
#include <hip/hip_runtime.h>
#include <hip/hip_cooperative_groups.h>
#include <cstdio>
namespace cg = cooperative_groups;
#define REP_GEMM 1
#define REP_G1 REP_GEMM
#define REP_GATE REP_GEMM
#define REP_Y REP_GEMM
#define REP_GLU REP_GEMM
#define REP_MERGE REP_GEMM
#define REP_UP REP_GEMM
#define REP_ELEM 1
#define REP_PREP REP_ELEM
#define REP_SG REP_ELEM
#define REP_CARRY REP_ELEM
#define REP_SAMPLE REP_ELEM
#define REP_LOCAL REP_ELEM
#define REP_LN2 REP_ELEM
#define DRY_CONV 0
#define DRY_APPLY 0
#define DRY_LN1 0
#define REP_SYNC 1
#define PROBE_ON 0
#define PROBE_A 0
#define PROBE_B 1
#define GSYNC() do { for (int _s = 0; _s < REP_SYNC; ++_s) { bar_n += (unsigned)G; gbar((unsigned*)(ld_args()->ws + OFF_BAR), bar_n, wv_); } ++pidx; if (PROBE_ON) { if (pidx == PROBE_A) tA = __builtin_amdgcn_s_memrealtime(); if (pidx == PROBE_B) tB = __builtin_amdgcn_s_memrealtime(); } } while (0)

#define LAS __attribute__((address_space(3)))
typedef unsigned short bf16_t;
typedef short bf16x8 __attribute__((ext_vector_type(8)));
typedef float f32x4 __attribute__((ext_vector_type(4)));
typedef float f32x2 __attribute__((ext_vector_type(2)));
typedef unsigned u32x4 __attribute__((ext_vector_type(4)));
typedef unsigned u32x2 __attribute__((ext_vector_type(2)));

constexpr int MP = 16384, MS = 512, M = MP + MS, D = 1024, NIN = 6144, BW = 512, DFF = 4096;
constexpr int NTHR = 512;
constexpr float ALPHA = 1.41421356237f;
constexpr float LN_EPS = 1e-5f;

constexpr size_t S17 = (size_t)M * 512 * 2;
constexpr size_t OFF_WUP = 0;
constexpr size_t OFF_WDOWN = OFF_WUP + (size_t)4096 * 1024 * 2;
constexpr size_t OFF_R = OFF_WDOWN + (size_t)4096 * 1024 * 2;
constexpr size_t OFF_XB = OFF_R + 4 * S17;
constexpr size_t OFF_BIG = OFF_XB + 2 * S17;
constexpr size_t OFF_H = OFF_BIG;
constexpr size_t OFF_WIN = OFF_BIG;
constexpr size_t OFF_WP = OFF_WIN + (size_t)6144 * 1024 * 2;
constexpr size_t OFF_WGLU = OFF_WP + (size_t)3 * 1024 * 512 * 2;
constexpr size_t OFF_WOUT = OFF_WGLU + (size_t)512 * 512 * 2;
constexpr size_t OFF_WGATE = OFF_WOUT + (size_t)1024 * 1024 * 2;
constexpr size_t OFF_W1T = OFF_WGATE + (size_t)1024 * 512 * 2;
constexpr size_t OFF_WYT = OFF_W1T + (size_t)32 * 128 * 256 * 2;
constexpr size_t OFF_GL8 = OFF_WYT + (size_t)32 * 256 * 384 * 2;
constexpr size_t OFF_YA = OFF_GL8 + (size_t)M * 3072;
constexpr size_t OFF_APACK = OFF_YA + S17;
constexpr size_t OFF_S = OFF_APACK + (size_t)32 * 1024 * 384 * 2;
constexpr size_t OFF_MB = OFF_APACK;
constexpr size_t OFF_USS = OFF_S + (size_t)32 * 1024 * 128 * 4;
constexpr size_t OFF_CAR = OFF_USS + (size_t)512 * 512 * 2;
constexpr size_t OFF_BAR = OFF_CAR + (size_t)8 * 32 * 512 * 8;
constexpr size_t OFF_PD = OFF_BAR + 256;
constexpr size_t OFF_PW = OFF_GL8;
constexpr size_t PART_STRIDE = (size_t)MS * 1024;
constexpr size_t OFF_ZCS = OFF_PD + 3 * PART_STRIDE * 4;
constexpr size_t WS_END = OFF_ZCS + (size_t)MS * 512 * 2;
static_assert(OFF_PD >= OFF_H + (size_t)M * 4096 * 2, "down partials must not overlap h");
static_assert(WS_END <= (size_t)268435456, "workspace map exceeds 256 MiB");
static_assert(OFF_MB + (size_t)M * 1024 * 2 <= OFF_USS, "m overlay");
static_assert(OFF_H + (size_t)M * 4096 * 2 <= (size_t)268435456, "h overlay");

constexpr size_t O_Y = 0;
constexpr size_t O_LCP = (size_t)M * 1024;
constexpr size_t O_LHP = O_LCP + 2 * 8 * 3 * 512;
constexpr size_t O_SCP = O_LHP + 2 * 8 * 512;
constexpr size_t O_SRP = O_SCP + 2 * 8 * 2 * 512;
constexpr size_t O_SIP = O_SRP + 2 * 8 * 2048;
constexpr size_t O_LCS = O_SIP + 2 * 8 * 2048;
constexpr size_t O_LHS = O_LCS + 2 * 128 * 3 * 512;
constexpr size_t O_SCS = O_LHS + 2 * 128 * 512;
constexpr size_t O_SRS = O_SCS + 2 * 128 * 2 * 512;
constexpr size_t O_SIS = O_SRS + 2 * 128 * 2048;

struct Args { const float* in[36]; float* out; unsigned char* ws; };
typedef const __attribute__((address_space(4))) Args* AP;
__device__ __forceinline__ AP ld_args() {
#if defined(__HIP_DEVICE_COMPILE__)
    auto p = __builtin_amdgcn_kernarg_segment_ptr();
    asm volatile("" : "+s"(p));
    return (AP)p;
#else
    return nullptr;
#endif
}
enum { I_XP = 0, I_XS, I_SLC, I_SLH, I_SSC, I_SSR, I_SSI, I_WIN, I_CAW, I_CAB, I_GXW, I_GXB, I_GAW, I_GAB, I_LAM, I_CBW, I_SAR, I_SAI, I_SDT,
       I_SBR, I_SBI, I_SCR, I_SCI, I_SD, I_GLW, I_GLB, I_PA, I_PB, I_PC, I_WO, I_L1G, I_L1B, I_UP, I_DN, I_L2G, I_L2B };

__device__ __forceinline__ unsigned cvt_pk_bf16(float lo, float hi) { unsigned r; asm volatile("v_cvt_pk_bf16_f32 %0, %1, %2" : "=v"(r) : "v"(lo), "v"(hi)); return r; }
__device__ __forceinline__ bf16_t f2bf(float f) { return (bf16_t)(cvt_pk_bf16(f, 0.f) & 0xffffu); }
__device__ __forceinline__ float bf2f(unsigned short b) { return __uint_as_float(((unsigned)b) << 16); }
__device__ __forceinline__ float bflo(unsigned w) { return __uint_as_float(w << 16); }
__device__ __forceinline__ float bfhi(unsigned w) { return __uint_as_float(w & 0xffff0000u); }
__device__ __forceinline__ float sigm(float x) { return 1.0f / (1.0f + __expf(-x)); }
__device__ __forceinline__ float gelu_t(float x) { const float u = 0.7978845608f * (x + 0.044715f * x * x * x); return x / (1.0f + __expf(-2.0f * u)); }
__device__ __forceinline__ u32x4 pack8(const f32x4 a, const f32x4 b) { u32x4 w; w.x = cvt_pk_bf16(a[0], a[1]); w.y = cvt_pk_bf16(a[2], a[3]); w.z = cvt_pk_bf16(b[0], b[1]); w.w = cvt_pk_bf16(b[2], b[3]); return w; }
__device__ __forceinline__ void unpack8(const u32x4 w, float (&f)[8]) { f[0] = bflo(w.x); f[1] = bfhi(w.x); f[2] = bflo(w.y); f[3] = bfhi(w.y); f[4] = bflo(w.z); f[5] = bfhi(w.z); f[6] = bflo(w.w); f[7] = bfhi(w.w); }

__device__ __forceinline__ int otid(const int wv_) { int t = wv_ * 64 + (int)__builtin_amdgcn_mbcnt_hi(~0u, __builtin_amdgcn_mbcnt_lo(~0u, 0u)); asm volatile("" : "+v"(t)); return t; }
__device__ __forceinline__ float shx(float v, int mask, int lane) { return __int_as_float(__builtin_amdgcn_ds_bpermute((lane ^ mask) << 2, __float_as_int(v))); }

__device__ __forceinline__ int opq(int x) { asm volatile("" : "+s"(x)); return x; }

__device__ __forceinline__ void gbar(unsigned* ctr, unsigned target, const int wv_) {
    asm volatile("s_waitcnt vmcnt(0)" ::: "memory");
    __syncthreads();
    if (otid(wv_) == 0) {
        __builtin_amdgcn_fence(__ATOMIC_RELEASE, "agent");
        asm volatile("s_waitcnt vmcnt(0)" ::: "memory");
        __hip_atomic_fetch_add(ctr, 1u, __ATOMIC_RELAXED, __HIP_MEMORY_SCOPE_AGENT);
        while (__hip_atomic_load(ctr, __ATOMIC_RELAXED, __HIP_MEMORY_SCOPE_AGENT) < target) __builtin_amdgcn_s_sleep(1);
        __builtin_amdgcn_fence(__ATOMIC_ACQUIRE, "agent");
        asm volatile("s_waitcnt vmcnt(0)" ::: "memory");
    }
    __syncthreads();
}

constexpr int BM = 256, BK = 64, HALF = 128, HTB = HALF * BK * 2, STAGE_BYTES = 8 * HTB;
__device__ __forceinline__ int lds_byte(int r, int c) { const int st = (r >> 4) * 2 + (c >> 5), rr = r & 15, cc = c & 31, ob = rr * 64 + cc * 2; return st * 1024 + (ob ^ (((ob >> 9) & 1) << 5)); }
__device__ __forceinline__ void stage_rc(int b, int& R, int& C) { const int st = b / 1024, sb = b % 1024, swz = sb ^ (((sb >> 9) & 1) << 5); R = (st >> 1) * 16 + swz / 64; C = (st & 1) * 32 + (swz % 64) / 2; }
__device__ __forceinline__ int perm32(int rho) { const int n = rho >> 4, i = rho & 15; return 8 * (i >> 2) + 4 * n + (i & 3); }
struct Unit { int pm, pn, z; };
__device__ __forceinline__ void tile_map(int L, int nM, int nN, int& pm, int& pn) {
    const int nwg = nM * nN; int wgid = L;
    { const int q = nwg / 8, r = nwg % 8, xcd = wgid % 8, off = wgid / 8; wgid = (xcd < r ? xcd * (q + 1) : r * (q + 1) + (xcd - r) * q) + off; }
    const int nig = 8 * nN, gid = wgid / nig, fm = gid * 8, gsz = (nM - fm) < 8 ? (nM - fm) : 8;
    pm = fm + ((wgid % nig) % gsz); pn = (wgid % nig) / gsz;
}

template <class P>
__device__ __forceinline__ void gemm_phase(LAS unsigned char* lds, const P& p, const int wv_) {
    const int tid = otid(wv_), wid = __builtin_amdgcn_readfirstlane(tid >> 6), lane = tid & 63, wr = wid >> 2, wc = wid & 3, fr = lane & 15, fq = lane >> 4;
    unsigned voffA[2], voffB[2];
#pragma unroll
    for (int i = 0; i < 2; ++i) { int R, C; stage_rc(tid * 16 + i * 8192, R, C); const int Rb = P::PERM ? ((R & ~31) + perm32(R & 31)) : R;
        voffA[i] = (unsigned)(R * p.lda + C) * 2u; voffB[i] = (unsigned)(Rb * p.ldb + C) * 2u; }
    const size_t kstep = (size_t)(BK * 2);
    const size_t hA = (size_t)HALF * p.lda * 2, hB = (size_t)HALF * p.ldb * 2;
    const unsigned ldsw = (unsigned)wid * 1024u;
    const int aoff = lds_byte(wr * 64 + fr, fq * 8), boff = lds_byte(wc * 32 + fr, fq * 8);
#define PG8_SA(b, h) (((b) * 2 + (h)) * HTB)
#define PG8_SB(b, h) ((4 + (b) * 2 + (h)) * HTB)
#define PG8_STAGE(bufoff, gbase, voff) do { _Pragma("unroll") for (int _i = 0; _i < 2; ++_i) \
        __builtin_amdgcn_global_load_lds((const unsigned*)((const char*)(gbase) + (voff)[_i]), (LAS unsigned*)(lds + (bufoff) + ldsw + _i * 8192), 16, 0, 0); } while (0)
#define PG8_LDA(dst, b, h) do { _Pragma("unroll") for (int m = 0; m < 4; ++m) _Pragma("unroll") for (int k = 0; k < 2; ++k) dst[m][k] = *(const LAS bf16x8*)(lds + PG8_SA(b, h) + aoff + m * 2048 + k * 1024); } while (0)
#define PG8_LDB(dst, b, h) do { _Pragma("unroll") for (int n = 0; n < 2; ++n) _Pragma("unroll") for (int k = 0; k < 2; ++k) dst[n][k] = *(const LAS bf16x8*)(lds + PG8_SB(b, h) + boff + n * 2048 + k * 1024); } while (0)
#define PG8_MMA(ai, bj, At, Bt) do { __builtin_amdgcn_s_setprio(1); _Pragma("unroll") for (int m = 0; m < 4; ++m) _Pragma("unroll") for (int n = 0; n < 2; ++n) _Pragma("unroll") for (int k = 0; k < 2; ++k) \
        acc[ai][bj][m][n] = __builtin_amdgcn_mfma_f32_16x16x32_bf16(Bt[n][k], At[m][k], acc[ai][bj][m][n], 0, 0, 0); __builtin_amdgcn_s_setprio(0); } while (0)
#define PG8_WAIT_V(n) asm volatile("s_waitcnt vmcnt(" #n ")" ::: "memory")
#define PG8_WAIT_L(n) asm volatile("s_waitcnt lgkmcnt(" #n ")" ::: "memory")
#define PG8_BAR __builtin_amdgcn_s_barrier()
#define PG8_SCHED __builtin_amdgcn_sched_barrier(0)
    Unit cur, nxt; int ui = 0;
    if (!p.next(0, cur)) return;
    f32x4 acc[2][2][4][2];
#pragma unroll
    for (int a = 0; a < 2; ++a)
#pragma unroll
        for (int b = 0; b < 2; ++b)
#pragma unroll
            for (int m = 0; m < 4; ++m)
#pragma unroll
                for (int n = 0; n < 2; ++n) acc[a][b][m][n] = (f32x4){0.f, 0.f, 0.f, 0.f};
    bf16x8 At[4][2], B0[2][2], B1[2][2];
    const char* cA = p.aptr(cur); const char* cB = p.bptr(cur);
    PG8_STAGE(PG8_SB(0, 0), cB, voffB); PG8_STAGE(PG8_SA(0, 0), cA, voffA); PG8_STAGE(PG8_SB(0, 1), cB + hB, voffB); PG8_STAGE(PG8_SA(0, 1), cA + hA, voffA);
    if (wr == 1) PG8_BAR;
    PG8_WAIT_V(4); PG8_BAR;
    PG8_STAGE(PG8_SB(1, 0), cB + kstep, voffB); PG8_STAGE(PG8_SA(1, 0), cA + kstep, voffA); PG8_STAGE(PG8_SB(1, 1), cB + hB + kstep, voffB);
    PG8_WAIT_V(6); PG8_BAR;
    for (;;) {
        const bool has_next = p.next(ui + 1, nxt);
        const int nt = p.nt(cur);
        const char* nA = has_next ? p.aptr(nxt) : cA; const char* nB = has_next ? p.bptr(nxt) : cB;
        for (int t = 0; t < nt; t += 2) {
            const bool last = (t == nt - 2);
            const char* a1 = cA + (size_t)(t + 1) * kstep;
            const char* a2 = last ? nA : cA + (size_t)(t + 2) * kstep; const char* b2 = last ? nB : cB + (size_t)(t + 2) * kstep;
            const char* a3 = a2 + kstep; const char* b3 = b2 + kstep;
            PG8_LDB(B0, 0, 0); PG8_SCHED; PG8_LDA(At, 0, 0); PG8_STAGE(PG8_SA(1, 1), a1 + hA, voffA);
            PG8_WAIT_L(8); PG8_BAR; PG8_WAIT_L(0); PG8_MMA(0, 0, At, B0); PG8_BAR; PG8_SCHED;
            PG8_LDB(B1, 0, 1); PG8_STAGE(PG8_SB(0, 0), b2, voffB);
            PG8_BAR; PG8_WAIT_L(0); PG8_MMA(0, 1, At, B1); PG8_BAR;
            PG8_LDA(At, 0, 1); PG8_STAGE(PG8_SA(0, 0), a2, voffA);
            PG8_BAR; PG8_WAIT_L(0); PG8_MMA(1, 0, At, B0); PG8_BAR; PG8_SCHED;
            PG8_STAGE(PG8_SB(0, 1), b2 + hB, voffB);
            PG8_WAIT_V(6); PG8_BAR; PG8_MMA(1, 1, At, B1); PG8_BAR;
            PG8_LDB(B0, 1, 0); PG8_SCHED; PG8_LDA(At, 1, 0); PG8_STAGE(PG8_SA(0, 1), a2 + hA, voffA);
            PG8_WAIT_L(8); PG8_BAR; PG8_WAIT_L(0); PG8_MMA(0, 0, At, B0); PG8_BAR; PG8_SCHED;
            PG8_LDB(B1, 1, 1); PG8_STAGE(PG8_SB(1, 0), b3, voffB);
            PG8_BAR; PG8_WAIT_L(0); PG8_MMA(0, 1, At, B1); PG8_BAR;
            PG8_LDA(At, 1, 1); PG8_STAGE(PG8_SA(1, 0), a3, voffA);
            PG8_BAR; PG8_WAIT_L(0); PG8_MMA(1, 0, At, B0); PG8_BAR; PG8_SCHED;
            PG8_STAGE(PG8_SB(1, 1), b3 + hB, voffB);
            PG8_WAIT_V(6); PG8_BAR; PG8_MMA(1, 1, At, B1); PG8_BAR;
        }
        Unit eu = cur;
        asm volatile("" : "+s"(eu.pm), "+s"(eu.pn), "+s"(eu.z));
        const bool rst = p.epi(acc, eu, wr, wc, fr, fq);
        if (!has_next) break;
        if (rst) {
#pragma unroll
            for (int a = 0; a < 2; ++a)
#pragma unroll
                for (int b = 0; b < 2; ++b)
#pragma unroll
                    for (int m = 0; m < 4; ++m)
#pragma unroll
                        for (int n = 0; n < 2; ++n) acc[a][b][m][n] = (f32x4){0.f, 0.f, 0.f, 0.f};
        }
        cur = nxt; cA = nA; cB = nB; ++ui;
    }
    PG8_WAIT_V(0);
    if (wr == 0) PG8_BAR;
    PG8_BAR;
#undef PG8_SA
#undef PG8_SB
#undef PG8_STAGE
#undef PG8_LDA
#undef PG8_LDB
#undef PG8_MMA
#undef PG8_WAIT_V
#undef PG8_WAIT_L
#undef PG8_BAR
#undef PG8_SCHED
}
typedef f32x4 Acc[2][2][4][2];

struct PG1 {
    __device__ __forceinline__ int nt(const Unit&) const { return K / BK; }
    static constexpr bool PERM = true;
    int K, lda, ldb, G, c;
    const bf16_t* A; const bf16_t* Bt;
    bf16_t *xa, *ya, *sb, *sc, *sh, *apack, *uss; unsigned char* gl8;
    __device__ __forceinline__ bool next(int i, Unit& u) const { const long L = (long)i * G + c; if (L >= 66 * 24) return false; tile_map((int)L, 66, 24, u.pm, u.pn); u.z = 0; return true; }
    __device__ __forceinline__ const char* aptr(const Unit& u) const { return (const char*)A + (size_t)u.pm * 256 * 1024 * 2; }
    __device__ __forceinline__ const char* bptr(const Unit& u) const { return (const char*)Bt + (size_t)u.pn * 256 * 1024 * 2; }
    __device__ __forceinline__ bool epi(Acc& acc, const Unit& u, int wr, int wc, int fr, int fq) const {
        const int pn = u.pn;
        if (pn < 10) {
            const int b = pn >> 1; bf16_t* base = b == 0 ? xa : b == 1 ? ya : b == 2 ? sb : b == 3 ? sc : sh;
#pragma unroll
            for (int ai = 0; ai < 2; ++ai)
#pragma unroll
                for (int m = 0; m < 4; ++m) { const size_t r = (size_t)u.pm * 256 + ai * 128 + wr * 64 + m * 16 + fr;
#pragma unroll
                    for (int bj = 0; bj < 2; ++bj) { const int col = (pn & 1) * 256 + bj * 128 + wc * 32 + 8 * fq;
                        *(u32x4*)(base + r * 512 + col) = pack8(acc[ai][bj][m][0], acc[ai][bj][m][1]); } }
        } else if (pn < 12) {
#pragma unroll
            for (int ai = 0; ai < 2; ++ai)
#pragma unroll
                for (int m = 0; m < 4; ++m) { const int r = u.pm * 256 + ai * 128 + wr * 64 + m * 16 + fr;
#pragma unroll
                    for (int bj = 0; bj < 2; ++bj) { const int cc = (pn - 10) * 256 + bj * 128 + wc * 32 + 8 * fq;
                        bf16_t* dst = (u.pm < 64) ? apack + ((size_t)((cc >> 4) * 1024 + (r >> 4)) * 384 + 128 + (r & 15) * 16 + (cc & 15)) : uss + (size_t)(r - MP) * 512 + cc;
                        *(u32x4*)dst = pack8(acc[ai][bj][m][0], acc[ai][bj][m][1]); } }
        } else {
            unsigned char* blk = gl8 + ((size_t)(u.pm * 12 + (pn - 12)) << 16) + (size_t)(((wr * 4 + wc) * 64 + fq * 16 + fr) * 128);
#pragma unroll
            for (int ai = 0; ai < 2; ++ai)
#pragma unroll
                for (int m = 0; m < 4; ++m) { u32x4 w;
#pragma unroll
                    for (int bj = 0; bj < 2; ++bj)
#pragma unroll
                        for (int n = 0; n < 2; ++n) { unsigned pk = 0;
#pragma unroll
                            for (int j = 0; j < 4; ++j) { int v = (int)(sigm(acc[ai][bj][m][n][j]) * 256.0f); v = v < 0 ? 0 : (v > 255 ? 255 : v); pk |= (unsigned)v << (8 * j); }
                            w[bj * 2 + n] = pk; }
                    *(u32x4*)(blk + (ai * 4 + m) * 16) = w; }
        }
        return true;
    }
};

struct PGate {
    __device__ __forceinline__ int nt(const Unit&) const { return K / BK; }
    static constexpr bool PERM = true;
    int K, lda, ldb, G, c;
    const bf16_t* A; const bf16_t* Bt;
    const float *gxb, *gab, *lam; _Float16* aout; bf16_t* bxout;
    __device__ __forceinline__ bool next(int i, Unit& u) const { const long L = (long)i * G + c; if (L >= 66 * 4) return false; tile_map((int)L, 66, 4, u.pm, u.pn); u.z = 0; return true; }
    __device__ __forceinline__ const char* aptr(const Unit& u) const { return (const char*)A + (size_t)u.pm * 256 * 512 * 2 + (size_t)(u.pn >> 1) * 512; }
    __device__ __forceinline__ const char* bptr(const Unit& u) const { return (const char*)Bt + (size_t)u.pn * 256 * 256 * 2; }
    __device__ __forceinline__ bool epi(Acc& acc, const Unit& u, int wr, int wc, int fr, int fq) const {
        typedef _Float16 h8 __attribute__((ext_vector_type(8)));
        const int ch0 = u.pn * 128 + wc * 32 + 8 * fq;
        float bxv[8], bav[8], kk[8];
#pragma unroll
        for (int j = 0; j < 8; ++j) { bxv[j] = gxb[ch0 + j]; bav[j] = gab[ch0 + j]; kk[j] = -8.0f * log1pf(expf(-lam[ch0 + j])); }
#pragma unroll
        for (int ai = 0; ai < 2; ++ai)
#pragma unroll
            for (int m = 0; m < 4; ++m) { const size_t r = (size_t)u.pm * 256 + ai * 128 + wr * 64 + m * 16 + fr;
                float xc[8]; unpack8(*(const u32x4*)(A + r * 512 + ch0), xc);
                h8 lav; f32x4 b0, b1;
#pragma unroll
                for (int j = 0; j < 8; ++j) { const float px = acc[ai][0][m][j >> 2][j & 3], pa = acc[ai][1][m][j >> 2][j & 3];
                    const float gx = sigm(px + bxv[j]), ga = sigm(pa + bav[j]);
                    const float la = kk[j] * ga, av = __expf(la); lav[j] = (_Float16)la;
                    const float bv = __builtin_amdgcn_sqrtf(fmaxf(1.0f - av * av, 0.f)) * gx * xc[j];
                    if (j < 4) b0[j] = bv; else b1[j - 4] = bv; }
                *(h8*)(aout + r * 512 + ch0) = lav;
                *(u32x4*)(bxout + r * 512 + ch0) = pack8(b0, b1); }
        return true;
    }
};

struct PY {
    __device__ __forceinline__ int nt(const Unit&) const { return K / BK; }
    static constexpr bool PERM = true;
    int K, lda, ldb, G, c;
    const bf16_t* apack; const bf16_t* wyt; const float* dvec; bf16_t* zc;
    __device__ __forceinline__ bool next(int i, Unit& u) const { const long L = (long)i * G + c; if (L >= 128) return false; u.pm = (int)L; u.pn = (int)L >> 2; u.z = 0; return true; }
    __device__ __forceinline__ const char* aptr(const Unit& u) const { return (const char*)apack + (size_t)u.pm * 256 * 384 * 2; }
    __device__ __forceinline__ const char* bptr(const Unit& u) const { return (const char*)wyt + (size_t)u.pn * 256 * 384 * 2; }
    __device__ __forceinline__ bool epi(Acc& acc, const Unit& u, int wr, int wc, int fr, int fq) const {
        const int g = u.pn;
#pragma unroll
        for (int bj = 0; bj < 2; ++bj) {
            const int n0 = bj * 128 + wc * 32 + 8 * fq, ti = n0 >> 4, c0 = n0 & 15;
            const f32x4 d0 = *(const f32x4*)(dvec + g * 16 + c0), d1 = *(const f32x4*)(dvec + g * 16 + c0 + 4);
#pragma unroll
            for (int ai = 0; ai < 2; ++ai)
#pragma unroll
                for (int m = 0; m < 4; ++m) { const int rr = (u.pm & 3) * 256 + ai * 128 + wr * 64 + m * 16 + fr;
                    const u32x4 uw = *(const u32x4*)(apack + ((size_t)(g * 1024 + rr) * 384 + 128 + n0));
                    float uf[8]; unpack8(uw, uf);
                    f32x4 y0, y1;
#pragma unroll
                    for (int j = 0; j < 4; ++j) { y0[j] = gelu_t(acc[ai][bj][m][0][j] + d0[j] * uf[j]); y1[j] = gelu_t(acc[ai][bj][m][1][j] + d1[j] * uf[4 + j]); }
                    const size_t tok = (size_t)(rr >> 7) * 2048 + (rr & 127) * 16 + ti;
                    *(u32x4*)(zc + tok * 512 + g * 16 + c0) = pack8(y0, y1); }
        }
        return true;
    }
};

struct PGlu {
    __device__ __forceinline__ int nt(const Unit&) const { return K / BK; }
    static constexpr bool PERM = true;
    int K, lda, ldb, G, c, sample;
    const bf16_t* A; const bf16_t* As; const bf16_t* Bt; const float* bias; bf16_t* out;
    __device__ __forceinline__ bool next(int i, Unit& u) const {
        if (sample) { const int j = c - 128; if (i != 0 || j < 0 || j >= 4) return false; u.pm = 64 + (j >> 1); u.pn = j & 1; u.z = 0; return true; }
        const long L = (long)i * G + c; if (L >= 64 * 2) return false; tile_map((int)L, 64, 2, u.pm, u.pn); u.z = 0; return true; }
    __device__ __forceinline__ const bf16_t* arow0(const Unit& u) const { return u.pm < 64 ? A + (size_t)u.pm * 256 * 512 : As + (size_t)(u.pm - 64) * 256 * 512; }
    __device__ __forceinline__ const char* aptr(const Unit& u) const { return (const char*)arow0(u); }
    __device__ __forceinline__ const char* bptr(const Unit& u) const { return (const char*)Bt + (size_t)u.pn * 256 * 512 * 2; }
    __device__ __forceinline__ bool epi(Acc& acc, const Unit& u, int wr, int wc, int fr, int fq) const {
        const bf16_t* zsrc = arow0(u);
#pragma unroll
        for (int bj = 0; bj < 2; ++bj) {
            const int col = u.pn * 256 + bj * 128 + wc * 32 + 8 * fq;
            const f32x4 b0 = *(const f32x4*)(bias + col), b1 = *(const f32x4*)(bias + col + 4);
#pragma unroll
            for (int ai = 0; ai < 2; ++ai)
#pragma unroll
                for (int m = 0; m < 4; ++m) { const int rl = ai * 128 + wr * 64 + m * 16 + fr; const size_t r = (size_t)u.pm * 256 + rl;
                    const u32x4 zw = *(const u32x4*)(zsrc + (size_t)rl * 512 + col); float zf[8]; unpack8(zw, zf);
                    f32x4 y0, y1;
#pragma unroll
                    for (int j = 0; j < 4; ++j) { y0[j] = zf[j] * sigm(acc[ai][bj][m][0][j] + b0[j]); y1[j] = zf[4 + j] * sigm(acc[ai][bj][m][1][j] + b1[j]); }
                    *(u32x4*)(out + r * 512 + col) = pack8(y0, y1); }
        }
        return true;
    }
};

template <bool SAMPLE> struct PMergeT {
    __device__ __forceinline__ int nt(const Unit&) const { return K / BK; }
    static constexpr bool PERM = true;
    int K, lda, ldb, G, c;
    const bf16_t* a0; const bf16_t* wp; const unsigned char* gl8; bf16_t* mb; float* pm3;
    __device__ __forceinline__ bool next(int i, Unit& u) const { const int ti = i / 3;
        if (SAMPLE) { const int j = c - (G - 24); if (i != 0 || j < 0) return false; const int t = j / 3; u.pm = 64 + (t >> 2); u.pn = t & 3; u.z = j - t * 3; return true; }
        const long L = (long)ti * G + c; if (L >= 64 * 4) return false; tile_map((int)L, 64, 4, u.pm, u.pn); u.z = i - ti * 3; return true; }
    __device__ __forceinline__ const char* aptr(const Unit& u) const { const size_t off = (u.z == 2) ? (OFF_XB + S17 - OFF_R) : (size_t)u.z * S17; return (const char*)a0 + off + (size_t)u.pm * 256 * 512 * 2; }
    __device__ __forceinline__ const char* bptr(const Unit& u) const { return (const char*)wp + ((size_t)u.z * 1024 + (size_t)u.pn * 256) * 512 * 2; }
    __device__ __forceinline__ bool epi(Acc& acc, const Unit& u, int wr, int wc, int fr, int fq) const {
        const int br = u.z;
        const unsigned char* blk = gl8 + ((size_t)(u.pm * 12 + br * 4 + u.pn) << 16) + (size_t)(((wr * 4 + wc) * 64 + fq * 16 + fr) * 128);
#pragma unroll
        for (int ai = 0; ai < 2; ++ai)
#pragma unroll
            for (int m = 0; m < 4; ++m) { const size_t r = (size_t)u.pm * 256 + ai * 128 + wr * 64 + m * 16 + fr;
                const u32x4 qc = *(const u32x4*)(blk + (ai * 4 + m) * 16);
                if (SAMPLE) {
#pragma unroll
                    for (int bj = 0; bj < 2; ++bj) { const int col = u.pn * 256 + bj * 128 + wc * 32 + 8 * fq;
                        f32x4 y0, y1;
#pragma unroll
                        for (int j = 0; j < 4; ++j) {
                            y0[j] = acc[ai][bj][m][0][j] * (((float)((qc[bj * 2] >> (8 * j)) & 255u) + 0.5f) * (1.0f / 256.0f));
                            y1[j] = acc[ai][bj][m][1][j] * (((float)((qc[bj * 2 + 1] >> (8 * j)) & 255u) + 0.5f) * (1.0f / 256.0f)); }
                        float* pp = pm3 + (size_t)br * PART_STRIDE + (r - MP) * 1024 + col; *(f32x4*)pp = y0; *(f32x4*)(pp + 4) = y1; }
                } else if (br < 2) {
                    const u32x4 qn = *(const u32x4*)(blk + 4 * 65536 + (ai * 4 + m) * 16);
#pragma unroll
                    for (int bj = 0; bj < 2; ++bj)
#pragma unroll
                        for (int n = 0; n < 2; ++n)
#pragma unroll
                            for (int j = 0; j < 4; ++j) { const float gc = (float)((qc[bj * 2 + n] >> (8 * j)) & 255u) + 0.5f, gn = (float)((qn[bj * 2 + n] >> (8 * j)) & 255u) + 0.5f;
                                acc[ai][bj][m][n][j] *= gc * __builtin_amdgcn_rcpf(gn); }
                } else {
#pragma unroll
                    for (int bj = 0; bj < 2; ++bj) { const int col = u.pn * 256 + bj * 128 + wc * 32 + 8 * fq;
                        f32x4 y0, y1;
#pragma unroll
                        for (int j = 0; j < 4; ++j) {
                            y0[j] = acc[ai][bj][m][0][j] * (((float)((qc[bj * 2] >> (8 * j)) & 255u) + 0.5f) * (1.0f / 256.0f));
                            y1[j] = acc[ai][bj][m][1][j] * (((float)((qc[bj * 2 + 1] >> (8 * j)) & 255u) + 0.5f) * (1.0f / 256.0f)); }
                        *(u32x4*)(mb + r * 1024 + col) = pack8(y0, y1); }
                } }
        return SAMPLE || br == 2;
    }
};

struct PWout {
    static constexpr bool PERM = true;
    int K, lda, ldb, G, c;
    const bf16_t* A; const bf16_t* Bt; bf16_t* T; float* R; float* part;
    __device__ __forceinline__ int nt(const Unit& u) const { return u.z < 0 ? 16 : 4; }
    __device__ __forceinline__ bool next(int i, Unit& u) const {
        const int nP = c < 256 ? (256 - c + G - 1) / G : 0;
        if (i < nP) { tile_map(i * G + c, 64, 4, u.pm, u.pn); u.z = -1; return true; }
        const int j = (i - nP) * G + c; if (j >= 32) return false;
        u.pm = 64 + (j >> 4); u.pn = (j >> 2) & 3; u.z = j & 3; return true; }
    __device__ __forceinline__ const char* aptr(const Unit& u) const { return (const char*)A + (size_t)u.pm * 256 * 1024 * 2 + (u.z < 0 ? 0 : u.z * 512); }
    __device__ __forceinline__ const char* bptr(const Unit& u) const { return (const char*)Bt + (size_t)u.pn * 256 * 1024 * 2 + (u.z < 0 ? 0 : u.z * 512); }
    __device__ __forceinline__ bool epi(Acc& acc, const Unit& u, int wr, int wc, int fr, int fq) const {
#pragma unroll
        for (int ai = 0; ai < 2; ++ai)
#pragma unroll
            for (int m = 0; m < 4; ++m) { const size_t r = (size_t)u.pm * 256 + ai * 128 + wr * 64 + m * 16 + fr;
#pragma unroll
                for (int bj = 0; bj < 2; ++bj) { const int col = u.pn * 256 + bj * 128 + wc * 32 + 8 * fq;
                    if (u.z < 0) *(u32x4*)(T + r * 1024 + col) = pack8(acc[ai][bj][m][0], acc[ai][bj][m][1]);
                    else { float* pp = (u.z == 0) ? R + r * 1024 + col : part + (size_t)(u.z - 1) * PART_STRIDE + (r - MP) * 1024 + col;
                        *(f32x4*)pp = acc[ai][bj][m][0]; *(f32x4*)(pp + 4) = acc[ai][bj][m][1]; } } }
        return true;
    }
};

struct PUp {
    __device__ __forceinline__ int nt(const Unit&) const { return K / BK; }
    static constexpr bool PERM = true;
    int K, lda, ldb, G, c;
    const bf16_t* A; const bf16_t* Bt; bf16_t* h;
    __device__ __forceinline__ bool next(int i, Unit& u) const { const long L = (long)i * G + c; if (L >= 66 * 16) return false; tile_map((int)L, 66, 16, u.pm, u.pn); u.z = 0; return true; }
    __device__ __forceinline__ const char* aptr(const Unit& u) const { return (const char*)A + (size_t)u.pm * 256 * 1024 * 2; }
    __device__ __forceinline__ const char* bptr(const Unit& u) const { return (const char*)Bt + (size_t)u.pn * 256 * 1024 * 2; }
    __device__ __forceinline__ bool epi(Acc& acc, const Unit& u, int wr, int wc, int fr, int fq) const {
#pragma unroll
        for (int ai = 0; ai < 2; ++ai)
#pragma unroll
            for (int m = 0; m < 4; ++m) { const size_t r = (size_t)u.pm * 256 + ai * 128 + wr * 64 + m * 16 + fr;
#pragma unroll
                for (int bj = 0; bj < 2; ++bj) { const int col = u.pn * 256 + bj * 128 + wc * 32 + 8 * fq;
                    f32x4 y0, y1;
#pragma unroll
                    for (int j = 0; j < 4; ++j) { const float v0 = fmaxf(acc[ai][bj][m][0][j], 0.f), v1 = fmaxf(acc[ai][bj][m][1][j], 0.f); y0[j] = v0 * v0; y1[j] = v1 * v1; }
                    *(u32x4*)(h + r * 4096 + col) = pack8(y0, y1); } }
        return true;
    }
};

struct PDown {
    static constexpr bool PERM = true;
    int K, lda, ldb, G, c;
    const bf16_t* A; const bf16_t* Bt; bf16_t* T; float* R; float* part;
    __device__ __forceinline__ int nt(const Unit& u) const { return u.z < 0 ? 64 : 16; }
    __device__ __forceinline__ bool next(int i, Unit& u) const {
        const int nP = c < 256 ? (256 - c + G - 1) / G : 0;
        if (i < nP) { tile_map(i * G + c, 64, 4, u.pm, u.pn); u.z = -1; return true; }
        const int j = (i - nP) * G + c; if (j >= 32) return false;
        u.pm = 64 + (j >> 4); u.pn = (j >> 2) & 3; u.z = j & 3; return true; }
    __device__ __forceinline__ const char* aptr(const Unit& u) const { return (const char*)A + (size_t)u.pm * 256 * 4096 * 2 + (u.z < 0 ? 0 : u.z * 2048); }
    __device__ __forceinline__ const char* bptr(const Unit& u) const { return (const char*)Bt + (size_t)u.pn * 256 * 4096 * 2 + (u.z < 0 ? 0 : u.z * 2048); }
    __device__ __forceinline__ bool epi(Acc& acc, const Unit& u, int wr, int wc, int fr, int fq) const {
#pragma unroll
        for (int ai = 0; ai < 2; ++ai)
#pragma unroll
            for (int m = 0; m < 4; ++m) { const size_t r = (size_t)u.pm * 256 + ai * 128 + wr * 64 + m * 16 + fr;
#pragma unroll
                for (int bj = 0; bj < 2; ++bj) { const int col = u.pn * 256 + bj * 128 + wc * 32 + 8 * fq;
                    if (u.z < 0) *(u32x4*)(T + r * 1024 + col) = pack8(acc[ai][bj][m][0], acc[ai][bj][m][1]);
                    else { float* pp = (u.z == 0) ? R + r * 1024 + col : part + (size_t)(u.z - 1) * PART_STRIDE + (r - MP) * 1024 + col;
                        *(f32x4*)pp = acc[ai][bj][m][0]; *(f32x4*)(pp + 4) = acc[ai][bj][m][1]; } } }
        return true;
    }
};

struct TJob { const float* W; bf16_t* Wt; int K, N, tk, tn4; };
__device__ __forceinline__ TJob tjob(AP a, int layer, int t) {
    unsigned char* ws = a->ws; TJob j; int tt;
    if (t < 384) { tt = t; j.W = a->in[I_WIN] + (size_t)layer * 1024 * 6144; j.Wt = (bf16_t*)(ws + OFF_WIN); j.K = 1024; j.N = 6144; }
    else if (t < 480) { const int q = (t - 384) / 32; tt = (t - 384) % 32; j.W = a->in[I_PA + q] + (size_t)layer * 512 * 1024; j.Wt = (bf16_t*)(ws + OFF_WP) + (size_t)q * 1024 * 512; j.K = 512; j.N = 1024; }
    else if (t < 496) { tt = t - 480; j.W = a->in[I_GLW] + (size_t)layer * 512 * 512; j.Wt = (bf16_t*)(ws + OFF_WGLU); j.K = 512; j.N = 512; }
    else if (t < 560) { tt = t - 496; j.W = a->in[I_WO] + (size_t)layer * 1024 * 1024; j.Wt = (bf16_t*)(ws + OFF_WOUT); j.K = 1024; j.N = 1024; }
    else if (t < 816) { tt = t - 560; j.W = a->in[I_UP] + (size_t)layer * 1024 * 4096; j.Wt = (bf16_t*)(ws + OFF_WUP); j.K = 1024; j.N = 4096; }
    else { tt = t - 816; j.W = a->in[I_DN] + (size_t)layer * 4096 * 1024; j.Wt = (bf16_t*)(ws + OFF_WDOWN); j.K = 4096; j.N = 1024; }
    const int ntn = j.N / 256; j.tk = tt / ntn; j.tn4 = tt % ntn; return j;
}
__device__ __forceinline__ void tload(const TJob& j, int tid, f32x4 (&v)[4][2]) {
    const int r = tid >> 3, c8 = (tid & 7) * 8; const float* src = j.W + (size_t)(j.tk * 64 + r) * j.N + j.tn4 * 256 + c8;
#pragma unroll
    for (int q = 0; q < 4; ++q) { v[q][0] = *(const f32x4*)(src + q * 64); v[q][1] = *(const f32x4*)(src + q * 64 + 4); }
}

__device__ __forceinline__ void abar_pow(const float* are, const float* aim, const float* ldt, int sp, float e, float& pr, float& pi) {
    const float step = expf(ldt[sp]); const float x = e * step * are[sp], th = e * step * aim[sp];
    float s, c; sincosf(th, &s, &c); const float mg = expf(x); pr = mg * c; pi = mg * s;
}
__device__ __forceinline__ void ssm_coef(const float* are, const float* aim, const float* ldt, int sp, float& cr, float& ci) {
    const float step = expf(ldt[sp]); const float ar = are[sp], ai = aim[sp];
    const float x = step * ar, th = step * ai;
    float s, c; sincosf(th, &s, &c); const float em1 = expm1f(x); const float sh = sinf(0.5f * th);
    const float nr = em1 * c - 2.0f * sh * sh, ni = (em1 + 1.0f) * s;
    const float den = ar * ar + ai * ai;
    cr = (nr * ar + ni * ai) / den; ci = (ni * ar - nr * ai) / den;
}

__device__ __forceinline__ void prep_layer(AP a, int layer, float* sm, const int wv_) {
    unsigned char* ws = a->ws;
    const int G = gridDim.x;
    {
        const int tid = otid(wv_), r = tid >> 3, c8 = (tid & 7) * 8, n = tid >> 3, k8 = (tid & 7) * 8;
        int t = blockIdx.x; f32x4 v[4][2]; TJob j;
        if (t < 1072) { j = tjob(a, layer, t); tload(j, tid, v); }
        while (t < 1072) {
#pragma unroll
            for (int q = 0; q < 4; ++q)
#pragma unroll
                for (int e = 0; e < 4; ++e) { sm[q * 4160 + r * 65 + c8 + e] = v[q][0][e]; sm[q * 4160 + r * 65 + c8 + 4 + e] = v[q][1][e]; }
            __syncthreads();
            const TJob cj = j; const int tn = t + G;
            if (tn < 1072) { j = tjob(a, layer, tn); tload(j, tid, v); }
#pragma unroll
            for (int q = 0; q < 4; ++q) { const float* tt = sm + q * 4160;
                u32x4 w;
                w.x = cvt_pk_bf16(tt[(k8 + 0) * 65 + n], tt[(k8 + 1) * 65 + n]); w.y = cvt_pk_bf16(tt[(k8 + 2) * 65 + n], tt[(k8 + 3) * 65 + n]);
                w.z = cvt_pk_bf16(tt[(k8 + 4) * 65 + n], tt[(k8 + 5) * 65 + n]); w.w = cvt_pk_bf16(tt[(k8 + 6) * 65 + n], tt[(k8 + 7) * 65 + n]);
                *(u32x4*)(cj.Wt + (size_t)(cj.tn4 * 256 + q * 64 + n) * cj.K + cj.tk * 64 + k8) = w; }
            __syncthreads();
            t = tn;
        }
    }
    const int GT = G * NTHR;
    {
        bf16_t* wg = (bf16_t*)(ws + OFF_WGATE);
        for (int idx = blockIdx.x * NTHR + otid(wv_); idx < 1024 * 32; idx += GT) {
            const int n = idx >> 5, k0 = (idx & 31) * 8; const int pn = n >> 8, bj = (n >> 7) & 1, ch = pn * 128 + (n & 127), hd = ch >> 6, j = ch & 63;
            u32x4 w = (u32x4){0u, 0u, 0u, 0u};
            if ((pn >> 1) * 4 + (k0 >> 6) == hd) { const float* src = a->in[bj ? I_GAW : I_GXW] + (size_t)layer * 8 * 64 * 64 + (size_t)hd * 4096 + (size_t)(k0 & 63) * 64 + j;
                w.x = cvt_pk_bf16(src[0], src[64]); w.y = cvt_pk_bf16(src[128], src[192]); w.z = cvt_pk_bf16(src[256], src[320]); w.w = cvt_pk_bf16(src[384], src[448]); }
            *(u32x4*)(wg + (size_t)n * 256 + k0) = w;
        }
    }
    const float* are = a->in[I_SAR] + layer * 2048; const float* aim = a->in[I_SAI] + layer * 2048; const float* ldt = a->in[I_SDT] + layer * 2048;
    const float* bre = a->in[I_SBR] + layer * 32768; const float* bim = a->in[I_SBI] + layer * 32768;
    const float* cre = a->in[I_SCR] + layer * 32768; const float* cim = a->in[I_SCI] + layer * 32768;
    {
        bf16_t* w1 = (bf16_t*)(ws + OFF_W1T);
        for (int idx = blockIdx.x * NTHR + otid(wv_); idx < 32 * 128 * 32; idx += GT) {
            const int g = idx >> 12, n = (idx >> 5) & 127, k0 = (idx & 31) * 8, j = k0 >> 4, c0 = k0 & 15, p = n & 63, part = n >> 6, sp = g * 64 + p;
            float pr, pi, cr, ci; abar_pow(are, aim, ldt, sp, (float)(15 - j), pr, pi); ssm_coef(are, aim, ldt, sp, cr, ci);
            const float qr = pr * cr - pi * ci, qi = pr * ci + pi * cr;
            float o[8];
#pragma unroll
            for (int q = 0; q < 8; ++q) { const float br = bre[sp * 16 + c0 + q], bi = bim[sp * 16 + c0 + q]; o[q] = part ? (qr * bi + qi * br) : (qr * br - qi * bi); }
            u32x4 w; w.x = cvt_pk_bf16(o[0], o[1]); w.y = cvt_pk_bf16(o[2], o[3]); w.z = cvt_pk_bf16(o[4], o[5]); w.w = cvt_pk_bf16(o[6], o[7]);
            *(u32x4*)(w1 + ((size_t)(g * 128 + n) * 256 + k0)) = w;
        }
    }
    {
        bf16_t* wy = (bf16_t*)(ws + OFF_WYT);
        for (int idx = blockIdx.x * NTHR + otid(wv_); idx < 32 * 256 * 16; idx += GT) {
            const int g = idx >> 12, n = (idx >> 4) & 255, k0 = (idx & 15) * 8, i = n >> 4, c = n & 15, part = k0 >> 6, p0 = k0 & 63;
            float o[8];
#pragma unroll
            for (int q = 0; q < 8; ++q) { const int p = p0 + q, sp = g * 64 + p; float pr, pi; abar_pow(are, aim, ldt, sp, (float)(i + 1), pr, pi);
                const float xr = cre[(g * 16 + c) * 64 + p], xi = cim[(g * 16 + c) * 64 + p];
                o[q] = part ? -(xr * pi + xi * pr) : (xr * pr - xi * pi); }
            u32x4 w; w.x = cvt_pk_bf16(o[0], o[1]); w.y = cvt_pk_bf16(o[2], o[3]); w.z = cvt_pk_bf16(o[4], o[5]); w.w = cvt_pk_bf16(o[6], o[7]);
            *(u32x4*)(wy + ((size_t)(g * 256 + n) * 384 + k0)) = w;
        }
        for (int idx = blockIdx.x * NTHR + otid(wv_); idx < 32 * 256 * 4; idx += GT) {
            const int pq = idx & 3, c2 = (idx >> 2) & 15, c = (idx >> 6) & 15, g = idx >> 10;
            float km[16];
#pragma unroll
            for (int d = 0; d < 16; ++d) km[d] = 0.f;
            for (int pp = 0; pp < 16; ++pp) { const int p = pq * 16 + pp, sp = g * 64 + p; float ar, ai, cr, ci; abar_pow(are, aim, ldt, sp, 1.0f, ar, ai); ssm_coef(are, aim, ldt, sp, cr, ci);
                const float br = bre[sp * 16 + c2], bi = bim[sp * 16 + c2];
                const float bbr = cr * br - ci * bi, bbi = cr * bi + ci * br;
                const float xr = cre[(g * 16 + c) * 64 + p], xi = cim[(g * 16 + c) * 64 + p];
                float tr = xr * bbr - xi * bbi, ti = xr * bbi + xi * bbr;
#pragma unroll
                for (int d = 0; d < 16; ++d) { km[d] += tr; const float nr = tr * ar - ti * ai, ni = tr * ai + ti * ar; tr = nr; ti = ni; } }
            { const int ln = idx & 63;
#pragma unroll
            for (int d = 0; d < 16; ++d) { km[d] += shx(km[d], 1, ln); km[d] += shx(km[d], 2, ln); } }
#pragma unroll
            for (int d = 0; d < 16; ++d) if ((d & 3) == pq) { const bf16_t kb = f2bf(km[d]);
                for (int i = d; i < 16; ++i) wy[(size_t)(g * 256 + i * 16 + c) * 384 + 128 + (i - d) * 16 + c2] = kb;
                if (d > 0) for (int i = 0; i < 16 - d; ++i) wy[(size_t)(g * 256 + i * 16 + c) * 384 + 128 + (i + d) * 16 + c2] = (bf16_t)0; }
        }
    }
}

__device__ __forceinline__ void prep_x(AP a, const int wv_) {
    bf16_t* xb = (bf16_t*)(a->ws + OFF_XB);
    const int gt = blockIdx.x * NTHR + otid(wv_), GT = gridDim.x * NTHR;
    for (int idx = gt; idx < M * 128; idx += GT) {
        const size_t e = (size_t)idx * 8; const float* src = e < (size_t)MP * 1024 ? a->in[I_XP] + e : a->in[I_XS] + (e - (size_t)MP * 1024);
        const f32x4 v0 = *(const f32x4*)src, v1 = *(const f32x4*)(src + 4);
        *(u32x4*)(xb + e) = pack8(v0, v1);
    }
}

__device__ __forceinline__ void conv_phase(AP a, int layer, bf16_t* bin_out, const int wv_) {
    unsigned char* ws = a->ws;
    const bf16_t* xa = (const bf16_t*)(ws + OFF_R); bf16_t* sb = (bf16_t*)(ws + OFF_R + S17);
    const bf16_t* sc = (const bf16_t*)(ws + OFF_R + 2 * S17); const bf16_t* sh = (const bf16_t*)(ws + OFF_R + 3 * S17);
    bf16_t* xac = (bf16_t*)(ws + OFF_XB);
    const float* caw = a->in[I_CAW] + layer * 4 * 512; const float* cab = a->in[I_CAB] + layer * 512; const float* cbw = a->in[I_CBW] + layer * 3 * 512;
    const int gt = blockIdx.x * NTHR + otid(wv_), GT = gridDim.x * NTHR;
    for (int it = gt; it < (2048 + 128) * 64; it += GT) {
        const int idx = it < 128 * 64 ? it + 2048 * 64 : it - 128 * 64;
        const int seg = idx >> 6, c0 = (idx & 63) * 8;
        const bool prompt = seg < 2048;
        int row0, nrows;
        float x0[8], x1[8], x2[8], u1[8], u2[8];
        if (prompt) { row0 = seg * 8; nrows = 8; const bool first = (seg & 255) == 0;
            if (first) {
#pragma unroll
                for (int j = 0; j < 8; ++j) { x0[j] = 0.f; x1[j] = 0.f; x2[j] = 0.f; u1[j] = 0.f; u2[j] = 0.f; }
            } else {
                unpack8(*(const u32x4*)(xa + (size_t)(row0 - 3) * 512 + c0), x0); unpack8(*(const u32x4*)(xa + (size_t)(row0 - 2) * 512 + c0), x1); unpack8(*(const u32x4*)(xa + (size_t)(row0 - 1) * 512 + c0), x2);
                float s1[8], s2[8];
                unpack8(*(const u32x4*)(sc + (size_t)(row0 - 2) * 512 + c0), u1); unpack8(*(const u32x4*)(sh + (size_t)(row0 - 2) * 512 + c0), s1);
                unpack8(*(const u32x4*)(sc + (size_t)(row0 - 1) * 512 + c0), u2); unpack8(*(const u32x4*)(sh + (size_t)(row0 - 1) * 512 + c0), s2);
#pragma unroll
                for (int j = 0; j < 8; ++j) { u1[j] *= s1[j]; u2[j] *= s2[j]; }
            }
        } else { const int b = seg - 2048; row0 = MP + b * 4; nrows = 4;
            const float* lc = a->in[I_SLC] + ((size_t)(layer * 128 + b) * 3) * 512 + c0; const float* scs = a->in[I_SSC] + ((size_t)(layer * 128 + b) * 2) * 512 + c0;
#pragma unroll
            for (int j = 0; j < 8; ++j) { x0[j] = lc[j]; x1[j] = lc[512 + j]; x2[j] = lc[1024 + j]; u1[j] = scs[j]; u2[j] = scs[512 + j]; }
        }
        float w0[8], w1[8], w2[8], w3[8], wb[8], v0[8], v1[8], v2[8];
#pragma unroll
        for (int j = 0; j < 8; ++j) { w0[j] = caw[c0 + j]; w1[j] = caw[512 + c0 + j]; w2[j] = caw[1024 + c0 + j]; w3[j] = caw[1536 + c0 + j]; wb[j] = cab[c0 + j];
            v0[j] = cbw[c0 + j]; v1[j] = cbw[512 + c0 + j]; v2[j] = cbw[1024 + c0 + j]; }
        for (int t0 = 0; t0 < nrows; t0 += 2) {
            u32x4 lx[2], lc[2], lh[2], lb[2];
#pragma unroll
            for (int k = 0; k < 2; ++k) { const size_t off = (size_t)(row0 + t0 + k) * 512 + c0;
                lx[k] = *(const u32x4*)(xa + off); lc[k] = *(const u32x4*)(sc + off); lh[k] = *(const u32x4*)(sh + off); lb[k] = *(const u32x4*)(sb + off); }
#pragma unroll
            for (int k = 0; k < 2; ++k) { const size_t off = (size_t)(row0 + t0 + k) * 512 + c0;
                float xv[8], scv[8], shv[8], sbv[8];
                unpack8(lx[k], xv); unpack8(lc[k], scv); unpack8(lh[k], shv); unpack8(lb[k], sbv);
                f32x4 o0, o1, q0, q1;
#pragma unroll
                for (int j = 0; j < 8; ++j) {
                    const float o = w0[j] * x0[j] + w1[j] * x1[j] + w2[j] * x2[j] + w3[j] * xv[j] + wb[j];
                    const float uu = scv[j] * shv[j]; const float cu = v0[j] * u1[j] + v1[j] * u2[j] + v2[j] * uu; const float bi = sbv[j] * cu;
                    if (j < 4) { o0[j] = o; q0[j] = bi; } else { o1[j - 4] = o; q1[j - 4] = bi; }
                    x0[j] = x1[j]; x1[j] = x2[j]; x2[j] = xv[j]; u1[j] = u2[j]; u2[j] = uu;
                }
                *(u32x4*)(xac + off) = pack8(o0, o1);
                *(u32x4*)(bin_out + off) = pack8(q0, q1); }
        }
        if (prompt) { if ((seg & 255) == 255) { const int b = seg >> 8;
                float* o1 = a->out + O_LCP + ((size_t)(layer * 8 + b) * 3) * 512 + c0; float* o2 = a->out + O_SCP + ((size_t)(layer * 8 + b) * 2) * 512 + c0;
#pragma unroll
                for (int j = 0; j < 8; ++j) { o1[j] = x0[j]; o1[512 + j] = x1[j]; o1[1024 + j] = x2[j]; o2[j] = u1[j]; o2[512 + j] = u2[j]; } }
        } else { const int b = seg - 2048;
            float* o1 = a->out + O_LCS + ((size_t)(layer * 128 + b) * 3) * 512 + c0; float* o2 = a->out + O_SCS + ((size_t)(layer * 128 + b) * 2) * 512 + c0;
#pragma unroll
            for (int j = 0; j < 8; ++j) { o1[j] = x0[j]; o1[512 + j] = x1[j]; o1[1024 + j] = x2[j]; o2[j] = u1[j]; o2[512 + j] = u2[j]; }
        }
    }
}

__device__ __forceinline__ void ssm_s_gemm(AP a, const int wv_) {
    const bf16_t* apack = (const bf16_t*)(a->ws + OFF_APACK); const bf16_t* w1 = (const bf16_t*)(a->ws + OFF_W1T); float* S = (float*)(a->ws + OFF_S);
    const int tid_ = otid(wv_); const int lane = tid_ & 63, wv = blockIdx.x * 8 + (tid_ >> 6), NW = gridDim.x * 8;
    const int lr = lane & 15, kq = lane >> 4;
    for (int t = wv; t < 1024; t += NW) {
        const int g = t >> 5, rt = (t >> 1) & 15, ct = t & 1;
        f32x4 acc[4][4];
#pragma unroll
        for (int i = 0; i < 4; ++i)
#pragma unroll
            for (int j = 0; j < 4; ++j) acc[i][j] = (f32x4){0.f, 0.f, 0.f, 0.f};
        const bf16_t* ab = apack + ((size_t)(g * 1024 + rt * 64 + lr) * 384 + 128 + kq * 8);
        const bf16_t* bb = w1 + ((size_t)(g * 128 + ct * 64 + lr) * 256 + kq * 8);
#pragma unroll 2
        for (int ks = 0; ks < 8; ++ks) {
            bf16x8 af[4], bf[4];
#pragma unroll
            for (int i = 0; i < 4; ++i) { af[i] = *(const bf16x8*)(ab + (size_t)i * 16 * 384 + ks * 32); bf[i] = *(const bf16x8*)(bb + (size_t)i * 16 * 256 + ks * 32); }
#pragma unroll
            for (int i = 0; i < 4; ++i)
#pragma unroll
                for (int j = 0; j < 4; ++j) acc[i][j] = __builtin_amdgcn_mfma_f32_16x16x32_bf16(af[i], bf[j], acc[i][j], 0, 0, 0);
        }
#pragma unroll
        for (int i = 0; i < 4; ++i)
#pragma unroll
            for (int j = 0; j < 4; ++j)
#pragma unroll
                for (int q = 0; q < 4; ++q) S[(size_t)(g * 1024 + rt * 64 + i * 16 + kq * 4 + q) * 128 + ct * 64 + j * 16 + lr] = acc[i][j][q];
    }
}

__device__ __forceinline__ void ssm_carry(AP a, int layer, float* sm, const int wv_) {
    bf16_t* apack = (bf16_t*)(a->ws + OFF_APACK); const float* S = (const float*)(a->ws + OFF_S);
    const int tid = otid(wv_), p = tid & 63, seg = tid >> 6;
    for (int pair = blockIdx.x; pair < 256; pair += gridDim.x) {
        const int b = pair >> 5, g = pair & 31, sp = g * 64 + p;
        float ar, ai, Ar, Ai;
        abar_pow(a->in[I_SAR] + layer * 2048, a->in[I_SAI] + layer * 2048, a->in[I_SDT] + layer * 2048, sp, 16.0f, ar, ai);
        abar_pow(a->in[I_SAR] + layer * 2048, a->in[I_SAI] + layer * 2048, a->in[I_SDT] + layer * 2048, sp, 256.0f, Ar, Ai);
        const size_t rbase = (size_t)g * 1024 + b * 128 + seg * 16;
        float sr[16], si[16];
#pragma unroll
        for (int j = 0; j < 16; ++j) { sr[j] = S[(rbase + j) * 128 + p]; si[j] = S[(rbase + j) * 128 + 64 + p]; }
        float hr = 0.f, hi = 0.f;
#pragma unroll
        for (int j = 0; j < 16; ++j) { const float nr = ar * hr - ai * hi + sr[j], ni = ar * hi + ai * hr + si[j]; sr[j] = hr; si[j] = hi; hr = nr; hi = ni; }
        sm[seg * 128 + p] = hr; sm[seg * 128 + 64 + p] = hi;
        __syncthreads();
        float cr = 0.f, ci = 0.f;
        for (int s2 = 0; s2 < seg; ++s2) { const float er = sm[s2 * 128 + p], ei = sm[s2 * 128 + 64 + p]; const float nr = Ar * cr - Ai * ci + er, ni = Ar * ci + Ai * cr + ei; cr = nr; ci = ni; }
        if (seg == 7) { const float fr_ = Ar * cr - Ai * ci + hr, fi_ = Ar * ci + Ai * cr + hi;
            a->out[O_SRP + (size_t)(layer * 8 + b) * 2048 + sp] = fr_; a->out[O_SIP + (size_t)(layer * 8 + b) * 2048 + sp] = fi_; }
#pragma unroll
        for (int j = 0; j < 16; ++j) { apack[(rbase + j) * 384 + p] = f2bf(sr[j] + cr); apack[(rbase + j) * 384 + 64 + p] = f2bf(si[j] + ci);
            const float nr = ar * cr - ai * ci, ni = ar * ci + ai * cr; cr = nr; ci = ni; }
        __syncthreads();
    }
}

__device__ __forceinline__ void ssm_sample(AP a, int layer, int wv, int NW, const int wv_) {
    const bf16_t* uss = (const bf16_t*)(a->ws + OFF_USS); bf16_t* zc = (bf16_t*)(a->ws + OFF_ZCS);
    const float* are = a->in[I_SAR] + layer * 2048; const float* aim = a->in[I_SAI] + layer * 2048; const float* ldt = a->in[I_SDT] + layer * 2048;
    const float* bre = a->in[I_SBR] + layer * 32768; const float* bim = a->in[I_SBI] + layer * 32768;
    const float* cre = a->in[I_SCR] + layer * 32768; const float* cim = a->in[I_SCI] + layer * 32768; const float* dv = a->in[I_SD] + layer * 512;
    const int lane = otid(wv_) & 63;
    for (int t = wv; t < 128 * 32; t += NW) {
        const int b = t >> 5, g = t & 31, sp = g * 64 + lane;
        float ar, ai, cr, ci; abar_pow(are, aim, ldt, sp, 1.0f, ar, ai); ssm_coef(are, aim, ldt, sp, cr, ci);
        float bbr[16], bbi[16], xr[16], xi[16];
#pragma unroll
        for (int c = 0; c < 16; ++c) { const float br = bre[sp * 16 + c], bi = bim[sp * 16 + c]; bbr[c] = cr * br - ci * bi; bbi[c] = cr * bi + ci * br;
            xr[c] = cre[(g * 16 + c) * 64 + lane]; xi[c] = cim[(g * 16 + c) * 64 + lane]; }
        float hr = a->in[I_SSR][(size_t)(layer * 128 + b) * 2048 + sp], hi = a->in[I_SSI][(size_t)(layer * 128 + b) * 2048 + sp];
        const float dme = lane < 16 ? dv[g * 16 + lane] : 0.f;
        for (int tt = 0; tt < 4; ++tt) {
            const bf16_t* up = uss + (size_t)(b * 4 + tt) * 512 + g * 16;
            const u32x4 w0 = *(const u32x4*)up, w1 = *(const u32x4*)(up + 8);
            float u[16]; { float t0[8], t1[8]; unpack8(w0, t0); unpack8(w1, t1);
#pragma unroll
                for (int c = 0; c < 8; ++c) { u[c] = t0[c]; u[8 + c] = t1[c]; } }
            float br_ = 0.f, bi_ = 0.f;
#pragma unroll
            for (int c = 0; c < 16; ++c) { br_ += bbr[c] * u[c]; bi_ += bbi[c] * u[c]; }
            const float nr = ar * hr - ai * hi + br_, ni = ar * hi + ai * hr + bi_; hr = nr; hi = ni;
            float mine = 0.f, ume = 0.f;
#pragma unroll
            for (int c = 0; c < 16; ++c) { float y = xr[c] * hr - xi[c] * hi;
#pragma unroll
                for (int o = 32; o >= 1; o >>= 1) y += shx(y, o, lane);
                if (lane == c) { mine = y; ume = u[c]; } }
            if (lane < 16) zc[(size_t)(b * 4 + tt) * 512 + g * 16 + lane] = f2bf(gelu_t(mine + dme * ume));
        }
        a->out[O_SRS + (size_t)(layer * 128 + b) * 2048 + sp] = hr; a->out[O_SIS + (size_t)(layer * 128 + b) * 2048 + sp] = hi;
    }
}

__device__ __forceinline__ void lru_local(AP a, const int wv_) {
    const _Float16* av = (const _Float16*)(a->ws + OFF_R + 2 * S17); const bf16_t* bx = (const bf16_t*)(a->ws + OFF_R); f32x2* car = (f32x2*)(a->ws + OFF_CAR);
    const int gt = blockIdx.x * NTHR + otid(wv_), GT = gridDim.x * NTHR;
    for (int idx = gt; idx < 8 * 32 * 512; idx += GT) {
        const int c = idx & 511, sc = idx >> 9;
        const size_t base = (size_t)sc * 64 * 512 + c;
        float P = 1.f, h = 0.f;
        for (int t0 = 0; t0 < 64; t0 += 16) {
            _Float16 al[16]; bf16_t bb[16];
#pragma unroll
            for (int j = 0; j < 16; ++j) { al[j] = av[base + (size_t)(t0 + j) * 512]; bb[j] = bx[base + (size_t)(t0 + j) * 512]; }
#pragma unroll
            for (int j = 0; j < 16; ++j) { const float aa = __expf((float)al[j]); h = aa * h + bf2f(bb[j]); P *= aa; }
        }
        car[idx] = (f32x2){P, h};
    }
}
template <int B>
__device__ __forceinline__ float lru_run(const _Float16* av, const bf16_t* bx, bf16_t* ao, const bf16_t* ya, size_t base, int n, float h) {
    for (int t0 = 0; t0 < n; t0 += B) {
        _Float16 aa[B]; bf16_t bb[B], yy[B];
#pragma unroll
        for (int j = 0; j < B; ++j) { const size_t o = base + (size_t)(t0 + j) * 512; aa[j] = av[o]; bb[j] = bx[o]; yy[j] = ya[o]; }
        bf16_t oo[B];
#pragma unroll
        for (int j = 0; j < B; ++j) { h = __expf((float)aa[j]) * h + bf2f(bb[j]); oo[j] = f2bf(h * gelu_t(bf2f(yy[j]))); }
#pragma unroll
        for (int j = 0; j < B; ++j) ao[base + (size_t)(t0 + j) * 512] = oo[j];
    }
    return h;
}
__device__ __forceinline__ void lru_apply(AP a, int layer, bf16_t* ao, int mode, const int wv_) {
    const _Float16* av = (const _Float16*)(a->ws + OFF_R + 2 * S17); const bf16_t* bx = (const bf16_t*)(a->ws + OFF_R); const f32x2* car = (const f32x2*)(a->ws + OFF_CAR);
    const bf16_t* ya = (const bf16_t*)(a->ws + OFF_YA);
    const int G = gridDim.x, bid = blockIdx.x;
    if (mode == 0) {
        for (int idx = bid * NTHR + otid(wv_); idx < 8 * 32 * 512; idx += G * NTHR) {
            const int c = idx & 511, sc = idx >> 9, seq = sc >> 5, chunk = sc & 31;
            float h = 0.f;
            f32x2 ph[31];
#pragma unroll
            for (int k = 0; k < 31; ++k) ph[k] = car[(seq * 32 + (k < chunk ? k : 0)) * 512 + c];
#pragma unroll
            for (int k = 0; k < 31; ++k) if (k < chunk) h = ph[k].x * h + ph[k].y;
            h = lru_run<8>(av, bx, ao, ya, (size_t)sc * 64 * 512 + c, 64, h);
            if (chunk == 31) a->out[O_LHP + (size_t)(layer * 8 + seq) * 512 + c] = h;
        }
    } else {
        for (int j = bid * NTHR + otid(wv_); j < 128 * 512; j += G * NTHR) {
            const int c = j & 511, b = j >> 9;
            float h = a->in[I_SLH][(size_t)(layer * 128 + b) * 512 + c];
            h = lru_run<4>(av, bx, ao, ya, (size_t)(MP + b * 4) * 512 + c, 4, h);
            a->out[O_LHS + (size_t)(layer * 128 + b) * 512 + c] = h;
        }
    }
}

template <bool RES16>
__device__ __forceinline__ void ln_phase(const bf16_t* T, const float* Rs, const float* part, const float* resp, const float* ress, const bf16_t* res16,
                                         float* dst32, bf16_t* dst16, const float* gam, const float* bet, const int wv_) {
    const int tid_ = otid(wv_); const int lane = tid_ & 63, wv = blockIdx.x * 8 + (tid_ >> 6), NW = gridDim.x * 8;
    for (int r0 = wv; r0 < M; r0 += 3 * NW) {
        f32x4 v[3][4];
#pragma unroll
        for (int k = 0; k < 3; ++k) { const int rr = r0 + k * NW; const int r = rr < M ? rr : r0;
            if (r < MP) {
#pragma unroll
                for (int i = 0; i < 4; ++i) { const u32x2 w = *(const u32x2*)(T + (size_t)r * 1024 + i * 256 + lane * 4); v[k][i] = (f32x4){bflo(w.x), bfhi(w.x), bflo(w.y), bfhi(w.y)}; }
            } else {
#pragma unroll
                for (int i = 0; i < 4; ++i) v[k][i] = *(const f32x4*)(Rs + (size_t)r * 1024 + i * 256 + lane * 4);
#pragma unroll
                for (int q = 0; q < 3; ++q)
#pragma unroll
                    for (int i = 0; i < 4; ++i) v[k][i] += *(const f32x4*)(part + (size_t)q * PART_STRIDE + (size_t)(r - MP) * 1024 + i * 256 + lane * 4);
            }
            if (RES16) {
#pragma unroll
                for (int i = 0; i < 4; ++i) { const u32x2 w = *(const u32x2*)(res16 + (size_t)r * 1024 + i * 256 + lane * 4); v[k][i] += (f32x4){bflo(w.x), bfhi(w.x), bflo(w.y), bfhi(w.y)} * ALPHA; }
            } else { const float* rp = r < MP ? resp + (size_t)r * 1024 : ress + (size_t)(r - MP) * 1024;
#pragma unroll
                for (int i = 0; i < 4; ++i) v[k][i] += *(const f32x4*)(rp + i * 256 + lane * 4) * ALPHA;
            } }
#pragma unroll
        for (int k = 0; k < 3; ++k) { const int r = r0 + k * NW;
            float s = 0.f;
#pragma unroll
            for (int i = 0; i < 4; ++i) s += (v[k][i][0] + v[k][i][1]) + (v[k][i][2] + v[k][i][3]);
#pragma unroll
            for (int o = 32; o >= 1; o >>= 1) s += shx(s, o, lane);
            const float mu = s * (1.0f / 1024.0f); float q = 0.f;
#pragma unroll
            for (int i = 0; i < 4; ++i) { const f32x4 d = v[k][i] - mu; q += (d[0] * d[0] + d[1] * d[1]) + (d[2] * d[2] + d[3] * d[3]); }
#pragma unroll
            for (int o = 32; o >= 1; o >>= 1) q += shx(q, o, lane);
            const float rs = rsqrtf(q * (1.0f / 1024.0f) + LN_EPS);
            if (r < M) {
#pragma unroll
                for (int i = 0; i < 4; ++i) { const int col = i * 256 + lane * 4; const f32x4 gg = *(const f32x4*)(gam + col), bb = *(const f32x4*)(bet + col);
                    const f32x4 y = (v[k][i] - mu) * rs * gg + bb;
                    if (dst32) *(f32x4*)(dst32 + (size_t)r * 1024 + col) = y;
                    if (dst16) { u32x2 w; w.x = cvt_pk_bf16(y[0], y[1]); w.y = cvt_pk_bf16(y[2], y[3]);
                        *(u32x2*)(dst16 + (size_t)r * 1024 + col) = w; } }
            }
        }
    }
}

__global__ void __launch_bounds__(NTHR, 2) fwd_megakernel(Args a_unused) {
    extern __shared__ __attribute__((aligned(16))) unsigned char lds_raw[];
    cg::grid_group grid = cg::this_grid();
    LAS unsigned char* lds = (LAS unsigned char*)lds_raw;
    const int G = gridDim.x, bid = blockIdx.x;
    int wv_; { const int tw = (int)threadIdx.x >> 6; asm volatile("v_readfirstlane_b32 %0, %1" : "=s"(wv_) : "v"(tw)); }

    const unsigned long long t_start = PROBE_ON ? __builtin_amdgcn_s_memrealtime() : 0ull;
    for (int rep = 0; rep < REP_PREP; ++rep) { const AP a = ld_args(); prep_layer(a, 0, (float*)lds_raw, wv_); prep_x(a, wv_); }
    int pidx = 1; unsigned long long tA = PROBE_A == 0 ? t_start : 0ull, tB = 0ull;
    if (PROBE_ON) { if (PROBE_A == 1) tA = __builtin_amdgcn_s_memrealtime(); if (PROBE_B == 1) tB = __builtin_amdgcn_s_memrealtime(); }
    unsigned bar_n = 0; { const AP a = ld_args(); if (a->ws == nullptr) grid.sync(); }
    bar_n += (unsigned)G; gbar((unsigned*)(ld_args()->ws + OFF_BAR), bar_n, wv_);

#pragma unroll 1
    for (int layer = 0; layer < 2; ++layer) {
        { const AP a = ld_args(); unsigned char* ws = a->ws;
          PG1 p; p.K = 1024; p.lda = 1024; p.ldb = 1024; p.G = opq(G); p.c = opq(bid); p.A = layer == 0 ? (const bf16_t*)(ws + OFF_XB) : (const bf16_t*)a->out; p.Bt = (const bf16_t*)(ws + OFF_WIN);
          p.xa = (bf16_t*)(ws + OFF_R); p.ya = (bf16_t*)(ws + OFF_YA); p.sb = (bf16_t*)(ws + OFF_R + S17); p.sc = (bf16_t*)(ws + OFF_R + 2 * S17); p.sh = (bf16_t*)(ws + OFF_R + 3 * S17);
          p.apack = (bf16_t*)(ws + OFF_APACK); p.uss = (bf16_t*)(ws + OFF_USS); p.gl8 = ws + OFF_GL8;
          for (int rep = 0; rep < REP_G1; ++rep) gemm_phase(lds, p, wv_); }
        GSYNC();
        if (DRY_CONV) { const AP a = ld_args(); conv_phase(a, layer, (bf16_t*)(a->ws + OFF_XB + S17), wv_); }
        { const AP a = ld_args(); conv_phase(a, layer, (bf16_t*)(a->ws + OFF_R + S17), wv_); }
        for (int rep = 0; rep < REP_SG; ++rep) { const AP a = ld_args(); ssm_s_gemm(a, wv_); }
        GSYNC();
        for (int rep = 0; rep < REP_CARRY; ++rep) { const AP a = ld_args(); ssm_carry(a, layer, (float*)lds_raw, wv_); }
        { const AP a = ld_args(); unsigned char* ws = a->ws;
          PGate p; p.K = 256; p.lda = 512; p.ldb = 256; p.G = opq(G); p.c = opq(bid); p.A = (const bf16_t*)(ws + OFF_XB); p.Bt = (const bf16_t*)(ws + OFF_WGATE);
          p.gxb = a->in[I_GXB] + layer * 512; p.gab = a->in[I_GAB] + layer * 512; p.lam = a->in[I_LAM] + layer * 512;
          p.aout = (_Float16*)(ws + OFF_R + 2 * S17); p.bxout = (bf16_t*)(ws + OFF_R);
          for (int rep = 0; rep < REP_GATE; ++rep) gemm_phase(lds, p, wv_); }
        for (int rep = 0; rep < REP_SAMPLE; ++rep) if (bid >= 8) { const AP a = ld_args(); ssm_sample(a, layer, (bid - 8) * 8 + wv_, (G - 8) * 8, wv_); }
        GSYNC();
        { const AP a = ld_args(); unsigned char* ws = a->ws;
          PY p; p.K = 384; p.lda = 384; p.ldb = 384; p.G = opq(G); p.c = opq(bid); p.apack = (const bf16_t*)(ws + OFF_APACK); p.wyt = (const bf16_t*)(ws + OFF_WYT);
          p.dvec = a->in[I_SD] + layer * 512; p.zc = (bf16_t*)(ws + OFF_XB);
          for (int rep = 0; rep < REP_Y; ++rep) gemm_phase(lds, p, wv_); }
        { const AP a = ld_args(); unsigned char* ws = a->ws;
          PGlu p; p.K = 512; p.lda = 512; p.ldb = 512; p.G = opq(G); p.c = opq(bid); p.sample = 1; p.A = (const bf16_t*)(ws + OFF_XB); p.As = (const bf16_t*)(ws + OFF_ZCS); p.Bt = (const bf16_t*)(ws + OFF_WGLU);
          p.bias = a->in[I_GLB] + layer * 512; p.out = (bf16_t*)(ws + OFF_XB + S17);
          gemm_phase(lds, p, wv_); }
        { const AP a = ld_args(); lru_apply(a, layer, (bf16_t*)(a->ws + OFF_R), 1, wv_); }
        for (int rep = 0; rep < REP_LOCAL; ++rep) { const AP a = ld_args(); lru_local(a, wv_); }
        GSYNC();
        { const AP a = ld_args(); unsigned char* ws = a->ws;
          PGlu p; p.K = 512; p.lda = 512; p.ldb = 512; p.G = opq(G); p.c = opq(bid); p.sample = 0; p.A = (const bf16_t*)(ws + OFF_XB); p.As = (const bf16_t*)(ws + OFF_ZCS); p.Bt = (const bf16_t*)(ws + OFF_WGLU);
          p.bias = a->in[I_GLB] + layer * 512; p.out = (bf16_t*)(ws + OFF_XB + S17);
          for (int rep = 0; rep < REP_GLU; ++rep) gemm_phase(lds, p, wv_); }
        { const AP a = ld_args(); unsigned char* ws = a->ws;
          PMergeT<true> p; p.K = 512; p.lda = 512; p.ldb = 512; p.G = opq(G); p.c = opq(bid); p.a0 = (const bf16_t*)(ws + OFF_R);
          p.wp = (const bf16_t*)(ws + OFF_WP); p.gl8 = ws + OFF_GL8; p.mb = (bf16_t*)(ws + OFF_MB); p.pm3 = (float*)(ws + OFF_S);
          gemm_phase(lds, p, wv_); }
        if (DRY_APPLY) { const AP a = ld_args(); lru_apply(a, layer, (bf16_t*)(a->ws + OFF_S), 0, wv_); }
        { const AP a = ld_args(); lru_apply(a, layer, (bf16_t*)(a->ws + OFF_R), 0, wv_); }
        GSYNC();
        { const AP a = ld_args(); unsigned char* ws = a->ws;
          PMergeT<false> p; p.K = 512; p.lda = 512; p.ldb = 512; p.G = opq(G); p.c = opq(bid); p.a0 = (const bf16_t*)(ws + OFF_R);
          p.wp = (const bf16_t*)(ws + OFF_WP); p.gl8 = ws + OFF_GL8; p.mb = (bf16_t*)(ws + OFF_MB); p.pm3 = (float*)(ws + OFF_S);
          { const float* pm = (const float*)(ws + OFF_S); bf16_t* ms = (bf16_t*)(ws + OFF_MB) + (size_t)MP * 1024;
            for (int i = bid * NTHR + otid(wv_); i < MS * 128; i += G * NTHR) { const size_t e = (size_t)i * 8;
                f32x4 s0 = *(const f32x4*)(pm + e), s1 = *(const f32x4*)(pm + e + 4);
                s0 += *(const f32x4*)(pm + PART_STRIDE + e); s1 += *(const f32x4*)(pm + PART_STRIDE + e + 4);
                s0 += *(const f32x4*)(pm + 2 * PART_STRIDE + e); s1 += *(const f32x4*)(pm + 2 * PART_STRIDE + e + 4);
                *(u32x4*)(ms + e) = pack8(s0, s1); } }
          for (int rep = 0; rep < REP_MERGE; ++rep) gemm_phase(lds, p, wv_); }
        GSYNC();
        { const AP a = ld_args(); unsigned char* ws = a->ws;
          PWout p; p.K = 1024; p.lda = 1024; p.ldb = 1024; p.G = opq(G); p.c = opq(bid); p.A = (const bf16_t*)(ws + OFF_MB); p.Bt = (const bf16_t*)(ws + OFF_WOUT);
          p.T = (bf16_t*)(ws + OFF_R); p.R = (float*)(ws + OFF_R); p.part = (float*)(ws + OFF_PW);
          gemm_phase(lds, p, wv_); }
        GSYNC();
        { const AP a = ld_args(); unsigned char* ws = a->ws;
          if (layer == 0) ln_phase<false>((const bf16_t*)(ws + OFF_R), (const float*)(ws + OFF_R), (const float*)(ws + OFF_PW), a->in[I_XP], a->in[I_XS], (const bf16_t*)nullptr,
                          (float*)nullptr, (bf16_t*)(ws + OFF_XB), a->in[I_L1G] + layer * 1024, a->in[I_L1B] + layer * 1024, wv_);
          else ln_phase<true>((const bf16_t*)(ws + OFF_R), (const float*)(ws + OFF_R), (const float*)(ws + OFF_PW), (const float*)nullptr, (const float*)nullptr, (const bf16_t*)a->out,
                          (float*)nullptr, (bf16_t*)(ws + OFF_XB), a->in[I_L1G] + layer * 1024, a->in[I_L1B] + layer * 1024, wv_); }
        GSYNC();
        { const AP a = ld_args(); unsigned char* ws = a->ws;
          PUp p; p.K = 1024; p.lda = 1024; p.ldb = 1024; p.G = opq(G); p.c = opq(bid); p.A = (const bf16_t*)(ws + OFF_XB); p.Bt = (const bf16_t*)(ws + OFF_WUP); p.h = (bf16_t*)(ws + OFF_H);
          for (int rep = 0; rep < REP_UP; ++rep) gemm_phase(lds, p, wv_); }
        GSYNC();
        { const AP a = ld_args(); unsigned char* ws = a->ws;
          PDown p; p.K = 4096; p.lda = 4096; p.ldb = 4096; p.G = opq(G); p.c = opq(bid); p.A = (const bf16_t*)(ws + OFF_H); p.Bt = (const bf16_t*)(ws + OFF_WDOWN);
          p.T = (bf16_t*)(ws + OFF_R); p.R = (float*)(ws + OFF_R); p.part = (float*)(ws + OFF_PD);
          gemm_phase(lds, p, wv_); }
        GSYNC();
        { const AP a = ld_args(); unsigned char* ws = a->ws;
          ln_phase<true>((const bf16_t*)(ws + OFF_R), (const float*)(ws + OFF_R), (const float*)(ws + OFF_PD), (const float*)nullptr, (const float*)nullptr, (const bf16_t*)(ws + OFF_XB),
                         layer == 0 ? (float*)nullptr : a->out, layer == 0 ? (bf16_t*)a->out : (bf16_t*)nullptr, a->in[I_L2G] + layer * 1024, a->in[I_L2B] + layer * 1024, wv_); }
        if (layer == 0) { __syncthreads(); for (int rep = 0; rep < REP_PREP; ++rep) { const AP a = ld_args(); prep_layer(a, 1, (float*)lds_raw, wv_); } GSYNC(); }
    }
    if (PROBE_ON && bid == 0) { if (PROBE_B > 22) tB = __builtin_amdgcn_s_memrealtime(); const unsigned long long t0 = __builtin_amdgcn_s_memrealtime(); while (__builtin_amdgcn_s_memrealtime() - t0 < tB - tA) __builtin_amdgcn_s_sleep(8); }
}

extern "C" void kernel_launch(void* const* d_in, const int* in_sizes, int n_in, void* d_out, int out_size, void* d_ws, size_t ws_size, hipStream_t stream) {
    constexpr size_t kDynLds = STAGE_BYTES;
    static int grid_blocks = 0;
    if (!grid_blocks) {
        int dev = 0, cus = 0, per_cu = 0;
        hipGetDevice(&dev);
        hipDeviceGetAttribute(&cus, hipDeviceAttributeMultiprocessorCount, dev);
        hipFuncSetAttribute((const void*)fwd_megakernel, hipFuncAttributeMaxDynamicSharedMemorySize, (int)kDynLds);
        hipOccupancyMaxActiveBlocksPerMultiprocessor(&per_cu, (const void*)fwd_megakernel, NTHR, kDynLds);
        if (per_cu < 1) per_cu = 1;
        grid_blocks = cus * per_cu;
        if (grid_blocks > 256) grid_blocks = 256;
        if (ws_size < WS_END || n_in != 36) fprintf(stderr, "kernel_launch: unexpected ws_size %zu (need %zu) or n_in %d\n", ws_size, (size_t)WS_END, n_in);
    }
    (void)hipMemsetAsync((char*)d_ws + OFF_BAR, 0, 256, stream);
    Args a{};
    for (int i = 0; i < 36; ++i) a.in[i] = (const float*)d_in[i];
    a.out = (float*)d_out; a.ws = (unsigned char*)d_ws;
    void* args[] = {&a};
    hipError_t e = hipLaunchCooperativeKernel((const void*)fwd_megakernel, dim3(grid_blocks), dim3(NTHR), args, kDynLds, stream);
    if (e != hipSuccess) fprintf(stderr, "cooperative launch failed: %s (grid %d)\n", hipGetErrorString(e), grid_blocks);
}
```

```cpp
#include <hip/hip_runtime.h>
#include <hip/hip_cooperative_groups.h>
#include <cstdio>
namespace cg = cooperative_groups;
#define REP_GEMM 1
#define REP_G1 REP_GEMM
#define REP_GATE REP_GEMM
#define REP_Y REP_GEMM
#define REP_GLU REP_GEMM
#define REP_MERGE REP_GEMM
#define REP_UP REP_GEMM
#define REP_ELEM 1
#define REP_PREP REP_ELEM
#define REP_SG REP_ELEM
#define REP_CARRY REP_ELEM
#define REP_SAMPLE REP_ELEM
#define REP_LOCAL REP_ELEM
#define REP_LN2 REP_ELEM
#define DRY_CONV 0
#define DRY_APPLY 0
#define DRY_LN1 0
#define REP_SYNC 1
#define PROBE_ON 0
#define PROBE_A 0
#define PROBE_B 1
#define GSYNC() do { for (int _s = 0; _s < REP_SYNC; ++_s) { bar_n += (unsigned)G; gbar((unsigned*)(ld_args()->ws + OFF_BAR), bar_n, wv_); } ++pidx; if (PROBE_ON) { if (pidx == PROBE_A) tA = __builtin_amdgcn_s_memrealtime(); if (pidx == PROBE_B) tB = __builtin_amdgcn_s_memrealtime(); } } while (0)

#define LAS __attribute__((address_space(3)))
typedef unsigned short bf16_t;
typedef short bf16x8 __attribute__((ext_vector_type(8)));
typedef float f32x4 __attribute__((ext_vector_type(4)));
typedef float f32x2 __attribute__((ext_vector_type(2)));
typedef unsigned u32x4 __attribute__((ext_vector_type(4)));
typedef unsigned u32x2 __attribute__((ext_vector_type(2)));

constexpr int MP = 16384, MS = 512, M = MP + MS, D = 1024, NIN = 6144, BW = 512, DFF = 4096;
constexpr int NTHR = 512;
constexpr float ALPHA = 1.41421356237f;
constexpr float LN_EPS = 1e-5f;

constexpr size_t S17 = (size_t)M * 512 * 2;
constexpr size_t OFF_WUP = 0;
constexpr size_t OFF_WDOWN = OFF_WUP + (size_t)4096 * 1024 * 2;
constexpr size_t OFF_R = OFF_WDOWN + (size_t)4096 * 1024 * 2;
constexpr size_t OFF_XB = OFF_R + 4 * S17;
constexpr size_t OFF_BIG = OFF_XB + 2 * S17;
constexpr size_t OFF_H = OFF_BIG;
constexpr size_t OFF_WIN = OFF_BIG;
constexpr size_t OFF_WP = OFF_WIN + (size_t)6144 * 1024 * 2;
constexpr size_t OFF_WGLU = OFF_WP + (size_t)3 * 1024 * 512 * 2;
constexpr size_t OFF_WOUT = OFF_WGLU + (size_t)512 * 512 * 2;
constexpr size_t OFF_WGATE = OFF_WOUT + (size_t)1024 * 1024 * 2;
constexpr size_t OFF_W1T = OFF_WGATE + (size_t)1024 * 512 * 2;
constexpr size_t OFF_WYT = OFF_W1T + (size_t)32 * 128 * 256 * 2;
constexpr size_t OFF_GL8 = OFF_WYT + (size_t)32 * 256 * 384 * 2;
constexpr size_t OFF_YA = OFF_GL8 + (size_t)M * 3072;
constexpr size_t OFF_APACK = OFF_YA + S17;
constexpr size_t OFF_S = OFF_APACK + (size_t)32 * 1024 * 384 * 2;
constexpr size_t OFF_MB = OFF_APACK;
constexpr size_t OFF_USS = OFF_S + (size_t)32 * 1024 * 128 * 4;
constexpr size_t OFF_CAR = OFF_USS + (size_t)512 * 512 * 2;
constexpr size_t OFF_BAR = OFF_CAR + (size_t)8 * 32 * 512 * 8;
constexpr size_t OFF_PD = OFF_BAR + 256;
constexpr size_t OFF_PW = OFF_GL8;
constexpr size_t PART_STRIDE = (size_t)MS * 1024;
constexpr size_t OFF_ZCS = OFF_PD + 3 * PART_STRIDE * 4;
constexpr size_t WS_END = OFF_ZCS + (size_t)MS * 512 * 2;
static_assert(OFF_PD >= OFF_H + (size_t)M * 4096 * 2, "down partials must not overlap h");
static_assert(WS_END <= (size_t)268435456, "workspace map exceeds 256 MiB");
static_assert(OFF_MB + (size_t)M * 1024 * 2 <= OFF_USS, "m overlay");
static_assert(OFF_H + (size_t)M * 4096 * 2 <= (size_t)268435456, "h overlay");

constexpr size_t O_Y = 0;
constexpr size_t O_LCP = (size_t)M * 1024;
constexpr size_t O_LHP = O_LCP + 2 * 8 * 3 * 512;
constexpr size_t O_SCP = O_LHP + 2 * 8 * 512;
constexpr size_t O_SRP = O_SCP + 2 * 8 * 2 * 512;
constexpr size_t O_SIP = O_SRP + 2 * 8 * 2048;
constexpr size_t O_LCS = O_SIP + 2 * 8 * 2048;
constexpr size_t O_LHS = O_LCS + 2 * 128 * 3 * 512;
constexpr size_t O_SCS = O_LHS + 2 * 128 * 512;
constexpr size_t O_SRS = O_SCS + 2 * 128 * 2 * 512;
constexpr size_t O_SIS = O_SRS + 2 * 128 * 2048;

struct Args { const float* in[36]; float* out; unsigned char* ws; };
typedef const __attribute__((address_space(4))) Args* AP;
__device__ __forceinline__ AP ld_args() {
#if defined(__HIP_DEVICE_COMPILE__)
    auto p = __builtin_amdgcn_kernarg_segment_ptr();
    asm volatile("" : "+s"(p));
    return (AP)p;
#else
    return nullptr;
#endif
}
enum { I_XP = 0, I_XS, I_SLC, I_SLH, I_SSC, I_SSR, I_SSI, I_WIN, I_CAW, I_CAB, I_GXW, I_GXB, I_GAW, I_GAB, I_LAM, I_CBW, I_SAR, I_SAI, I_SDT,
       I_SBR, I_SBI, I_SCR, I_SCI, I_SD, I_GLW, I_GLB, I_PA, I_PB, I_PC, I_WO, I_L1G, I_L1B, I_UP, I_DN, I_L2G, I_L2B };

__device__ __forceinline__ unsigned cvt_pk_bf16(float lo, float hi) { unsigned r; asm volatile("v_cvt_pk_bf16_f32 %0, %1, %2" : "=v"(r) : "v"(lo), "v"(hi)); return r; }
__device__ __forceinline__ bf16_t f2bf(float f) { return (bf16_t)(cvt_pk_bf16(f, 0.f) & 0xffffu); }
__device__ __forceinline__ float bf2f(unsigned short b) { return __uint_as_float(((unsigned)b) << 16); }
__device__ __forceinline__ float bflo(unsigned w) { return __uint_as_float(w << 16); }
__device__ __forceinline__ float bfhi(unsigned w) { return __uint_as_float(w & 0xffff0000u); }
__device__ __forceinline__ float sigm(float x) { return 1.0f / (1.0f + __expf(-x)); }
__device__ __forceinline__ float gelu_t(float x) { const float u = 0.7978845608f * (x + 0.044715f * x * x * x); return x / (1.0f + __expf(-2.0f * u)); }
__device__ __forceinline__ u32x4 pack8(const f32x4 a, const f32x4 b) { u32x4 w; w.x = cvt_pk_bf16(a[0], a[1]); w.y = cvt_pk_bf16(a[2], a[3]); w.z = cvt_pk_bf16(b[0], b[1]); w.w = cvt_pk_bf16(b[2], b[3]); return w; }
__device__ __forceinline__ void unpack8(const u32x4 w, float (&f)[8]) { f[0] = bflo(w.x); f[1] = bfhi(w.x); f[2] = bflo(w.y); f[3] = bfhi(w.y); f[4] = bflo(w.z); f[5] = bfhi(w.z); f[6] = bflo(w.w); f[7] = bfhi(w.w); }

__device__ __forceinline__ int otid(const int wv_) { int t = wv_ * 64 + (int)__builtin_amdgcn_mbcnt_hi(~0u, __builtin_amdgcn_mbcnt_lo(~0u, 0u)); asm volatile("" : "+v"(t)); return t; }
__device__ __forceinline__ float shx(float v, int mask, int lane) { return __int_as_float(__builtin_amdgcn_ds_bpermute((lane ^ mask) << 2, __float_as_int(v))); }

__device__ __forceinline__ int opq(int x) { asm volatile("" : "+s"(x)); return x; }

__device__ __forceinline__ void gbar(unsigned* ctr, unsigned target, const int wv_) {
    asm volatile("s_waitcnt vmcnt(0)" ::: "memory");
    __syncthreads();
    if (otid(wv_) == 0) {
        __builtin_amdgcn_fence(__ATOMIC_RELEASE, "agent");
        asm volatile("s_waitcnt vmcnt(0)" ::: "memory");
        __hip_atomic_fetch_add(ctr, 1u, __ATOMIC_RELAXED, __HIP_MEMORY_SCOPE_AGENT);
        while (__hip_atomic_load(ctr, __ATOMIC_RELAXED, __HIP_MEMORY_SCOPE_AGENT) < target) __builtin_amdgcn_s_sleep(1);
        __builtin_amdgcn_fence(__ATOMIC_ACQUIRE, "agent");
        asm volatile("s_waitcnt vmcnt(0)" ::: "memory");
    }
    __syncthreads();
}

constexpr int BM = 256, BK = 64, HALF = 128, HTB = HALF * BK * 2, STAGE_BYTES = 8 * HTB;
__device__ __forceinline__ int lds_byte(int r, int c) { const int st = (r >> 4) * 2 + (c >> 5), rr = r & 15, cc = c & 31, ob = rr * 64 + cc * 2; return st * 1024 + (ob ^ (((ob >> 9) & 1) << 5)); }
__device__ __forceinline__ void stage_rc(int b, int& R, int& C) { const int st = b / 1024, sb = b % 1024, swz = sb ^ (((sb >> 9) & 1) << 5); R = (st >> 1) * 16 + swz / 64; C = (st & 1) * 32 + (swz % 64) / 2; }
__device__ __forceinline__ int perm32(int rho) { const int n = rho >> 4, i = rho & 15; return 8 * (i >> 2) + 4 * n + (i & 3); }
struct Unit { int pm, pn, z; };
__device__ __forceinline__ void tile_map(int L, int nM, int nN, int& pm, int& pn) {
    const int nwg = nM * nN; int wgid = L;
    { const int q = nwg / 8, r = nwg % 8, xcd = wgid % 8, off = wgid / 8; wgid = (xcd < r ? xcd * (q + 1) : r * (q + 1) + (xcd - r) * q) + off; }
    const int nig = 8 * nN, gid = wgid / nig, fm = gid * 8, gsz = (nM - fm) < 8 ? (nM - fm) : 8;
    pm = fm + ((wgid % nig) % gsz); pn = (wgid % nig) / gsz;
}

template <class P>
__device__ __forceinline__ void gemm_phase(LAS unsigned char* lds, const P& p, const int wv_) {
    const int tid = otid(wv_), wid = __builtin_amdgcn_readfirstlane(tid >> 6), lane = tid & 63, wr = wid >> 2, wc = wid & 3, fr = lane & 15, fq = lane >> 4;
    unsigned voffA[2], voffB[2];
#pragma unroll
    for (int i = 0; i < 2; ++i) { int R, C; stage_rc(tid * 16 + i * 8192, R, C); const int Rb = P::PERM ? ((R & ~31) + perm32(R & 31)) : R;
        voffA[i] = (unsigned)(R * p.lda + C) * 2u; voffB[i] = (unsigned)(Rb * p.ldb + C) * 2u; }
    const size_t kstep = (size_t)(BK * 2);
    const size_t hA = (size_t)HALF * p.lda * 2, hB = (size_t)HALF * p.ldb * 2;
    const unsigned ldsw = (unsigned)wid * 1024u;
    const int aoff = lds_byte(wr * 64 + fr, fq * 8), boff = lds_byte(wc * 32 + fr, fq * 8);
#define PG8_SA(b, h) (((b) * 2 + (h)) * HTB)
#define PG8_SB(b, h) ((4 + (b) * 2 + (h)) * HTB)
#define PG8_STAGE(bufoff, gbase, voff) do { _Pragma("unroll") for (int _i = 0; _i < 2; ++_i) \
        __builtin_amdgcn_global_load_lds((const unsigned*)((const char*)(gbase) + (voff)[_i]), (LAS unsigned*)(lds + (bufoff) + ldsw + _i * 8192), 16, 0, 0); } while (0)
#define PG8_LDA(dst, b, h) do { _Pragma("unroll") for (int m = 0; m < 4; ++m) _Pragma("unroll") for (int k = 0; k < 2; ++k) dst[m][k] = *(const LAS bf16x8*)(lds + PG8_SA(b, h) + aoff + m * 2048 + k * 1024); } while (0)
#define PG8_LDB(dst, b, h) do { _Pragma("unroll") for (int n = 0; n < 2; ++n) _Pragma("unroll") for (int k = 0; k < 2; ++k) dst[n][k] = *(const LAS bf16x8*)(lds + PG8_SB(b, h) + boff + n * 2048 + k * 1024); } while (0)
#define PG8_MMA(ai, bj, At, Bt) do { __builtin_amdgcn_s_setprio(1); _Pragma("unroll") for (int m = 0; m < 4; ++m) _Pragma("unroll") for (int n = 0; n < 2; ++n) _Pragma("unroll") for (int k = 0; k < 2; ++k) \
        acc[ai][bj][m][n] = __builtin_amdgcn_mfma_f32_16x16x32_bf16(Bt[n][k], At[m][k], acc[ai][bj][m][n], 0, 0, 0); __builtin_amdgcn_s_setprio(0); } while (0)
#define PG8_WAIT_V(n) asm volatile("s_waitcnt vmcnt(" #n ")" ::: "memory")
#define PG8_WAIT_L(n) asm volatile("s_waitcnt lgkmcnt(" #n ")" ::: "memory")
#define PG8_BAR __builtin_amdgcn_s_barrier()
#define PG8_SCHED __builtin_amdgcn_sched_barrier(0)
    Unit cur, nxt; int ui = 0;
    if (!p.next(0, cur)) return;
    f32x4 acc[2][2][4][2];
#pragma unroll
    for (int a = 0; a < 2; ++a)
#pragma unroll
        for (int b = 0; b < 2; ++b)
#pragma unroll
            for (int m = 0; m < 4; ++m)
#pragma unroll
                for (int n = 0; n < 2; ++n) acc[a][b][m][n] = (f32x4){0.f, 0.f, 0.f, 0.f};
    bf16x8 At[4][2], B0[2][2], B1[2][2];
    const char* cA = p.aptr(cur); const char* cB = p.bptr(cur);
    PG8_STAGE(PG8_SB(0, 0), cB, voffB); PG8_STAGE(PG8_SA(0, 0), cA, voffA); PG8_STAGE(PG8_SB(0, 1), cB + hB, voffB); PG8_STAGE(PG8_SA(0, 1), cA + hA, voffA);
    if (wr == 1) PG8_BAR;
    PG8_WAIT_V(4); PG8_BAR;
    PG8_STAGE(PG8_SB(1, 0), cB + kstep, voffB); PG8_STAGE(PG8_SA(1, 0), cA + kstep, voffA); PG8_STAGE(PG8_SB(1, 1), cB + hB + kstep, voffB);
    PG8_WAIT_V(6); PG8_BAR;
    for (;;) {
        const bool has_next = p.next(ui + 1, nxt);
        const int nt = p.nt(cur);
        const char* nA = has_next ? p.aptr(nxt) : cA; const char* nB = has_next ? p.bptr(nxt) : cB;
        for (int t = 0; t < nt; t += 2) {
            const bool last = (t == nt - 2);
            const char* a1 = cA + (size_t)(t + 1) * kstep;
            const char* a2 = last ? nA : cA + (size_t)(t + 2) * kstep; const char* b2 = last ? nB : cB + (size_t)(t + 2) * kstep;
            const char* a3 = a2 + kstep; const char* b3 = b2 + kstep;
            PG8_LDB(B0, 0, 0); PG8_SCHED; PG8_LDA(At, 0, 0); PG8_STAGE(PG8_SA(1, 1), a1 + hA, voffA);
            PG8_WAIT_L(8); PG8_BAR; PG8_WAIT_L(0); PG8_MMA(0, 0, At, B0); PG8_BAR; PG8_SCHED;
            PG8_LDB(B1, 0, 1); PG8_STAGE(PG8_SB(0, 0), b2, voffB);
            PG8_BAR; PG8_WAIT_L(0); PG8_MMA(0, 1, At, B1); PG8_BAR;
            PG8_LDA(At, 0, 1); PG8_STAGE(PG8_SA(0, 0), a2, voffA);
            PG8_BAR; PG8_WAIT_L(0); PG8_MMA(1, 0, At, B0); PG8_BAR; PG8_SCHED;
            PG8_STAGE(PG8_SB(0, 1), b2 + hB, voffB);
            PG8_WAIT_V(6); PG8_BAR; PG8_MMA(1, 1, At, B1); PG8_BAR;
            PG8_LDB(B0, 1, 0); PG8_SCHED; PG8_LDA(At, 1, 0); PG8_STAGE(PG8_SA(0, 1), a2 + hA, voffA);
            PG8_WAIT_L(8); PG8_BAR; PG8_WAIT_L(0); PG8_MMA(0, 0, At, B0); PG8_BAR; PG8_SCHED;
            PG8_LDB(B1, 1, 1); PG8_STAGE(PG8_SB(1, 0), b3, voffB);
            PG8_BAR; PG8_WAIT_L(0); PG8_MMA(0, 1, At, B1); PG8_BAR;
            PG8_LDA(At, 1, 1); PG8_STAGE(PG8_SA(1, 0), a3, voffA);
            PG8_BAR; PG8_WAIT_L(0); PG8_MMA(1, 0, At, B0); PG8_BAR; PG8_SCHED;
            PG8_STAGE(PG8_SB(1, 1), b3 + hB, voffB);
            PG8_WAIT_V(6); PG8_BAR; PG8_MMA(1, 1, At, B1); PG8_BAR;
        }
        Unit eu = cur;
        asm volatile("" : "+s"(eu.pm), "+s"(eu.pn), "+s"(eu.z));
        const bool rst = p.epi(acc, eu, wr, wc, fr, fq);
        if (!has_next) break;
        if (rst) {
#pragma unroll
            for (int a = 0; a < 2; ++a)
#pragma unroll
                for (int b = 0; b < 2; ++b)
#pragma unroll
                    for (int m = 0; m < 4; ++m)
#pragma unroll
                        for (int n = 0; n < 2; ++n) acc[a][b][m][n] = (f32x4){0.f, 0.f, 0.f, 0.f};
        }
        cur = nxt; cA = nA; cB = nB; ++ui;
    }
    PG8_WAIT_V(0);
    if (wr == 0) PG8_BAR;
    PG8_BAR;
#undef PG8_SA
#undef PG8_SB
#undef PG8_STAGE
#undef PG8_LDA
#undef PG8_LDB
#undef PG8_MMA
#undef PG8_WAIT_V
#undef PG8_WAIT_L
#undef PG8_BAR
#undef PG8_SCHED
}
typedef f32x4 Acc[2][2][4][2];

struct PG1 {
    __device__ __forceinline__ int nt(const Unit&) const { return K / BK; }
    static constexpr bool PERM = true;
    int K, lda, ldb, G, c;
    const bf16_t* A; const bf16_t* Bt;
    bf16_t* xa; unsigned char* gl8; bf16_t* ya; bf16_t* apack; bf16_t* uss; bf16_t* sb; bf16_t* sh; bf16_t* sc;
    __device__ __forceinline__ bool next(int i, Unit& u) const { const long L = (long)i * G + c; if (L >= 66 * 24) return false; tile_map((int)L, 66, 24, u.pm, u.pn); u.z = 0; return true; }
    __device__ __forceinline__ const char* aptr(const Unit& u) const { return (const char*)A + (size_t)u.pm * 256 * 1024 * 2; }
    __device__ __forceinline__ const char* bptr(const Unit& u) const { return (const char*)Bt + (size_t)u.pn * 256 * 1024 * 2; }
    __device__ __forceinline__ bool epi(Acc& acc, const Unit& u, int wr, int wc, int fr, int fq) const {
        const int pn = u.pn;
        if (pn >= 6 && pn < 10) {
#pragma unroll
            for (int ai = 0; ai < 2; ++ai)
#pragma unroll
                for (int m = 0; m < 4; ++m) { const size_t r = (size_t)u.pm * 256 + ai * 128 + wr * 64 + m * 16 + fr;
                    *(u32x4*)(sc + r * 512 + (pn - 6) * 128 + wc * 32 + 8 * fq) = pack8(acc[ai][0][m][0] * acc[ai][1][m][0], acc[ai][0][m][1] * acc[ai][1][m][1]); }
        } else if (pn < 10) {
            bf16_t* base = (bf16_t*)((unsigned char*)xa + (pn >= 4 ? S17 : pn >= 2 ? (OFF_YA - OFF_R) : (size_t)0));
#pragma unroll
            for (int ai = 0; ai < 2; ++ai)
#pragma unroll
                for (int m = 0; m < 4; ++m) { const size_t r = (size_t)u.pm * 256 + ai * 128 + wr * 64 + m * 16 + fr;
#pragma unroll
                    for (int bj = 0; bj < 2; ++bj) { const int col = (pn & 1) * 256 + bj * 128 + wc * 32 + 8 * fq;
                        *(u32x4*)(base + r * 512 + col) = pack8(acc[ai][bj][m][0], acc[ai][bj][m][1]); } }
        } else if (pn < 12) {
#pragma unroll
            for (int ai = 0; ai < 2; ++ai)
#pragma unroll
                for (int m = 0; m < 4; ++m) { const int r = u.pm * 256 + ai * 128 + wr * 64 + m * 16 + fr;
#pragma unroll
                    for (int bj = 0; bj < 2; ++bj) { const int cc = (pn - 10) * 256 + bj * 128 + wc * 32 + 8 * fq;
                        bf16_t* dst = (u.pm < 64) ? apack + ((size_t)((cc >> 4) * 1024 + (r >> 4)) * 384 + 128 + (r & 15) * 16 + (cc & 15)) : uss + (size_t)(r - MP) * 512 + cc;
                        *(u32x4*)dst = pack8(acc[ai][bj][m][0], acc[ai][bj][m][1]); } }
        } else {
            unsigned char* blk = gl8 + ((size_t)(u.pm * 12 + (pn - 12)) << 16) + (size_t)(((wr * 4 + wc) * 64 + fq * 16 + fr) * 128);
#pragma unroll
            for (int ai = 0; ai < 2; ++ai)
#pragma unroll
                for (int m = 0; m < 4; ++m) { u32x4 w;
#pragma unroll
                    for (int bj = 0; bj < 2; ++bj)
#pragma unroll
                        for (int n = 0; n < 2; ++n) { unsigned pk = 0;
#pragma unroll
                            for (int j = 0; j < 4; ++j) { int v = (int)(sigm(acc[ai][bj][m][n][j]) * 256.0f); v = v < 0 ? 0 : (v > 255 ? 255 : v); pk |= (unsigned)v << (8 * j); }
                            w[bj * 2 + n] = pk; }
                    *(u32x4*)(blk + (ai * 4 + m) * 16) = w; }
        }
        return true;
    }
};

struct PGate {
    __device__ __forceinline__ int nt(const Unit&) const { return K / BK; }
    static constexpr bool PERM = true;
    int K, lda, ldb, G, c;
    const bf16_t* A; const bf16_t* Bt;
    const float *gxb, *gab, *lam; _Float16* aout; bf16_t* bxout;
    __device__ __forceinline__ bool next(int i, Unit& u) const { const long L = (long)i * G + c; if (L >= 66 * 4) return false; tile_map((int)L, 66, 4, u.pm, u.pn); u.z = 0; return true; }
    __device__ __forceinline__ const char* aptr(const Unit& u) const { return (const char*)A + (size_t)u.pm * 256 * 512 * 2 + (size_t)(u.pn >> 1) * 512; }
    __device__ __forceinline__ const char* bptr(const Unit& u) const { return (const char*)Bt + (size_t)u.pn * 256 * 256 * 2; }
    __device__ __forceinline__ bool epi(Acc& acc, const Unit& u, int wr, int wc, int fr, int fq) const {
        typedef _Float16 h8 __attribute__((ext_vector_type(8)));
        const int ch0 = u.pn * 128 + wc * 32 + 8 * fq;
        float bxv[8], bav[8], kk[8];
#pragma unroll
        for (int j = 0; j < 8; ++j) { bxv[j] = gxb[ch0 + j]; bav[j] = gab[ch0 + j]; kk[j] = -8.0f * log1pf(expf(-lam[ch0 + j])); }
#pragma unroll
        for (int ai = 0; ai < 2; ++ai)
#pragma unroll
            for (int m = 0; m < 4; ++m) { const size_t r = (size_t)u.pm * 256 + ai * 128 + wr * 64 + m * 16 + fr;
                float xc[8]; unpack8(*(const u32x4*)(A + r * 512 + ch0), xc);
                h8 lav; f32x4 b0, b1;
#pragma unroll
                for (int j = 0; j < 8; ++j) { const float px = acc[ai][0][m][j >> 2][j & 3], pa = acc[ai][1][m][j >> 2][j & 3];
                    const float gx = sigm(px + bxv[j]), ga = sigm(pa + bav[j]);
                    const float la = kk[j] * ga, av = __expf(la); lav[j] = (_Float16)la;
                    const float bv = __builtin_amdgcn_sqrtf(fmaxf(1.0f - av * av, 0.f)) * gx * xc[j];
                    if (j < 4) b0[j] = bv; else b1[j - 4] = bv; }
                *(h8*)(aout + r * 512 + ch0) = lav;
                *(u32x4*)(bxout + r * 512 + ch0) = pack8(b0, b1); }
        return true;
    }
};

struct PY {
    __device__ __forceinline__ int nt(const Unit&) const { return K / BK; }
    static constexpr bool PERM = true;
    int K, lda, ldb, G, c;
    const bf16_t* apack; const bf16_t* wyt; const float* dvec; bf16_t* zc;
    __device__ __forceinline__ bool next(int i, Unit& u) const { const long L = (long)i * G + c; if (L >= 128) return false; u.pm = (int)L; u.pn = (int)L >> 2; u.z = 0; return true; }
    __device__ __forceinline__ const char* aptr(const Unit& u) const { return (const char*)apack + (size_t)u.pm * 256 * 384 * 2; }
    __device__ __forceinline__ const char* bptr(const Unit& u) const { return (const char*)wyt + (size_t)u.pn * 256 * 384 * 2; }
    __device__ __forceinline__ bool epi(Acc& acc, const Unit& u, int wr, int wc, int fr, int fq) const {
        const int g = u.pn;
#pragma unroll
        for (int bj = 0; bj < 2; ++bj) {
            const int n0 = bj * 128 + wc * 32 + 8 * fq, ti = n0 >> 4, c0 = n0 & 15;
#pragma unroll
            for (int ai = 0; ai < 2; ++ai)
#pragma unroll
                for (int m = 0; m < 4; ++m) { const int rr = (u.pm & 3) * 256 + ai * 128 + wr * 64 + m * 16 + fr;
                    f32x4 y0, y1;
#pragma unroll
                    for (int j = 0; j < 4; ++j) { y0[j] = gelu_t(acc[ai][bj][m][0][j]); y1[j] = gelu_t(acc[ai][bj][m][1][j]); }
                    const size_t tok = (size_t)(rr >> 7) * 2048 + (rr & 127) * 16 + ti;
                    *(u32x4*)(zc + tok * 512 + g * 16 + c0) = pack8(y0, y1); }
        }
        return true;
    }
};

struct PGlu {
    __device__ __forceinline__ int nt(const Unit&) const { return K / BK; }
    static constexpr bool PERM = true;
    int K, lda, ldb, G, c, sample;
    const bf16_t* A; const bf16_t* As; const bf16_t* Bt; const float* bias; bf16_t* out;
    __device__ __forceinline__ bool next(int i, Unit& u) const {
        if (sample) { const int j = c - 128; if (i != 0 || j < 0 || j >= 4) return false; u.pm = 64 + (j >> 1); u.pn = j & 1; u.z = 0; return true; }
        const long L = (long)i * G + c; if (L >= 64 * 2) return false; tile_map((int)L, 64, 2, u.pm, u.pn); u.z = 0; return true; }
    __device__ __forceinline__ const bf16_t* arow0(const Unit& u) const { return u.pm < 64 ? A + (size_t)u.pm * 256 * 512 : As + (size_t)(u.pm - 64) * 256 * 512; }
    __device__ __forceinline__ const char* aptr(const Unit& u) const { return (const char*)arow0(u); }
    __device__ __forceinline__ const char* bptr(const Unit& u) const { return (const char*)Bt + (size_t)u.pn * 256 * 512 * 2; }
    __device__ __forceinline__ bool epi(Acc& acc, const Unit& u, int wr, int wc, int fr, int fq) const {
        const bf16_t* zsrc = arow0(u);
#pragma unroll
        for (int bj = 0; bj < 2; ++bj) {
            const int col = u.pn * 256 + bj * 128 + wc * 32 + 8 * fq;
            const f32x4 b0 = *(const f32x4*)(bias + col), b1 = *(const f32x4*)(bias + col + 4);
#pragma unroll
            for (int ai = 0; ai < 2; ++ai)
#pragma unroll
                for (int m = 0; m < 4; ++m) { const int rl = ai * 128 + wr * 64 + m * 16 + fr; const size_t r = (size_t)u.pm * 256 + rl;
                    const u32x4 zw = *(const u32x4*)(zsrc + (size_t)rl * 512 + col); float zf[8]; unpack8(zw, zf);
                    f32x4 y0, y1;
#pragma unroll
                    for (int j = 0; j < 4; ++j) { y0[j] = zf[j] * sigm(acc[ai][bj][m][0][j] + b0[j]); y1[j] = zf[4 + j] * sigm(acc[ai][bj][m][1][j] + b1[j]); }
                    *(u32x4*)(out + r * 512 + col) = pack8(y0, y1); }
        }
        return true;
    }
};

template <bool SAMPLE> struct PMergeT {
    __device__ __forceinline__ int nt(const Unit&) const { return K / BK; }
    static constexpr bool PERM = true;
    int K, lda, ldb, G, c;
    const bf16_t* a0; const bf16_t* wp; const unsigned char* gl8; bf16_t* mb; float* pm3;
    __device__ __forceinline__ bool next(int i, Unit& u) const { const int ti = i / 3;
        if (SAMPLE) { const int j = c - (G - 24); if (i != 0 || j < 0) return false; const int t = j / 3; u.pm = 64 + (t >> 2); u.pn = t & 3; u.z = j - t * 3; return true; }
        const long L = (long)ti * G + c; if (L >= 64 * 4) return false; tile_map((int)L, 64, 4, u.pm, u.pn); u.z = i - ti * 3; return true; }
    __device__ __forceinline__ const char* aptr(const Unit& u) const { const size_t off = (u.z == 2) ? (OFF_XB + S17 - OFF_R) : (size_t)u.z * S17; return (const char*)a0 + off + (size_t)u.pm * 256 * 512 * 2; }
    __device__ __forceinline__ const char* bptr(const Unit& u) const { return (const char*)wp + ((size_t)u.z * 1024 + (size_t)u.pn * 256) * 512 * 2; }
    __device__ __forceinline__ bool epi(Acc& acc, const Unit& u, int wr, int wc, int fr, int fq) const {
        const int br = u.z;
        const unsigned char* blk = gl8 + ((size_t)(u.pm * 12 + br * 4 + u.pn) << 16) + (size_t)(((wr * 4 + wc) * 64 + fq * 16 + fr) * 128);
#pragma unroll
        for (int ai = 0; ai < 2; ++ai)
#pragma unroll
            for (int m = 0; m < 4; ++m) { const size_t r = (size_t)u.pm * 256 + ai * 128 + wr * 64 + m * 16 + fr;
                const u32x4 qc = *(const u32x4*)(blk + (ai * 4 + m) * 16);
                if (SAMPLE) {
#pragma unroll
                    for (int bj = 0; bj < 2; ++bj) { const int col = u.pn * 256 + bj * 128 + wc * 32 + 8 * fq;
                        f32x4 y0, y1;
#pragma unroll
                        for (int j = 0; j < 4; ++j) {
                            y0[j] = acc[ai][bj][m][0][j] * (((float)((qc[bj * 2] >> (8 * j)) & 255u) + 0.5f) * (1.0f / 256.0f));
                            y1[j] = acc[ai][bj][m][1][j] * (((float)((qc[bj * 2 + 1] >> (8 * j)) & 255u) + 0.5f) * (1.0f / 256.0f)); }
                        float* pp = pm3 + (size_t)br * PART_STRIDE + (r - MP) * 1024 + col; *(f32x4*)pp = y0; *(f32x4*)(pp + 4) = y1; }
                } else if (br < 2) {
                    const u32x4 qn = *(const u32x4*)(blk + 4 * 65536 + (ai * 4 + m) * 16);
#pragma unroll
                    for (int bj = 0; bj < 2; ++bj)
#pragma unroll
                        for (int n = 0; n < 2; ++n)
#pragma unroll
                            for (int j = 0; j < 4; ++j) { const float gc = (float)((qc[bj * 2 + n] >> (8 * j)) & 255u) + 0.5f, gn = (float)((qn[bj * 2 + n] >> (8 * j)) & 255u) + 0.5f;
                                acc[ai][bj][m][n][j] *= gc * __builtin_amdgcn_rcpf(gn); }
                } else {
#pragma unroll
                    for (int bj = 0; bj < 2; ++bj) { const int col = u.pn * 256 + bj * 128 + wc * 32 + 8 * fq;
                        f32x4 y0, y1;
#pragma unroll
                        for (int j = 0; j < 4; ++j) {
                            y0[j] = acc[ai][bj][m][0][j] * (((float)((qc[bj * 2] >> (8 * j)) & 255u) + 0.5f) * (1.0f / 256.0f));
                            y1[j] = acc[ai][bj][m][1][j] * (((float)((qc[bj * 2 + 1] >> (8 * j)) & 255u) + 0.5f) * (1.0f / 256.0f)); }
                        *(u32x4*)(mb + r * 1024 + col) = pack8(y0, y1); }
                } }
        return SAMPLE || br == 2;
    }
};

struct PWout {
    static constexpr bool PERM = true;
    int K, lda, ldb, G, c;
    const bf16_t* A; const bf16_t* Bt; bf16_t* T; float* R; float* part;
    __device__ __forceinline__ int nt(const Unit& u) const { return u.z < 0 ? 16 : 4; }
    __device__ __forceinline__ bool next(int i, Unit& u) const {
        const int nP = c < 256 ? (256 - c + G - 1) / G : 0;
        if (i < nP) { tile_map(i * G + c, 64, 4, u.pm, u.pn); u.z = -1; return true; }
        const int j = (i - nP) * G + c; if (j >= 32) return false;
        u.pm = 64 + (j >> 4); u.pn = (j >> 2) & 3; u.z = j & 3; return true; }
    __device__ __forceinline__ const char* aptr(const Unit& u) const { return (const char*)A + (size_t)u.pm * 256 * 1024 * 2 + (u.z < 0 ? 0 : u.z * 512); }
    __device__ __forceinline__ const char* bptr(const Unit& u) const { return (const char*)Bt + (size_t)u.pn * 256 * 1024 * 2 + (u.z < 0 ? 0 : u.z * 512); }
    __device__ __forceinline__ bool epi(Acc& acc, const Unit& u, int wr, int wc, int fr, int fq) const {
#pragma unroll
        for (int ai = 0; ai < 2; ++ai)
#pragma unroll
            for (int m = 0; m < 4; ++m) { const size_t r = (size_t)u.pm * 256 + ai * 128 + wr * 64 + m * 16 + fr;
#pragma unroll
                for (int bj = 0; bj < 2; ++bj) { const int col = u.pn * 256 + bj * 128 + wc * 32 + 8 * fq;
                    if (u.z < 0) *(u32x4*)(T + r * 1024 + col) = pack8(acc[ai][bj][m][0], acc[ai][bj][m][1]);
                    else { float* pp = (u.z == 0) ? R + r * 1024 + col : part + (size_t)(u.z - 1) * PART_STRIDE + (r - MP) * 1024 + col;
                        *(f32x4*)pp = acc[ai][bj][m][0]; *(f32x4*)(pp + 4) = acc[ai][bj][m][1]; } } }
        return true;
    }
};

struct PUp {
    __device__ __forceinline__ int nt(const Unit&) const { return K / BK; }
    static constexpr bool PERM = true;
    int K, lda, ldb, G, c;
    const bf16_t* A; const bf16_t* Bt; bf16_t* h;
    __device__ __forceinline__ bool next(int i, Unit& u) const { const long L = (long)i * G + c; if (L >= 66 * 16) return false; tile_map((int)L, 66, 16, u.pm, u.pn); u.z = 0; return true; }
    __device__ __forceinline__ const char* aptr(const Unit& u) const { return (const char*)A + (size_t)u.pm * 256 * 1024 * 2; }
    __device__ __forceinline__ const char* bptr(const Unit& u) const { return (const char*)Bt + (size_t)u.pn * 256 * 1024 * 2; }
    __device__ __forceinline__ bool epi(Acc& acc, const Unit& u, int wr, int wc, int fr, int fq) const {
#pragma unroll
        for (int ai = 0; ai < 2; ++ai)
#pragma unroll
            for (int m = 0; m < 4; ++m) { const size_t r = (size_t)u.pm * 256 + ai * 128 + wr * 64 + m * 16 + fr;
#pragma unroll
                for (int bj = 0; bj < 2; ++bj) { const int col = u.pn * 256 + bj * 128 + wc * 32 + 8 * fq;
                    f32x4 y0, y1;
#pragma unroll
                    for (int j = 0; j < 4; ++j) { const float v0 = fmaxf(acc[ai][bj][m][0][j], 0.f), v1 = fmaxf(acc[ai][bj][m][1][j], 0.f); y0[j] = v0 * v0; y1[j] = v1 * v1; }
                    *(u32x4*)(h + r * 4096 + col) = pack8(y0, y1); } }
        return true;
    }
};

struct PDown {
    static constexpr bool PERM = true;
    int K, lda, ldb, G, c;
    const bf16_t* A; const bf16_t* Bt; bf16_t* T; float* R; float* part;
    __device__ __forceinline__ int nt(const Unit& u) const { return u.z < 0 ? 64 : 16; }
    __device__ __forceinline__ bool next(int i, Unit& u) const {
        const int nP = c < 256 ? (256 - c + G - 1) / G : 0;
        if (i < nP) { tile_map(i * G + c, 64, 4, u.pm, u.pn); u.z = -1; return true; }
        const int j = (i - nP) * G + c; if (j >= 32) return false;
        u.pm = 64 + (j >> 4); u.pn = (j >> 2) & 3; u.z = j & 3; return true; }
    __device__ __forceinline__ const char* aptr(const Unit& u) const { return (const char*)A + (size_t)u.pm * 256 * 4096 * 2 + (u.z < 0 ? 0 : u.z * 2048); }
    __device__ __forceinline__ const char* bptr(const Unit& u) const { return (const char*)Bt + (size_t)u.pn * 256 * 4096 * 2 + (u.z < 0 ? 0 : u.z * 2048); }
    __device__ __forceinline__ bool epi(Acc& acc, const Unit& u, int wr, int wc, int fr, int fq) const {
#pragma unroll
        for (int ai = 0; ai < 2; ++ai)
#pragma unroll
            for (int m = 0; m < 4; ++m) { const size_t r = (size_t)u.pm * 256 + ai * 128 + wr * 64 + m * 16 + fr;
#pragma unroll
                for (int bj = 0; bj < 2; ++bj) { const int col = u.pn * 256 + bj * 128 + wc * 32 + 8 * fq;
                    if (u.z < 0) *(u32x4*)(T + r * 1024 + col) = pack8(acc[ai][bj][m][0], acc[ai][bj][m][1]);
                    else { float* pp = (u.z == 0) ? R + r * 1024 + col : part + (size_t)(u.z - 1) * PART_STRIDE + (r - MP) * 1024 + col;
                        *(f32x4*)pp = acc[ai][bj][m][0]; *(f32x4*)(pp + 4) = acc[ai][bj][m][1]; } } }
        return true;
    }
};

__device__ __forceinline__ void tdec(AP a, int layer, int t, const float*& W, bf16_t*& Wt, int& K, int& N, int& tk, int& tn4, int& c0, int& c1, int& c2, int& c3) {
    unsigned char* ws = a->ws; int tt;
    if (t < 384) { tt = t; W = a->in[I_WIN] + (size_t)layer * 1024 * 6144; Wt = (bf16_t*)(ws + OFF_WIN); K = 1024; N = 6144; }
    else if (t < 480) { const int q = (t - 384) / 32; tt = (t - 384) % 32; W = a->in[I_PA + q] + (size_t)layer * 512 * 1024; Wt = (bf16_t*)(ws + OFF_WP) + (size_t)q * 1024 * 512; K = 512; N = 1024; }
    else if (t < 496) { tt = t - 480; W = a->in[I_GLW] + (size_t)layer * 512 * 512; Wt = (bf16_t*)(ws + OFF_WGLU); K = 512; N = 512; }
    else if (t < 560) { tt = t - 496; W = a->in[I_WO] + (size_t)layer * 1024 * 1024; Wt = (bf16_t*)(ws + OFF_WOUT); K = 1024; N = 1024; }
    else if (t < 816) { tt = t - 560; W = a->in[I_UP] + (size_t)layer * 1024 * 4096; Wt = (bf16_t*)(ws + OFF_WUP); K = 1024; N = 4096; }
    else { tt = t - 816; W = a->in[I_DN] + (size_t)layer * 4096 * 1024; Wt = (bf16_t*)(ws + OFF_WDOWN); K = 4096; N = 1024; }
    const int ntn = N / 256; tk = tt / ntn; tn4 = tt % ntn;
    c0 = tn4 * 256; c2 = c0 + 128;
    if (t < 384 && tn4 >= 6 && tn4 < 10) { c0 = 1536 + 128 * (tn4 - 6); c2 = 2048 + 128 * (tn4 - 6); }
    c1 = c0 + 64; c3 = c2 + 64;
}
__device__ __forceinline__ void tload(const float* W, int N, int tk, int c0, int c1, int c2, int c3, int tid, f32x4 (&v)[4][2]) {
    const int r = tid >> 3, c8 = (tid & 7) * 8; const float* src = W + (size_t)(tk * 64 + r) * N + c8;
    v[0][0] = *(const f32x4*)(src + c0); v[0][1] = *(const f32x4*)(src + c0 + 4); v[1][0] = *(const f32x4*)(src + c1); v[1][1] = *(const f32x4*)(src + c1 + 4);
    v[2][0] = *(const f32x4*)(src + c2); v[2][1] = *(const f32x4*)(src + c2 + 4); v[3][0] = *(const f32x4*)(src + c3); v[3][1] = *(const f32x4*)(src + c3 + 4);
}

__device__ __forceinline__ void abar_pow(const float* are, const float* aim, const float* ldt, int sp, float e, float& pr, float& pi) {
    const float step = expf(ldt[sp]); const float x = e * step * are[sp], th = e * step * aim[sp];
    float s, c; sincosf(th, &s, &c); const float mg = expf(x); pr = mg * c; pi = mg * s;
}
__device__ __forceinline__ void ssm_coef(const float* are, const float* aim, const float* ldt, int sp, float& cr, float& ci) {
    const float step = expf(ldt[sp]); const float ar = are[sp], ai = aim[sp];
    const float x = step * ar, th = step * ai;
    float s, c; sincosf(th, &s, &c); const float em1 = expm1f(x); const float sh = sinf(0.5f * th);
    const float nr = em1 * c - 2.0f * sh * sh, ni = (em1 + 1.0f) * s;
    const float den = ar * ar + ai * ai;
    cr = (nr * ar + ni * ai) / den; ci = (ni * ar - nr * ai) / den;
}

__device__ __forceinline__ void prep_layer(AP a, int layer, float* sm, const int wv_) {
    unsigned char* ws = a->ws;
    const int G = gridDim.x;
    {
        const int tid = otid(wv_), r = tid >> 3, c8 = (tid & 7) * 8, n = tid >> 3, k8 = (tid & 7) * 8;
        int t = blockIdx.x; f32x4 v[4][2];
        const float* W = nullptr; bf16_t* Wt = nullptr; int K = 0, N = 0, tk = 0, tn4 = 0, c0 = 0, c1 = 0, c2 = 0, c3 = 0;
        if (t < 1072) { tdec(a, layer, t, W, Wt, K, N, tk, tn4, c0, c1, c2, c3); tload(W, N, tk, c0, c1, c2, c3, tid, v); }
        while (t < 1072) {
#pragma unroll
            for (int q = 0; q < 4; ++q)
#pragma unroll
                for (int e = 0; e < 4; ++e) { sm[q * 4160 + r * 65 + c8 + e] = v[q][0][e]; sm[q * 4160 + r * 65 + c8 + 4 + e] = v[q][1][e]; }
            __syncthreads();
            bf16_t* const cWt = Wt; const int cK = K, ctk = tk, ctn4 = tn4; const int tn = t + G;
            if (tn < 1072) { tdec(a, layer, tn, W, Wt, K, N, tk, tn4, c0, c1, c2, c3); tload(W, N, tk, c0, c1, c2, c3, tid, v); }
#pragma unroll
            for (int q = 0; q < 4; ++q) { const float* tt = sm + q * 4160;
                u32x4 w;
                w.x = cvt_pk_bf16(tt[(k8 + 0) * 65 + n], tt[(k8 + 1) * 65 + n]); w.y = cvt_pk_bf16(tt[(k8 + 2) * 65 + n], tt[(k8 + 3) * 65 + n]);
                w.z = cvt_pk_bf16(tt[(k8 + 4) * 65 + n], tt[(k8 + 5) * 65 + n]); w.w = cvt_pk_bf16(tt[(k8 + 6) * 65 + n], tt[(k8 + 7) * 65 + n]);
                *(u32x4*)(cWt + (size_t)(ctn4 * 256 + q * 64 + n) * cK + ctk * 64 + k8) = w; }
            __syncthreads();
            t = tn;
        }
    }
    const int GT = G * NTHR;
    {
        bf16_t* wg = (bf16_t*)(ws + OFF_WGATE);
        for (int idx = blockIdx.x * NTHR + otid(wv_); idx < 1024 * 32; idx += GT) {
            const int n = idx >> 5, k0 = (idx & 31) * 8; const int pn = n >> 8, bj = (n >> 7) & 1, ch = pn * 128 + (n & 127), hd = ch >> 6, j = ch & 63;
            u32x4 w = (u32x4){0u, 0u, 0u, 0u};
            if ((pn >> 1) * 4 + (k0 >> 6) == hd) { const float* src = a->in[bj ? I_GAW : I_GXW] + (size_t)layer * 8 * 64 * 64 + (size_t)hd * 4096 + (size_t)(k0 & 63) * 64 + j;
                w.x = cvt_pk_bf16(src[0], src[64]); w.y = cvt_pk_bf16(src[128], src[192]); w.z = cvt_pk_bf16(src[256], src[320]); w.w = cvt_pk_bf16(src[384], src[448]); }
            *(u32x4*)(wg + (size_t)n * 256 + k0) = w;
        }
    }
    const float* are = a->in[I_SAR] + layer * 2048; const float* aim = a->in[I_SAI] + layer * 2048; const float* ldt = a->in[I_SDT] + layer * 2048;
    const float* bre = a->in[I_SBR] + layer * 32768; const float* bim = a->in[I_SBI] + layer * 32768;
    const float* cre = a->in[I_SCR] + layer * 32768; const float* cim = a->in[I_SCI] + layer * 32768;
    {
        bf16_t* w1 = (bf16_t*)(ws + OFF_W1T);
        for (int idx = blockIdx.x * NTHR + otid(wv_); idx < 32 * 128 * 32; idx += GT) {
            const int g = idx >> 12, n = (idx >> 5) & 127, k0 = (idx & 31) * 8, j = k0 >> 4, c0 = k0 & 15, p = n & 63, part = n >> 6, sp = g * 64 + p;
            float pr, pi, cr, ci; abar_pow(are, aim, ldt, sp, (float)(15 - j), pr, pi); ssm_coef(are, aim, ldt, sp, cr, ci);
            const float qr = pr * cr - pi * ci, qi = pr * ci + pi * cr;
            float o[8];
#pragma unroll
            for (int q = 0; q < 8; ++q) { const float br = bre[sp * 16 + c0 + q], bi = bim[sp * 16 + c0 + q]; o[q] = part ? (qr * bi + qi * br) : (qr * br - qi * bi); }
            u32x4 w; w.x = cvt_pk_bf16(o[0], o[1]); w.y = cvt_pk_bf16(o[2], o[3]); w.z = cvt_pk_bf16(o[4], o[5]); w.w = cvt_pk_bf16(o[6], o[7]);
            *(u32x4*)(w1 + ((size_t)(g * 128 + n) * 256 + k0)) = w;
        }
    }
    {
        bf16_t* wy = (bf16_t*)(ws + OFF_WYT);
        for (int idx = blockIdx.x * NTHR + otid(wv_); idx < 32 * 256 * 16; idx += GT) {
            const int g = idx >> 12, n = (idx >> 4) & 255, k0 = (idx & 15) * 8, i = n >> 4, c = n & 15, part = k0 >> 6, p0 = k0 & 63;
            float o[8];
#pragma unroll
            for (int q = 0; q < 8; ++q) { const int p = p0 + q, sp = g * 64 + p; float pr, pi; abar_pow(are, aim, ldt, sp, (float)(i + 1), pr, pi);
                const float xr = cre[(g * 16 + c) * 64 + p], xi = cim[(g * 16 + c) * 64 + p];
                o[q] = part ? -(xr * pi + xi * pr) : (xr * pr - xi * pi); }
            u32x4 w; w.x = cvt_pk_bf16(o[0], o[1]); w.y = cvt_pk_bf16(o[2], o[3]); w.z = cvt_pk_bf16(o[4], o[5]); w.w = cvt_pk_bf16(o[6], o[7]);
            *(u32x4*)(wy + ((size_t)(g * 256 + n) * 384 + k0)) = w;
        }
        for (int idx = blockIdx.x * NTHR + otid(wv_); idx < 32 * 256 * 4; idx += GT) {
            const int pq = idx & 3, c2 = (idx >> 2) & 15, c = (idx >> 6) & 15, g = idx >> 10;
            float km[16];
#pragma unroll
            for (int d = 0; d < 16; ++d) km[d] = 0.f;
            for (int pp = 0; pp < 16; ++pp) { const int p = pq * 16 + pp, sp = g * 64 + p; float ar, ai, cr, ci; abar_pow(are, aim, ldt, sp, 1.0f, ar, ai); ssm_coef(are, aim, ldt, sp, cr, ci);
                const float br = bre[sp * 16 + c2], bi = bim[sp * 16 + c2];
                const float bbr = cr * br - ci * bi, bbi = cr * bi + ci * br;
                const float xr = cre[(g * 16 + c) * 64 + p], xi = cim[(g * 16 + c) * 64 + p];
                float tr = xr * bbr - xi * bbi, ti = xr * bbi + xi * bbr;
#pragma unroll
                for (int d = 0; d < 16; ++d) { km[d] += tr; const float nr = tr * ar - ti * ai, ni = tr * ai + ti * ar; tr = nr; ti = ni; } }
            { const int ln = idx & 63;
#pragma unroll
            for (int d = 0; d < 16; ++d) { km[d] += shx(km[d], 1, ln); km[d] += shx(km[d], 2, ln); } }
            if (c == c2) km[0] += a->in[I_SD][layer * 512 + g * 16 + c];
#pragma unroll
            for (int d = 0; d < 16; ++d) if ((d & 3) == pq) { const bf16_t kb = f2bf(km[d]);
                for (int i = d; i < 16; ++i) wy[(size_t)(g * 256 + i * 16 + c) * 384 + 128 + (i - d) * 16 + c2] = kb;
                if (d > 0) for (int i = 0; i < 16 - d; ++i) wy[(size_t)(g * 256 + i * 16 + c) * 384 + 128 + (i + d) * 16 + c2] = (bf16_t)0; }
        }
    }
}

__device__ __forceinline__ void prep_x(AP a, const int wv_) {
    bf16_t* xb = (bf16_t*)(a->ws + OFF_XB);
    const int gt = blockIdx.x * NTHR + otid(wv_), GT = gridDim.x * NTHR;
    for (int idx = gt; idx < M * 128; idx += GT) {
        const size_t e = (size_t)idx * 8; const float* src = e < (size_t)MP * 1024 ? a->in[I_XP] + e : a->in[I_XS] + (e - (size_t)MP * 1024);
        const f32x4 v0 = *(const f32x4*)src, v1 = *(const f32x4*)(src + 4);
        *(u32x4*)(xb + e) = pack8(v0, v1);
    }
}

__device__ __forceinline__ void conv_phase(AP a, int layer, bf16_t* bin_out, const int wv_) {
    unsigned char* ws = a->ws;
    const bf16_t* xa = (const bf16_t*)(ws + OFF_R); bf16_t* sb = (bf16_t*)(ws + OFF_R + S17);
    const bf16_t* sc = (const bf16_t*)(ws + OFF_R + 2 * S17);
    bf16_t* xac = (bf16_t*)(ws + OFF_XB);
    const float* caw = a->in[I_CAW] + layer * 4 * 512; const float* cab = a->in[I_CAB] + layer * 512; const float* cbw = a->in[I_CBW] + layer * 3 * 512;
    const int gt = blockIdx.x * NTHR + otid(wv_), GT = gridDim.x * NTHR;
    for (int it = gt; it < (2048 + 128) * 64; it += GT) {
        const int idx = it < 128 * 64 ? it + 2048 * 64 : it - 128 * 64;
        const int seg = idx >> 6, c0 = (idx & 63) * 8;
        const bool prompt = seg < 2048;
        int row0, nrows;
        float x0[8], x1[8], x2[8], u1[8], u2[8];
        if (prompt) { row0 = seg * 8; nrows = 8; const bool first = (seg & 255) == 0;
            if (first) {
#pragma unroll
                for (int j = 0; j < 8; ++j) { x0[j] = 0.f; x1[j] = 0.f; x2[j] = 0.f; u1[j] = 0.f; u2[j] = 0.f; }
            } else {
                unpack8(*(const u32x4*)(xa + (size_t)(row0 - 3) * 512 + c0), x0); unpack8(*(const u32x4*)(xa + (size_t)(row0 - 2) * 512 + c0), x1); unpack8(*(const u32x4*)(xa + (size_t)(row0 - 1) * 512 + c0), x2);
                unpack8(*(const u32x4*)(sc + (size_t)(row0 - 2) * 512 + c0), u1);
                unpack8(*(const u32x4*)(sc + (size_t)(row0 - 1) * 512 + c0), u2);
            }
        } else { const int b = seg - 2048; row0 = MP + b * 4; nrows = 4;
            const float* lc = a->in[I_SLC] + ((size_t)(layer * 128 + b) * 3) * 512 + c0; const float* scs = a->in[I_SSC] + ((size_t)(layer * 128 + b) * 2) * 512 + c0;
#pragma unroll
            for (int j = 0; j < 8; ++j) { x0[j] = lc[j]; x1[j] = lc[512 + j]; x2[j] = lc[1024 + j]; u1[j] = scs[j]; u2[j] = scs[512 + j]; }
        }
        float w0[8], w1[8], w2[8], w3[8], wb[8], v0[8], v1[8], v2[8];
#pragma unroll
        for (int j = 0; j < 8; ++j) { w0[j] = caw[c0 + j]; w1[j] = caw[512 + c0 + j]; w2[j] = caw[1024 + c0 + j]; w3[j] = caw[1536 + c0 + j]; wb[j] = cab[c0 + j];
            v0[j] = cbw[c0 + j]; v1[j] = cbw[512 + c0 + j]; v2[j] = cbw[1024 + c0 + j]; }
        for (int t0 = 0; t0 < nrows; t0 += 2) {
            u32x4 lx[2], lc[2], lb[2];
#pragma unroll
            for (int k = 0; k < 2; ++k) { const size_t off = (size_t)(row0 + t0 + k) * 512 + c0;
                lx[k] = *(const u32x4*)(xa + off); lc[k] = *(const u32x4*)(sc + off); lb[k] = *(const u32x4*)(sb + off); }
#pragma unroll
            for (int k = 0; k < 2; ++k) { const size_t off = (size_t)(row0 + t0 + k) * 512 + c0;
                float xv[8], scv[8], sbv[8];
                unpack8(lx[k], xv); unpack8(lc[k], scv); unpack8(lb[k], sbv);
                f32x4 o0, o1, q0, q1;
#pragma unroll
                for (int j = 0; j < 8; ++j) {
                    const float o = w0[j] * x0[j] + w1[j] * x1[j] + w2[j] * x2[j] + w3[j] * xv[j] + wb[j];
                    const float uu = scv[j]; const float cu = v0[j] * u1[j] + v1[j] * u2[j] + v2[j] * uu; const float bi = sbv[j] * cu;
                    if (j < 4) { o0[j] = o; q0[j] = bi; } else { o1[j - 4] = o; q1[j - 4] = bi; }
                    x0[j] = x1[j]; x1[j] = x2[j]; x2[j] = xv[j]; u1[j] = u2[j]; u2[j] = uu;
                }
                *(u32x4*)(xac + off) = pack8(o0, o1);
                *(u32x4*)(bin_out + off) = pack8(q0, q1); }
        }
        if (prompt) { if ((seg & 255) == 255) { const int b = seg >> 8;
                float* o1 = a->out + O_LCP + ((size_t)(layer * 8 + b) * 3) * 512 + c0; float* o2 = a->out + O_SCP + ((size_t)(layer * 8 + b) * 2) * 512 + c0;
#pragma unroll
                for (int j = 0; j < 8; ++j) { o1[j] = x0[j]; o1[512 + j] = x1[j]; o1[1024 + j] = x2[j]; o2[j] = u1[j]; o2[512 + j] = u2[j]; } }
        } else { const int b = seg - 2048;
            float* o1 = a->out + O_LCS + ((size_t)(layer * 128 + b) * 3) * 512 + c0; float* o2 = a->out + O_SCS + ((size_t)(layer * 128 + b) * 2) * 512 + c0;
#pragma unroll
            for (int j = 0; j < 8; ++j) { o1[j] = x0[j]; o1[512 + j] = x1[j]; o1[1024 + j] = x2[j]; o2[j] = u1[j]; o2[512 + j] = u2[j]; }
        }
    }
}

__device__ __forceinline__ void ssm_s_gemm(AP a, const int wv_) {
    const bf16_t* apack = (const bf16_t*)(a->ws + OFF_APACK); const bf16_t* w1 = (const bf16_t*)(a->ws + OFF_W1T); float* S = (float*)(a->ws + OFF_S);
    const int tid_ = otid(wv_); const int lane = tid_ & 63, wv = blockIdx.x * 8 + (tid_ >> 6), NW = gridDim.x * 8;
    const int lr = lane & 15, kq = lane >> 4;
    for (int t = wv; t < 1024; t += NW) {
        const int g = t >> 5, rt = (t >> 1) & 15, ct = t & 1;
        f32x4 acc[4][4];
#pragma unroll
        for (int i = 0; i < 4; ++i)
#pragma unroll
            for (int j = 0; j < 4; ++j) acc[i][j] = (f32x4){0.f, 0.f, 0.f, 0.f};
        const bf16_t* ab = apack + ((size_t)(g * 1024 + rt * 64 + lr) * 384 + 128 + kq * 8);
        const bf16_t* bb = w1 + ((size_t)(g * 128 + ct * 64 + lr) * 256 + kq * 8);
#pragma unroll 2
        for (int ks = 0; ks < 8; ++ks) {
            bf16x8 af[4], bf[4];
#pragma unroll
            for (int i = 0; i < 4; ++i) { af[i] = *(const bf16x8*)(ab + (size_t)i * 16 * 384 + ks * 32); bf[i] = *(const bf16x8*)(bb + (size_t)i * 16 * 256 + ks * 32); }
#pragma unroll
            for (int i = 0; i < 4; ++i)
#pragma unroll
                for (int j = 0; j < 4; ++j) acc[i][j] = __builtin_amdgcn_mfma_f32_16x16x32_bf16(af[i], bf[j], acc[i][j], 0, 0, 0);
        }
#pragma unroll
        for (int i = 0; i < 4; ++i)
#pragma unroll
            for (int j = 0; j < 4; ++j)
#pragma unroll
                for (int q = 0; q < 4; ++q) S[(size_t)(g * 1024 + rt * 64 + i * 16 + kq * 4 + q) * 128 + ct * 64 + j * 16 + lr] = acc[i][j][q];
    }
}

__device__ __forceinline__ void ssm_carry(AP a, int layer, float* sm, const int wv_) {
    bf16_t* apack = (bf16_t*)(a->ws + OFF_APACK); const float* S = (const float*)(a->ws + OFF_S);
    const int tid = otid(wv_), p = tid & 63, seg = tid >> 6;
    for (int pair = blockIdx.x; pair < 256; pair += gridDim.x) {
        const int b = pair >> 5, g = pair & 31, sp = g * 64 + p;
        float ar, ai, Ar, Ai;
        abar_pow(a->in[I_SAR] + layer * 2048, a->in[I_SAI] + layer * 2048, a->in[I_SDT] + layer * 2048, sp, 16.0f, ar, ai);
        abar_pow(a->in[I_SAR] + layer * 2048, a->in[I_SAI] + layer * 2048, a->in[I_SDT] + layer * 2048, sp, 256.0f, Ar, Ai);
        const size_t rbase = (size_t)g * 1024 + b * 128 + seg * 16;
        float sr[16], si[16];
#pragma unroll
        for (int j = 0; j < 16; ++j) { sr[j] = S[(rbase + j) * 128 + p]; si[j] = S[(rbase + j) * 128 + 64 + p]; }
        float hr = 0.f, hi = 0.f;
#pragma unroll
        for (int j = 0; j < 16; ++j) { const float nr = ar * hr - ai * hi + sr[j], ni = ar * hi + ai * hr + si[j]; sr[j] = hr; si[j] = hi; hr = nr; hi = ni; }
        sm[seg * 128 + p] = hr; sm[seg * 128 + 64 + p] = hi;
        __syncthreads();
        float cr = 0.f, ci = 0.f;
        for (int s2 = 0; s2 < seg; ++s2) { const float er = sm[s2 * 128 + p], ei = sm[s2 * 128 + 64 + p]; const float nr = Ar * cr - Ai * ci + er, ni = Ar * ci + Ai * cr + ei; cr = nr; ci = ni; }
        if (seg == 7) { const float fr_ = Ar * cr - Ai * ci + hr, fi_ = Ar * ci + Ai * cr + hi;
            a->out[O_SRP + (size_t)(layer * 8 + b) * 2048 + sp] = fr_; a->out[O_SIP + (size_t)(layer * 8 + b) * 2048 + sp] = fi_; }
#pragma unroll
        for (int j = 0; j < 16; ++j) { apack[(rbase + j) * 384 + p] = f2bf(sr[j] + cr); apack[(rbase + j) * 384 + 64 + p] = f2bf(si[j] + ci);
            const float nr = ar * cr - ai * ci, ni = ar * ci + ai * cr; cr = nr; ci = ni; }
        __syncthreads();
    }
}

__device__ __forceinline__ void ssm_sample(AP a, int layer, int wv, int NW, const int wv_) {
    const bf16_t* uss = (const bf16_t*)(a->ws + OFF_USS); bf16_t* zc = (bf16_t*)(a->ws + OFF_ZCS);
    const float* are = a->in[I_SAR] + layer * 2048; const float* aim = a->in[I_SAI] + layer * 2048; const float* ldt = a->in[I_SDT] + layer * 2048;
    const float* bre = a->in[I_SBR] + layer * 32768; const float* bim = a->in[I_SBI] + layer * 32768;
    const float* cre = a->in[I_SCR] + layer * 32768; const float* cim = a->in[I_SCI] + layer * 32768; const float* dv = a->in[I_SD] + layer * 512;
    const int lane = otid(wv_) & 63;
    for (int t = wv; t < 128 * 32; t += NW) {
        const int b = t >> 5, g = t & 31, sp = g * 64 + lane;
        float ar, ai, cr, ci; abar_pow(are, aim, ldt, sp, 1.0f, ar, ai); ssm_coef(are, aim, ldt, sp, cr, ci);
        float bbr[16], bbi[16], xr[16], xi[16];
#pragma unroll
        for (int c = 0; c < 16; ++c) { const float br = bre[sp * 16 + c], bi = bim[sp * 16 + c]; bbr[c] = cr * br - ci * bi; bbi[c] = cr * bi + ci * br;
            xr[c] = cre[(g * 16 + c) * 64 + lane]; xi[c] = cim[(g * 16 + c) * 64 + lane]; }
        float hr = a->in[I_SSR][(size_t)(layer * 128 + b) * 2048 + sp], hi = a->in[I_SSI][(size_t)(layer * 128 + b) * 2048 + sp];
        const float dme = lane < 16 ? dv[g * 16 + lane] : 0.f;
        for (int tt = 0; tt < 4; ++tt) {
            const bf16_t* up = uss + (size_t)(b * 4 + tt) * 512 + g * 16;
            const u32x4 w0 = *(const u32x4*)up, w1 = *(const u32x4*)(up + 8);
            float u[16]; { float t0[8], t1[8]; unpack8(w0, t0); unpack8(w1, t1);
#pragma unroll
                for (int c = 0; c < 8; ++c) { u[c] = t0[c]; u[8 + c] = t1[c]; } }
            float br_ = 0.f, bi_ = 0.f;
#pragma unroll
            for (int c = 0; c < 16; ++c) { br_ += bbr[c] * u[c]; bi_ += bbi[c] * u[c]; }
            const float nr = ar * hr - ai * hi + br_, ni = ar * hi + ai * hr + bi_; hr = nr; hi = ni;
            float mine = 0.f, ume = 0.f;
#pragma unroll
            for (int c = 0; c < 16; ++c) { float y = xr[c] * hr - xi[c] * hi;
#pragma unroll
                for (int o = 32; o >= 1; o >>= 1) y += shx(y, o, lane);
                if (lane == c) { mine = y; ume = u[c]; } }
            if (lane < 16) zc[(size_t)(b * 4 + tt) * 512 + g * 16 + lane] = f2bf(gelu_t(mine + dme * ume));
        }
        a->out[O_SRS + (size_t)(layer * 128 + b) * 2048 + sp] = hr; a->out[O_SIS + (size_t)(layer * 128 + b) * 2048 + sp] = hi;
    }
}

__device__ __forceinline__ void lru_local(AP a, const int wv_) {
    const _Float16* av = (const _Float16*)(a->ws + OFF_R + 2 * S17); const bf16_t* bx = (const bf16_t*)(a->ws + OFF_R); f32x2* car = (f32x2*)(a->ws + OFF_CAR);
    const int gt = blockIdx.x * NTHR + otid(wv_), GT = gridDim.x * NTHR;
    for (int idx = gt; idx < 8 * 32 * 512; idx += GT) {
        const int c = idx & 511, sc = idx >> 9;
        const size_t base = (size_t)sc * 64 * 512 + c;
        float P = 1.f, h = 0.f;
        for (int t0 = 0; t0 < 64; t0 += 16) {
            _Float16 al[16]; bf16_t bb[16];
#pragma unroll
            for (int j = 0; j < 16; ++j) { al[j] = av[base + (size_t)(t0 + j) * 512]; bb[j] = bx[base + (size_t)(t0 + j) * 512]; }
#pragma unroll
            for (int j = 0; j < 16; ++j) { const float aa = __expf((float)al[j]); h = aa * h + bf2f(bb[j]); P *= aa; }
        }
        car[idx] = (f32x2){P, h};
    }
}
template <int B>
__device__ __forceinline__ float lru_run(const _Float16* av, const bf16_t* bx, bf16_t* ao, const bf16_t* ya, size_t base, int n, float h) {
    for (int t0 = 0; t0 < n; t0 += B) {
        _Float16 aa[B]; bf16_t bb[B], yy[B];
#pragma unroll
        for (int j = 0; j < B; ++j) { const size_t o = base + (size_t)(t0 + j) * 512; aa[j] = av[o]; bb[j] = bx[o]; yy[j] = ya[o]; }
        bf16_t oo[B];
#pragma unroll
        for (int j = 0; j < B; ++j) { h = __expf((float)aa[j]) * h + bf2f(bb[j]); oo[j] = f2bf(h * gelu_t(bf2f(yy[j]))); }
#pragma unroll
        for (int j = 0; j < B; ++j) ao[base + (size_t)(t0 + j) * 512] = oo[j];
    }
    return h;
}
__device__ __forceinline__ void lru_apply(AP a, int layer, bf16_t* ao, int mode, const int wv_) {
    const _Float16* av = (const _Float16*)(a->ws + OFF_R + 2 * S17); const bf16_t* bx = (const bf16_t*)(a->ws + OFF_R); const f32x2* car = (const f32x2*)(a->ws + OFF_CAR);
    const bf16_t* ya = (const bf16_t*)(a->ws + OFF_YA);
    const int G = gridDim.x, bid = blockIdx.x;
    if (mode == 0) {
        for (int idx = bid * NTHR + otid(wv_); idx < 8 * 32 * 512; idx += G * NTHR) {
            const int c = idx & 511, sc = idx >> 9, seq = sc >> 5, chunk = sc & 31;
            float h = 0.f;
            f32x2 ph[31];
#pragma unroll
            for (int k = 0; k < 31; ++k) ph[k] = car[(seq * 32 + (k < chunk ? k : 0)) * 512 + c];
#pragma unroll
            for (int k = 0; k < 31; ++k) if (k < chunk) h = ph[k].x * h + ph[k].y;
            h = lru_run<8>(av, bx, ao, ya, (size_t)sc * 64 * 512 + c, 64, h);
            if (chunk == 31) a->out[O_LHP + (size_t)(layer * 8 + seq) * 512 + c] = h;
        }
    } else {
        for (int j = bid * NTHR + otid(wv_); j < 128 * 512; j += G * NTHR) {
            const int c = j & 511, b = j >> 9;
            float h = a->in[I_SLH][(size_t)(layer * 128 + b) * 512 + c];
            h = lru_run<4>(av, bx, ao, ya, (size_t)(MP + b * 4) * 512 + c, 4, h);
            a->out[O_LHS + (size_t)(layer * 128 + b) * 512 + c] = h;
        }
    }
}

template <bool RES16>
__device__ __forceinline__ void ln_phase(const bf16_t* T, const float* Rs, const float* part, const float* resp, const float* ress, const bf16_t* res16,
                                         float* dst32, bf16_t* dst16, const float* gam, const float* bet, const int wv_) {
    const int tid_ = otid(wv_); const int lane = tid_ & 63, wv = blockIdx.x * 8 + (tid_ >> 6), NW = gridDim.x * 8;
    for (int r0 = wv; r0 < M; r0 += 3 * NW) {
        f32x4 v[3][4];
#pragma unroll
        for (int k = 0; k < 3; ++k) { const int rr = r0 + k * NW; const int r = rr < M ? rr : r0;
            if (r < MP) {
#pragma unroll
                for (int i = 0; i < 4; ++i) { const u32x2 w = *(const u32x2*)(T + (size_t)r * 1024 + i * 256 + lane * 4); v[k][i] = (f32x4){bflo(w.x), bfhi(w.x), bflo(w.y), bfhi(w.y)}; }
            } else {
#pragma unroll
                for (int i = 0; i < 4; ++i) v[k][i] = *(const f32x4*)(Rs + (size_t)r * 1024 + i * 256 + lane * 4);
#pragma unroll
                for (int q = 0; q < 3; ++q)
#pragma unroll
                    for (int i = 0; i < 4; ++i) v[k][i] += *(const f32x4*)(part + (size_t)q * PART_STRIDE + (size_t)(r - MP) * 1024 + i * 256 + lane * 4);
            }
            if (RES16) {
#pragma unroll
                for (int i = 0; i < 4; ++i) { const u32x2 w = *(const u32x2*)(res16 + (size_t)r * 1024 + i * 256 + lane * 4); v[k][i] += (f32x4){bflo(w.x), bfhi(w.x), bflo(w.y), bfhi(w.y)} * ALPHA; }
            } else { const float* rp = r < MP ? resp + (size_t)r * 1024 : ress + (size_t)(r - MP) * 1024;
#pragma unroll
                for (int i = 0; i < 4; ++i) v[k][i] += *(const f32x4*)(rp + i * 256 + lane * 4) * ALPHA;
            } }
#pragma unroll
        for (int k = 0; k < 3; ++k) { const int r = r0 + k * NW;
            float s = 0.f;
#pragma unroll
            for (int i = 0; i < 4; ++i) s += (v[k][i][0] + v[k][i][1]) + (v[k][i][2] + v[k][i][3]);
#pragma unroll
            for (int o = 32; o >= 1; o >>= 1) s += shx(s, o, lane);
            const float mu = s * (1.0f / 1024.0f); float q = 0.f;
#pragma unroll
            for (int i = 0; i < 4; ++i) { const f32x4 d = v[k][i] - mu; q += (d[0] * d[0] + d[1] * d[1]) + (d[2] * d[2] + d[3] * d[3]); }
#pragma unroll
            for (int o = 32; o >= 1; o >>= 1) q += shx(q, o, lane);
            const float rs = rsqrtf(q * (1.0f / 1024.0f) + LN_EPS);
            if (r < M) {
#pragma unroll
                for (int i = 0; i < 4; ++i) { const int col = i * 256 + lane * 4; const f32x4 gg = *(const f32x4*)(gam + col), bb = *(const f32x4*)(bet + col);
                    const f32x4 y = (v[k][i] - mu) * rs * gg + bb;
                    if (dst32) *(f32x4*)(dst32 + (size_t)r * 1024 + col) = y;
                    if (dst16) { u32x2 w; w.x = cvt_pk_bf16(y[0], y[1]); w.y = cvt_pk_bf16(y[2], y[3]);
                        *(u32x2*)(dst16 + (size_t)r * 1024 + col) = w; } }
            }
        }
    }
}

__global__ void __launch_bounds__(NTHR, 2) fwd_megakernel(Args a_unused) {
    extern __shared__ __attribute__((aligned(16))) unsigned char lds_raw[];
    cg::grid_group grid = cg::this_grid();
    LAS unsigned char* lds = (LAS unsigned char*)lds_raw;
    const int G = gridDim.x, bid = blockIdx.x;
    int wv_; { const int tw = (int)threadIdx.x >> 6; asm volatile("v_readfirstlane_b32 %0, %1" : "=s"(wv_) : "v"(tw)); }

    const unsigned long long t_start = PROBE_ON ? __builtin_amdgcn_s_memrealtime() : 0ull;
    for (int rep = 0; rep < REP_PREP; ++rep) { const AP a = ld_args(); prep_layer(a, 0, (float*)lds_raw, wv_); prep_x(a, wv_); }
    int pidx = 1; unsigned long long tA = PROBE_A == 0 ? t_start : 0ull, tB = 0ull;
    if (PROBE_ON) { if (PROBE_A == 1) tA = __builtin_amdgcn_s_memrealtime(); if (PROBE_B == 1) tB = __builtin_amdgcn_s_memrealtime(); }
    unsigned bar_n = 0; { const AP a = ld_args(); if (a->ws == nullptr) grid.sync(); }
    bar_n += (unsigned)G; gbar((unsigned*)(ld_args()->ws + OFF_BAR), bar_n, wv_);

#pragma unroll 1
    for (int layer = 0; layer < 2; ++layer) {
        { const AP a = ld_args(); unsigned char* ws = a->ws;
          PG1 p; p.K = 1024; p.lda = 1024; p.ldb = 1024; p.G = opq(G); p.c = opq(bid); p.A = layer == 0 ? (const bf16_t*)(ws + OFF_XB) : (const bf16_t*)a->out; p.Bt = (const bf16_t*)(ws + OFF_WIN);
          p.xa = (bf16_t*)(ws + OFF_R); p.ya = (bf16_t*)(ws + OFF_YA); p.sb = (bf16_t*)(ws + OFF_R + S17); p.sc = (bf16_t*)(ws + OFF_R + 2 * S17); p.sh = (bf16_t*)(ws + OFF_R + 3 * S17);
          p.apack = (bf16_t*)(ws + OFF_APACK); p.uss = (bf16_t*)(ws + OFF_USS); p.gl8 = ws + OFF_GL8;
          for (int rep = 0; rep < REP_G1; ++rep) gemm_phase(lds, p, wv_); }
        GSYNC();
        if (DRY_CONV) { const AP a = ld_args(); conv_phase(a, layer, (bf16_t*)(a->ws + OFF_XB + S17), wv_); }
        { const AP a = ld_args(); conv_phase(a, layer, (bf16_t*)(a->ws + OFF_R + S17), wv_); }
        for (int rep = 0; rep < REP_SG; ++rep) { const AP a = ld_args(); ssm_s_gemm(a, wv_); }
        GSYNC();
        for (int rep = 0; rep < REP_CARRY; ++rep) { const AP a = ld_args(); ssm_carry(a, layer, (float*)lds_raw, wv_); }
        { const AP a = ld_args(); unsigned char* ws = a->ws;
          PGate p; p.K = 256; p.lda = 512; p.ldb = 256; p.G = opq(G); p.c = opq(bid); p.A = (const bf16_t*)(ws + OFF_XB); p.Bt = (const bf16_t*)(ws + OFF_WGATE);
          p.gxb = a->in[I_GXB] + layer * 512; p.gab = a->in[I_GAB] + layer * 512; p.lam = a->in[I_LAM] + layer * 512;
          p.aout = (_Float16*)(ws + OFF_R + 2 * S17); p.bxout = (bf16_t*)(ws + OFF_R);
          for (int rep = 0; rep < REP_GATE; ++rep) gemm_phase(lds, p, wv_); }
        for (int rep = 0; rep < REP_SAMPLE; ++rep) if (bid >= 8) { const AP a = ld_args(); ssm_sample(a, layer, (bid - 8) * 8 + wv_, (G - 8) * 8, wv_); }
        GSYNC();
        { const AP a = ld_args(); unsigned char* ws = a->ws;
          PY p; p.K = 384; p.lda = 384; p.ldb = 384; p.G = opq(G); p.c = opq(bid); p.apack = (const bf16_t*)(ws + OFF_APACK); p.wyt = (const bf16_t*)(ws + OFF_WYT);
          p.dvec = a->in[I_SD] + layer * 512; p.zc = (bf16_t*)(ws + OFF_XB);
          for (int rep = 0; rep < REP_Y; ++rep) gemm_phase(lds, p, wv_); }
        { const AP a = ld_args(); unsigned char* ws = a->ws;
          PGlu p; p.K = 512; p.lda = 512; p.ldb = 512; p.G = opq(G); p.c = opq(bid); p.sample = 1; p.A = (const bf16_t*)(ws + OFF_XB); p.As = (const bf16_t*)(ws + OFF_ZCS); p.Bt = (const bf16_t*)(ws + OFF_WGLU);
          p.bias = a->in[I_GLB] + layer * 512; p.out = (bf16_t*)(ws + OFF_XB + S17);
          gemm_phase(lds, p, wv_); }
        { const AP a = ld_args(); lru_apply(a, layer, (bf16_t*)(a->ws + OFF_R), 1, wv_); }
        for (int rep = 0; rep < REP_LOCAL; ++rep) { const AP a = ld_args(); lru_local(a, wv_); }
        GSYNC();
        { const AP a = ld_args(); unsigned char* ws = a->ws;
          PGlu p; p.K = 512; p.lda = 512; p.ldb = 512; p.G = opq(G); p.c = opq(bid); p.sample = 0; p.A = (const bf16_t*)(ws + OFF_XB); p.As = (const bf16_t*)(ws + OFF_ZCS); p.Bt = (const bf16_t*)(ws + OFF_WGLU);
          p.bias = a->in[I_GLB] + layer * 512; p.out = (bf16_t*)(ws + OFF_XB + S17);
          for (int rep = 0; rep < REP_GLU; ++rep) gemm_phase(lds, p, wv_); }
        { const AP a = ld_args(); unsigned char* ws = a->ws;
          PMergeT<true> p; p.K = 512; p.lda = 512; p.ldb = 512; p.G = opq(G); p.c = opq(bid); p.a0 = (const bf16_t*)(ws + OFF_R);
          p.wp = (const bf16_t*)(ws + OFF_WP); p.gl8 = ws + OFF_GL8; p.mb = (bf16_t*)(ws + OFF_MB); p.pm3 = (float*)(ws + OFF_S);
          gemm_phase(lds, p, wv_); }
        if (DRY_APPLY) { const AP a = ld_args(); lru_apply(a, layer, (bf16_t*)(a->ws + OFF_S), 0, wv_); }
        { const AP a = ld_args(); lru_apply(a, layer, (bf16_t*)(a->ws + OFF_R), 0, wv_); }
        GSYNC();
        { const AP a = ld_args(); unsigned char* ws = a->ws;
          PMergeT<false> p; p.K = 512; p.lda = 512; p.ldb = 512; p.G = opq(G); p.c = opq(bid); p.a0 = (const bf16_t*)(ws + OFF_R);
          p.wp = (const bf16_t*)(ws + OFF_WP); p.gl8 = ws + OFF_GL8; p.mb = (bf16_t*)(ws + OFF_MB); p.pm3 = (float*)(ws + OFF_S);
          { const float* pm = (const float*)(ws + OFF_S); bf16_t* ms = (bf16_t*)(ws + OFF_MB) + (size_t)MP * 1024;
            for (int i = bid * NTHR + otid(wv_); i < MS * 128; i += G * NTHR) { const size_t e = (size_t)i * 8;
                f32x4 s0 = *(const f32x4*)(pm + e), s1 = *(const f32x4*)(pm + e + 4);
                s0 += *(const f32x4*)(pm + PART_STRIDE + e); s1 += *(const f32x4*)(pm + PART_STRIDE + e + 4);
                s0 += *(const f32x4*)(pm + 2 * PART_STRIDE + e); s1 += *(const f32x4*)(pm + 2 * PART_STRIDE + e + 4);
                *(u32x4*)(ms + e) = pack8(s0, s1); } }
          for (int rep = 0; rep < REP_MERGE; ++rep) gemm_phase(lds, p, wv_); }
        GSYNC();
        { const AP a = ld_args(); unsigned char* ws = a->ws;
          PWout p; p.K = 1024; p.lda = 1024; p.ldb = 1024; p.G = opq(G); p.c = opq(bid); p.A = (const bf16_t*)(ws + OFF_MB); p.Bt = (const bf16_t*)(ws + OFF_WOUT);
          p.T = (bf16_t*)(ws + OFF_R); p.R = (float*)(ws + OFF_R); p.part = (float*)(ws + OFF_PW);
          gemm_phase(lds, p, wv_); }
        GSYNC();
        { const AP a = ld_args(); unsigned char* ws = a->ws;
          if (layer == 0) ln_phase<false>((const bf16_t*)(ws + OFF_R), (const float*)(ws + OFF_R), (const float*)(ws + OFF_PW), a->in[I_XP], a->in[I_XS], (const bf16_t*)nullptr,
                          (float*)nullptr, (bf16_t*)(ws + OFF_XB), a->in[I_L1G] + layer * 1024, a->in[I_L1B] + layer * 1024, wv_);
          else ln_phase<true>((const bf16_t*)(ws + OFF_R), (const float*)(ws + OFF_R), (const float*)(ws + OFF_PW), (const float*)nullptr, (const float*)nullptr, (const bf16_t*)a->out,
                          (float*)nullptr, (bf16_t*)(ws + OFF_XB), a->in[I_L1G] + layer * 1024, a->in[I_L1B] + layer * 1024, wv_); }
        GSYNC();
        { const AP a = ld_args(); unsigned char* ws = a->ws;
          PUp p; p.K = 1024; p.lda = 1024; p.ldb = 1024; p.G = opq(G); p.c = opq(bid); p.A = (const bf16_t*)(ws + OFF_XB); p.Bt = (const bf16_t*)(ws + OFF_WUP); p.h = (bf16_t*)(ws + OFF_H);
          for (int rep = 0; rep < REP_UP; ++rep) gemm_phase(lds, p, wv_); }
        GSYNC();
        { const AP a = ld_args(); unsigned char* ws = a->ws;
          PDown p; p.K = 4096; p.lda = 4096; p.ldb = 4096; p.G = opq(G); p.c = opq(bid); p.A = (const bf16_t*)(ws + OFF_H); p.Bt = (const bf16_t*)(ws + OFF_WDOWN);
          p.T = (bf16_t*)(ws + OFF_R); p.R = (float*)(ws + OFF_R); p.part = (float*)(ws + OFF_PD);
          gemm_phase(lds, p, wv_); }
        GSYNC();
        { const AP a = ld_args(); unsigned char* ws = a->ws;
          ln_phase<true>((const bf16_t*)(ws + OFF_R), (const float*)(ws + OFF_R), (const float*)(ws + OFF_PD), (const float*)nullptr, (const float*)nullptr, (const bf16_t*)(ws + OFF_XB),
                         layer == 0 ? (float*)nullptr : a->out, layer == 0 ? (bf16_t*)a->out : (bf16_t*)nullptr, a->in[I_L2G] + layer * 1024, a->in[I_L2B] + layer * 1024, wv_); }
        if (layer == 0) { __syncthreads(); for (int rep = 0; rep < REP_PREP; ++rep) { const AP a = ld_args(); prep_layer(a, 1, (float*)lds_raw, wv_); } GSYNC(); }
    }
    if (PROBE_ON && bid == 0) { if (PROBE_B > 22) tB = __builtin_amdgcn_s_memrealtime(); const unsigned long long t0 = __builtin_amdgcn_s_memrealtime(); while (__builtin_amdgcn_s_memrealtime() - t0 < tB - tA) __builtin_amdgcn_s_sleep(8); }
}

extern "C" void kernel_launch(void* const* d_in, const int* in_sizes, int n_in, void* d_out, int out_size, void* d_ws, size_t ws_size, hipStream_t stream) {
    constexpr size_t kDynLds = STAGE_BYTES;
    static int grid_blocks = 0;
    if (!grid_blocks) {
        int dev = 0, cus = 0, per_cu = 0;
        hipGetDevice(&dev);
        hipDeviceGetAttribute(&cus, hipDeviceAttributeMultiprocessorCount, dev);
        hipFuncSetAttribute((const void*)fwd_megakernel, hipFuncAttributeMaxDynamicSharedMemorySize, (int)kDynLds);
        hipOccupancyMaxActiveBlocksPerMultiprocessor(&per_cu, (const void*)fwd_megakernel, NTHR, kDynLds);
        if (per_cu < 1) per_cu = 1;
        grid_blocks = cus * per_cu;
        if (grid_blocks > 256) grid_blocks = 256;
        if (ws_size < WS_END || n_in != 36) fprintf(stderr, "kernel_launch: unexpected ws_size %zu (need %zu) or n_in %d\n", ws_size, (size_t)WS_END, n_in);
    }
    (void)hipMemsetAsync((char*)d_ws + OFF_BAR, 0, 256, stream);
    Args a{};
    for (int i = 0; i < 36; ++i) a.in[i] = (const float*)d_in[i];
    a.out = (float*)d_out; a.ws = (unsigned char*)d_ws;
    void* args[] = {&a};
    hipError_t e = hipLaunchCooperativeKernel((const void*)fwd_megakernel, dim3(grid_blocks), dim3(NTHR), args, kDynLds, stream);
    if (e != hipSuccess) fprintf(stderr, "cooperative launch failed: %s (grid %d)\n", hipGetErrorString(e), grid_blocks);
}
```

```cpp
#include <hip/hip_runtime.h>
#include <hip/hip_cooperative_groups.h>
#include <cstdio>
namespace cg = cooperative_groups;
#define REP_GEMM 1
#define REP_G1 REP_GEMM
#define REP_GATE REP_GEMM
#define REP_Y REP_GEMM
#define REP_GLU REP_GEMM
#define REP_MERGE REP_GEMM
#define REP_UP REP_GEMM
#define REP_ELEM 1
#define REP_PREP REP_ELEM
#define REP_SG REP_ELEM
#define REP_CARRY REP_ELEM
#define REP_SAMPLE REP_ELEM
#define REP_LOCAL REP_ELEM
#define REP_LN2 REP_ELEM
#define DRY_CONV 0
#define DRY_APPLY 0
#define DRY_LN1 0
#define REP_SYNC 1
#define PROBE_ON 0
#define PROBE_A 0
#define PROBE_B 1
#define GSYNC() do { for (int _s = 0; _s < REP_SYNC; ++_s) { bar_n += (unsigned)G; gbar((unsigned*)(ld_args()->ws + OFF_BAR), bar_n, wv_); } ++pidx; if (PROBE_ON) { if (pidx == PROBE_A) tA = __builtin_amdgcn_s_memrealtime(); if (pidx == PROBE_B) tB = __builtin_amdgcn_s_memrealtime(); } } while (0)

#define LAS __attribute__((address_space(3)))
typedef unsigned short bf16_t;
typedef short bf16x8 __attribute__((ext_vector_type(8)));
typedef float f32x4 __attribute__((ext_vector_type(4)));
typedef float f32x2 __attribute__((ext_vector_type(2)));
typedef unsigned u32x4 __attribute__((ext_vector_type(4)));
typedef unsigned u32x2 __attribute__((ext_vector_type(2)));

constexpr int MP = 16384, MS = 512, M = MP + MS, D = 1024, NIN = 6144, BW = 512, DFF = 4096;
constexpr int NTHR = 512;
constexpr float ALPHA = 1.41421356237f;
constexpr float LN_EPS = 1e-5f;

constexpr size_t S17 = (size_t)M * 512 * 2;
constexpr size_t OFF_WUP = 0;
constexpr size_t OFF_WDOWN = OFF_WUP + (size_t)4096 * 1024 * 2;
constexpr size_t OFF_R = OFF_WDOWN + (size_t)4096 * 1024 * 2;
constexpr size_t OFF_XB = OFF_R + 4 * S17;
constexpr size_t OFF_BIG = OFF_XB + 2 * S17;
constexpr size_t OFF_H = OFF_BIG;
constexpr size_t OFF_WIN = OFF_BIG;
constexpr size_t OFF_WP = OFF_WIN + (size_t)6144 * 1024 * 2;
constexpr size_t OFF_WGLU = OFF_WP + (size_t)3 * 1024 * 512 * 2;
constexpr size_t OFF_WOUT = OFF_WGLU + (size_t)512 * 512 * 2;
constexpr size_t OFF_WGATE = OFF_WOUT + (size_t)1024 * 1024 * 2;
constexpr size_t OFF_W1T = OFF_WGATE + (size_t)1024 * 512 * 2;
constexpr size_t OFF_WYT = OFF_W1T + (size_t)32 * 128 * 256 * 2;
constexpr size_t OFF_GL8 = OFF_WYT + (size_t)32 * 256 * 384 * 2;
constexpr size_t OFF_YA = OFF_GL8 + (size_t)M * 3072;
constexpr size_t OFF_APACK = OFF_YA + S17;
constexpr size_t OFF_S = OFF_APACK + (size_t)32 * 1024 * 384 * 2;
constexpr size_t OFF_MB = OFF_APACK;
constexpr size_t OFF_USS = OFF_S + (size_t)32 * 1024 * 128 * 4;
constexpr size_t OFF_CAR = OFF_USS + (size_t)512 * 512 * 2;
constexpr size_t OFF_BAR = OFF_CAR + (size_t)8 * 32 * 512 * 8;
constexpr size_t OFF_PD = OFF_BAR + 256;
constexpr size_t OFF_PW = OFF_GL8;
constexpr size_t PART_STRIDE = (size_t)MS * 1024;
constexpr size_t OFF_ZCS = OFF_PD + 3 * PART_STRIDE * 4;
constexpr size_t WS_END = OFF_ZCS + (size_t)MS * 512 * 2;
static_assert(OFF_PD >= OFF_H + (size_t)M * 4096 * 2, "down partials must not overlap h");
static_assert(WS_END <= (size_t)268435456, "workspace map exceeds 256 MiB");
static_assert(OFF_MB + (size_t)M * 1024 * 2 <= OFF_USS, "m overlay");
static_assert(OFF_H + (size_t)M * 4096 * 2 <= (size_t)268435456, "h overlay");

constexpr size_t O_Y = 0;
constexpr size_t O_LCP = (size_t)M * 1024;
constexpr size_t O_LHP = O_LCP + 2 * 8 * 3 * 512;
constexpr size_t O_SCP = O_LHP + 2 * 8 * 512;
constexpr size_t O_SRP = O_SCP + 2 * 8 * 2 * 512;
constexpr size_t O_SIP = O_SRP + 2 * 8 * 2048;
constexpr size_t O_LCS = O_SIP + 2 * 8 * 2048;
constexpr size_t O_LHS = O_LCS + 2 * 128 * 3 * 512;
constexpr size_t O_SCS = O_LHS + 2 * 128 * 512;
constexpr size_t O_SRS = O_SCS + 2 * 128 * 2 * 512;
constexpr size_t O_SIS = O_SRS + 2 * 128 * 2048;

struct Args { const float* in[36]; float* out; unsigned char* ws; };
typedef const __attribute__((address_space(4))) Args* AP;
__device__ __forceinline__ AP ld_args() {
#if defined(__HIP_DEVICE_COMPILE__)
    auto p = __builtin_amdgcn_kernarg_segment_ptr();
    asm volatile("" : "+s"(p));
    return (AP)p;
#else
    return nullptr;
#endif
}
enum { I_XP = 0, I_XS, I_SLC, I_SLH, I_SSC, I_SSR, I_SSI, I_WIN, I_CAW, I_CAB, I_GXW, I_GXB, I_GAW, I_GAB, I_LAM, I_CBW, I_SAR, I_SAI, I_SDT,
       I_SBR, I_SBI, I_SCR, I_SCI, I_SD, I_GLW, I_GLB, I_PA, I_PB, I_PC, I_WO, I_L1G, I_L1B, I_UP, I_DN, I_L2G, I_L2B };

__device__ __forceinline__ unsigned cvt_pk_bf16(float lo, float hi) { unsigned r; asm volatile("v_cvt_pk_bf16_f32 %0, %1, %2" : "=v"(r) : "v"(lo), "v"(hi)); return r; }
__device__ __forceinline__ bf16_t f2bf(float f) { return (bf16_t)(cvt_pk_bf16(f, 0.f) & 0xffffu); }
__device__ __forceinline__ float bf2f(unsigned short b) { return __uint_as_float(((unsigned)b) << 16); }
__device__ __forceinline__ float bflo(unsigned w) { return __uint_as_float(w << 16); }
__device__ __forceinline__ float bfhi(unsigned w) { return __uint_as_float(w & 0xffff0000u); }
__device__ __forceinline__ float sigm(float x) { return 1.0f / (1.0f + __expf(-x)); }
__device__ __forceinline__ float gelu_t(float x) { const float u = 0.7978845608f * (x + 0.044715f * x * x * x); return x / (1.0f + __expf(-2.0f * u)); }
__device__ __forceinline__ u32x4 pack8(const f32x4 a, const f32x4 b) { u32x4 w; w.x = cvt_pk_bf16(a[0], a[1]); w.y = cvt_pk_bf16(a[2], a[3]); w.z = cvt_pk_bf16(b[0], b[1]); w.w = cvt_pk_bf16(b[2], b[3]); return w; }
__device__ __forceinline__ void unpack8(const u32x4 w, float (&f)[8]) { f[0] = bflo(w.x); f[1] = bfhi(w.x); f[2] = bflo(w.y); f[3] = bfhi(w.y); f[4] = bflo(w.z); f[5] = bfhi(w.z); f[6] = bflo(w.w); f[7] = bfhi(w.w); }

__device__ __forceinline__ int otid(const int wv_) { int t = wv_ * 64 + (int)__builtin_amdgcn_mbcnt_hi(~0u, __builtin_amdgcn_mbcnt_lo(~0u, 0u)); asm volatile("" : "+v"(t)); return t; }
__device__ __forceinline__ float shx(float v, int mask, int lane) { return __int_as_float(__builtin_amdgcn_ds_bpermute((lane ^ mask) << 2, __float_as_int(v))); }

__device__ __forceinline__ int opq(int x) { asm volatile("" : "+s"(x)); return x; }

__device__ __forceinline__ void gbar(unsigned* ctr, unsigned target, const int wv_) {
    asm volatile("s_waitcnt vmcnt(0)" ::: "memory");
    __syncthreads();
    if (otid(wv_) == 0) {
        __builtin_amdgcn_fence(__ATOMIC_RELEASE, "agent");
        asm volatile("s_waitcnt vmcnt(0)" ::: "memory");
        __hip_atomic_fetch_add(ctr, 1u, __ATOMIC_RELAXED, __HIP_MEMORY_SCOPE_AGENT);
        while (__hip_atomic_load(ctr, __ATOMIC_RELAXED, __HIP_MEMORY_SCOPE_AGENT) < target) __builtin_amdgcn_s_sleep(1);
        __builtin_amdgcn_fence(__ATOMIC_ACQUIRE, "agent");
        asm volatile("s_waitcnt vmcnt(0)" ::: "memory");
    }
    __syncthreads();
}

constexpr int BM = 256, BK = 64, HALF = 128, HTB = HALF * BK * 2, STAGE_BYTES = 8 * HTB;
__device__ __forceinline__ int lds_byte(int r, int c) { const int st = (r >> 4) * 2 + (c >> 5), rr = r & 15, cc = c & 31, ob = rr * 64 + cc * 2; return st * 1024 + (ob ^ (((ob >> 9) & 1) << 5)); }
__device__ __forceinline__ void stage_rc(int b, int& R, int& C) { const int st = b / 1024, sb = b % 1024, swz = sb ^ (((sb >> 9) & 1) << 5); R = (st >> 1) * 16 + swz / 64; C = (st & 1) * 32 + (swz % 64) / 2; }
__device__ __forceinline__ int perm32(int rho) { const int n = rho >> 4, i = rho & 15; return 8 * (i >> 2) + 4 * n + (i & 3); }
struct Unit { int pm, pn, z; };
__device__ __forceinline__ void tile_map(int L, int nM, int nN, int& pm, int& pn) {
    const int nwg = nM * nN; int wgid = L;
    { const int q = nwg / 8, r = nwg % 8, xcd = wgid % 8, off = wgid / 8; wgid = (xcd < r ? xcd * (q + 1) : r * (q + 1) + (xcd - r) * q) + off; }
    const int nig = 8 * nN, gid = wgid / nig, fm = gid * 8, gsz = (nM - fm) < 8 ? (nM - fm) : 8;
    pm = fm + ((wgid % nig) % gsz); pn = (wgid % nig) / gsz;
}

template <class P>
__device__ __forceinline__ void gemm_phase(LAS unsigned char* lds, const P& p, const int wv_) {
    const int tid = otid(wv_), wid = __builtin_amdgcn_readfirstlane(tid >> 6), lane = tid & 63, wr = wid >> 2, wc = wid & 3, fr = lane & 15, fq = lane >> 4;
    unsigned voffA[2], voffB[2];
#pragma unroll
    for (int i = 0; i < 2; ++i) { int R, C; stage_rc(tid * 16 + i * 8192, R, C); const int Rb = P::PERM ? ((R & ~31) + perm32(R & 31)) : R;
        voffA[i] = (unsigned)(R * p.lda + C) * 2u; voffB[i] = (unsigned)(Rb * p.ldb + C) * 2u; }
    const size_t kstep = (size_t)(BK * 2);
    const size_t hA = (size_t)HALF * p.lda * 2, hB = (size_t)HALF * p.ldb * 2;
    const unsigned ldsw = (unsigned)wid * 1024u;
    const int aoff = lds_byte(wr * 64 + fr, fq * 8), boff = lds_byte(wc * 32 + fr, fq * 8);
#define PG8_SA(b, h) (((b) * 2 + (h)) * HTB)
#define PG8_SB(b, h) ((4 + (b) * 2 + (h)) * HTB)
#define PG8_STAGE(bufoff, gbase, voff) do { _Pragma("unroll") for (int _i = 0; _i < 2; ++_i) \
        __builtin_amdgcn_global_load_lds((const unsigned*)((const char*)(gbase) + (voff)[_i]), (LAS unsigned*)(lds + (bufoff) + ldsw + _i * 8192), 16, 0, 0); } while (0)
#define PG8_LDA(dst, b, h) do { _Pragma("unroll") for (int m = 0; m < 4; ++m) _Pragma("unroll") for (int k = 0; k < 2; ++k) dst[m][k] = *(const LAS bf16x8*)(lds + PG8_SA(b, h) + aoff + m * 2048 + k * 1024); } while (0)
#define PG8_LDB(dst, b, h) do { _Pragma("unroll") for (int n = 0; n < 2; ++n) _Pragma("unroll") for (int k = 0; k < 2; ++k) dst[n][k] = *(const LAS bf16x8*)(lds + PG8_SB(b, h) + boff + n * 2048 + k * 1024); } while (0)
#define PG8_MMA(ai, bj, At, Bt) do { __builtin_amdgcn_s_setprio(1); _Pragma("unroll") for (int m = 0; m < 4; ++m) _Pragma("unroll") for (int n = 0; n < 2; ++n) _Pragma("unroll") for (int k = 0; k < 2; ++k) \
        acc[ai][bj][m][n] = __builtin_amdgcn_mfma_f32_16x16x32_bf16(Bt[n][k], At[m][k], acc[ai][bj][m][n], 0, 0, 0); __builtin_amdgcn_s_setprio(0); } while (0)
#define PG8_WAIT_V(n) asm volatile("s_waitcnt vmcnt(" #n ")" ::: "memory")
#define PG8_WAIT_L(n) asm volatile("s_waitcnt lgkmcnt(" #n ")" ::: "memory")
#define PG8_BAR __builtin_amdgcn_s_barrier()
#define PG8_SCHED __builtin_amdgcn_sched_barrier(0)
    Unit cur, nxt; int ui = 0;
    if (!p.next(0, cur)) return;
    f32x4 acc[2][2][4][2];
#pragma unroll
    for (int a = 0; a < 2; ++a)
#pragma unroll
        for (int b = 0; b < 2; ++b)
#pragma unroll
            for (int m = 0; m < 4; ++m)
#pragma unroll
                for (int n = 0; n < 2; ++n) acc[a][b][m][n] = (f32x4){0.f, 0.f, 0.f, 0.f};
    bf16x8 At[4][2], B0[2][2], B1[2][2];
    const char* cA = p.aptr(cur); const char* cB = p.bptr(cur);
    PG8_STAGE(PG8_SB(0, 0), cB, voffB); PG8_STAGE(PG8_SA(0, 0), cA, voffA); PG8_STAGE(PG8_SB(0, 1), cB + hB, voffB); PG8_STAGE(PG8_SA(0, 1), cA + hA, voffA);
    if (wr == 1) PG8_BAR;
    PG8_WAIT_V(4); PG8_BAR;
    PG8_STAGE(PG8_SB(1, 0), cB + kstep, voffB); PG8_STAGE(PG8_SA(1, 0), cA + kstep, voffA); PG8_STAGE(PG8_SB(1, 1), cB + hB + kstep, voffB);
    PG8_WAIT_V(6); PG8_BAR;
    for (;;) {
        const bool has_next = p.next(ui + 1, nxt);
        const int nt = p.nt(cur);
        const char* nA = has_next ? p.aptr(nxt) : cA; const char* nB = has_next ? p.bptr(nxt) : cB;
        for (int t = 0; t < nt; t += 2) {
            const bool last = (t == nt - 2);
            const char* a1 = cA + (size_t)(t + 1) * kstep;
            const char* a2 = last ? nA : cA + (size_t)(t + 2) * kstep; const char* b2 = last ? nB : cB + (size_t)(t + 2) * kstep;
            const char* a3 = a2 + kstep; const char* b3 = b2 + kstep;
            PG8_LDB(B0, 0, 0); PG8_SCHED; PG8_LDA(At, 0, 0); PG8_STAGE(PG8_SA(1, 1), a1 + hA, voffA);
            PG8_WAIT_L(8); PG8_BAR; PG8_WAIT_L(0); PG8_MMA(0, 0, At, B0); PG8_BAR; PG8_SCHED;
            PG8_LDB(B1, 0, 1); PG8_STAGE(PG8_SB(0, 0), b2, voffB);
            PG8_BAR; PG8_WAIT_L(0); PG8_MMA(0, 1, At, B1); PG8_BAR;
            PG8_LDA(At, 0, 1); PG8_STAGE(PG8_SA(0, 0), a2, voffA);
            PG8_BAR; PG8_WAIT_L(0); PG8_MMA(1, 0, At, B0); PG8_BAR; PG8_SCHED;
            PG8_STAGE(PG8_SB(0, 1), b2 + hB, voffB);
            PG8_WAIT_V(6); PG8_BAR; PG8_MMA(1, 1, At, B1); PG8_BAR;
            PG8_LDB(B0, 1, 0); PG8_SCHED; PG8_LDA(At, 1, 0); PG8_STAGE(PG8_SA(0, 1), a2 + hA, voffA);
            PG8_WAIT_L(8); PG8_BAR; PG8_WAIT_L(0); PG8_MMA(0, 0, At, B0); PG8_BAR; PG8_SCHED;
            PG8_LDB(B1, 1, 1); PG8_STAGE(PG8_SB(1, 0), b3, voffB);
            PG8_BAR; PG8_WAIT_L(0); PG8_MMA(0, 1, At, B1); PG8_BAR;
            PG8_LDA(At, 1, 1); PG8_STAGE(PG8_SA(1, 0), a3, voffA);
            PG8_BAR; PG8_WAIT_L(0); PG8_MMA(1, 0, At, B0); PG8_BAR; PG8_SCHED;
            PG8_STAGE(PG8_SB(1, 1), b3 + hB, voffB);
            PG8_WAIT_V(6); PG8_BAR; PG8_MMA(1, 1, At, B1); PG8_BAR;
        }
        Unit eu = cur;
        asm volatile("" : "+s"(eu.pm), "+s"(eu.pn), "+s"(eu.z));
        const bool rst = p.epi(acc, eu, wr, wc, fr, fq);
        if (!has_next) break;
        if (rst) {
#pragma unroll
            for (int a = 0; a < 2; ++a)
#pragma unroll
                for (int b = 0; b < 2; ++b)
#pragma unroll
                    for (int m = 0; m < 4; ++m)
#pragma unroll
                        for (int n = 0; n < 2; ++n) acc[a][b][m][n] = (f32x4){0.f, 0.f, 0.f, 0.f};
        }
        cur = nxt; cA = nA; cB = nB; ++ui;
    }
    PG8_WAIT_V(0);
    if (wr == 0) PG8_BAR;
    PG8_BAR;
#undef PG8_SA
#undef PG8_SB
#undef PG8_STAGE
#undef PG8_LDA
#undef PG8_LDB
#undef PG8_MMA
#undef PG8_WAIT_V
#undef PG8_WAIT_L
#undef PG8_BAR
#undef PG8_SCHED
}
typedef f32x4 Acc[2][2][4][2];

struct PG1 {
    __device__ __forceinline__ int nt(const Unit&) const { return K / BK; }
    static constexpr bool PERM = true;
    int K, lda, ldb, G, c;
    const bf16_t* A; const bf16_t* Bt;
    bf16_t* xa; unsigned char* gl8; bf16_t* ya; bf16_t* apack; bf16_t* uss; bf16_t* sb; bf16_t* sh; bf16_t* sc;
    __device__ __forceinline__ bool next(int i, Unit& u) const { const long L = (long)i * G + c; if (L >= 66 * 24) return false; tile_map((int)L, 66, 24, u.pm, u.pn); u.z = 0; return true; }
    __device__ __forceinline__ const char* aptr(const Unit& u) const { return (const char*)A + (size_t)u.pm * 256 * 1024 * 2; }
    __device__ __forceinline__ const char* bptr(const Unit& u) const { return (const char*)Bt + (size_t)u.pn * 256 * 1024 * 2; }
    __device__ __forceinline__ bool epi(Acc& acc, const Unit& u, int wr, int wc, int fr, int fq) const {
        const int pn = u.pn;
        if (pn >= 6 && pn < 10) {
#pragma unroll
            for (int ai = 0; ai < 2; ++ai)
#pragma unroll
                for (int m = 0; m < 4; ++m) { const size_t r = (size_t)u.pm * 256 + ai * 128 + wr * 64 + m * 16 + fr;
                    *(u32x4*)(sc + r * 512 + (pn - 6) * 128 + wc * 32 + 8 * fq) = pack8(acc[ai][0][m][0] * acc[ai][1][m][0], acc[ai][0][m][1] * acc[ai][1][m][1]); }
        } else if (pn < 10) {
            bf16_t* base = (bf16_t*)((unsigned char*)xa + (pn >= 4 ? S17 : pn >= 2 ? (OFF_YA - OFF_R) : (size_t)0));
#pragma unroll
            for (int ai = 0; ai < 2; ++ai)
#pragma unroll
                for (int m = 0; m < 4; ++m) { const size_t r = (size_t)u.pm * 256 + ai * 128 + wr * 64 + m * 16 + fr;
#pragma unroll
                    for (int bj = 0; bj < 2; ++bj) { const int col = (pn & 1) * 256 + bj * 128 + wc * 32 + 8 * fq;
                        *(u32x4*)(base + r * 512 + col) = pack8(acc[ai][bj][m][0], acc[ai][bj][m][1]); } }
        } else if (pn < 12) {
#pragma unroll
            for (int ai = 0; ai < 2; ++ai)
#pragma unroll
                for (int m = 0; m < 4; ++m) { const int r = u.pm * 256 + ai * 128 + wr * 64 + m * 16 + fr;
#pragma unroll
                    for (int bj = 0; bj < 2; ++bj) { const int cc = (pn - 10) * 256 + bj * 128 + wc * 32 + 8 * fq;
                        bf16_t* dst = (u.pm < 64) ? apack + ((size_t)((cc >> 4) * 1024 + (r >> 4)) * 384 + 128 + (r & 15) * 16 + (cc & 15)) : uss + (size_t)(r - MP) * 512 + cc;
                        *(u32x4*)dst = pack8(acc[ai][bj][m][0], acc[ai][bj][m][1]); } }
        } else {
            unsigned char* blk = gl8 + ((size_t)(u.pm * 12 + (pn - 12)) << 16) + (size_t)(((wr * 4 + wc) * 64 + fq * 16 + fr) * 128);
#pragma unroll
            for (int ai = 0; ai < 2; ++ai)
#pragma unroll
                for (int m = 0; m < 4; ++m) { u32x4 w;
#pragma unroll
                    for (int bj = 0; bj < 2; ++bj)
#pragma unroll
                        for (int n = 0; n < 2; ++n) { unsigned pk = 0;
#pragma unroll
                            for (int j = 0; j < 4; ++j) { int v = (int)(sigm(acc[ai][bj][m][n][j]) * 256.0f); v = v < 0 ? 0 : (v > 255 ? 255 : v); pk |= (unsigned)v << (8 * j); }
                            w[bj * 2 + n] = pk; }
                    *(u32x4*)(blk + (ai * 4 + m) * 16) = w; }
        }
        return true;
    }
};

struct PGate {
    __device__ __forceinline__ int nt(const Unit&) const { return K / BK; }
    static constexpr bool PERM = true;
    int K, lda, ldb, G, c;
    const bf16_t* A; const bf16_t* Bt;
    const float *gxb, *gab, *lam; _Float16* aout; bf16_t* bxout;
    __device__ __forceinline__ bool next(int i, Unit& u) const { const long L = (long)i * G + c; if (L >= 66 * 4) return false; tile_map((int)L, 66, 4, u.pm, u.pn); u.z = 0; return true; }
    __device__ __forceinline__ const char* aptr(const Unit& u) const { return (const char*)A + (size_t)u.pm * 256 * 512 * 2 + (size_t)(u.pn >> 1) * 512; }
    __device__ __forceinline__ const char* bptr(const Unit& u) const { return (const char*)Bt + (size_t)u.pn * 256 * 256 * 2; }
    __device__ __forceinline__ bool epi(Acc& acc, const Unit& u, int wr, int wc, int fr, int fq) const {
        typedef _Float16 h8 __attribute__((ext_vector_type(8)));
        const int ch0 = u.pn * 128 + wc * 32 + 8 * fq;
        float bxv[8], bav[8], kk[8];
#pragma unroll
        for (int j = 0; j < 8; ++j) { bxv[j] = gxb[ch0 + j]; bav[j] = gab[ch0 + j]; kk[j] = -8.0f * log1pf(expf(-lam[ch0 + j])); }
#pragma unroll
        for (int ai = 0; ai < 2; ++ai)
#pragma unroll
            for (int m = 0; m < 4; ++m) { const size_t r = (size_t)u.pm * 256 + ai * 128 + wr * 64 + m * 16 + fr;
                float xc[8]; unpack8(*(const u32x4*)(A + r * 512 + ch0), xc);
                h8 lav; f32x4 b0, b1;
#pragma unroll
                for (int j = 0; j < 8; ++j) { const float px = acc[ai][0][m][j >> 2][j & 3], pa = acc[ai][1][m][j >> 2][j & 3];
                    const float gx = sigm(px + bxv[j]), ga = sigm(pa + bav[j]);
                    const float la = kk[j] * ga, av = __expf(la); lav[j] = (_Float16)la;
                    const float bv = __builtin_amdgcn_sqrtf(fmaxf(1.0f - av * av, 0.f)) * gx * xc[j];
                    if (j < 4) b0[j] = bv; else b1[j - 4] = bv; }
                *(h8*)(aout + r * 512 + ch0) = lav;
                *(u32x4*)(bxout + r * 512 + ch0) = pack8(b0, b1); }
        return true;
    }
};

struct PY {
    __device__ __forceinline__ int nt(const Unit&) const { return K / BK; }
    static constexpr bool PERM = true;
    int K, lda, ldb, G, c;
    const bf16_t* apack; const bf16_t* wyt; const float* dvec; bf16_t* zc;
    __device__ __forceinline__ bool next(int i, Unit& u) const { const long L = (long)i * G + c; if (L >= 128) return false; u.pm = (int)L; u.pn = (int)L >> 2; u.z = 0; return true; }
    __device__ __forceinline__ const char* aptr(const Unit& u) const { return (const char*)apack + (size_t)u.pm * 256 * 384 * 2; }
    __device__ __forceinline__ const char* bptr(const Unit& u) const { return (const char*)wyt + (size_t)u.pn * 256 * 384 * 2; }
    __device__ __forceinline__ bool epi(Acc& acc, const Unit& u, int wr, int wc, int fr, int fq) const {
        const int g = u.pn;
#pragma unroll
        for (int bj = 0; bj < 2; ++bj) {
            const int n0 = bj * 128 + wc * 32 + 8 * fq, ti = n0 >> 4, c0 = n0 & 15;
#pragma unroll
            for (int ai = 0; ai < 2; ++ai)
#pragma unroll
                for (int m = 0; m < 4; ++m) { const int rr = (u.pm & 3) * 256 + ai * 128 + wr * 64 + m * 16 + fr;
                    f32x4 y0, y1;
#pragma unroll
                    for (int j = 0; j < 4; ++j) { y0[j] = gelu_t(acc[ai][bj][m][0][j]); y1[j] = gelu_t(acc[ai][bj][m][1][j]); }
                    const size_t tok = (size_t)(rr >> 7) * 2048 + (rr & 127) * 16 + ti;
                    *(u32x4*)(zc + tok * 512 + g * 16 + c0) = pack8(y0, y1); }
        }
        return true;
    }
};

struct PGlu {
    __device__ __forceinline__ int nt(const Unit&) const { return K / BK; }
    static constexpr bool PERM = true;
    int K, lda, ldb, G, c, sample;
    const bf16_t* A; const bf16_t* As; const bf16_t* Bt; const float* bias; bf16_t* out;
    __device__ __forceinline__ bool next(int i, Unit& u) const {
        if (sample) { const int j = c - 128; if (i != 0 || j < 0 || j >= 4) return false; u.pm = 64 + (j >> 1); u.pn = j & 1; u.z = 0; return true; }
        const long L = (long)i * G + c; if (L >= 64 * 2) return false; tile_map((int)L, 64, 2, u.pm, u.pn); u.z = 0; return true; }
    __device__ __forceinline__ const bf16_t* arow0(const Unit& u) const { return u.pm < 64 ? A + (size_t)u.pm * 256 * 512 : As + (size_t)(u.pm - 64) * 256 * 512; }
    __device__ __forceinline__ const char* aptr(const Unit& u) const { return (const char*)arow0(u); }
    __device__ __forceinline__ const char* bptr(const Unit& u) const { return (const char*)Bt + (size_t)u.pn * 256 * 512 * 2; }
    __device__ __forceinline__ bool epi(Acc& acc, const Unit& u, int wr, int wc, int fr, int fq) const {
        const bf16_t* zsrc = arow0(u);
#pragma unroll
        for (int bj = 0; bj < 2; ++bj) {
            const int col = u.pn * 256 + bj * 128 + wc * 32 + 8 * fq;
            const f32x4 b0 = *(const f32x4*)(bias + col), b1 = *(const f32x4*)(bias + col + 4);
#pragma unroll
            for (int ai = 0; ai < 2; ++ai)
#pragma unroll
                for (int m = 0; m < 4; ++m) { const int rl = ai * 128 + wr * 64 + m * 16 + fr; const size_t r = (size_t)u.pm * 256 + rl;
                    const u32x4 zw = *(const u32x4*)(zsrc + (size_t)rl * 512 + col); float zf[8]; unpack8(zw, zf);
                    f32x4 y0, y1;
#pragma unroll
                    for (int j = 0; j < 4; ++j) { y0[j] = zf[j] * sigm(acc[ai][bj][m][0][j] + b0[j]); y1[j] = zf[4 + j] * sigm(acc[ai][bj][m][1][j] + b1[j]); }
                    *(u32x4*)(out + r * 512 + col) = pack8(y0, y1); }
        }
        return true;
    }
};

template <bool SAMPLE> struct PMergeT {
    __device__ __forceinline__ int nt(const Unit&) const { return K / BK; }
    static constexpr bool PERM = true;
    int K, lda, ldb, G, c;
    const bf16_t* a0; const bf16_t* wp; const unsigned char* gl8; bf16_t* mb; float* pm3;
    __device__ __forceinline__ bool next(int i, Unit& u) const { const int ti = i / 3;
        if (SAMPLE) { const int j = c - (G - 24); if (i != 0 || j < 0) return false; const int t = j / 3; u.pm = 64 + (t >> 2); u.pn = t & 3; u.z = j - t * 3; return true; }
        const long L = (long)ti * G + c; if (L >= 64 * 4) return false; tile_map((int)L, 64, 4, u.pm, u.pn); u.z = i - ti * 3; return true; }
    __device__ __forceinline__ const char* aptr(const Unit& u) const { const size_t off = (u.z == 2) ? (OFF_XB + S17 - OFF_R) : (size_t)u.z * S17; return (const char*)a0 + off + (size_t)u.pm * 256 * 512 * 2; }
    __device__ __forceinline__ const char* bptr(const Unit& u) const { return (const char*)wp + ((size_t)u.z * 1024 + (size_t)u.pn * 256) * 512 * 2; }
    __device__ __forceinline__ bool epi(Acc& acc, const Unit& u, int wr, int wc, int fr, int fq) const {
        const int br = u.z;
        const unsigned char* blk = gl8 + ((size_t)(u.pm * 12 + br * 4 + u.pn) << 16) + (size_t)(((wr * 4 + wc) * 64 + fq * 16 + fr) * 128);
#pragma unroll
        for (int ai = 0; ai < 2; ++ai)
#pragma unroll
            for (int m = 0; m < 4; ++m) { const size_t r = (size_t)u.pm * 256 + ai * 128 + wr * 64 + m * 16 + fr;
                const u32x4 qc = *(const u32x4*)(blk + (ai * 4 + m) * 16);
                if (SAMPLE) {
#pragma unroll
                    for (int bj = 0; bj < 2; ++bj) { const int col = u.pn * 256 + bj * 128 + wc * 32 + 8 * fq;
                        f32x4 y0, y1;
#pragma unroll
                        for (int j = 0; j < 4; ++j) {
                            y0[j] = acc[ai][bj][m][0][j] * (((float)((qc[bj * 2] >> (8 * j)) & 255u) + 0.5f) * (1.0f / 256.0f));
                            y1[j] = acc[ai][bj][m][1][j] * (((float)((qc[bj * 2 + 1] >> (8 * j)) & 255u) + 0.5f) * (1.0f / 256.0f)); }
                        float* pp = pm3 + (size_t)br * PART_STRIDE + (r - MP) * 1024 + col; *(f32x4*)pp = y0; *(f32x4*)(pp + 4) = y1; }
                } else if (br < 2) {
                    const u32x4 qn = *(const u32x4*)(blk + 4 * 65536 + (ai * 4 + m) * 16);
#pragma unroll
                    for (int bj = 0; bj < 2; ++bj)
#pragma unroll
                        for (int n = 0; n < 2; ++n)
#pragma unroll
                            for (int j = 0; j < 4; ++j) { const float gc = (float)((qc[bj * 2 + n] >> (8 * j)) & 255u) + 0.5f, gn = (float)((qn[bj * 2 + n] >> (8 * j)) & 255u) + 0.5f;
                                acc[ai][bj][m][n][j] *= gc * __builtin_amdgcn_rcpf(gn); }
                } else {
#pragma unroll
                    for (int bj = 0; bj < 2; ++bj) { const int col = u.pn * 256 + bj * 128 + wc * 32 + 8 * fq;
                        f32x4 y0, y1;
#pragma unroll
                        for (int j = 0; j < 4; ++j) {
                            y0[j] = acc[ai][bj][m][0][j] * (((float)((qc[bj * 2] >> (8 * j)) & 255u) + 0.5f) * (1.0f / 256.0f));
                            y1[j] = acc[ai][bj][m][1][j] * (((float)((qc[bj * 2 + 1] >> (8 * j)) & 255u) + 0.5f) * (1.0f / 256.0f)); }
                        *(u32x4*)(mb + r * 1024 + col) = pack8(y0, y1); }
                } }
        return SAMPLE || br == 2;
    }
};

struct PWout {
    static constexpr bool PERM = true;
    int K, lda, ldb, G, c;
    const bf16_t* A; const bf16_t* Bt; bf16_t* T; float* R; float* part;
    __device__ __forceinline__ int nt(const Unit& u) const { return u.z < 0 ? 16 : 4; }
    __device__ __forceinline__ bool next(int i, Unit& u) const {
        const int nP = c < 256 ? (256 - c + G - 1) / G : 0;
        if (i < nP) { tile_map(i * G + c, 64, 4, u.pm, u.pn); u.z = -1; return true; }
        const int j = (i - nP) * G + c; if (j >= 32) return false;
        u.pm = 64 + (j >> 4); u.pn = (j >> 2) & 3; u.z = j & 3; return true; }
    __device__ __forceinline__ const char* aptr(const Unit& u) const { return (const char*)A + (size_t)u.pm * 256 * 1024 * 2 + (u.z < 0 ? 0 : u.z * 512); }
    __device__ __forceinline__ const char* bptr(const Unit& u) const { return (const char*)Bt + (size_t)u.pn * 256 * 1024 * 2 + (u.z < 0 ? 0 : u.z * 512); }
    __device__ __forceinline__ bool epi(Acc& acc, const Unit& u, int wr, int wc, int fr, int fq) const {
#pragma unroll
        for (int ai = 0; ai < 2; ++ai)
#pragma unroll
            for (int m = 0; m < 4; ++m) { const size_t r = (size_t)u.pm * 256 + ai * 128 + wr * 64 + m * 16 + fr;
#pragma unroll
                for (int bj = 0; bj < 2; ++bj) { const int col = u.pn * 256 + bj * 128 + wc * 32 + 8 * fq;
                    if (u.z < 0) *(u32x4*)(T + r * 1024 + col) = pack8(acc[ai][bj][m][0], acc[ai][bj][m][1]);
                    else { float* pp = (u.z == 0) ? R + r * 1024 + col : part + (size_t)(u.z - 1) * PART_STRIDE + (r - MP) * 1024 + col;
                        *(f32x4*)pp = acc[ai][bj][m][0]; *(f32x4*)(pp + 4) = acc[ai][bj][m][1]; } } }
        return true;
    }
};

struct PUp {
    __device__ __forceinline__ int nt(const Unit&) const { return K / BK; }
    static constexpr bool PERM = true;
    int K, lda, ldb, G, c;
    const bf16_t* A; const bf16_t* Bt; bf16_t* h;
    __device__ __forceinline__ bool next(int i, Unit& u) const { const long L = (long)i * G + c; if (L >= 66 * 16) return false; tile_map((int)L, 66, 16, u.pm, u.pn); u.z = 0; return true; }
    __device__ __forceinline__ const char* aptr(const Unit& u) const { return (const char*)A + (size_t)u.pm * 256 * 1024 * 2; }
    __device__ __forceinline__ const char* bptr(const Unit& u) const { return (const char*)Bt + (size_t)u.pn * 256 * 1024 * 2; }
    __device__ __forceinline__ bool epi(Acc& acc, const Unit& u, int wr, int wc, int fr, int fq) const {
#pragma unroll
        for (int ai = 0; ai < 2; ++ai)
#pragma unroll
            for (int m = 0; m < 4; ++m) { const size_t r = (size_t)u.pm * 256 + ai * 128 + wr * 64 + m * 16 + fr;
#pragma unroll
                for (int bj = 0; bj < 2; ++bj) { const int col = u.pn * 256 + bj * 128 + wc * 32 + 8 * fq;
                    f32x4 y0, y1;
#pragma unroll
                    for (int j = 0; j < 4; ++j) { const float v0 = fmaxf(acc[ai][bj][m][0][j], 0.f), v1 = fmaxf(acc[ai][bj][m][1][j], 0.f); y0[j] = v0 * v0; y1[j] = v1 * v1; }
                    *(u32x4*)(h + r * 4096 + col) = pack8(y0, y1); } }
        return true;
    }
};

struct PDown {
    static constexpr bool PERM = true;
    int K, lda, ldb, G, c;
    const bf16_t* A; const bf16_t* Bt; bf16_t* T; float* R; float* part;
    __device__ __forceinline__ int nt(const Unit& u) const { return u.z < 0 ? 64 : 16; }
    __device__ __forceinline__ bool next(int i, Unit& u) const {
        const int nP = c < 256 ? (256 - c + G - 1) / G : 0;
        if (i < nP) { tile_map(i * G + c, 64, 4, u.pm, u.pn); u.z = -1; return true; }
        const int j = (i - nP) * G + c; if (j >= 32) return false;
        u.pm = 64 + (j >> 4); u.pn = (j >> 2) & 3; u.z = j & 3; return true; }
    __device__ __forceinline__ const char* aptr(const Unit& u) const { return (const char*)A + (size_t)u.pm * 256 * 4096 * 2 + (u.z < 0 ? 0 : u.z * 2048); }
    __device__ __forceinline__ const char* bptr(const Unit& u) const { return (const char*)Bt + (size_t)u.pn * 256 * 4096 * 2 + (u.z < 0 ? 0 : u.z * 2048); }
    __device__ __forceinline__ bool epi(Acc& acc, const Unit& u, int wr, int wc, int fr, int fq) const {
#pragma unroll
        for (int ai = 0; ai < 2; ++ai)
#pragma unroll
            for (int m = 0; m < 4; ++m) { const size_t r = (size_t)u.pm * 256 + ai * 128 + wr * 64 + m * 16 + fr;
#pragma unroll
                for (int bj = 0; bj < 2; ++bj) { const int col = u.pn * 256 + bj * 128 + wc * 32 + 8 * fq;
                    if (u.z < 0) *(u32x4*)(T + r * 1024 + col) = pack8(acc[ai][bj][m][0], acc[ai][bj][m][1]);
                    else { float* pp = (u.z == 0) ? R + r * 1024 + col : part + (size_t)(u.z - 1) * PART_STRIDE + (r - MP) * 1024 + col;
                        *(f32x4*)pp = acc[ai][bj][m][0]; *(f32x4*)(pp + 4) = acc[ai][bj][m][1]; } } }
        return true;
    }
};

__device__ __forceinline__ void tdec(AP a, int layer, int t, const float*& W, bf16_t*& Wt, int& K, int& N, int& tk, int& tn4, int& c0, int& c1, int& c2, int& c3) {
    unsigned char* ws = a->ws; int tt;
    if (t < 384) { tt = t; W = a->in[I_WIN] + (size_t)layer * 1024 * 6144; Wt = (bf16_t*)(ws + OFF_WIN); K = 1024; N = 6144; }
    else if (t < 480) { const int q = (t - 384) / 32; tt = (t - 384) % 32; W = a->in[I_PA + q] + (size_t)layer * 512 * 1024; Wt = (bf16_t*)(ws + OFF_WP) + (size_t)q * 1024 * 512; K = 512; N = 1024; }
    else if (t < 496) { tt = t - 480; W = a->in[I_GLW] + (size_t)layer * 512 * 512; Wt = (bf16_t*)(ws + OFF_WGLU); K = 512; N = 512; }
    else if (t < 560) { tt = t - 496; W = a->in[I_WO] + (size_t)layer * 1024 * 1024; Wt = (bf16_t*)(ws + OFF_WOUT); K = 1024; N = 1024; }
    else if (t < 816) { tt = t - 560; W = a->in[I_UP] + (size_t)layer * 1024 * 4096; Wt = (bf16_t*)(ws + OFF_WUP); K = 1024; N = 4096; }
    else { tt = t - 816; W = a->in[I_DN] + (size_t)layer * 4096 * 1024; Wt = (bf16_t*)(ws + OFF_WDOWN); K = 4096; N = 1024; }
    const int ntn = N / 256; tk = tt / ntn; tn4 = tt % ntn;
    c0 = tn4 * 256; c2 = c0 + 128;
    if (t < 384 && tn4 >= 6 && tn4 < 10) { c0 = 1536 + 128 * (tn4 - 6); c2 = 2048 + 128 * (tn4 - 6); }
    c1 = c0 + 64; c3 = c2 + 64;
}
__device__ __forceinline__ void tload(const float* W, int N, int tk, int c0, int c1, int c2, int c3, int tid, f32x4 (&v)[4][2]) {
    const int r = tid >> 3, c8 = (tid & 7) * 8; const float* src = W + (size_t)(tk * 64 + r) * N + c8;
    v[0][0] = *(const f32x4*)(src + c0); v[0][1] = *(const f32x4*)(src + c0 + 4); v[1][0] = *(const f32x4*)(src + c1); v[1][1] = *(const f32x4*)(src + c1 + 4);
    v[2][0] = *(const f32x4*)(src + c2); v[2][1] = *(const f32x4*)(src + c2 + 4); v[3][0] = *(const f32x4*)(src + c3); v[3][1] = *(const f32x4*)(src + c3 + 4);
}

__device__ __forceinline__ void abar_pow(const float* are, const float* aim, const float* ldt, int sp, float e, float& pr, float& pi) {
    const float step = expf(ldt[sp]); const float x = e * step * are[sp], th = e * step * aim[sp];
    float s, c; sincosf(th, &s, &c); const float mg = expf(x); pr = mg * c; pi = mg * s;
}
__device__ __forceinline__ void ssm_coef(const float* are, const float* aim, const float* ldt, int sp, float& cr, float& ci) {
    const float step = expf(ldt[sp]); const float ar = are[sp], ai = aim[sp];
    const float x = step * ar, th = step * ai;
    float s, c; sincosf(th, &s, &c); const float em1 = expm1f(x); const float sh = sinf(0.5f * th);
    const float nr = em1 * c - 2.0f * sh * sh, ni = (em1 + 1.0f) * s;
    const float den = ar * ar + ai * ai;
    cr = (nr * ar + ni * ai) / den; ci = (ni * ar - nr * ai) / den;
}

__device__ __forceinline__ void prep_layer(AP a, int layer, float* sm, const int wv_) {
    unsigned char* ws = a->ws;
    const int G = gridDim.x;
    {
        const int tid = otid(wv_), r = tid >> 3, c8 = (tid & 7) * 8, n = tid >> 3, k8 = (tid & 7) * 8;
        int t = blockIdx.x; f32x4 v[4][2];
        const float* W = nullptr; bf16_t* Wt = nullptr; int K = 0, N = 0, tk = 0, tn4 = 0, c0 = 0, c1 = 0, c2 = 0, c3 = 0;
        if (t < 1072) { tdec(a, layer, t, W, Wt, K, N, tk, tn4, c0, c1, c2, c3); tload(W, N, tk, c0, c1, c2, c3, tid, v); }
        while (t < 1072) {
#pragma unroll
            for (int q = 0; q < 4; ++q)
#pragma unroll
                for (int e = 0; e < 4; ++e) { sm[q * 4160 + r * 65 + c8 + e] = v[q][0][e]; sm[q * 4160 + r * 65 + c8 + 4 + e] = v[q][1][e]; }
            __syncthreads();
            bf16_t* const cWt = Wt; const int cK = K, ctk = tk, ctn4 = tn4; const int tn = t + G;
            if (tn < 1072) { tdec(a, layer, tn, W, Wt, K, N, tk, tn4, c0, c1, c2, c3); tload(W, N, tk, c0, c1, c2, c3, tid, v); }
#pragma unroll
            for (int q = 0; q < 4; ++q) { const float* tt = sm + q * 4160;
                u32x4 w;
                w.x = cvt_pk_bf16(tt[(k8 + 0) * 65 + n], tt[(k8 + 1) * 65 + n]); w.y = cvt_pk_bf16(tt[(k8 + 2) * 65 + n], tt[(k8 + 3) * 65 + n]);
                w.z = cvt_pk_bf16(tt[(k8 + 4) * 65 + n], tt[(k8 + 5) * 65 + n]); w.w = cvt_pk_bf16(tt[(k8 + 6) * 65 + n], tt[(k8 + 7) * 65 + n]);
                *(u32x4*)(cWt + (size_t)(ctn4 * 256 + q * 64 + n) * cK + ctk * 64 + k8) = w; }
            __syncthreads();
            t = tn;
        }
    }
    const int GT = G * NTHR;
    {
        bf16_t* wg = (bf16_t*)(ws + OFF_WGATE);
        for (int idx = blockIdx.x * NTHR + otid(wv_); idx < 1024 * 32; idx += GT) {
            const int n = idx >> 5, k0 = (idx & 31) * 8; const int pn = n >> 8, bj = (n >> 7) & 1, ch = pn * 128 + (n & 127), hd = ch >> 6, j = ch & 63;
            u32x4 w = (u32x4){0u, 0u, 0u, 0u};
            if ((pn >> 1) * 4 + (k0 >> 6) == hd) { const float* src = a->in[bj ? I_GAW : I_GXW] + (size_t)layer * 8 * 64 * 64 + (size_t)hd * 4096 + (size_t)(k0 & 63) * 64 + j;
                w.x = cvt_pk_bf16(src[0], src[64]); w.y = cvt_pk_bf16(src[128], src[192]); w.z = cvt_pk_bf16(src[256], src[320]); w.w = cvt_pk_bf16(src[384], src[448]); }
            *(u32x4*)(wg + (size_t)n * 256 + k0) = w;
        }
    }
    const float* are = a->in[I_SAR] + layer * 2048; const float* aim = a->in[I_SAI] + layer * 2048; const float* ldt = a->in[I_SDT] + layer * 2048;
    const float* bre = a->in[I_SBR] + layer * 32768; const float* bim = a->in[I_SBI] + layer * 32768;
    const float* cre = a->in[I_SCR] + layer * 32768; const float* cim = a->in[I_SCI] + layer * 32768;
    {
        bf16_t* w1 = (bf16_t*)(ws + OFF_W1T);
        for (int idx = blockIdx.x * NTHR + otid(wv_); idx < 32 * 128 * 32; idx += GT) {
            const int g = idx >> 12, n = (idx >> 5) & 127, k0 = (idx & 31) * 8, j = k0 >> 4, c0 = k0 & 15, p = n & 63, part = n >> 6, sp = g * 64 + p;
            float pr, pi, cr, ci; abar_pow(are, aim, ldt, sp, (float)(15 - j), pr, pi); ssm_coef(are, aim, ldt, sp, cr, ci);
            const float qr = pr * cr - pi * ci, qi = pr * ci + pi * cr;
            float o[8];
#pragma unroll
            for (int q = 0; q < 8; ++q) { const float br = bre[sp * 16 + c0 + q], bi = bim[sp * 16 + c0 + q]; o[q] = part ? (qr * bi + qi * br) : (qr * br - qi * bi); }
            u32x4 w; w.x = cvt_pk_bf16(o[0], o[1]); w.y = cvt_pk_bf16(o[2], o[3]); w.z = cvt_pk_bf16(o[4], o[5]); w.w = cvt_pk_bf16(o[6], o[7]);
            *(u32x4*)(w1 + ((size_t)(g * 128 + n) * 256 + k0)) = w;
        }
    }
    {
        bf16_t* wy = (bf16_t*)(ws + OFF_WYT);
        for (int idx = blockIdx.x * NTHR + otid(wv_); idx < 32 * 256 * 16; idx += GT) {
            const int g = idx >> 12, n = (idx >> 4) & 255, k0 = (idx & 15) * 8, i = n >> 4, c = n & 15, part = k0 >> 6, p0 = k0 & 63;
            float o[8];
#pragma unroll
            for (int q = 0; q < 8; ++q) { const int p = p0 + q, sp = g * 64 + p; float pr, pi; abar_pow(are, aim, ldt, sp, (float)(i + 1), pr, pi);
                const float xr = cre[(g * 16 + c) * 64 + p], xi = cim[(g * 16 + c) * 64 + p];
                o[q] = part ? -(xr * pi + xi * pr) : (xr * pr - xi * pi); }
            u32x4 w; w.x = cvt_pk_bf16(o[0], o[1]); w.y = cvt_pk_bf16(o[2], o[3]); w.z = cvt_pk_bf16(o[4], o[5]); w.w = cvt_pk_bf16(o[6], o[7]);
            *(u32x4*)(wy + ((size_t)(g * 256 + n) * 384 + k0)) = w;
        }
        for (int idx = blockIdx.x * NTHR + otid(wv_); idx < 32 * 256 * 4; idx += GT) {
            const int pq = idx & 3, c2 = (idx >> 2) & 15, c = (idx >> 6) & 15, g = idx >> 10;
            float km[16];
#pragma unroll
            for (int d = 0; d < 16; ++d) km[d] = 0.f;
            for (int pp = 0; pp < 16; ++pp) { const int p = pq * 16 + pp, sp = g * 64 + p; float ar, ai, cr, ci; abar_pow(are, aim, ldt, sp, 1.0f, ar, ai); ssm_coef(are, aim, ldt, sp, cr, ci);
                const float br = bre[sp * 16 + c2], bi = bim[sp * 16 + c2];
                const float bbr = cr * br - ci * bi, bbi = cr * bi + ci * br;
                const float xr = cre[(g * 16 + c) * 64 + p], xi = cim[(g * 16 + c) * 64 + p];
                float tr = xr * bbr - xi * bbi, ti = xr * bbi + xi * bbr;
#pragma unroll
                for (int d = 0; d < 16; ++d) { km[d] += tr; const float nr = tr * ar - ti * ai, ni = tr * ai + ti * ar; tr = nr; ti = ni; } }
            { const int ln = idx & 63;
#pragma unroll
            for (int d = 0; d < 16; ++d) { km[d] += shx(km[d], 1, ln); km[d] += shx(km[d], 2, ln); } }
            if (c == c2) km[0] += a->in[I_SD][layer * 512 + g * 16 + c];
#pragma unroll
            for (int d = 0; d < 16; ++d) if ((d & 3) == pq) { const bf16_t kb = f2bf(km[d]);
                for (int i = d; i < 16; ++i) wy[(size_t)(g * 256 + i * 16 + c) * 384 + 128 + (i - d) * 16 + c2] = kb;
                if (d > 0) for (int i = 0; i < 16 - d; ++i) wy[(size_t)(g * 256 + i * 16 + c) * 384 + 128 + (i + d) * 16 + c2] = (bf16_t)0; }
        }
    }
}

__device__ __forceinline__ void prep_x(AP a, const int wv_) {
    bf16_t* xb = (bf16_t*)(a->ws + OFF_XB);
    const int gt = blockIdx.x * NTHR + otid(wv_), GT = gridDim.x * NTHR;
    for (int idx = gt; idx < M * 128; idx += GT) {
        const size_t e = (size_t)idx * 8; const float* src = e < (size_t)MP * 1024 ? a->in[I_XP] + e : a->in[I_XS] + (e - (size_t)MP * 1024);
        const f32x4 v0 = *(const f32x4*)src, v1 = *(const f32x4*)(src + 4);
        *(u32x4*)(xb + e) = pack8(v0, v1);
    }
}

__device__ __forceinline__ void conv_phase(AP a, int layer, bf16_t* bin_out, const int wv_) {
    unsigned char* ws = a->ws;
    const bf16_t* xa = (const bf16_t*)(ws + OFF_R); bf16_t* sb = (bf16_t*)(ws + OFF_R + S17);
    const bf16_t* sc = (const bf16_t*)(ws + OFF_R + 2 * S17);
    bf16_t* xac = (bf16_t*)(ws + OFF_XB);
    const float* caw = a->in[I_CAW] + layer * 4 * 512; const float* cab = a->in[I_CAB] + layer * 512; const float* cbw = a->in[I_CBW] + layer * 3 * 512;
    const int gt = blockIdx.x * NTHR + otid(wv_), GT = gridDim.x * NTHR;
#pragma unroll 1
    for (int pass = 0; pass < 2; ++pass) {
        int idx;
        if (pass == 0) { idx = gt; if (idx >= 2048 * 64) continue; }
        else { const int j = gt - (GT >> 1); if (j < 0 || j >= 128 * 64) continue; idx = 2048 * 64 + j; }
        const int seg = idx >> 6, c0 = (idx & 63) * 8;
        const bool prompt = seg < 2048;
        int row0, nrows;
        float x0[8], x1[8], x2[8], u1[8], u2[8];
        if (prompt) { row0 = seg * 8; nrows = 8; const bool first = (seg & 255) == 0;
            if (first) {
#pragma unroll
                for (int j = 0; j < 8; ++j) { x0[j] = 0.f; x1[j] = 0.f; x2[j] = 0.f; u1[j] = 0.f; u2[j] = 0.f; }
            } else {
                unpack8(*(const u32x4*)(xa + (size_t)(row0 - 3) * 512 + c0), x0); unpack8(*(const u32x4*)(xa + (size_t)(row0 - 2) * 512 + c0), x1); unpack8(*(const u32x4*)(xa + (size_t)(row0 - 1) * 512 + c0), x2);
                unpack8(*(const u32x4*)(sc + (size_t)(row0 - 2) * 512 + c0), u1);
                unpack8(*(const u32x4*)(sc + (size_t)(row0 - 1) * 512 + c0), u2);
            }
        } else { const int b = seg - 2048; row0 = MP + b * 4; nrows = 4;
            const float* lc = a->in[I_SLC] + ((size_t)(layer * 128 + b) * 3) * 512 + c0; const float* scs = a->in[I_SSC] + ((size_t)(layer * 128 + b) * 2) * 512 + c0;
#pragma unroll
            for (int j = 0; j < 8; ++j) { x0[j] = lc[j]; x1[j] = lc[512 + j]; x2[j] = lc[1024 + j]; u1[j] = scs[j]; u2[j] = scs[512 + j]; }
        }
        float w0[8], w1[8], w2[8], w3[8], wb[8], v0[8], v1[8], v2[8];
#pragma unroll
        for (int j = 0; j < 8; ++j) { w0[j] = caw[c0 + j]; w1[j] = caw[512 + c0 + j]; w2[j] = caw[1024 + c0 + j]; w3[j] = caw[1536 + c0 + j]; wb[j] = cab[c0 + j];
            v0[j] = cbw[c0 + j]; v1[j] = cbw[512 + c0 + j]; v2[j] = cbw[1024 + c0 + j]; }
        for (int t0 = 0; t0 < nrows; t0 += 2) {
            u32x4 lx[2], lc[2], lb[2];
#pragma unroll
            for (int k = 0; k < 2; ++k) { const size_t off = (size_t)(row0 + t0 + k) * 512 + c0;
                lx[k] = *(const u32x4*)(xa + off); lc[k] = *(const u32x4*)(sc + off); lb[k] = *(const u32x4*)(sb + off); }
#pragma unroll
            for (int k = 0; k < 2; ++k) { const size_t off = (size_t)(row0 + t0 + k) * 512 + c0;
                float xv[8], scv[8], sbv[8];
                unpack8(lx[k], xv); unpack8(lc[k], scv); unpack8(lb[k], sbv);
                f32x4 o0, o1, q0, q1;
#pragma unroll
                for (int j = 0; j < 8; ++j) {
                    const float o = w0[j] * x0[j] + w1[j] * x1[j] + w2[j] * x2[j] + w3[j] * xv[j] + wb[j];
                    const float uu = scv[j]; const float cu = v0[j] * u1[j] + v1[j] * u2[j] + v2[j] * uu; const float bi = sbv[j] * cu;
                    if (j < 4) { o0[j] = o; q0[j] = bi; } else { o1[j - 4] = o; q1[j - 4] = bi; }
                    x0[j] = x1[j]; x1[j] = x2[j]; x2[j] = xv[j]; u1[j] = u2[j]; u2[j] = uu;
                }
                *(u32x4*)(xac + off) = pack8(o0, o1);
                *(u32x4*)(bin_out + off) = pack8(q0, q1); }
        }
        if (prompt) { if ((seg & 255) == 255) { const int b = seg >> 8;
                float* o1 = a->out + O_LCP + ((size_t)(layer * 8 + b) * 3) * 512 + c0; float* o2 = a->out + O_SCP + ((size_t)(layer * 8 + b) * 2) * 512 + c0;
#pragma unroll
                for (int j = 0; j < 8; ++j) { o1[j] = x0[j]; o1[512 + j] = x1[j]; o1[1024 + j] = x2[j]; o2[j] = u1[j]; o2[512 + j] = u2[j]; } }
        } else { const int b = seg - 2048;
            float* o1 = a->out + O_LCS + ((size_t)(layer * 128 + b) * 3) * 512 + c0; float* o2 = a->out + O_SCS + ((size_t)(layer * 128 + b) * 2) * 512 + c0;
#pragma unroll
            for (int j = 0; j < 8; ++j) { o1[j] = x0[j]; o1[512 + j] = x1[j]; o1[1024 + j] = x2[j]; o2[j] = u1[j]; o2[512 + j] = u2[j]; }
        }
    }
}

__device__ __forceinline__ void ssm_s_gemm(AP a, const int wv_) {
    const bf16_t* apack = (const bf16_t*)(a->ws + OFF_APACK); const bf16_t* w1 = (const bf16_t*)(a->ws + OFF_W1T); float* S = (float*)(a->ws + OFF_S);
    const int tid_ = otid(wv_); const int lane = tid_ & 63, wv = blockIdx.x * 8 + (tid_ >> 6), NW = gridDim.x * 8;
    const int lr = lane & 15, kq = lane >> 4;
    for (int t = wv; t < 1024; t += NW) {
        const int g = t >> 5, rt = (t >> 1) & 15, ct = t & 1;
        f32x4 acc[4][4];
#pragma unroll
        for (int i = 0; i < 4; ++i)
#pragma unroll
            for (int j = 0; j < 4; ++j) acc[i][j] = (f32x4){0.f, 0.f, 0.f, 0.f};
        const bf16_t* ab = apack + ((size_t)(g * 1024 + rt * 64 + lr) * 384 + 128 + kq * 8);
        const bf16_t* bb = w1 + ((size_t)(g * 128 + ct * 64 + lr) * 256 + kq * 8);
#pragma unroll 2
        for (int ks = 0; ks < 8; ++ks) {
            bf16x8 af[4], bf[4];
#pragma unroll
            for (int i = 0; i < 4; ++i) { af[i] = *(const bf16x8*)(ab + (size_t)i * 16 * 384 + ks * 32); bf[i] = *(const bf16x8*)(bb + (size_t)i * 16 * 256 + ks * 32); }
#pragma unroll
            for (int i = 0; i < 4; ++i)
#pragma unroll
                for (int j = 0; j < 4; ++j) acc[i][j] = __builtin_amdgcn_mfma_f32_16x16x32_bf16(af[i], bf[j], acc[i][j], 0, 0, 0);
        }
#pragma unroll
        for (int i = 0; i < 4; ++i)
#pragma unroll
            for (int j = 0; j < 4; ++j)
#pragma unroll
                for (int q = 0; q < 4; ++q) S[(size_t)(g * 1024 + rt * 64 + i * 16 + kq * 4 + q) * 128 + ct * 64 + j * 16 + lr] = acc[i][j][q];
    }
}

__device__ __forceinline__ void ssm_carry(AP a, int layer, float* sm, const int wv_) {
    bf16_t* apack = (bf16_t*)(a->ws + OFF_APACK); const float* S = (const float*)(a->ws + OFF_S);
    const int tid = otid(wv_), p = tid & 63, seg = tid >> 6;
    for (int pair = blockIdx.x; pair < 256; pair += gridDim.x) {
        const int b = pair >> 5, g = pair & 31, sp = g * 64 + p;
        float ar, ai, Ar, Ai;
        abar_pow(a->in[I_SAR] + layer * 2048, a->in[I_SAI] + layer * 2048, a->in[I_SDT] + layer * 2048, sp, 16.0f, ar, ai);
        abar_pow(a->in[I_SAR] + layer * 2048, a->in[I_SAI] + layer * 2048, a->in[I_SDT] + layer * 2048, sp, 256.0f, Ar, Ai);
        const size_t rbase = (size_t)g * 1024 + b * 128 + seg * 16;
        float sr[16], si[16];
#pragma unroll
        for (int j = 0; j < 16; ++j) { sr[j] = S[(rbase + j) * 128 + p]; si[j] = S[(rbase + j) * 128 + 64 + p]; }
        float hr = 0.f, hi = 0.f;
#pragma unroll
        for (int j = 0; j < 16; ++j) { const float nr = ar * hr - ai * hi + sr[j], ni = ar * hi + ai * hr + si[j]; sr[j] = hr; si[j] = hi; hr = nr; hi = ni; }
        sm[seg * 128 + p] = hr; sm[seg * 128 + 64 + p] = hi;
        __syncthreads();
        float cr = 0.f, ci = 0.f;
        for (int s2 = 0; s2 < seg; ++s2) { const float er = sm[s2 * 128 + p], ei = sm[s2 * 128 + 64 + p]; const float nr = Ar * cr - Ai * ci + er, ni = Ar * ci + Ai * cr + ei; cr = nr; ci = ni; }
        if (seg == 7) { const float fr_ = Ar * cr - Ai * ci + hr, fi_ = Ar * ci + Ai * cr + hi;
            a->out[O_SRP + (size_t)(layer * 8 + b) * 2048 + sp] = fr_; a->out[O_SIP + (size_t)(layer * 8 + b) * 2048 + sp] = fi_; }
#pragma unroll
        for (int j = 0; j < 16; ++j) { apack[(rbase + j) * 384 + p] = f2bf(sr[j] + cr); apack[(rbase + j) * 384 + 64 + p] = f2bf(si[j] + ci);
            const float nr = ar * cr - ai * ci, ni = ar * ci + ai * cr; cr = nr; ci = ni; }
        __syncthreads();
    }
}

__device__ __forceinline__ void ssm_sample(AP a, int layer, int wv, int NW, const int wv_) {
    const bf16_t* uss = (const bf16_t*)(a->ws + OFF_USS); bf16_t* zc = (bf16_t*)(a->ws + OFF_ZCS);
    const float* are = a->in[I_SAR] + layer * 2048; const float* aim = a->in[I_SAI] + layer * 2048; const float* ldt = a->in[I_SDT] + layer * 2048;
    const float* bre = a->in[I_SBR] + layer * 32768; const float* bim = a->in[I_SBI] + layer * 32768;
    const float* cre = a->in[I_SCR] + layer * 32768; const float* cim = a->in[I_SCI] + layer * 32768; const float* dv = a->in[I_SD] + layer * 512;
    const int lane = otid(wv_) & 63;
    for (int t = wv; t < 128 * 32; t += NW) {
        const int b = t >> 5, g = t & 31, sp = g * 64 + lane;
        float ar, ai, cr, ci; abar_pow(are, aim, ldt, sp, 1.0f, ar, ai); ssm_coef(are, aim, ldt, sp, cr, ci);
        float bbr[16], bbi[16], xr[16], xi[16];
#pragma unroll
        for (int c = 0; c < 16; ++c) { const float br = bre[sp * 16 + c], bi = bim[sp * 16 + c]; bbr[c] = cr * br - ci * bi; bbi[c] = cr * bi + ci * br;
            xr[c] = cre[(g * 16 + c) * 64 + lane]; xi[c] = cim[(g * 16 + c) * 64 + lane]; }
        float hr = a->in[I_SSR][(size_t)(layer * 128 + b) * 2048 + sp], hi = a->in[I_SSI][(size_t)(layer * 128 + b) * 2048 + sp];
        const float dme = lane < 16 ? dv[g * 16 + lane] : 0.f;
        for (int tt = 0; tt < 4; ++tt) {
            const bf16_t* up = uss + (size_t)(b * 4 + tt) * 512 + g * 16;
            const u32x4 w0 = *(const u32x4*)up, w1 = *(const u32x4*)(up + 8);
            float u[16]; { float t0[8], t1[8]; unpack8(w0, t0); unpack8(w1, t1);
#pragma unroll
                for (int c = 0; c < 8; ++c) { u[c] = t0[c]; u[8 + c] = t1[c]; } }
            float br_ = 0.f, bi_ = 0.f;
#pragma unroll
            for (int c = 0; c < 16; ++c) { br_ += bbr[c] * u[c]; bi_ += bbi[c] * u[c]; }
            const float nr = ar * hr - ai * hi + br_, ni = ar * hi + ai * hr + bi_; hr = nr; hi = ni;
            float mine = 0.f, ume = 0.f;
#pragma unroll
            for (int c = 0; c < 16; ++c) { float y = xr[c] * hr - xi[c] * hi;
#pragma unroll
                for (int o = 32; o >= 1; o >>= 1) y += shx(y, o, lane);
                if (lane == c) { mine = y; ume = u[c]; } }
            if (lane < 16) zc[(size_t)(b * 4 + tt) * 512 + g * 16 + lane] = f2bf(gelu_t(mine + dme * ume));
        }
        a->out[O_SRS + (size_t)(layer * 128 + b) * 2048 + sp] = hr; a->out[O_SIS + (size_t)(layer * 128 + b) * 2048 + sp] = hi;
    }
}

__device__ __forceinline__ void lru_local(AP a, const int wv_) {
    const _Float16* av = (const _Float16*)(a->ws + OFF_R + 2 * S17); const bf16_t* bx = (const bf16_t*)(a->ws + OFF_R); f32x2* car = (f32x2*)(a->ws + OFF_CAR);
    const int gt = blockIdx.x * NTHR + otid(wv_), GT = gridDim.x * NTHR;
    for (int idx = gt; idx < 8 * 32 * 512; idx += GT) {
        const int c = idx & 511, sc = idx >> 9;
        const size_t base = (size_t)sc * 64 * 512 + c;
        float P = 1.f, h = 0.f;
        for (int t0 = 0; t0 < 64; t0 += 16) {
            _Float16 al[16]; bf16_t bb[16];
#pragma unroll
            for (int j = 0; j < 16; ++j) { al[j] = av[base + (size_t)(t0 + j) * 512]; bb[j] = bx[base + (size_t)(t0 + j) * 512]; }
#pragma unroll
            for (int j = 0; j < 16; ++j) { const float aa = __expf((float)al[j]); h = aa * h + bf2f(bb[j]); P *= aa; }
        }
        car[idx] = (f32x2){P, h};
    }
}
template <int B>
__device__ __forceinline__ float lru_run(const _Float16* av, const bf16_t* bx, bf16_t* ao, const bf16_t* ya, size_t base, int n, float h) {
    for (int t0 = 0; t0 < n; t0 += B) {
        _Float16 aa[B]; bf16_t bb[B], yy[B];
#pragma unroll
        for (int j = 0; j < B; ++j) { const size_t o = base + (size_t)(t0 + j) * 512; aa[j] = av[o]; bb[j] = bx[o]; yy[j] = ya[o]; }
        bf16_t oo[B];
#pragma unroll
        for (int j = 0; j < B; ++j) { h = __expf((float)aa[j]) * h + bf2f(bb[j]); oo[j] = f2bf(h * gelu_t(bf2f(yy[j]))); }
#pragma unroll
        for (int j = 0; j < B; ++j) ao[base + (size_t)(t0 + j) * 512] = oo[j];
    }
    return h;
}
__device__ __forceinline__ void lru_apply(AP a, int layer, bf16_t* ao, int mode, const int wv_) {
    const _Float16* av = (const _Float16*)(a->ws + OFF_R + 2 * S17); const bf16_t* bx = (const bf16_t*)(a->ws + OFF_R); const f32x2* car = (const f32x2*)(a->ws + OFF_CAR);
    const bf16_t* ya = (const bf16_t*)(a->ws + OFF_YA);
    const int G = gridDim.x, bid = blockIdx.x;
    if (mode == 0) {
        for (int idx = bid * NTHR + otid(wv_); idx < 8 * 32 * 512; idx += G * NTHR) {
            const int c = idx & 511, sc = idx >> 9, seq = sc >> 5, chunk = sc & 31;
            float h = 0.f;
            f32x2 ph[31];
#pragma unroll
            for (int k = 0; k < 31; ++k) ph[k] = car[(seq * 32 + (k < chunk ? k : 0)) * 512 + c];
#pragma unroll
            for (int k = 0; k < 31; ++k) if (k < chunk) h = ph[k].x * h + ph[k].y;
            h = lru_run<8>(av, bx, ao, ya, (size_t)sc * 64 * 512 + c, 64, h);
            if (chunk == 31) a->out[O_LHP + (size_t)(layer * 8 + seq) * 512 + c] = h;
        }
    } else {
        for (int j = bid * NTHR + otid(wv_); j < 128 * 512; j += G * NTHR) {
            const int c = j & 511, b = j >> 9;
            float h = a->in[I_SLH][(size_t)(layer * 128 + b) * 512 + c];
            h = lru_run<4>(av, bx, ao, ya, (size_t)(MP + b * 4) * 512 + c, 4, h);
            a->out[O_LHS + (size_t)(layer * 128 + b) * 512 + c] = h;
        }
    }
}

template <bool RES16>
__device__ __forceinline__ void ln_phase(const bf16_t* T, const float* Rs, const float* part, const float* resp, const float* ress, const bf16_t* res16,
                                         float* dst32, bf16_t* dst16, const float* gam, const float* bet, const int wv_) {
    const int tid_ = otid(wv_); const int lane = tid_ & 63, wv = blockIdx.x * 8 + (tid_ >> 6), NW = gridDim.x * 8;
    for (int r0 = wv; r0 < M; r0 += 3 * NW) {
        f32x4 v[3][4];
#pragma unroll
        for (int k = 0; k < 3; ++k) { const int rr = r0 + k * NW; const int r = rr < M ? rr : r0;
            if (r < MP) {
#pragma unroll
                for (int i = 0; i < 4; ++i) { const u32x2 w = *(const u32x2*)(T + (size_t)r * 1024 + i * 256 + lane * 4); v[k][i] = (f32x4){bflo(w.x), bfhi(w.x), bflo(w.y), bfhi(w.y)}; }
            } else {
#pragma unroll
                for (int i = 0; i < 4; ++i) v[k][i] = *(const f32x4*)(Rs + (size_t)r * 1024 + i * 256 + lane * 4);
#pragma unroll
                for (int q = 0; q < 3; ++q)
#pragma unroll
                    for (int i = 0; i < 4; ++i) v[k][i] += *(const f32x4*)(part + (size_t)q * PART_STRIDE + (size_t)(r - MP) * 1024 + i * 256 + lane * 4);
            }
            if (RES16) {
#pragma unroll
                for (int i = 0; i < 4; ++i) { const u32x2 w = *(const u32x2*)(res16 + (size_t)r * 1024 + i * 256 + lane * 4); v[k][i] += (f32x4){bflo(w.x), bfhi(w.x), bflo(w.y), bfhi(w.y)} * ALPHA; }
            } else { const float* rp = r < MP ? resp + (size_t)r * 1024 : ress + (size_t)(r - MP) * 1024;
#pragma unroll
                for (int i = 0; i < 4; ++i) v[k][i] += *(const f32x4*)(rp + i * 256 + lane * 4) * ALPHA;
            } }
#pragma unroll
        for (int k = 0; k < 3; ++k) { const int r = r0 + k * NW;
            float s = 0.f;
#pragma unroll
            for (int i = 0; i < 4; ++i) s += (v[k][i][0] + v[k][i][1]) + (v[k][i][2] + v[k][i][3]);
#pragma unroll
            for (int o = 32; o >= 1; o >>= 1) s += shx(s, o, lane);
            const float mu = s * (1.0f / 1024.0f); float q = 0.f;
#pragma unroll
            for (int i = 0; i < 4; ++i) { const f32x4 d = v[k][i] - mu; q += (d[0] * d[0] + d[1] * d[1]) + (d[2] * d[2] + d[3] * d[3]); }
#pragma unroll
            for (int o = 32; o >= 1; o >>= 1) q += shx(q, o, lane);
            const float rs = rsqrtf(q * (1.0f / 1024.0f) + LN_EPS);
            if (r < M) {
#pragma unroll
                for (int i = 0; i < 4; ++i) { const int col = i * 256 + lane * 4; const f32x4 gg = *(const f32x4*)(gam + col), bb = *(const f32x4*)(bet + col);
                    const f32x4 y = (v[k][i] - mu) * rs * gg + bb;
                    if (dst32) *(f32x4*)(dst32 + (size_t)r * 1024 + col) = y;
                    if (dst16) { u32x2 w; w.x = cvt_pk_bf16(y[0], y[1]); w.y = cvt_pk_bf16(y[2], y[3]);
                        *(u32x2*)(dst16 + (size_t)r * 1024 + col) = w; } }
            }
        }
    }
}

__global__ void __launch_bounds__(NTHR, 2) fwd_megakernel(Args a_unused) {
    extern __shared__ __attribute__((aligned(16))) unsigned char lds_raw[];
    cg::grid_group grid = cg::this_grid();
    LAS unsigned char* lds = (LAS unsigned char*)lds_raw;
    const int G = gridDim.x, bid = blockIdx.x;
    int wv_; { const int tw = (int)threadIdx.x >> 6; asm volatile("v_readfirstlane_b32 %0, %1" : "=s"(wv_) : "v"(tw)); }

    const unsigned long long t_start = PROBE_ON ? __builtin_amdgcn_s_memrealtime() : 0ull;
    for (int rep = 0; rep < REP_PREP; ++rep) { const AP a = ld_args(); prep_layer(a, 0, (float*)lds_raw, wv_); prep_x(a, wv_); }
    int pidx = 1; unsigned long long tA = PROBE_A == 0 ? t_start : 0ull, tB = 0ull;
    if (PROBE_ON) { if (PROBE_A == 1) tA = __builtin_amdgcn_s_memrealtime(); if (PROBE_B == 1) tB = __builtin_amdgcn_s_memrealtime(); }
    unsigned bar_n = 0; { const AP a = ld_args(); if (a->ws == nullptr) grid.sync(); }
    bar_n += (unsigned)G; gbar((unsigned*)(ld_args()->ws + OFF_BAR), bar_n, wv_);

#pragma unroll 1
    for (int layer = 0; layer < 2; ++layer) {
        { const AP a = ld_args(); unsigned char* ws = a->ws;
          PG1 p; p.K = 1024; p.lda = 1024; p.ldb = 1024; p.G = opq(G); p.c = opq(bid); p.A = layer == 0 ? (const bf16_t*)(ws + OFF_XB) : (const bf16_t*)a->out; p.Bt = (const bf16_t*)(ws + OFF_WIN);
          p.xa = (bf16_t*)(ws + OFF_R); p.ya = (bf16_t*)(ws + OFF_YA); p.sb = (bf16_t*)(ws + OFF_R + S17); p.sc = (bf16_t*)(ws + OFF_R + 2 * S17); p.sh = (bf16_t*)(ws + OFF_R + 3 * S17);
          p.apack = (bf16_t*)(ws + OFF_APACK); p.uss = (bf16_t*)(ws + OFF_USS); p.gl8 = ws + OFF_GL8;
          for (int rep = 0; rep < REP_G1; ++rep) gemm_phase(lds, p, wv_); }
        GSYNC();
        if (DRY_CONV) { const AP a = ld_args(); conv_phase(a, layer, (bf16_t*)(a->ws + OFF_XB + S17), wv_); }
        { const AP a = ld_args(); conv_phase(a, layer, (bf16_t*)(a->ws + OFF_R + S17), wv_); }
        for (int rep = 0; rep < REP_SG; ++rep) { const AP a = ld_args(); ssm_s_gemm(a, wv_); }
        GSYNC();
        for (int rep = 0; rep < REP_CARRY; ++rep) { const AP a = ld_args(); ssm_carry(a, layer, (float*)lds_raw, wv_); }
        { const AP a = ld_args(); unsigned char* ws = a->ws;
          PGate p; p.K = 256; p.lda = 512; p.ldb = 256; p.G = opq(G); p.c = opq(bid); p.A = (const bf16_t*)(ws + OFF_XB); p.Bt = (const bf16_t*)(ws + OFF_WGATE);
          p.gxb = a->in[I_GXB] + layer * 512; p.gab = a->in[I_GAB] + layer * 512; p.lam = a->in[I_LAM] + layer * 512;
          p.aout = (_Float16*)(ws + OFF_R + 2 * S17); p.bxout = (bf16_t*)(ws + OFF_R);
          for (int rep = 0; rep < REP_GATE; ++rep) gemm_phase(lds, p, wv_); }
        for (int rep = 0; rep < REP_SAMPLE; ++rep) if (bid >= 8) { const AP a = ld_args(); ssm_sample(a, layer, (bid - 8) * 8 + wv_, (G - 8) * 8, wv_); }
        GSYNC();
        { const AP a = ld_args(); unsigned char* ws = a->ws;
          PY p; p.K = 384; p.lda = 384; p.ldb = 384; p.G = opq(G); p.c = opq(bid); p.apack = (const bf16_t*)(ws + OFF_APACK); p.wyt = (const bf16_t*)(ws + OFF_WYT);
          p.dvec = a->in[I_SD] + layer * 512; p.zc = (bf16_t*)(ws + OFF_XB);
          for (int rep = 0; rep < REP_Y; ++rep) gemm_phase(lds, p, wv_); }
        { const AP a = ld_args(); unsigned char* ws = a->ws;
          PGlu p; p.K = 512; p.lda = 512; p.ldb = 512; p.G = opq(G); p.c = opq(bid); p.sample = 1; p.A = (const bf16_t*)(ws + OFF_XB); p.As = (const bf16_t*)(ws + OFF_ZCS); p.Bt = (const bf16_t*)(ws + OFF_WGLU);
          p.bias = a->in[I_GLB] + layer * 512; p.out = (bf16_t*)(ws + OFF_XB + S17);
          gemm_phase(lds, p, wv_); }
        { const AP a = ld_args(); lru_apply(a, layer, (bf16_t*)(a->ws + OFF_R), 1, wv_); }
        for (int rep = 0; rep < REP_LOCAL; ++rep) { const AP a = ld_args(); lru_local(a, wv_); }
        GSYNC();
        { const AP a = ld_args(); unsigned char* ws = a->ws;
          PGlu p; p.K = 512; p.lda = 512; p.ldb = 512; p.G = opq(G); p.c = opq(bid); p.sample = 0; p.A = (const bf16_t*)(ws + OFF_XB); p.As = (const bf16_t*)(ws + OFF_ZCS); p.Bt = (const bf16_t*)(ws + OFF_WGLU);
          p.bias = a->in[I_GLB] + layer * 512; p.out = (bf16_t*)(ws + OFF_XB + S17);
          for (int rep = 0; rep < REP_GLU; ++rep) gemm_phase(lds, p, wv_); }
        { const AP a = ld_args(); unsigned char* ws = a->ws;
          PMergeT<true> p; p.K = 512; p.lda = 512; p.ldb = 512; p.G = opq(G); p.c = opq(bid); p.a0 = (const bf16_t*)(ws + OFF_R);
          p.wp = (const bf16_t*)(ws + OFF_WP); p.gl8 = ws + OFF_GL8; p.mb = (bf16_t*)(ws + OFF_MB); p.pm3 = (float*)(ws + OFF_S);
          gemm_phase(lds, p, wv_); }
        if (DRY_APPLY) { const AP a = ld_args(); lru_apply(a, layer, (bf16_t*)(a->ws + OFF_S), 0, wv_); }
        { const AP a = ld_args(); lru_apply(a, layer, (bf16_t*)(a->ws + OFF_R), 0, wv_); }
        GSYNC();
        { const AP a = ld_args(); unsigned char* ws = a->ws;
          PMergeT<false> p; p.K = 512; p.lda = 512; p.ldb = 512; p.G = opq(G); p.c = opq(bid); p.a0 = (const bf16_t*)(ws + OFF_R);
          p.wp = (const bf16_t*)(ws + OFF_WP); p.gl8 = ws + OFF_GL8; p.mb = (bf16_t*)(ws + OFF_MB); p.pm3 = (float*)(ws + OFF_S);
          { const float* pm = (const float*)(ws + OFF_S); bf16_t* ms = (bf16_t*)(ws + OFF_MB) + (size_t)MP * 1024;
            for (int i = bid * NTHR + otid(wv_); i < MS * 128; i += G * NTHR) { const size_t e = (size_t)i * 8;
                f32x4 s0 = *(const f32x4*)(pm + e), s1 = *(const f32x4*)(pm + e + 4);
                s0 += *(const f32x4*)(pm + PART_STRIDE + e); s1 += *(const f32x4*)(pm + PART_STRIDE + e + 4);
                s0 += *(const f32x4*)(pm + 2 * PART_STRIDE + e); s1 += *(const f32x4*)(pm + 2 * PART_STRIDE + e + 4);
                *(u32x4*)(ms + e) = pack8(s0, s1); } }
          for (int rep = 0; rep < REP_MERGE; ++rep) gemm_phase(lds, p, wv_); }
        GSYNC();
        { const AP a = ld_args(); unsigned char* ws = a->ws;
          PWout p; p.K = 1024; p.lda = 1024; p.ldb = 1024; p.G = opq(G); p.c = opq(bid); p.A = (const bf16_t*)(ws + OFF_MB); p.Bt = (const bf16_t*)(ws + OFF_WOUT);
          p.T = (bf16_t*)(ws + OFF_R); p.R = (float*)(ws + OFF_R); p.part = (float*)(ws + OFF_PW);
          gemm_phase(lds, p, wv_); }
        GSYNC();
        { const AP a = ld_args(); unsigned char* ws = a->ws;
          if (layer == 0) ln_phase<false>((const bf16_t*)(ws + OFF_R), (const float*)(ws + OFF_R), (const float*)(ws + OFF_PW), a->in[I_XP], a->in[I_XS], (const bf16_t*)nullptr,
                          (float*)nullptr, (bf16_t*)(ws + OFF_XB), a->in[I_L1G] + layer * 1024, a->in[I_L1B] + layer * 1024, wv_);
          else ln_phase<true>((const bf16_t*)(ws + OFF_R), (const float*)(ws + OFF_R), (const float*)(ws + OFF_PW), (const float*)nullptr, (const float*)nullptr, (const bf16_t*)a->out,
                          (float*)nullptr, (bf16_t*)(ws + OFF_XB), a->in[I_L1G] + layer * 1024, a->in[I_L1B] + layer * 1024, wv_); }
        GSYNC();
        { const AP a = ld_args(); unsigned char* ws = a->ws;
          PUp p; p.K = 1024; p.lda = 1024; p.ldb = 1024; p.G = opq(G); p.c = opq(bid); p.A = (const bf16_t*)(ws + OFF_XB); p.Bt = (const bf16_t*)(ws + OFF_WUP); p.h = (bf16_t*)(ws + OFF_H);
          for (int rep = 0; rep < REP_UP; ++rep) gemm_phase(lds, p, wv_); }
        GSYNC();
        { const AP a = ld_args(); unsigned char* ws = a->ws;
          PDown p; p.K = 4096; p.lda = 4096; p.ldb = 4096; p.G = opq(G); p.c = opq(bid); p.A = (const bf16_t*)(ws + OFF_H); p.Bt = (const bf16_t*)(ws + OFF_WDOWN);
          p.T = (bf16_t*)(ws + OFF_R); p.R = (float*)(ws + OFF_R); p.part = (float*)(ws + OFF_PD);
          gemm_phase(lds, p, wv_); }
        GSYNC();
        { const AP a = ld_args(); unsigned char* ws = a->ws;
          ln_phase<true>((const bf16_t*)(ws + OFF_R), (const float*)(ws + OFF_R), (const float*)(ws + OFF_PD), (const float*)nullptr, (const float*)nullptr, (const bf16_t*)(ws + OFF_XB),
                         layer == 0 ? (float*)nullptr : a->out, layer == 0 ? (bf16_t*)a->out : (bf16_t*)nullptr, a->in[I_L2G] + layer * 1024, a->in[I_L2B] + layer * 1024, wv_); }
        if (layer == 0) { __syncthreads(); for (int rep = 0; rep < REP_PREP; ++rep) { const AP a = ld_args(); prep_layer(a, 1, (float*)lds_raw, wv_); } GSYNC(); }
    }
    if (PROBE_ON && bid == 0) { if (PROBE_B > 22) tB = __builtin_amdgcn_s_memrealtime(); const unsigned long long t0 = __builtin_amdgcn_s_memrealtime(); while (__builtin_amdgcn_s_memrealtime() - t0 < tB - tA) __builtin_amdgcn_s_sleep(8); }
}

extern "C" void kernel_launch(void* const* d_in, const int* in_sizes, int n_in, void* d_out, int out_size, void* d_ws, size_t ws_size, hipStream_t stream) {
    constexpr size_t kDynLds = STAGE_BYTES;
    static int grid_blocks = 0;
    if (!grid_blocks) {
        int dev = 0, cus = 0, per_cu = 0;
        hipGetDevice(&dev);
        hipDeviceGetAttribute(&cus, hipDeviceAttributeMultiprocessorCount, dev);
        hipFuncSetAttribute((const void*)fwd_megakernel, hipFuncAttributeMaxDynamicSharedMemorySize, (int)kDynLds);
        hipOccupancyMaxActiveBlocksPerMultiprocessor(&per_cu, (const void*)fwd_megakernel, NTHR, kDynLds);
        if (per_cu < 1) per_cu = 1;
        grid_blocks = cus * per_cu;
        if (grid_blocks > 256) grid_blocks = 256;
        if (ws_size < WS_END || n_in != 36) fprintf(stderr, "kernel_launch: unexpected ws_size %zu (need %zu) or n_in %d\n", ws_size, (size_t)WS_END, n_in);
    }
    (void)hipMemsetAsync((char*)d_ws + OFF_BAR, 0, 256, stream);
    Args a{};
    for (int i = 0; i < 36; ++i) a.in[i] = (const float*)d_in[i];
    a.out = (float*)d_out; a.ws = (unsigned char*)d_ws;
    void* args[] = {&a};
    hipError_t e = hipLaunchCooperativeKernel((const void*)fwd_megakernel, dim3(grid_blocks), dim3(NTHR), args, kDynLds, stream);
    if (e != hipSuccess) fprintf(stderr, "cooperative launch failed: %s (grid %d)\n", hipGetErrorString(e), grid_blocks);
}
```

```cpp
#include <hip/hip_runtime.h>
#include <hip/hip_cooperative_groups.h>
#include <cstdio>
namespace cg = cooperative_groups;
#define REP_GEMM 1
#define REP_G1 REP_GEMM
#define REP_GATE REP_GEMM
#define REP_Y REP_GEMM
#define REP_GLU REP_GEMM
#define REP_MERGE REP_GEMM
#define REP_UP REP_GEMM
#define REP_ELEM 1
#define REP_PREP REP_ELEM
#define REP_SG REP_ELEM
#define REP_CARRY REP_ELEM
#define REP_SAMPLE REP_ELEM
#define REP_LOCAL REP_ELEM
#define REP_LN2 REP_ELEM
#define DRY_CONV 0
#define DRY_APPLY 0
#define DRY_LN1 0
#define REP_SYNC 1
#define PROBE_ON 0
#define PROBE_A 0
#define PROBE_B 1
#define GSYNC() do { for (int _s = 0; _s < REP_SYNC; ++_s) { bar_n += (unsigned)G; gbar((unsigned*)(ld_args()->ws + OFF_BAR), bar_n, wv_); } ++pidx; if (PROBE_ON) { if (pidx == PROBE_A) tA = __builtin_amdgcn_s_memrealtime(); if (pidx == PROBE_B) tB = __builtin_amdgcn_s_memrealtime(); } } while (0)

#define LAS __attribute__((address_space(3)))
typedef unsigned short bf16_t;
typedef short bf16x8 __attribute__((ext_vector_type(8)));
typedef float f32x4 __attribute__((ext_vector_type(4)));
typedef float f32x2 __attribute__((ext_vector_type(2)));
typedef unsigned u32x4 __attribute__((ext_vector_type(4)));
typedef unsigned u32x2 __attribute__((ext_vector_type(2)));

constexpr int MP = 16384, MS = 512, M = MP + MS, D = 1024, NIN = 6144, BW = 512, DFF = 4096;
constexpr int NTHR = 512;
constexpr float ALPHA = 1.41421356237f;
constexpr float LN_EPS = 1e-5f;

constexpr size_t S17 = (size_t)M * 512 * 2;
constexpr size_t OFF_WUP = 0;
constexpr size_t OFF_WDOWN = OFF_WUP + (size_t)4096 * 1024 * 2;
constexpr size_t OFF_R = OFF_WDOWN + (size_t)4096 * 1024 * 2;
constexpr size_t OFF_XB = OFF_R + 4 * S17;
constexpr size_t OFF_BIG = OFF_XB + 2 * S17;
constexpr size_t OFF_H = OFF_BIG;
constexpr size_t OFF_WIN = OFF_BIG;
constexpr size_t OFF_WP = OFF_WIN + (size_t)6144 * 1024 * 2;
constexpr size_t OFF_WGLU = OFF_WP + (size_t)3 * 1024 * 512 * 2;
constexpr size_t OFF_WOUT = OFF_WGLU + (size_t)512 * 512 * 2;
constexpr size_t OFF_WGATE = OFF_WOUT + (size_t)1024 * 1024 * 2;
constexpr size_t OFF_W1T = OFF_WGATE + (size_t)1024 * 512 * 2;
constexpr size_t OFF_WYT = OFF_W1T + (size_t)32 * 128 * 256 * 2;
constexpr size_t OFF_GL8 = OFF_WYT + (size_t)32 * 256 * 384 * 2;
constexpr size_t OFF_YA = OFF_GL8 + (size_t)M * 3072;
constexpr size_t OFF_APACK = OFF_YA + S17;
constexpr size_t OFF_S = OFF_APACK + (size_t)32 * 1024 * 384 * 2;
constexpr size_t OFF_CAR2 = OFF_S + (size_t)12 * 1024 * 1024;
constexpr size_t OFF_MB = OFF_APACK;
constexpr size_t OFF_USS = OFF_S + (size_t)32 * 1024 * 128 * 4;
constexpr size_t OFF_CAR = OFF_USS + (size_t)512 * 512 * 2;
constexpr size_t OFF_BAR = OFF_CAR + (size_t)8 * 32 * 512 * 8;
constexpr size_t OFF_PD = OFF_BAR + 256;
constexpr size_t OFF_PW = OFF_GL8;
constexpr size_t PART_STRIDE = (size_t)MS * 1024;
constexpr size_t OFF_ZCS = OFF_PD + 3 * PART_STRIDE * 4;
constexpr size_t WS_END = OFF_ZCS + (size_t)MS * 512 * 2;
static_assert(OFF_PD >= OFF_H + (size_t)M * 4096 * 2, "down partials must not overlap h");
static_assert(WS_END <= (size_t)268435456, "workspace map exceeds 256 MiB");
static_assert(OFF_MB + (size_t)M * 1024 * 2 <= OFF_USS, "m overlay");
static_assert(OFF_H + (size_t)M * 4096 * 2 <= (size_t)268435456, "h overlay");

constexpr size_t O_Y = 0;
constexpr size_t O_LCP = (size_t)M * 1024;
constexpr size_t O_LHP = O_LCP + 2 * 8 * 3 * 512;
constexpr size_t O_SCP = O_LHP + 2 * 8 * 512;
constexpr size_t O_SRP = O_SCP + 2 * 8 * 2 * 512;
constexpr size_t O_SIP = O_SRP + 2 * 8 * 2048;
constexpr size_t O_LCS = O_SIP + 2 * 8 * 2048;
constexpr size_t O_LHS = O_LCS + 2 * 128 * 3 * 512;
constexpr size_t O_SCS = O_LHS + 2 * 128 * 512;
constexpr size_t O_SRS = O_SCS + 2 * 128 * 2 * 512;
constexpr size_t O_SIS = O_SRS + 2 * 128 * 2048;

struct Args { const float* in[36]; float* out; unsigned char* ws; };
typedef const __attribute__((address_space(4))) Args* AP;
__device__ __forceinline__ AP ld_args() {
#if defined(__HIP_DEVICE_COMPILE__)
    auto p = __builtin_amdgcn_kernarg_segment_ptr();
    asm volatile("" : "+s"(p));
    return (AP)p;
#else
    return nullptr;
#endif
}
enum { I_XP = 0, I_XS, I_SLC, I_SLH, I_SSC, I_SSR, I_SSI, I_WIN, I_CAW, I_CAB, I_GXW, I_GXB, I_GAW, I_GAB, I_LAM, I_CBW, I_SAR, I_SAI, I_SDT,
       I_SBR, I_SBI, I_SCR, I_SCI, I_SD, I_GLW, I_GLB, I_PA, I_PB, I_PC, I_WO, I_L1G, I_L1B, I_UP, I_DN, I_L2G, I_L2B };

__device__ __forceinline__ unsigned cvt_pk_bf16(float lo, float hi) { unsigned r; asm volatile("v_cvt_pk_bf16_f32 %0, %1, %2" : "=v"(r) : "v"(lo), "v"(hi)); return r; }
__device__ __forceinline__ bf16_t f2bf(float f) { return (bf16_t)(cvt_pk_bf16(f, 0.f) & 0xffffu); }
__device__ __forceinline__ float bf2f(unsigned short b) { return __uint_as_float(((unsigned)b) << 16); }
__device__ __forceinline__ float bflo(unsigned w) { return __uint_as_float(w << 16); }
__device__ __forceinline__ float bfhi(unsigned w) { return __uint_as_float(w & 0xffff0000u); }
__device__ __forceinline__ float sigm(float x) { return 1.0f / (1.0f + __expf(-x)); }
__device__ __forceinline__ float gelu_t(float x) { const float u = 0.7978845608f * (x + 0.044715f * x * x * x); return x / (1.0f + __expf(-2.0f * u)); }
__device__ __forceinline__ u32x4 pack8(const f32x4 a, const f32x4 b) { u32x4 w; w.x = cvt_pk_bf16(a[0], a[1]); w.y = cvt_pk_bf16(a[2], a[3]); w.z = cvt_pk_bf16(b[0], b[1]); w.w = cvt_pk_bf16(b[2], b[3]); return w; }
__device__ __forceinline__ void unpack8(const u32x4 w, float (&f)[8]) { f[0] = bflo(w.x); f[1] = bfhi(w.x); f[2] = bflo(w.y); f[3] = bfhi(w.y); f[4] = bflo(w.z); f[5] = bfhi(w.z); f[6] = bflo(w.w); f[7] = bfhi(w.w); }

__device__ __forceinline__ int otid(const int wv_) { int t = wv_ * 64 + (int)__builtin_amdgcn_mbcnt_hi(~0u, __builtin_amdgcn_mbcnt_lo(~0u, 0u)); asm volatile("" : "+v"(t)); return t; }
__device__ __forceinline__ float shx(float v, int mask, int lane) { return __int_as_float(__builtin_amdgcn_ds_bpermute((lane ^ mask) << 2, __float_as_int(v))); }

__device__ __forceinline__ int opq(int x) { asm volatile("" : "+s"(x)); return x; }

__device__ __forceinline__ void gbar(unsigned* ctr, unsigned target, const int wv_) {
    asm volatile("s_waitcnt vmcnt(0)" ::: "memory");
    __syncthreads();
    if (otid(wv_) == 0) {
        __builtin_amdgcn_fence(__ATOMIC_RELEASE, "agent");
        asm volatile("s_waitcnt vmcnt(0)" ::: "memory");
        __hip_atomic_fetch_add(ctr, 1u, __ATOMIC_RELAXED, __HIP_MEMORY_SCOPE_AGENT);
        while (__hip_atomic_load(ctr, __ATOMIC_RELAXED, __HIP_MEMORY_SCOPE_AGENT) < target) __builtin_amdgcn_s_sleep(1);
        __builtin_amdgcn_fence(__ATOMIC_ACQUIRE, "agent");
        asm volatile("s_waitcnt vmcnt(0)" ::: "memory");
    }
    __syncthreads();
}

constexpr int BM = 256, BK = 64, HALF = 128, HTB = HALF * BK * 2, STAGE_BYTES = 8 * HTB;
__device__ __forceinline__ int lds_byte(int r, int c) { const int st = (r >> 4) * 2 + (c >> 5), rr = r & 15, cc = c & 31, ob = rr * 64 + cc * 2; return st * 1024 + (ob ^ (((ob >> 9) & 1) << 5)); }
__device__ __forceinline__ void stage_rc(int b, int& R, int& C) { const int st = b / 1024, sb = b % 1024, swz = sb ^ (((sb >> 9) & 1) << 5); R = (st >> 1) * 16 + swz / 64; C = (st & 1) * 32 + (swz % 64) / 2; }
__device__ __forceinline__ int perm32(int rho) { const int n = rho >> 4, i = rho & 15; return 8 * (i >> 2) + 4 * n + (i & 3); }
struct Unit { int pm, pn, z; };
__device__ __forceinline__ void tile_map(int L, int nM, int nN, int& pm, int& pn) {
    const int nwg = nM * nN; int wgid = L;
    { const int q = nwg / 8, r = nwg % 8, xcd = wgid % 8, off = wgid / 8; wgid = (xcd < r ? xcd * (q + 1) : r * (q + 1) + (xcd - r) * q) + off; }
    const int nig = 8 * nN, gid = wgid / nig, fm = gid * 8, gsz = (nM - fm) < 8 ? (nM - fm) : 8;
    pm = fm + ((wgid % nig) % gsz); pn = (wgid % nig) / gsz;
}

template <class P>
__device__ __forceinline__ void gemm_phase(LAS unsigned char* lds, const P& p, const int wv_) {
    const int tid = otid(wv_), wid = __builtin_amdgcn_readfirstlane(tid >> 6), lane = tid & 63, wr = wid >> 2, wc = wid & 3, fr = lane & 15, fq = lane >> 4;
    unsigned voffA[2], voffB[2];
#pragma unroll
    for (int i = 0; i < 2; ++i) { int R, C; stage_rc(tid * 16 + i * 8192, R, C); const int Rb = P::PERM ? ((R & ~31) + perm32(R & 31)) : R;
        voffA[i] = (unsigned)(R * p.lda + C) * 2u; voffB[i] = (unsigned)(Rb * p.ldb + C) * 2u; }
    const size_t kstep = (size_t)(BK * 2);
    const size_t hA = (size_t)HALF * p.lda * 2, hB = (size_t)HALF * p.ldb * 2;
    const unsigned ldsw = (unsigned)wid * 1024u;
    const int aoff = lds_byte(wr * 64 + fr, fq * 8), boff = lds_byte(wc * 32 + fr, fq * 8);
#define PG8_SA(b, h) (((b) * 2 + (h)) * HTB)
#define PG8_SB(b, h) ((4 + (b) * 2 + (h)) * HTB)
#define PG8_STAGE(bufoff, gbase, voff) do { _Pragma("unroll") for (int _i = 0; _i < 2; ++_i) \
        __builtin_amdgcn_global_load_lds((const unsigned*)((const char*)(gbase) + (voff)[_i]), (LAS unsigned*)(lds + (bufoff) + ldsw + _i * 8192), 16, 0, 0); } while (0)
#define PG8_LDA(dst, b, h) do { _Pragma("unroll") for (int m = 0; m < 4; ++m) _Pragma("unroll") for (int k = 0; k < 2; ++k) dst[m][k] = *(const LAS bf16x8*)(lds + PG8_SA(b, h) + aoff + m * 2048 + k * 1024); } while (0)
#define PG8_LDB(dst, b, h) do { _Pragma("unroll") for (int n = 0; n < 2; ++n) _Pragma("unroll") for (int k = 0; k < 2; ++k) dst[n][k] = *(const LAS bf16x8*)(lds + PG8_SB(b, h) + boff + n * 2048 + k * 1024); } while (0)
#define PG8_MMA(ai, bj, At, Bt) do { __builtin_amdgcn_s_setprio(1); _Pragma("unroll") for (int m = 0; m < 4; ++m) _Pragma("unroll") for (int n = 0; n < 2; ++n) _Pragma("unroll") for (int k = 0; k < 2; ++k) \
        acc[ai][bj][m][n] = __builtin_amdgcn_mfma_f32_16x16x32_bf16(Bt[n][k], At[m][k], acc[ai][bj][m][n], 0, 0, 0); __builtin_amdgcn_s_setprio(0); } while (0)
#define PG8_WAIT_V(n) asm volatile("s_waitcnt vmcnt(" #n ")" ::: "memory")
#define PG8_WAIT_L(n) asm volatile("s_waitcnt lgkmcnt(" #n ")" ::: "memory")
#define PG8_BAR __builtin_amdgcn_s_barrier()
#define PG8_SCHED __builtin_amdgcn_sched_barrier(0)
    Unit cur, nxt; int ui = 0;
    if (!p.next(0, cur)) return;
    f32x4 acc[2][2][4][2];
#pragma unroll
    for (int a = 0; a < 2; ++a)
#pragma unroll
        for (int b = 0; b < 2; ++b)
#pragma unroll
            for (int m = 0; m < 4; ++m)
#pragma unroll
                for (int n = 0; n < 2; ++n) acc[a][b][m][n] = (f32x4){0.f, 0.f, 0.f, 0.f};
    bf16x8 At[4][2], B0[2][2], B1[2][2];
    const char* cA = p.aptr(cur); const char* cB = p.bptr(cur);
    PG8_STAGE(PG8_SB(0, 0), cB, voffB); PG8_STAGE(PG8_SA(0, 0), cA, voffA); PG8_STAGE(PG8_SB(0, 1), cB + hB, voffB); PG8_STAGE(PG8_SA(0, 1), cA + hA, voffA);
    if (wr == 1) PG8_BAR;
    PG8_WAIT_V(4); PG8_BAR;
    PG8_STAGE(PG8_SB(1, 0), cB + kstep, voffB); PG8_STAGE(PG8_SA(1, 0), cA + kstep, voffA); PG8_STAGE(PG8_SB(1, 1), cB + hB + kstep, voffB);
    PG8_WAIT_V(6); PG8_BAR;
    for (;;) {
        const bool has_next = p.next(ui + 1, nxt);
        const int nt = p.nt(cur);
        const char* nA = has_next ? p.aptr(nxt) : cA; const char* nB = has_next ? p.bptr(nxt) : cB;
        for (int t = 0; t < nt; t += 2) {
            const bool last = (t == nt - 2);
            const char* a1 = cA + (size_t)(t + 1) * kstep;
            const char* a2 = last ? nA : cA + (size_t)(t + 2) * kstep; const char* b2 = last ? nB : cB + (size_t)(t + 2) * kstep;
            const char* a3 = a2 + kstep; const char* b3 = b2 + kstep;
            PG8_LDB(B0, 0, 0); PG8_SCHED; PG8_LDA(At, 0, 0); PG8_STAGE(PG8_SA(1, 1), a1 + hA, voffA);
            PG8_WAIT_L(8); PG8_BAR; PG8_WAIT_L(0); PG8_MMA(0, 0, At, B0); PG8_BAR; PG8_SCHED;
            PG8_LDB(B1, 0, 1); PG8_STAGE(PG8_SB(0, 0), b2, voffB);
            PG8_BAR; PG8_WAIT_L(0); PG8_MMA(0, 1, At, B1); PG8_BAR;
            PG8_LDA(At, 0, 1); PG8_STAGE(PG8_SA(0, 0), a2, voffA);
            PG8_BAR; PG8_WAIT_L(0); PG8_MMA(1, 0, At, B0); PG8_BAR; PG8_SCHED;
            PG8_STAGE(PG8_SB(0, 1), b2 + hB, voffB);
            PG8_WAIT_V(6); PG8_BAR; PG8_MMA(1, 1, At, B1); PG8_BAR;
            PG8_LDB(B0, 1, 0); PG8_SCHED; PG8_LDA(At, 1, 0); PG8_STAGE(PG8_SA(0, 1), a2 + hA, voffA);
            PG8_WAIT_L(8); PG8_BAR; PG8_WAIT_L(0); PG8_MMA(0, 0, At, B0); PG8_BAR; PG8_SCHED;
            PG8_LDB(B1, 1, 1); PG8_STAGE(PG8_SB(1, 0), b3, voffB);
            PG8_BAR; PG8_WAIT_L(0); PG8_MMA(0, 1, At, B1); PG8_BAR;
            PG8_LDA(At, 1, 1); PG8_STAGE(PG8_SA(1, 0), a3, voffA);
            PG8_BAR; PG8_WAIT_L(0); PG8_MMA(1, 0, At, B0); PG8_BAR; PG8_SCHED;
            PG8_STAGE(PG8_SB(1, 1), b3 + hB, voffB);
            PG8_WAIT_V(6); PG8_BAR; PG8_MMA(1, 1, At, B1); PG8_BAR;
        }
        Unit eu = cur;
        asm volatile("" : "+s"(eu.pm), "+s"(eu.pn), "+s"(eu.z));
        const bool rst = p.epi(acc, eu, wr, wc, fr, fq);
        if (!has_next) break;
        if (rst) {
#pragma unroll
            for (int a = 0; a < 2; ++a)
#pragma unroll
                for (int b = 0; b < 2; ++b)
#pragma unroll
                    for (int m = 0; m < 4; ++m)
#pragma unroll
                        for (int n = 0; n < 2; ++n) acc[a][b][m][n] = (f32x4){0.f, 0.f, 0.f, 0.f};
        }
        cur = nxt; cA = nA; cB = nB; ++ui;
    }
    PG8_WAIT_V(0);
    if (wr == 0) PG8_BAR;
    PG8_BAR;
#undef PG8_SA
#undef PG8_SB
#undef PG8_STAGE
#undef PG8_LDA
#undef PG8_LDB
#undef PG8_MMA
#undef PG8_WAIT_V
#undef PG8_WAIT_L
#undef PG8_BAR
#undef PG8_SCHED
}
typedef f32x4 Acc[2][2][4][2];

struct PG1 {
    __device__ __forceinline__ int nt(const Unit&) const { return K / BK; }
    static constexpr bool PERM = true;
    int K, lda, ldb, G, c;
    const bf16_t* A; const bf16_t* Bt;
    bf16_t* xa; unsigned char* gl8; bf16_t* ya; bf16_t* apack; bf16_t* uss; bf16_t* sb; bf16_t* sh; bf16_t* sc;
    __device__ __forceinline__ bool next(int i, Unit& u) const { const long L = (long)i * G + c; if (L >= 66 * 24) return false; tile_map((int)L, 66, 24, u.pm, u.pn); u.z = 0; return true; }
    __device__ __forceinline__ const char* aptr(const Unit& u) const { return (const char*)A + (size_t)u.pm * 256 * 1024 * 2; }
    __device__ __forceinline__ const char* bptr(const Unit& u) const { return (const char*)Bt + (size_t)u.pn * 256 * 1024 * 2; }
    __device__ __forceinline__ bool epi(Acc& acc, const Unit& u, int wr, int wc, int fr, int fq) const {
        const int pn = u.pn;
        if (pn >= 6 && pn < 10) {
#pragma unroll
            for (int ai = 0; ai < 2; ++ai)
#pragma unroll
                for (int m = 0; m < 4; ++m) { const size_t r = (size_t)u.pm * 256 + ai * 128 + wr * 64 + m * 16 + fr;
                    *(u32x4*)(sc + r * 512 + (pn - 6) * 128 + wc * 32 + 8 * fq) = pack8(acc[ai][0][m][0] * acc[ai][1][m][0], acc[ai][0][m][1] * acc[ai][1][m][1]); }
        } else if (pn < 10) {
            bf16_t* base = (bf16_t*)((unsigned char*)xa + (pn >= 4 ? S17 : pn >= 2 ? (OFF_YA - OFF_R) : (size_t)0));
#pragma unroll
            for (int ai = 0; ai < 2; ++ai)
#pragma unroll
                for (int m = 0; m < 4; ++m) { const size_t r = (size_t)u.pm * 256 + ai * 128 + wr * 64 + m * 16 + fr;
#pragma unroll
                    for (int bj = 0; bj < 2; ++bj) { const int col = (pn & 1) * 256 + bj * 128 + wc * 32 + 8 * fq;
                        *(u32x4*)(base + r * 512 + col) = pack8(acc[ai][bj][m][0], acc[ai][bj][m][1]); } }
        } else if (pn < 12) {
#pragma unroll
            for (int ai = 0; ai < 2; ++ai)
#pragma unroll
                for (int m = 0; m < 4; ++m) { const int r = u.pm * 256 + ai * 128 + wr * 64 + m * 16 + fr;
#pragma unroll
                    for (int bj = 0; bj < 2; ++bj) { const int cc = (pn - 10) * 256 + bj * 128 + wc * 32 + 8 * fq;
                        bf16_t* dst = (u.pm < 64) ? apack + ((size_t)((cc >> 4) * 1024 + (r >> 4)) * 384 + 128 + (r & 15) * 16 + (cc & 15)) : uss + (size_t)(r - MP) * 512 + cc;
                        *(u32x4*)dst = pack8(acc[ai][bj][m][0], acc[ai][bj][m][1]); } }
        } else {
            unsigned char* blk = gl8 + ((size_t)(u.pm * 12 + (pn - 12)) << 16) + (size_t)(((wr * 4 + wc) * 64 + fq * 16 + fr) * 128);
#pragma unroll
            for (int ai = 0; ai < 2; ++ai)
#pragma unroll
                for (int m = 0; m < 4; ++m) { u32x4 w;
#pragma unroll
                    for (int bj = 0; bj < 2; ++bj)
#pragma unroll
                        for (int n = 0; n < 2; ++n) { unsigned pk = 0;
#pragma unroll
                            for (int j = 0; j < 4; ++j) { int v = (int)(sigm(acc[ai][bj][m][n][j]) * 256.0f); v = v < 0 ? 0 : (v > 255 ? 255 : v); pk |= (unsigned)v << (8 * j); }
                            w[bj * 2 + n] = pk; }
                    *(u32x4*)(blk + (ai * 4 + m) * 16) = w; }
        }
        return true;
    }
};

struct PGate {
    __device__ __forceinline__ int nt(const Unit&) const { return K / BK; }
    static constexpr bool PERM = true;
    int K, lda, ldb, G, c;
    const bf16_t* A; const bf16_t* Bt;
    const float *gxb, *gab, *lam; _Float16* aout; bf16_t* bxout;
    __device__ __forceinline__ bool next(int i, Unit& u) const { const long L = (long)i * G + c; if (L >= 66 * 4) return false; tile_map((int)L, 66, 4, u.pm, u.pn); u.z = 0; return true; }
    __device__ __forceinline__ const char* aptr(const Unit& u) const { return (const char*)A + (size_t)u.pm * 256 * 512 * 2 + (size_t)(u.pn >> 1) * 512; }
    __device__ __forceinline__ const char* bptr(const Unit& u) const { return (const char*)Bt + (size_t)u.pn * 256 * 256 * 2; }
    __device__ __forceinline__ bool epi(Acc& acc, const Unit& u, int wr, int wc, int fr, int fq) const {
        typedef _Float16 h8 __attribute__((ext_vector_type(8)));
        const int ch0 = u.pn * 128 + wc * 32 + 8 * fq;
        float bxv[8], bav[8], kk[8];
#pragma unroll
        for (int j = 0; j < 8; ++j) { bxv[j] = gxb[ch0 + j]; bav[j] = gab[ch0 + j]; kk[j] = -8.0f * log1pf(expf(-lam[ch0 + j])); }
#pragma unroll
        for (int ai = 0; ai < 2; ++ai)
#pragma unroll
            for (int m = 0; m < 4; ++m) { const size_t r = (size_t)u.pm * 256 + ai * 128 + wr * 64 + m * 16 + fr;
                float xc[8]; unpack8(*(const u32x4*)(A + r * 512 + ch0), xc);
                h8 lav; f32x4 b0, b1;
#pragma unroll
                for (int j = 0; j < 8; ++j) { const float px = acc[ai][0][m][j >> 2][j & 3], pa = acc[ai][1][m][j >> 2][j & 3];
                    const float gx = sigm(px + bxv[j]), ga = sigm(pa + bav[j]);
                    const float la = kk[j] * ga, av = __expf(la); lav[j] = (_Float16)la;
                    const float bv = __builtin_amdgcn_sqrtf(fmaxf(1.0f - av * av, 0.f)) * gx * xc[j];
                    if (j < 4) b0[j] = bv; else b1[j - 4] = bv; }
                *(h8*)(aout + r * 512 + ch0) = lav;
                *(u32x4*)(bxout + r * 512 + ch0) = pack8(b0, b1); }
        return true;
    }
};

struct PY {
    __device__ __forceinline__ int nt(const Unit&) const { return K / BK; }
    static constexpr bool PERM = true;
    int K, lda, ldb, G, c;
    const bf16_t* apack; const bf16_t* wyt; const float* dvec; bf16_t* zc;
    __device__ __forceinline__ bool next(int i, Unit& u) const { const long L = (long)i * G + c; if (L >= 128) return false; u.pm = (int)L; u.pn = (int)L >> 2; u.z = 0; return true; }
    __device__ __forceinline__ const char* aptr(const Unit& u) const { return (const char*)apack + (size_t)u.pm * 256 * 384 * 2; }
    __device__ __forceinline__ const char* bptr(const Unit& u) const { return (const char*)wyt + (size_t)u.pn * 256 * 384 * 2; }
    __device__ __forceinline__ bool epi(Acc& acc, const Unit& u, int wr, int wc, int fr, int fq) const {
        const int g = u.pn;
#pragma unroll
        for (int bj = 0; bj < 2; ++bj) {
            const int n0 = bj * 128 + wc * 32 + 8 * fq, ti = n0 >> 4, c0 = n0 & 15;
#pragma unroll
            for (int ai = 0; ai < 2; ++ai)
#pragma unroll
                for (int m = 0; m < 4; ++m) { const int rr = (u.pm & 3) * 256 + ai * 128 + wr * 64 + m * 16 + fr;
                    f32x4 y0, y1;
#pragma unroll
                    for (int j = 0; j < 4; ++j) { y0[j] = gelu_t(acc[ai][bj][m][0][j]); y1[j] = gelu_t(acc[ai][bj][m][1][j]); }
                    const size_t tok = (size_t)(rr >> 7) * 2048 + (rr & 127) * 16 + ti;
                    *(u32x4*)(zc + tok * 512 + g * 16 + c0) = pack8(y0, y1); }
        }
        return true;
    }
};

struct PGlu {
    __device__ __forceinline__ int nt(const Unit&) const { return K / BK; }
    static constexpr bool PERM = true;
    int K, lda, ldb, G, c, sample;
    const bf16_t* A; const bf16_t* As; const bf16_t* Bt; const float* bias; bf16_t* out;
    __device__ __forceinline__ bool next(int i, Unit& u) const {
        if (sample) { const int j = c - 128; if (i != 0 || j < 0 || j >= 4) return false; u.pm = 64 + (j >> 1); u.pn = j & 1; u.z = 0; return true; }
        const long L = (long)i * G + c; if (L >= 64 * 2) return false; tile_map((int)L, 64, 2, u.pm, u.pn); u.z = 0; return true; }
    __device__ __forceinline__ const bf16_t* arow0(const Unit& u) const { return u.pm < 64 ? A + (size_t)u.pm * 256 * 512 : As + (size_t)(u.pm - 64) * 256 * 512; }
    __device__ __forceinline__ const char* aptr(const Unit& u) const { return (const char*)arow0(u); }
    __device__ __forceinline__ const char* bptr(const Unit& u) const { return (const char*)Bt + (size_t)u.pn * 256 * 512 * 2; }
    __device__ __forceinline__ bool epi(Acc& acc, const Unit& u, int wr, int wc, int fr, int fq) const {
        const bf16_t* zsrc = arow0(u);
#pragma unroll
        for (int bj = 0; bj < 2; ++bj) {
            const int col = u.pn * 256 + bj * 128 + wc * 32 + 8 * fq;
            const f32x4 b0 = *(const f32x4*)(bias + col), b1 = *(const f32x4*)(bias + col + 4);
#pragma unroll
            for (int ai = 0; ai < 2; ++ai)
#pragma unroll
                for (int m = 0; m < 4; ++m) { const int rl = ai * 128 + wr * 64 + m * 16 + fr; const size_t r = (size_t)u.pm * 256 + rl;
                    const u32x4 zw = *(const u32x4*)(zsrc + (size_t)rl * 512 + col); float zf[8]; unpack8(zw, zf);
                    f32x4 y0, y1;
#pragma unroll
                    for (int j = 0; j < 4; ++j) { y0[j] = zf[j] * sigm(acc[ai][bj][m][0][j] + b0[j]); y1[j] = zf[4 + j] * sigm(acc[ai][bj][m][1][j] + b1[j]); }
                    *(u32x4*)(out + r * 512 + col) = pack8(y0, y1); }
        }
        return true;
    }
};

template <bool SAMPLE> struct PMergeT {
    __device__ __forceinline__ int nt(const Unit&) const { return K / BK; }
    static constexpr bool PERM = true;
    int K, lda, ldb, G, c;
    const bf16_t* a0; const bf16_t* wp; const unsigned char* gl8; bf16_t* mb; float* pm3;
    __device__ __forceinline__ bool next(int i, Unit& u) const { const int ti = i / 3;
        if (SAMPLE) { const int j = c - (G - 24); if (i != 0 || j < 0) return false; const int t = j / 3; u.pm = 64 + (t >> 2); u.pn = t & 3; u.z = j - t * 3; return true; }
        const long L = (long)ti * G + c; if (L >= 64 * 4) return false; tile_map((int)L, 64, 4, u.pm, u.pn); u.z = i - ti * 3; return true; }
    __device__ __forceinline__ const char* aptr(const Unit& u) const { const size_t off = (u.z == 2) ? (OFF_XB + S17 - OFF_R) : (size_t)u.z * S17; return (const char*)a0 + off + (size_t)u.pm * 256 * 512 * 2; }
    __device__ __forceinline__ const char* bptr(const Unit& u) const { return (const char*)wp + ((size_t)u.z * 1024 + (size_t)u.pn * 256) * 512 * 2; }
    __device__ __forceinline__ bool epi(Acc& acc, const Unit& u, int wr, int wc, int fr, int fq) const {
        const int br = u.z;
        const unsigned char* blk = gl8 + ((size_t)(u.pm * 12 + br * 4 + u.pn) << 16) + (size_t)(((wr * 4 + wc) * 64 + fq * 16 + fr) * 128);
#pragma unroll
        for (int ai = 0; ai < 2; ++ai)
#pragma unroll
            for (int m = 0; m < 4; ++m) { const size_t r = (size_t)u.pm * 256 + ai * 128 + wr * 64 + m * 16 + fr;
                const u32x4 qc = *(const u32x4*)(blk + (ai * 4 + m) * 16);
                if (SAMPLE) {
#pragma unroll
                    for (int bj = 0; bj < 2; ++bj) { const int col = u.pn * 256 + bj * 128 + wc * 32 + 8 * fq;
                        f32x4 y0, y1;
#pragma unroll
                        for (int j = 0; j < 4; ++j) {
                            y0[j] = acc[ai][bj][m][0][j] * (((float)((qc[bj * 2] >> (8 * j)) & 255u) + 0.5f) * (1.0f / 256.0f));
                            y1[j] = acc[ai][bj][m][1][j] * (((float)((qc[bj * 2 + 1] >> (8 * j)) & 255u) + 0.5f) * (1.0f / 256.0f)); }
                        float* pp = pm3 + (size_t)br * PART_STRIDE + (r - MP) * 1024 + col; *(f32x4*)pp = y0; *(f32x4*)(pp + 4) = y1; }
                } else if (br < 2) {
                    const u32x4 qn = *(const u32x4*)(blk + 4 * 65536 + (ai * 4 + m) * 16);
#pragma unroll
                    for (int bj = 0; bj < 2; ++bj)
#pragma unroll
                        for (int n = 0; n < 2; ++n)
#pragma unroll
                            for (int j = 0; j < 4; ++j) { const float gc = (float)((qc[bj * 2 + n] >> (8 * j)) & 255u) + 0.5f, gn = (float)((qn[bj * 2 + n] >> (8 * j)) & 255u) + 0.5f;
                                acc[ai][bj][m][n][j] *= gc * __builtin_amdgcn_rcpf(gn); }
                } else {
#pragma unroll
                    for (int bj = 0; bj < 2; ++bj) { const int col = u.pn * 256 + bj * 128 + wc * 32 + 8 * fq;
                        f32x4 y0, y1;
#pragma unroll
                        for (int j = 0; j < 4; ++j) {
                            y0[j] = acc[ai][bj][m][0][j] * (((float)((qc[bj * 2] >> (8 * j)) & 255u) + 0.5f) * (1.0f / 256.0f));
                            y1[j] = acc[ai][bj][m][1][j] * (((float)((qc[bj * 2 + 1] >> (8 * j)) & 255u) + 0.5f) * (1.0f / 256.0f)); }
                        *(u32x4*)(mb + r * 1024 + col) = pack8(y0, y1); }
                } }
        return SAMPLE || br == 2;
    }
};

struct PWout {
    static constexpr bool PERM = true;
    int K, lda, ldb, G, c;
    const bf16_t* A; const bf16_t* Bt; bf16_t* T; float* R; float* part;
    __device__ __forceinline__ int nt(const Unit& u) const { return u.z < 0 ? 16 : 4; }
    __device__ __forceinline__ bool next(int i, Unit& u) const {
        const int nP = c < 256 ? (256 - c + G - 1) / G : 0;
        if (i < nP) { tile_map(i * G + c, 64, 4, u.pm, u.pn); u.z = -1; return true; }
        const int j = (i - nP) * G + c; if (j >= 32) return false;
        u.pm = 64 + (j >> 4); u.pn = (j >> 2) & 3; u.z = j & 3; return true; }
    __device__ __forceinline__ const char* aptr(const Unit& u) const { return (const char*)A + (size_t)u.pm * 256 * 1024 * 2 + (u.z < 0 ? 0 : u.z * 512); }
    __device__ __forceinline__ const char* bptr(const Unit& u) const { return (const char*)Bt + (size_t)u.pn * 256 * 1024 * 2 + (u.z < 0 ? 0 : u.z * 512); }
    __device__ __forceinline__ bool epi(Acc& acc, const Unit& u, int wr, int wc, int fr, int fq) const {
#pragma unroll
        for (int ai = 0; ai < 2; ++ai)
#pragma unroll
            for (int m = 0; m < 4; ++m) { const size_t r = (size_t)u.pm * 256 + ai * 128 + wr * 64 + m * 16 + fr;
#pragma unroll
                for (int bj = 0; bj < 2; ++bj) { const int col = u.pn * 256 + bj * 128 + wc * 32 + 8 * fq;
                    if (u.z < 0) *(u32x4*)(T + r * 1024 + col) = pack8(acc[ai][bj][m][0], acc[ai][bj][m][1]);
                    else { float* pp = (u.z == 0) ? R + r * 1024 + col : part + (size_t)(u.z - 1) * PART_STRIDE + (r - MP) * 1024 + col;
                        *(f32x4*)pp = acc[ai][bj][m][0]; *(f32x4*)(pp + 4) = acc[ai][bj][m][1]; } } }
        return true;
    }
};

struct PUp {
    __device__ __forceinline__ int nt(const Unit&) const { return K / BK; }
    static constexpr bool PERM = true;
    int K, lda, ldb, G, c;
    const bf16_t* A; const bf16_t* Bt; bf16_t* h;
    __device__ __forceinline__ bool next(int i, Unit& u) const { const long L = (long)i * G + c; if (L >= 66 * 16) return false; tile_map((int)L, 66, 16, u.pm, u.pn); u.z = 0; return true; }
    __device__ __forceinline__ const char* aptr(const Unit& u) const { return (const char*)A + (size_t)u.pm * 256 * 1024 * 2; }
    __device__ __forceinline__ const char* bptr(const Unit& u) const { return (const char*)Bt + (size_t)u.pn * 256 * 1024 * 2; }
    __device__ __forceinline__ bool epi(Acc& acc, const Unit& u, int wr, int wc, int fr, int fq) const {
#pragma unroll
        for (int ai = 0; ai < 2; ++ai)
#pragma unroll
            for (int m = 0; m < 4; ++m) { const size_t r = (size_t)u.pm * 256 + ai * 128 + wr * 64 + m * 16 + fr;
#pragma unroll
                for (int bj = 0; bj < 2; ++bj) { const int col = u.pn * 256 + bj * 128 + wc * 32 + 8 * fq;
                    f32x4 y0, y1;
#pragma unroll
                    for (int j = 0; j < 4; ++j) { const float v0 = fmaxf(acc[ai][bj][m][0][j], 0.f), v1 = fmaxf(acc[ai][bj][m][1][j], 0.f); y0[j] = v0 * v0; y1[j] = v1 * v1; }
                    *(u32x4*)(h + r * 4096 + col) = pack8(y0, y1); } }
        return true;
    }
};

struct PDown {
    static constexpr bool PERM = true;
    int K, lda, ldb, G, c;
    const bf16_t* A; const bf16_t* Bt; bf16_t* T; float* R; float* part;
    __device__ __forceinline__ int nt(const Unit& u) const { return u.z < 0 ? 64 : 16; }
    __device__ __forceinline__ bool next(int i, Unit& u) const {
        const int nP = c < 256 ? (256 - c + G - 1) / G : 0;
        if (i < nP) { tile_map(i * G + c, 64, 4, u.pm, u.pn); u.z = -1; return true; }
        const int j = (i - nP) * G + c; if (j >= 32) return false;
        u.pm = 64 + (j >> 4); u.pn = (j >> 2) & 3; u.z = j & 3; return true; }
    __device__ __forceinline__ const char* aptr(const Unit& u) const { return (const char*)A + (size_t)u.pm * 256 * 4096 * 2 + (u.z < 0 ? 0 : u.z * 2048); }
    __device__ __forceinline__ const char* bptr(const Unit& u) const { return (const char*)Bt + (size_t)u.pn * 256 * 4096 * 2 + (u.z < 0 ? 0 : u.z * 2048); }
    __device__ __forceinline__ bool epi(Acc& acc, const Unit& u, int wr, int wc, int fr, int fq) const {
#pragma unroll
        for (int ai = 0; ai < 2; ++ai)
#pragma unroll
            for (int m = 0; m < 4; ++m) { const size_t r = (size_t)u.pm * 256 + ai * 128 + wr * 64 + m * 16 + fr;
#pragma unroll
                for (int bj = 0; bj < 2; ++bj) { const int col = u.pn * 256 + bj * 128 + wc * 32 + 8 * fq;
                    if (u.z < 0) *(u32x4*)(T + r * 1024 + col) = pack8(acc[ai][bj][m][0], acc[ai][bj][m][1]);
                    else { float* pp = (u.z == 0) ? R + r * 1024 + col : part + (size_t)(u.z - 1) * PART_STRIDE + (r - MP) * 1024 + col;
                        *(f32x4*)pp = acc[ai][bj][m][0]; *(f32x4*)(pp + 4) = acc[ai][bj][m][1]; } } }
        return true;
    }
};

__device__ __forceinline__ void tdec(AP a, int layer, int t, const float*& W, bf16_t*& Wt, int& K, int& N, int& tk, int& tn4, int& c0, int& c1, int& c2, int& c3) {
    unsigned char* ws = a->ws; int tt;
    if (t < 384) { tt = t; W = a->in[I_WIN] + (size_t)layer * 1024 * 6144; Wt = (bf16_t*)(ws + OFF_WIN); K = 1024; N = 6144; }
    else if (t < 480) { const int q = (t - 384) / 32; tt = (t - 384) % 32; W = a->in[I_PA + q] + (size_t)layer * 512 * 1024; Wt = (bf16_t*)(ws + OFF_WP) + (size_t)q * 1024 * 512; K = 512; N = 1024; }
    else if (t < 496) { tt = t - 480; W = a->in[I_GLW] + (size_t)layer * 512 * 512; Wt = (bf16_t*)(ws + OFF_WGLU); K = 512; N = 512; }
    else if (t < 560) { tt = t - 496; W = a->in[I_WO] + (size_t)layer * 1024 * 1024; Wt = (bf16_t*)(ws + OFF_WOUT); K = 1024; N = 1024; }
    else if (t < 816) { tt = t - 560; W = a->in[I_UP] + (size_t)layer * 1024 * 4096; Wt = (bf16_t*)(ws + OFF_WUP); K = 1024; N = 4096; }
    else { tt = t - 816; W = a->in[I_DN] + (size_t)layer * 4096 * 1024; Wt = (bf16_t*)(ws + OFF_WDOWN); K = 4096; N = 1024; }
    const int ntn = N / 256; tk = tt / ntn; tn4 = tt % ntn;
    c0 = tn4 * 256; c2 = c0 + 128;
    if (t < 384 && tn4 >= 6 && tn4 < 10) { c0 = 1536 + 128 * (tn4 - 6); c2 = 2048 + 128 * (tn4 - 6); }
    c1 = c0 + 64; c3 = c2 + 64;
}
__device__ __forceinline__ void tload(const float* W, int N, int tk, int c0, int c1, int c2, int c3, int tid, f32x4 (&v)[4][2]) {
    const int r = tid >> 3, c8 = (tid & 7) * 8; const float* src = W + (size_t)(tk * 64 + r) * N + c8;
    v[0][0] = *(const f32x4*)(src + c0); v[0][1] = *(const f32x4*)(src + c0 + 4); v[1][0] = *(const f32x4*)(src + c1); v[1][1] = *(const f32x4*)(src + c1 + 4);
    v[2][0] = *(const f32x4*)(src + c2); v[2][1] = *(const f32x4*)(src + c2 + 4); v[3][0] = *(const f32x4*)(src + c3); v[3][1] = *(const f32x4*)(src + c3 + 4);
}

__device__ __forceinline__ void abar_pow(const float* are, const float* aim, const float* ldt, int sp, float e, float& pr, float& pi) {
    const float step = expf(ldt[sp]); const float x = e * step * are[sp], th = e * step * aim[sp];
    float s, c; sincosf(th, &s, &c); const float mg = expf(x); pr = mg * c; pi = mg * s;
}
__device__ __forceinline__ void ssm_coef(const float* are, const float* aim, const float* ldt, int sp, float& cr, float& ci) {
    const float step = expf(ldt[sp]); const float ar = are[sp], ai = aim[sp];
    const float x = step * ar, th = step * ai;
    float s, c; sincosf(th, &s, &c); const float em1 = expm1f(x); const float sh = sinf(0.5f * th);
    const float nr = em1 * c - 2.0f * sh * sh, ni = (em1 + 1.0f) * s;
    const float den = ar * ar + ai * ai;
    cr = (nr * ar + ni * ai) / den; ci = (ni * ar - nr * ai) / den;
}

__device__ __forceinline__ void prep_layer(AP a, int layer, float* sm, const int wv_) {
    unsigned char* ws = a->ws;
    const int G = gridDim.x;
    {
        const int tid = otid(wv_), r = tid >> 3, c8 = (tid & 7) * 8, n = tid >> 3, k8 = (tid & 7) * 8;
        int t = blockIdx.x; f32x4 v[4][2];
        const float* W = nullptr; bf16_t* Wt = nullptr; int K = 0, N = 0, tk = 0, tn4 = 0, c0 = 0, c1 = 0, c2 = 0, c3 = 0;
        if (t < 1072) { tdec(a, layer, t, W, Wt, K, N, tk, tn4, c0, c1, c2, c3); tload(W, N, tk, c0, c1, c2, c3, tid, v); }
        while (t < 1072) {
#pragma unroll
            for (int q = 0; q < 4; ++q)
#pragma unroll
                for (int e = 0; e < 4; ++e) { sm[q * 4160 + r * 65 + c8 + e] = v[q][0][e]; sm[q * 4160 + r * 65 + c8 + 4 + e] = v[q][1][e]; }
            __syncthreads();
            bf16_t* const cWt = Wt; const int cK = K, ctk = tk, ctn4 = tn4; const int tn = t + G;
            if (tn < 1072) { tdec(a, layer, tn, W, Wt, K, N, tk, tn4, c0, c1, c2, c3); tload(W, N, tk, c0, c1, c2, c3, tid, v); }
#pragma unroll
            for (int q = 0; q < 4; ++q) { const float* tt = sm + q * 4160;
                u32x4 w;
                w.x = cvt_pk_bf16(tt[(k8 + 0) * 65 + n], tt[(k8 + 1) * 65 + n]); w.y = cvt_pk_bf16(tt[(k8 + 2) * 65 + n], tt[(k8 + 3) * 65 + n]);
                w.z = cvt_pk_bf16(tt[(k8 + 4) * 65 + n], tt[(k8 + 5) * 65 + n]); w.w = cvt_pk_bf16(tt[(k8 + 6) * 65 + n], tt[(k8 + 7) * 65 + n]);
                *(u32x4*)(cWt + (size_t)(ctn4 * 256 + q * 64 + n) * cK + ctk * 64 + k8) = w; }
            __syncthreads();
            t = tn;
        }
    }
    const int GT = G * NTHR;
    {
        bf16_t* wg = (bf16_t*)(ws + OFF_WGATE);
        for (int idx = blockIdx.x * NTHR + otid(wv_); idx < 1024 * 32; idx += GT) {
            const int n = idx >> 5, k0 = (idx & 31) * 8; const int pn = n >> 8, bj = (n >> 7) & 1, ch = pn * 128 + (n & 127), hd = ch >> 6, j = ch & 63;
            u32x4 w = (u32x4){0u, 0u, 0u, 0u};
            if ((pn >> 1) * 4 + (k0 >> 6) == hd) { const float* src = a->in[bj ? I_GAW : I_GXW] + (size_t)layer * 8 * 64 * 64 + (size_t)hd * 4096 + (size_t)(k0 & 63) * 64 + j;
                w.x = cvt_pk_bf16(src[0], src[64]); w.y = cvt_pk_bf16(src[128], src[192]); w.z = cvt_pk_bf16(src[256], src[320]); w.w = cvt_pk_bf16(src[384], src[448]); }
            *(u32x4*)(wg + (size_t)n * 256 + k0) = w;
        }
    }
    const float* are = a->in[I_SAR] + layer * 2048; const float* aim = a->in[I_SAI] + layer * 2048; const float* ldt = a->in[I_SDT] + layer * 2048;
    const float* bre = a->in[I_SBR] + layer * 32768; const float* bim = a->in[I_SBI] + layer * 32768;
    const float* cre = a->in[I_SCR] + layer * 32768; const float* cim = a->in[I_SCI] + layer * 32768;
    {
        bf16_t* w1 = (bf16_t*)(ws + OFF_W1T);
        for (int idx = blockIdx.x * NTHR + otid(wv_); idx < 32 * 128 * 32; idx += GT) {
            const int g = idx >> 12, n = (idx >> 5) & 127, k0 = (idx & 31) * 8, j = k0 >> 4, c0 = k0 & 15, p = n & 63, part = n >> 6, sp = g * 64 + p;
            float pr, pi, cr, ci; abar_pow(are, aim, ldt, sp, (float)(15 - j), pr, pi); ssm_coef(are, aim, ldt, sp, cr, ci);
            const float qr = pr * cr - pi * ci, qi = pr * ci + pi * cr;
            float o[8];
#pragma unroll
            for (int q = 0; q < 8; ++q) { const float br = bre[sp * 16 + c0 + q], bi = bim[sp * 16 + c0 + q]; o[q] = part ? (qr * bi + qi * br) : (qr * br - qi * bi); }
            u32x4 w; w.x = cvt_pk_bf16(o[0], o[1]); w.y = cvt_pk_bf16(o[2], o[3]); w.z = cvt_pk_bf16(o[4], o[5]); w.w = cvt_pk_bf16(o[6], o[7]);
            *(u32x4*)(w1 + ((size_t)(g * 128 + n) * 256 + k0)) = w;
        }
    }
    {
        bf16_t* wy = (bf16_t*)(ws + OFF_WYT);
        for (int idx = blockIdx.x * NTHR + otid(wv_); idx < 32 * 256 * 16; idx += GT) {
            const int g = idx >> 12, n = (idx >> 4) & 255, k0 = (idx & 15) * 8, i = n >> 4, c = n & 15, part = k0 >> 6, p0 = k0 & 63;
            float o[8];
#pragma unroll
            for (int q = 0; q < 8; ++q) { const int p = p0 + q, sp = g * 64 + p; float pr, pi; abar_pow(are, aim, ldt, sp, (float)(i + 1), pr, pi);
                const float xr = cre[(g * 16 + c) * 64 + p], xi = cim[(g * 16 + c) * 64 + p];
                o[q] = part ? -(xr * pi + xi * pr) : (xr * pr - xi * pi); }
            u32x4 w; w.x = cvt_pk_bf16(o[0], o[1]); w.y = cvt_pk_bf16(o[2], o[3]); w.z = cvt_pk_bf16(o[4], o[5]); w.w = cvt_pk_bf16(o[6], o[7]);
            *(u32x4*)(wy + ((size_t)(g * 256 + n) * 384 + k0)) = w;
        }
        for (int idx = blockIdx.x * NTHR + otid(wv_); idx < 32 * 256 * 4; idx += GT) {
            const int pq = idx & 3, c2 = (idx >> 2) & 15, c = (idx >> 6) & 15, g = idx >> 10;
            float km[16];
#pragma unroll
            for (int d = 0; d < 16; ++d) km[d] = 0.f;
            for (int pp = 0; pp < 16; ++pp) { const int p = pq * 16 + pp, sp = g * 64 + p; float ar, ai, cr, ci; abar_pow(are, aim, ldt, sp, 1.0f, ar, ai); ssm_coef(are, aim, ldt, sp, cr, ci);
                const float br = bre[sp * 16 + c2], bi = bim[sp * 16 + c2];
                const float bbr = cr * br - ci * bi, bbi = cr * bi + ci * br;
                const float xr = cre[(g * 16 + c) * 64 + p], xi = cim[(g * 16 + c) * 64 + p];
                float tr = xr * bbr - xi * bbi, ti = xr * bbi + xi * bbr;
#pragma unroll
                for (int d = 0; d < 16; ++d) { km[d] += tr; const float nr = tr * ar - ti * ai, ni = tr * ai + ti * ar; tr = nr; ti = ni; } }
            { const int ln = idx & 63;
#pragma unroll
            for (int d = 0; d < 16; ++d) { km[d] += shx(km[d], 1, ln); km[d] += shx(km[d], 2, ln); } }
            if (c == c2) km[0] += a->in[I_SD][layer * 512 + g * 16 + c];
#pragma unroll
            for (int d = 0; d < 16; ++d) if ((d & 3) == pq) { const bf16_t kb = f2bf(km[d]);
                for (int i = d; i < 16; ++i) wy[(size_t)(g * 256 + i * 16 + c) * 384 + 128 + (i - d) * 16 + c2] = kb;
                if (d > 0) for (int i = 0; i < 16 - d; ++i) wy[(size_t)(g * 256 + i * 16 + c) * 384 + 128 + (i + d) * 16 + c2] = (bf16_t)0; }
        }
    }
}

__device__ __forceinline__ void prep_x(AP a, const int wv_) {
    bf16_t* xb = (bf16_t*)(a->ws + OFF_XB);
    const int gt = blockIdx.x * NTHR + otid(wv_), GT = gridDim.x * NTHR;
    for (int idx = gt; idx < M * 128; idx += GT) {
        const size_t e = (size_t)idx * 8; const float* src = e < (size_t)MP * 1024 ? a->in[I_XP] + e : a->in[I_XS] + (e - (size_t)MP * 1024);
        const f32x4 v0 = *(const f32x4*)src, v1 = *(const f32x4*)(src + 4);
        *(u32x4*)(xb + e) = pack8(v0, v1);
    }
}

__device__ __forceinline__ void conv_phase(AP a, int layer, bf16_t* bin_out, const int wv_) {
    unsigned char* ws = a->ws;
    const bf16_t* xa = (const bf16_t*)(ws + OFF_R); bf16_t* sb = (bf16_t*)(ws + OFF_R + S17);
    const bf16_t* sc = (const bf16_t*)(ws + OFF_R + 2 * S17);
    bf16_t* xac = (bf16_t*)(ws + OFF_XB);
    const float* caw = a->in[I_CAW] + layer * 4 * 512; const float* cab = a->in[I_CAB] + layer * 512; const float* cbw = a->in[I_CBW] + layer * 3 * 512;
    const int gt = blockIdx.x * NTHR + otid(wv_), GT = gridDim.x * NTHR;
#pragma unroll 1
    for (int pass = 0; pass < 2; ++pass) {
        int idx;
        if (pass == 0) { idx = gt; if (idx >= 2048 * 64) continue; }
        else { const int j = gt - (GT >> 1); if (j < 0 || j >= 128 * 64) continue; idx = 2048 * 64 + j; }
        const int seg = idx >> 6, c0 = (idx & 63) * 8;
        const bool prompt = seg < 2048;
        int row0, nrows;
        float x0[8], x1[8], x2[8], u1[8], u2[8];
        if (prompt) { row0 = seg * 8; nrows = 8; const bool first = (seg & 255) == 0;
            if (first) {
#pragma unroll
                for (int j = 0; j < 8; ++j) { x0[j] = 0.f; x1[j] = 0.f; x2[j] = 0.f; u1[j] = 0.f; u2[j] = 0.f; }
            } else {
                unpack8(*(const u32x4*)(xa + (size_t)(row0 - 3) * 512 + c0), x0); unpack8(*(const u32x4*)(xa + (size_t)(row0 - 2) * 512 + c0), x1); unpack8(*(const u32x4*)(xa + (size_t)(row0 - 1) * 512 + c0), x2);
                unpack8(*(const u32x4*)(sc + (size_t)(row0 - 2) * 512 + c0), u1);
                unpack8(*(const u32x4*)(sc + (size_t)(row0 - 1) * 512 + c0), u2);
            }
        } else { const int b = seg - 2048; row0 = MP + b * 4; nrows = 4;
            const float* lc = a->in[I_SLC] + ((size_t)(layer * 128 + b) * 3) * 512 + c0; const float* scs = a->in[I_SSC] + ((size_t)(layer * 128 + b) * 2) * 512 + c0;
#pragma unroll
            for (int j = 0; j < 8; ++j) { x0[j] = lc[j]; x1[j] = lc[512 + j]; x2[j] = lc[1024 + j]; u1[j] = scs[j]; u2[j] = scs[512 + j]; }
        }
        float w0[8], w1[8], w2[8], w3[8], wb[8], v0[8], v1[8], v2[8];
#pragma unroll
        for (int j = 0; j < 8; ++j) { w0[j] = caw[c0 + j]; w1[j] = caw[512 + c0 + j]; w2[j] = caw[1024 + c0 + j]; w3[j] = caw[1536 + c0 + j]; wb[j] = cab[c0 + j];
            v0[j] = cbw[c0 + j]; v1[j] = cbw[512 + c0 + j]; v2[j] = cbw[1024 + c0 + j]; }
        for (int t0 = 0; t0 < nrows; t0 += 2) {
            u32x4 lx[2], lc[2], lb[2];
#pragma unroll
            for (int k = 0; k < 2; ++k) { const size_t off = (size_t)(row0 + t0 + k) * 512 + c0;
                lx[k] = *(const u32x4*)(xa + off); lc[k] = *(const u32x4*)(sc + off); lb[k] = *(const u32x4*)(sb + off); }
#pragma unroll
            for (int k = 0; k < 2; ++k) { const size_t off = (size_t)(row0 + t0 + k) * 512 + c0;
                float xv[8], scv[8], sbv[8];
                unpack8(lx[k], xv); unpack8(lc[k], scv); unpack8(lb[k], sbv);
                f32x4 o0, o1, q0, q1;
#pragma unroll
                for (int j = 0; j < 8; ++j) {
                    const float o = w0[j] * x0[j] + w1[j] * x1[j] + w2[j] * x2[j] + w3[j] * xv[j] + wb[j];
                    const float uu = scv[j]; const float cu = v0[j] * u1[j] + v1[j] * u2[j] + v2[j] * uu; const float bi = sbv[j] * cu;
                    if (j < 4) { o0[j] = o; q0[j] = bi; } else { o1[j - 4] = o; q1[j - 4] = bi; }
                    x0[j] = x1[j]; x1[j] = x2[j]; x2[j] = xv[j]; u1[j] = u2[j]; u2[j] = uu;
                }
                *(u32x4*)(xac + off) = pack8(o0, o1);
                *(u32x4*)(bin_out + off) = pack8(q0, q1); }
        }
        if (prompt) { if ((seg & 255) == 255) { const int b = seg >> 8;
                float* o1 = a->out + O_LCP + ((size_t)(layer * 8 + b) * 3) * 512 + c0; float* o2 = a->out + O_SCP + ((size_t)(layer * 8 + b) * 2) * 512 + c0;
#pragma unroll
                for (int j = 0; j < 8; ++j) { o1[j] = x0[j]; o1[512 + j] = x1[j]; o1[1024 + j] = x2[j]; o2[j] = u1[j]; o2[512 + j] = u2[j]; } }
        } else { const int b = seg - 2048;
            float* o1 = a->out + O_LCS + ((size_t)(layer * 128 + b) * 3) * 512 + c0; float* o2 = a->out + O_SCS + ((size_t)(layer * 128 + b) * 2) * 512 + c0;
#pragma unroll
            for (int j = 0; j < 8; ++j) { o1[j] = x0[j]; o1[512 + j] = x1[j]; o1[1024 + j] = x2[j]; o2[j] = u1[j]; o2[512 + j] = u2[j]; }
        }
    }
}

__device__ __forceinline__ void ssm_s_gemm(AP a, const int wv_) {
    const bf16_t* apack = (const bf16_t*)(a->ws + OFF_APACK); const bf16_t* w1 = (const bf16_t*)(a->ws + OFF_W1T); float* S = (float*)(a->ws + OFF_S);
    const int tid_ = otid(wv_); const int lane = tid_ & 63, wv = blockIdx.x * 8 + (tid_ >> 6), NW = gridDim.x * 8;
    const int lr = lane & 15, kq = lane >> 4;
    for (int t = wv; t < 1024; t += NW) {
        const int g = t >> 5, rt = (t >> 1) & 15, ct = t & 1;
        f32x4 acc[4][4];
#pragma unroll
        for (int i = 0; i < 4; ++i)
#pragma unroll
            for (int j = 0; j < 4; ++j) acc[i][j] = (f32x4){0.f, 0.f, 0.f, 0.f};
        const bf16_t* ab = apack + ((size_t)(g * 1024 + rt * 64 + lr) * 384 + 128 + kq * 8);
        const bf16_t* bb = w1 + ((size_t)(g * 128 + ct * 64 + lr) * 256 + kq * 8);
#pragma unroll 2
        for (int ks = 0; ks < 8; ++ks) {
            bf16x8 af[4], bf[4];
#pragma unroll
            for (int i = 0; i < 4; ++i) { af[i] = *(const bf16x8*)(ab + (size_t)i * 16 * 384 + ks * 32); bf[i] = *(const bf16x8*)(bb + (size_t)i * 16 * 256 + ks * 32); }
#pragma unroll
            for (int i = 0; i < 4; ++i)
#pragma unroll
                for (int j = 0; j < 4; ++j) acc[i][j] = __builtin_amdgcn_mfma_f32_16x16x32_bf16(af[i], bf[j], acc[i][j], 0, 0, 0);
        }
#pragma unroll
        for (int i = 0; i < 4; ++i)
#pragma unroll
            for (int j = 0; j < 4; ++j)
#pragma unroll
                for (int q = 0; q < 4; ++q) S[(size_t)(g * 1024 + rt * 64 + i * 16 + kq * 4 + q) * 128 + ct * 64 + j * 16 + lr] = acc[i][j][q];
    }
}

__device__ __forceinline__ void ssm_carry(AP a, int layer, float* sm, const int wv_) {
    bf16_t* apack = (bf16_t*)(a->ws + OFF_APACK); const float* S = (const float*)(a->ws + OFF_S);
    const int tid = otid(wv_), p = tid & 63, seg = tid >> 6;
    for (int pair = blockIdx.x; pair < 256; pair += gridDim.x) {
        const int b = pair >> 5, g = pair & 31, sp = g * 64 + p;
        float ar, ai, Ar, Ai;
        abar_pow(a->in[I_SAR] + layer * 2048, a->in[I_SAI] + layer * 2048, a->in[I_SDT] + layer * 2048, sp, 16.0f, ar, ai);
        abar_pow(a->in[I_SAR] + layer * 2048, a->in[I_SAI] + layer * 2048, a->in[I_SDT] + layer * 2048, sp, 256.0f, Ar, Ai);
        const size_t rbase = (size_t)g * 1024 + b * 128 + seg * 16;
        float sr[16], si[16];
#pragma unroll
        for (int j = 0; j < 16; ++j) { sr[j] = S[(rbase + j) * 128 + p]; si[j] = S[(rbase + j) * 128 + 64 + p]; }
        float hr = 0.f, hi = 0.f;
#pragma unroll
        for (int j = 0; j < 16; ++j) { const float nr = ar * hr - ai * hi + sr[j], ni = ar * hi + ai * hr + si[j]; sr[j] = hr; si[j] = hi; hr = nr; hi = ni; }
        sm[seg * 128 + p] = hr; sm[seg * 128 + 64 + p] = hi;
        __syncthreads();
        float cr = 0.f, ci = 0.f;
        for (int s2 = 0; s2 < seg; ++s2) { const float er = sm[s2 * 128 + p], ei = sm[s2 * 128 + 64 + p]; const float nr = Ar * cr - Ai * ci + er, ni = Ar * ci + Ai * cr + ei; cr = nr; ci = ni; }
        if (seg == 7) { const float fr_ = Ar * cr - Ai * ci + hr, fi_ = Ar * ci + Ai * cr + hi;
            a->out[O_SRP + (size_t)(layer * 8 + b) * 2048 + sp] = fr_; a->out[O_SIP + (size_t)(layer * 8 + b) * 2048 + sp] = fi_; }
#pragma unroll
        for (int j = 0; j < 16; ++j) { apack[(rbase + j) * 384 + p] = f2bf(sr[j] + cr); apack[(rbase + j) * 384 + 64 + p] = f2bf(si[j] + ci);
            const float nr = ar * cr - ai * ci, ni = ar * ci + ai * cr; cr = nr; ci = ni; }
        __syncthreads();
    }
}

__device__ __forceinline__ void ssm_sample(AP a, int layer, int wv, int NW, const int wv_) {
    const bf16_t* uss = (const bf16_t*)(a->ws + OFF_USS); bf16_t* zc = (bf16_t*)(a->ws + OFF_ZCS);
    const float* are = a->in[I_SAR] + layer * 2048; const float* aim = a->in[I_SAI] + layer * 2048; const float* ldt = a->in[I_SDT] + layer * 2048;
    const float* bre = a->in[I_SBR] + layer * 32768; const float* bim = a->in[I_SBI] + layer * 32768;
    const float* cre = a->in[I_SCR] + layer * 32768; const float* cim = a->in[I_SCI] + layer * 32768; const float* dv = a->in[I_SD] + layer * 512;
    const int lane = otid(wv_) & 63;
    for (int t = wv; t < 128 * 32; t += NW) {
        const int b = t >> 5, g = t & 31, sp = g * 64 + lane;
        float ar, ai, cr, ci; abar_pow(are, aim, ldt, sp, 1.0f, ar, ai); ssm_coef(are, aim, ldt, sp, cr, ci);
        float bbr[16], bbi[16], xr[16], xi[16];
#pragma unroll
        for (int c = 0; c < 16; ++c) { const float br = bre[sp * 16 + c], bi = bim[sp * 16 + c]; bbr[c] = cr * br - ci * bi; bbi[c] = cr * bi + ci * br;
            xr[c] = cre[(g * 16 + c) * 64 + lane]; xi[c] = cim[(g * 16 + c) * 64 + lane]; }
        float hr = a->in[I_SSR][(size_t)(layer * 128 + b) * 2048 + sp], hi = a->in[I_SSI][(size_t)(layer * 128 + b) * 2048 + sp];
        const float dme = lane < 16 ? dv[g * 16 + lane] : 0.f;
        for (int tt = 0; tt < 4; ++tt) {
            const bf16_t* up = uss + (size_t)(b * 4 + tt) * 512 + g * 16;
            const u32x4 w0 = *(const u32x4*)up, w1 = *(const u32x4*)(up + 8);
            float u[16]; { float t0[8], t1[8]; unpack8(w0, t0); unpack8(w1, t1);
#pragma unroll
                for (int c = 0; c < 8; ++c) { u[c] = t0[c]; u[8 + c] = t1[c]; } }
            float br_ = 0.f, bi_ = 0.f;
#pragma unroll
            for (int c = 0; c < 16; ++c) { br_ += bbr[c] * u[c]; bi_ += bbi[c] * u[c]; }
            const float nr = ar * hr - ai * hi + br_, ni = ar * hi + ai * hr + bi_; hr = nr; hi = ni;
            float mine = 0.f, ume = 0.f;
#pragma unroll
            for (int c = 0; c < 16; ++c) { float y = xr[c] * hr - xi[c] * hi;
#pragma unroll
                for (int o = 32; o >= 1; o >>= 1) y += shx(y, o, lane);
                if (lane == c) { mine = y; ume = u[c]; } }
            if (lane < 16) zc[(size_t)(b * 4 + tt) * 512 + g * 16 + lane] = f2bf(gelu_t(mine + dme * ume));
        }
        a->out[O_SRS + (size_t)(layer * 128 + b) * 2048 + sp] = hr; a->out[O_SIS + (size_t)(layer * 128 + b) * 2048 + sp] = hi;
    }
}

typedef _Float16 h2_t __attribute__((ext_vector_type(2)));
__device__ __forceinline__ void lru_local(AP a, const int wv_) {
    const _Float16* av = (const _Float16*)(a->ws + OFF_R + 2 * S17); const bf16_t* bx = (const bf16_t*)(a->ws + OFF_R); f32x4* car = (f32x4*)(a->ws + OFF_CAR2);
    const int gt = blockIdx.x * NTHR + otid(wv_), GT = gridDim.x * NTHR;
    for (int idx = gt; idx < 8 * 64 * 256; idx += GT) {
        const int cp = idx & 255, sc = idx >> 8;
        const size_t base = (size_t)sc * 32 * 512 + 2 * cp;
        float P0 = 1.f, h0 = 0.f, P1 = 1.f, h1 = 0.f;
        for (int t0 = 0; t0 < 32; t0 += 16) {
            h2_t al[16]; unsigned bb[16];
#pragma unroll
            for (int j = 0; j < 16; ++j) { al[j] = *(const h2_t*)(av + base + (size_t)(t0 + j) * 512); bb[j] = *(const unsigned*)(bx + base + (size_t)(t0 + j) * 512); }
#pragma unroll
            for (int j = 0; j < 16; ++j) { const float a0 = __expf((float)al[j][0]), a1 = __expf((float)al[j][1]);
                h0 = a0 * h0 + bflo(bb[j]); P0 *= a0; h1 = a1 * h1 + bfhi(bb[j]); P1 *= a1; }
        }
        car[idx] = (f32x4){P0, h0, P1, h1};
    }
}
template <int B>
__device__ __forceinline__ float lru_run(const _Float16* av, const bf16_t* bx, bf16_t* ao, const bf16_t* ya, size_t base, int n, float h) {
    for (int t0 = 0; t0 < n; t0 += B) {
        _Float16 aa[B]; bf16_t bb[B], yy[B];
#pragma unroll
        for (int j = 0; j < B; ++j) { const size_t o = base + (size_t)(t0 + j) * 512; aa[j] = av[o]; bb[j] = bx[o]; yy[j] = ya[o]; }
        bf16_t oo[B];
#pragma unroll
        for (int j = 0; j < B; ++j) { h = __expf((float)aa[j]) * h + bf2f(bb[j]); oo[j] = f2bf(h * gelu_t(bf2f(yy[j]))); }
#pragma unroll
        for (int j = 0; j < B; ++j) ao[base + (size_t)(t0 + j) * 512] = oo[j];
    }
    return h;
}
__device__ __forceinline__ void lru_apply(AP a, int layer, bf16_t* ao, int mode, const int wv_) {
    const _Float16* av = (const _Float16*)(a->ws + OFF_R + 2 * S17); const bf16_t* bx = (const bf16_t*)(a->ws + OFF_R); const f32x2* car = (const f32x2*)(a->ws + OFF_CAR);
    const bf16_t* ya = (const bf16_t*)(a->ws + OFF_YA);
    const int G = gridDim.x, bid = blockIdx.x;
    if (mode == 0) {
        const f32x4* car4 = (const f32x4*)(a->ws + OFF_CAR2);
        for (int idx = bid * NTHR + otid(wv_); idx < 8 * 64 * 256; idx += G * NTHR) {
            const int cp = idx & 255, sc = idx >> 8, seq = sc >> 6, chunk = sc & 63;
            float h0 = 0.f, h1 = 0.f;
            for (int k0 = 0; k0 < 64; k0 += 16) {
                if (k0 < chunk) {
                    f32x4 ph[16];
#pragma unroll
                    for (int k = 0; k < 16; ++k) ph[k] = car4[(seq * 64 + (k0 + k < chunk ? k0 + k : 0)) * 256 + cp];
#pragma unroll
                    for (int k = 0; k < 16; ++k) if (k0 + k < chunk) { h0 = ph[k][0] * h0 + ph[k][1]; h1 = ph[k][2] * h1 + ph[k][3]; }
                }
            }
            const size_t base = (size_t)sc * 32 * 512 + 2 * cp;
            for (int t0 = 0; t0 < 32; t0 += 8) {
                h2_t aa[8]; unsigned bb[8], yy[8], oo[8];
#pragma unroll
                for (int j = 0; j < 8; ++j) { const size_t o = base + (size_t)(t0 + j) * 512; aa[j] = *(const h2_t*)(av + o); bb[j] = *(const unsigned*)(bx + o); yy[j] = *(const unsigned*)(ya + o); }
#pragma unroll
                for (int j = 0; j < 8; ++j) { h0 = __expf((float)aa[j][0]) * h0 + bflo(bb[j]); h1 = __expf((float)aa[j][1]) * h1 + bfhi(bb[j]);
                    oo[j] = cvt_pk_bf16(h0 * gelu_t(bflo(yy[j])), h1 * gelu_t(bfhi(yy[j]))); }
#pragma unroll
                for (int j = 0; j < 8; ++j) *(unsigned*)(ao + base + (size_t)(t0 + j) * 512) = oo[j];
            }
            if (chunk == 63) { float* ho = a->out + O_LHP + (size_t)(layer * 8 + seq) * 512 + 2 * cp; ho[0] = h0; ho[1] = h1; }
        }
    } else {
        for (int j = bid * NTHR + otid(wv_); j < 128 * 512; j += G * NTHR) {
            const int c = j & 511, b = j >> 9;
            float h = a->in[I_SLH][(size_t)(layer * 128 + b) * 512 + c];
            h = lru_run<4>(av, bx, ao, ya, (size_t)(MP + b * 4) * 512 + c, 4, h);
            a->out[O_LHS + (size_t)(layer * 128 + b) * 512 + c] = h;
        }
    }
}

template <bool RES16>
__device__ __forceinline__ void ln_phase(const bf16_t* T, const float* Rs, const float* part, const float* resp, const float* ress, const bf16_t* res16,
                                         float* dst32, bf16_t* dst16, const float* gam, const float* bet, const int wv_) {
    const int tid_ = otid(wv_); const int lane = tid_ & 63, wv = blockIdx.x * 8 + (tid_ >> 6), NW = gridDim.x * 8;
    for (int r0 = wv; r0 < M; r0 += 3 * NW) {
        f32x4 v[3][4];
#pragma unroll
        for (int k = 0; k < 3; ++k) { const int rr = r0 + k * NW; const int r = rr < M ? rr : r0;
            if (r < MP) {
#pragma unroll
                for (int i = 0; i < 4; ++i) { const u32x2 w = *(const u32x2*)(T + (size_t)r * 1024 + i * 256 + lane * 4); v[k][i] = (f32x4){bflo(w.x), bfhi(w.x), bflo(w.y), bfhi(w.y)}; }
            } else {
#pragma unroll
                for (int i = 0; i < 4; ++i) v[k][i] = *(const f32x4*)(Rs + (size_t)r * 1024 + i * 256 + lane * 4);
#pragma unroll
                for (int q = 0; q < 3; ++q)
#pragma unroll
                    for (int i = 0; i < 4; ++i) v[k][i] += *(const f32x4*)(part + (size_t)q * PART_STRIDE + (size_t)(r - MP) * 1024 + i * 256 + lane * 4);
            }
            if (RES16) {
#pragma unroll
                for (int i = 0; i < 4; ++i) { const u32x2 w = *(const u32x2*)(res16 + (size_t)r * 1024 + i * 256 + lane * 4); v[k][i] += (f32x4){bflo(w.x), bfhi(w.x), bflo(w.y), bfhi(w.y)} * ALPHA; }
            } else { const float* rp = r < MP ? resp + (size_t)r * 1024 : ress + (size_t)(r - MP) * 1024;
#pragma unroll
                for (int i = 0; i < 4; ++i) v[k][i] += *(const f32x4*)(rp + i * 256 + lane * 4) * ALPHA;
            } }
#pragma unroll
        for (int k = 0; k < 3; ++k) { const int r = r0 + k * NW;
            float s = 0.f;
#pragma unroll
            for (int i = 0; i < 4; ++i) s += (v[k][i][0] + v[k][i][1]) + (v[k][i][2] + v[k][i][3]);
#pragma unroll
            for (int o = 32; o >= 1; o >>= 1) s += shx(s, o, lane);
            const float mu = s * (1.0f / 1024.0f); float q = 0.f;
#pragma unroll
            for (int i = 0; i < 4; ++i) { const f32x4 d = v[k][i] - mu; q += (d[0] * d[0] + d[1] * d[1]) + (d[2] * d[2] + d[3] * d[3]); }
#pragma unroll
            for (int o = 32; o >= 1; o >>= 1) q += shx(q, o, lane);
            const float rs = rsqrtf(q * (1.0f / 1024.0f) + LN_EPS);
            if (r < M) {
#pragma unroll
                for (int i = 0; i < 4; ++i) { const int col = i * 256 + lane * 4; const f32x4 gg = *(const f32x4*)(gam + col), bb = *(const f32x4*)(bet + col);
                    const f32x4 y = (v[k][i] - mu) * rs * gg + bb;
                    if (dst32) *(f32x4*)(dst32 + (size_t)r * 1024 + col) = y;
                    if (dst16) { u32x2 w; w.x = cvt_pk_bf16(y[0], y[1]); w.y = cvt_pk_bf16(y[2], y[3]);
                        *(u32x2*)(dst16 + (size_t)r * 1024 + col) = w; } }
            }
        }
    }
}

__global__ void __launch_bounds__(NTHR, 2) fwd_megakernel(Args a_unused) {
    extern __shared__ __attribute__((aligned(16))) unsigned char lds_raw[];
    cg::grid_group grid = cg::this_grid();
    LAS unsigned char* lds = (LAS unsigned char*)lds_raw;
    const int G = gridDim.x, bid = blockIdx.x;
    int wv_; { const int tw = (int)threadIdx.x >> 6; asm volatile("v_readfirstlane_b32 %0, %1" : "=s"(wv_) : "v"(tw)); }

    const unsigned long long t_start = PROBE_ON ? __builtin_amdgcn_s_memrealtime() : 0ull;
    for (int rep = 0; rep < REP_PREP; ++rep) { const AP a = ld_args(); prep_layer(a, 0, (float*)lds_raw, wv_); prep_x(a, wv_); }
    int pidx = 1; unsigned long long tA = PROBE_A == 0 ? t_start : 0ull, tB = 0ull;
    if (PROBE_ON) { if (PROBE_A == 1) tA = __builtin_amdgcn_s_memrealtime(); if (PROBE_B == 1) tB = __builtin_amdgcn_s_memrealtime(); }
    unsigned bar_n = 0; { const AP a = ld_args(); if (a->ws == nullptr) grid.sync(); }
    bar_n += (unsigned)G; gbar((unsigned*)(ld_args()->ws + OFF_BAR), bar_n, wv_);

#pragma unroll 1
    for (int layer = 0; layer < 2; ++layer) {
        { const AP a = ld_args(); unsigned char* ws = a->ws;
          PG1 p; p.K = 1024; p.lda = 1024; p.ldb = 1024; p.G = opq(G); p.c = opq(bid); p.A = layer == 0 ? (const bf16_t*)(ws + OFF_XB) : (const bf16_t*)a->out; p.Bt = (const bf16_t*)(ws + OFF_WIN);
          p.xa = (bf16_t*)(ws + OFF_R); p.ya = (bf16_t*)(ws + OFF_YA); p.sb = (bf16_t*)(ws + OFF_R + S17); p.sc = (bf16_t*)(ws + OFF_R + 2 * S17); p.sh = (bf16_t*)(ws + OFF_R + 3 * S17);
          p.apack = (bf16_t*)(ws + OFF_APACK); p.uss = (bf16_t*)(ws + OFF_USS); p.gl8 = ws + OFF_GL8;
          for (int rep = 0; rep < REP_G1; ++rep) gemm_phase(lds, p, wv_); }
        GSYNC();
        if (DRY_CONV) { const AP a = ld_args(); conv_phase(a, layer, (bf16_t*)(a->ws + OFF_XB + S17), wv_); }
        { const AP a = ld_args(); conv_phase(a, layer, (bf16_t*)(a->ws + OFF_R + S17), wv_); }
        for (int rep = 0; rep < REP_SG; ++rep) { const AP a = ld_args(); ssm_s_gemm(a, wv_); }
        GSYNC();
        for (int rep = 0; rep < REP_CARRY; ++rep) { const AP a = ld_args(); ssm_carry(a, layer, (float*)lds_raw, wv_); }
        { const AP a = ld_args(); unsigned char* ws = a->ws;
          PGate p; p.K = 256; p.lda = 512; p.ldb = 256; p.G = opq(G); p.c = opq(bid); p.A = (const bf16_t*)(ws + OFF_XB); p.Bt = (const bf16_t*)(ws + OFF_WGATE);
          p.gxb = a->in[I_GXB] + layer * 512; p.gab = a->in[I_GAB] + layer * 512; p.lam = a->in[I_LAM] + layer * 512;
          p.aout = (_Float16*)(ws + OFF_R + 2 * S17); p.bxout = (bf16_t*)(ws + OFF_R);
          for (int rep = 0; rep < REP_GATE; ++rep) gemm_phase(lds, p, wv_); }
        for (int rep = 0; rep < REP_SAMPLE; ++rep) if (bid >= 8) { const AP a = ld_args(); ssm_sample(a, layer, (bid - 8) * 8 + wv_, (G - 8) * 8, wv_); }
        GSYNC();
        { const AP a = ld_args(); unsigned char* ws = a->ws;
          PY p; p.K = 384; p.lda = 384; p.ldb = 384; p.G = opq(G); p.c = opq(bid); p.apack = (const bf16_t*)(ws + OFF_APACK); p.wyt = (const bf16_t*)(ws + OFF_WYT);
          p.dvec = a->in[I_SD] + layer * 512; p.zc = (bf16_t*)(ws + OFF_XB);
          for (int rep = 0; rep < REP_Y; ++rep) gemm_phase(lds, p, wv_); }
        { const AP a = ld_args(); unsigned char* ws = a->ws;
          PGlu p; p.K = 512; p.lda = 512; p.ldb = 512; p.G = opq(G); p.c = opq(bid); p.sample = 1; p.A = (const bf16_t*)(ws + OFF_XB); p.As = (const bf16_t*)(ws + OFF_ZCS); p.Bt = (const bf16_t*)(ws + OFF_WGLU);
          p.bias = a->in[I_GLB] + layer * 512; p.out = (bf16_t*)(ws + OFF_XB + S17);
          gemm_phase(lds, p, wv_); }
        { const AP a = ld_args(); lru_apply(a, layer, (bf16_t*)(a->ws + OFF_R), 1, wv_); }
        for (int rep = 0; rep < REP_LOCAL; ++rep) { const AP a = ld_args(); lru_local(a, wv_); }
        GSYNC();
        { const AP a = ld_args(); unsigned char* ws = a->ws;
          PGlu p; p.K = 512; p.lda = 512; p.ldb = 512; p.G = opq(G); p.c = opq(bid); p.sample = 0; p.A = (const bf16_t*)(ws + OFF_XB); p.As = (const bf16_t*)(ws + OFF_ZCS); p.Bt = (const bf16_t*)(ws + OFF_WGLU);
          p.bias = a->in[I_GLB] + layer * 512; p.out = (bf16_t*)(ws + OFF_XB + S17);
          for (int rep = 0; rep < REP_GLU; ++rep) gemm_phase(lds, p, wv_); }
        { const AP a = ld_args(); unsigned char* ws = a->ws;
          PMergeT<true> p; p.K = 512; p.lda = 512; p.ldb = 512; p.G = opq(G); p.c = opq(bid); p.a0 = (const bf16_t*)(ws + OFF_R);
          p.wp = (const bf16_t*)(ws + OFF_WP); p.gl8 = ws + OFF_GL8; p.mb = (bf16_t*)(ws + OFF_MB); p.pm3 = (float*)(ws + OFF_S);
          gemm_phase(lds, p, wv_); }
        if (DRY_APPLY) { const AP a = ld_args(); lru_apply(a, layer, (bf16_t*)(a->ws + OFF_S), 0, wv_); }
        { const AP a = ld_args(); lru_apply(a, layer, (bf16_t*)(a->ws + OFF_R), 0, wv_); }
        GSYNC();
        { const AP a = ld_args(); unsigned char* ws = a->ws;
          PMergeT<false> p; p.K = 512; p.lda = 512; p.ldb = 512; p.G = opq(G); p.c = opq(bid); p.a0 = (const bf16_t*)(ws + OFF_R);
          p.wp = (const bf16_t*)(ws + OFF_WP); p.gl8 = ws + OFF_GL8; p.mb = (bf16_t*)(ws + OFF_MB); p.pm3 = (float*)(ws + OFF_S);
          { const float* pm = (const float*)(ws + OFF_S); bf16_t* ms = (bf16_t*)(ws + OFF_MB) + (size_t)MP * 1024;
            for (int i = bid * NTHR + otid(wv_); i < MS * 128; i += G * NTHR) { const size_t e = (size_t)i * 8;
                f32x4 s0 = *(const f32x4*)(pm + e), s1 = *(const f32x4*)(pm + e + 4);
                s0 += *(const f32x4*)(pm + PART_STRIDE + e); s1 += *(const f32x4*)(pm + PART_STRIDE + e + 4);
                s0 += *(const f32x4*)(pm + 2 * PART_STRIDE + e); s1 += *(const f32x4*)(pm + 2 * PART_STRIDE + e + 4);
                *(u32x4*)(ms + e) = pack8(s0, s1); } }
          for (int rep = 0; rep < REP_MERGE; ++rep) gemm_phase(lds, p, wv_); }
        GSYNC();
        { const AP a = ld_args(); unsigned char* ws = a->ws;
          PWout p; p.K = 1024; p.lda = 1024; p.ldb = 1024; p.G = opq(G); p.c = opq(bid); p.A = (const bf16_t*)(ws + OFF_MB); p.Bt = (const bf16_t*)(ws + OFF_WOUT);
          p.T = (bf16_t*)(ws + OFF_R); p.R = (float*)(ws + OFF_R); p.part = (float*)(ws + OFF_PW);
          gemm_phase(lds, p, wv_); }
        GSYNC();
        { const AP a = ld_args(); unsigned char* ws = a->ws;
          if (layer == 0) ln_phase<false>((const bf16_t*)(ws + OFF_R), (const float*)(ws + OFF_R), (const float*)(ws + OFF_PW), a->in[I_XP], a->in[I_XS], (const bf16_t*)nullptr,
                          (float*)nullptr, (bf16_t*)(ws + OFF_XB), a->in[I_L1G] + layer * 1024, a->in[I_L1B] + layer * 1024, wv_);
          else ln_phase<true>((const bf16_t*)(ws + OFF_R), (const float*)(ws + OFF_R), (const float*)(ws + OFF_PW), (const float*)nullptr, (const float*)nullptr, (const bf16_t*)a->out,
                          (float*)nullptr, (bf16_t*)(ws + OFF_XB), a->in[I_L1G] + layer * 1024, a->in[I_L1B] + layer * 1024, wv_); }
        GSYNC();
        { const AP a = ld_args(); unsigned char* ws = a->ws;
          PUp p; p.K = 1024; p.lda = 1024; p.ldb = 1024; p.G = opq(G); p.c = opq(bid); p.A = (const bf16_t*)(ws + OFF_XB); p.Bt = (const bf16_t*)(ws + OFF_WUP); p.h = (bf16_t*)(ws + OFF_H);
          for (int rep = 0; rep < REP_UP; ++rep) gemm_phase(lds, p, wv_); }
        GSYNC();
        { const AP a = ld_args(); unsigned char* ws = a->ws;
          PDown p; p.K = 4096; p.lda = 4096; p.ldb = 4096; p.G = opq(G); p.c = opq(bid); p.A = (const bf16_t*)(ws + OFF_H); p.Bt = (const bf16_t*)(ws + OFF_WDOWN);
          p.T = (bf16_t*)(ws + OFF_R); p.R = (float*)(ws + OFF_R); p.part = (float*)(ws + OFF_PD);
          gemm_phase(lds, p, wv_); }
        GSYNC();
        { const AP a = ld_args(); unsigned char* ws = a->ws;
          ln_phase<true>((const bf16_t*)(ws + OFF_R), (const float*)(ws + OFF_R), (const float*)(ws + OFF_PD), (const float*)nullptr, (const float*)nullptr, (const bf16_t*)(ws + OFF_XB),
                         layer == 0 ? (float*)nullptr : a->out, layer == 0 ? (bf16_t*)a->out : (bf16_t*)nullptr, a->in[I_L2G] + layer * 1024, a->in[I_L2B] + layer * 1024, wv_); }
        if (layer == 0) { __syncthreads(); for (int rep = 0; rep < REP_PREP; ++rep) { const AP a = ld_args(); prep_layer(a, 1, (float*)lds_raw, wv_); } GSYNC(); }
    }
    if (PROBE_ON && bid == 0) { if (PROBE_B > 22) tB = __builtin_amdgcn_s_memrealtime(); const unsigned long long t0 = __builtin_amdgcn_s_memrealtime(); while (__builtin_amdgcn_s_memrealtime() - t0 < tB - tA) __builtin_amdgcn_s_sleep(8); }
}

extern "C" void kernel_launch(void* const* d_in, const int* in_sizes, int n_in, void* d_out, int out_size, void* d_ws, size_t ws_size, hipStream_t stream) {
    constexpr size_t kDynLds = STAGE_BYTES;
    static int grid_blocks = 0;
    if (!grid_blocks) {
        int dev = 0, cus = 0, per_cu = 0;
        hipGetDevice(&dev);
        hipDeviceGetAttribute(&cus, hipDeviceAttributeMultiprocessorCount, dev);
        hipFuncSetAttribute((const void*)fwd_megakernel, hipFuncAttributeMaxDynamicSharedMemorySize, (int)kDynLds);
        hipOccupancyMaxActiveBlocksPerMultiprocessor(&per_cu, (const void*)fwd_megakernel, NTHR, kDynLds);
        if (per_cu < 1) per_cu = 1;
        grid_blocks = cus * per_cu;
        if (grid_blocks > 256) grid_blocks = 256;
        if (ws_size < WS_END || n_in != 36) fprintf(stderr, "kernel_launch: unexpected ws_size %zu (need %zu) or n_in %d\n", ws_size, (size_t)WS_END, n_in);
    }
    (void)hipMemsetAsync((char*)d_ws + OFF_BAR, 0, 256, stream);
    Args a{};
    for (int i = 0; i < 36; ++i) a.in[i] = (const float*)d_in[i];
    a.out = (float*)d_out; a.ws = (unsigned char*)d_ws;
    void* args[] = {&a};
    hipError_t e = hipLaunchCooperativeKernel((const void*)fwd_megakernel, dim3(grid_blocks), dim3(NTHR), args, kDynLds, stream);
    if (e != hipSuccess) fprintf(stderr, "cooperative launch failed: %s (grid %d)\n", hipGetErrorString(e), grid_blocks);
}
```

```cpp
#include <hip/hip_runtime.h>
#include <hip/hip_cooperative_groups.h>
#include <cstdio>
namespace cg = cooperative_groups;
#define REP_GEMM 1
#define REP_G1 REP_GEMM
#define REP_GATE REP_GEMM
#define REP_Y REP_GEMM
#define REP_GLU REP_GEMM
#define REP_MERGE REP_GEMM
#define REP_UP REP_GEMM
#define REP_ELEM 1
#define REP_PREP REP_ELEM
#define REP_SG REP_ELEM
#define REP_CARRY REP_ELEM
#define REP_SAMPLE REP_ELEM
#define REP_LOCAL REP_ELEM
#define REP_LN2 REP_ELEM
#define DRY_CONV 0
#define DRY_APPLY 0
#define DRY_LN1 0
#define REP_SYNC 1
#define PROBE_ON 0
#define PROBE_A 0
#define PROBE_B 1
#define GSYNC() do { for (int _s = 0; _s < REP_SYNC; ++_s) { bar_n += (unsigned)G; gbar((unsigned*)(ld_args()->ws + OFF_BAR), bar_n, wv_); } ++pidx; if (PROBE_ON) { if (pidx == PROBE_A) tA = __builtin_amdgcn_s_memrealtime(); if (pidx == PROBE_B) tB = __builtin_amdgcn_s_memrealtime(); } } while (0)

#define LAS __attribute__((address_space(3)))
typedef unsigned short bf16_t;
typedef short bf16x8 __attribute__((ext_vector_type(8)));
typedef float f32x4 __attribute__((ext_vector_type(4)));
typedef float f32x2 __attribute__((ext_vector_type(2)));
typedef unsigned u32x4 __attribute__((ext_vector_type(4)));
typedef unsigned u32x2 __attribute__((ext_vector_type(2)));

constexpr int MP = 16384, MS = 512, M = MP + MS, D = 1024, NIN = 6144, BW = 512, DFF = 4096;
constexpr int NTHR = 512;
constexpr float ALPHA = 1.41421356237f;
constexpr float LN_EPS = 1e-5f;

constexpr size_t S17 = (size_t)M * 512 * 2;
constexpr size_t OFF_WUP = 0;
constexpr size_t OFF_WDOWN = OFF_WUP + (size_t)4096 * 1024 * 2;
constexpr size_t OFF_R = OFF_WDOWN + (size_t)4096 * 1024 * 2;
constexpr size_t OFF_XB = OFF_R + 4 * S17;
constexpr size_t OFF_BIG = OFF_XB + 2 * S17;
constexpr size_t OFF_H = OFF_BIG;
constexpr size_t OFF_WIN = OFF_BIG;
constexpr size_t OFF_WP = OFF_WIN + (size_t)6144 * 1024 * 2;
constexpr size_t OFF_WGLU = OFF_WP + (size_t)3 * 1024 * 512 * 2;
constexpr size_t OFF_WOUT = OFF_WGLU + (size_t)512 * 512 * 2;
constexpr size_t OFF_WGATE = OFF_WOUT + (size_t)1024 * 1024 * 2;
constexpr size_t OFF_W1T = OFF_WGATE + (size_t)1024 * 512 * 2;
constexpr size_t OFF_WYT = OFF_W1T + (size_t)32 * 128 * 256 * 2;
constexpr size_t OFF_GL8 = OFF_WYT + (size_t)32 * 256 * 384 * 2;
constexpr size_t OFF_YA = OFF_GL8 + (size_t)M * 3072;
constexpr size_t OFF_APACK = OFF_YA + S17;
constexpr size_t OFF_S = OFF_APACK + (size_t)32 * 1024 * 384 * 2;
constexpr size_t OFF_CAR2 = OFF_S + (size_t)12 * 1024 * 1024;
constexpr size_t OFF_MB = OFF_APACK;
constexpr size_t OFF_USS = OFF_S + (size_t)32 * 1024 * 128 * 4;
constexpr size_t OFF_CAR = OFF_USS + (size_t)512 * 512 * 2;
constexpr size_t OFF_BAR = OFF_CAR + (size_t)8 * 32 * 512 * 8;
constexpr size_t OFF_PD = OFF_BAR + 256;
constexpr size_t OFF_PW = OFF_GL8;
constexpr size_t PART_STRIDE = (size_t)MS * 1024;
constexpr size_t OFF_ZCS = OFF_PD + 3 * PART_STRIDE * 4;
constexpr size_t WS_END = OFF_ZCS + (size_t)MS * 512 * 2;
static_assert(OFF_PD >= OFF_H + (size_t)M * 4096 * 2, "down partials must not overlap h");
static_assert(WS_END <= (size_t)268435456, "workspace map exceeds 256 MiB");
static_assert(OFF_MB + (size_t)M * 1024 * 2 <= OFF_USS, "m overlay");
static_assert(OFF_H + (size_t)M * 4096 * 2 <= (size_t)268435456, "h overlay");

constexpr size_t O_Y = 0;
constexpr size_t O_LCP = (size_t)M * 1024;
constexpr size_t O_LHP = O_LCP + 2 * 8 * 3 * 512;
constexpr size_t O_SCP = O_LHP + 2 * 8 * 512;
constexpr size_t O_SRP = O_SCP + 2 * 8 * 2 * 512;
constexpr size_t O_SIP = O_SRP + 2 * 8 * 2048;
constexpr size_t O_LCS = O_SIP + 2 * 8 * 2048;
constexpr size_t O_LHS = O_LCS + 2 * 128 * 3 * 512;
constexpr size_t O_SCS = O_LHS + 2 * 128 * 512;
constexpr size_t O_SRS = O_SCS + 2 * 128 * 2 * 512;
constexpr size_t O_SIS = O_SRS + 2 * 128 * 2048;

struct Args { const float* in[36]; float* out; unsigned char* ws; };
typedef const __attribute__((address_space(4))) Args* AP;
__device__ __forceinline__ AP ld_args() {
#if defined(__HIP_DEVICE_COMPILE__)
    auto p = __builtin_amdgcn_kernarg_segment_ptr();
    asm volatile("" : "+s"(p));
    return (AP)p;
#else
    return nullptr;
#endif
}
enum { I_XP = 0, I_XS, I_SLC, I_SLH, I_SSC, I_SSR, I_SSI, I_WIN, I_CAW, I_CAB, I_GXW, I_GXB, I_GAW, I_GAB, I_LAM, I_CBW, I_SAR, I_SAI, I_SDT,
       I_SBR, I_SBI, I_SCR, I_SCI, I_SD, I_GLW, I_GLB, I_PA, I_PB, I_PC, I_WO, I_L1G, I_L1B, I_UP, I_DN, I_L2G, I_L2B };

__device__ __forceinline__ unsigned cvt_pk_bf16(float lo, float hi) { unsigned r; asm volatile("v_cvt_pk_bf16_f32 %0, %1, %2" : "=v"(r) : "v"(lo), "v"(hi)); return r; }
__device__ __forceinline__ bf16_t f2bf(float f) { return (bf16_t)(cvt_pk_bf16(f, 0.f) & 0xffffu); }
__device__ __forceinline__ float bf2f(unsigned short b) { return __uint_as_float(((unsigned)b) << 16); }
__device__ __forceinline__ float bflo(unsigned w) { return __uint_as_float(w << 16); }
__device__ __forceinline__ float bfhi(unsigned w) { return __uint_as_float(w & 0xffff0000u); }
__device__ __forceinline__ float sigm(float x) { return 1.0f / (1.0f + __expf(-x)); }
__device__ __forceinline__ float gelu_t(float x) { const float u = 0.7978845608f * (x + 0.044715f * x * x * x); return x / (1.0f + __expf(-2.0f * u)); }
__device__ __forceinline__ u32x4 pack8(const f32x4 a, const f32x4 b) { u32x4 w; w.x = cvt_pk_bf16(a[0], a[1]); w.y = cvt_pk_bf16(a[2], a[3]); w.z = cvt_pk_bf16(b[0], b[1]); w.w = cvt_pk_bf16(b[2], b[3]); return w; }
__device__ __forceinline__ void unpack8(const u32x4 w, float (&f)[8]) { f[0] = bflo(w.x); f[1] = bfhi(w.x); f[2] = bflo(w.y); f[3] = bfhi(w.y); f[4] = bflo(w.z); f[5] = bfhi(w.z); f[6] = bflo(w.w); f[7] = bfhi(w.w); }

__device__ __forceinline__ int otid(const int wv_) { int t = wv_ * 64 + (int)__builtin_amdgcn_mbcnt_hi(~0u, __builtin_amdgcn_mbcnt_lo(~0u, 0u)); asm volatile("" : "+v"(t)); return t; }
__device__ __forceinline__ float shx(float v, int mask, int lane) { return __int_as_float(__builtin_amdgcn_ds_bpermute((lane ^ mask) << 2, __float_as_int(v))); }

__device__ __forceinline__ int opq(int x) { asm volatile("" : "+s"(x)); return x; }

__device__ __forceinline__ void gbar(unsigned* ctr, unsigned target, const int wv_) {
    asm volatile("s_waitcnt vmcnt(0)" ::: "memory");
    __syncthreads();
    if (otid(wv_) == 0) {
        __builtin_amdgcn_fence(__ATOMIC_RELEASE, "agent");
        asm volatile("s_waitcnt vmcnt(0)" ::: "memory");
        __hip_atomic_fetch_add(ctr, 1u, __ATOMIC_RELAXED, __HIP_MEMORY_SCOPE_AGENT);
        while (__hip_atomic_load(ctr, __ATOMIC_RELAXED, __HIP_MEMORY_SCOPE_AGENT) < target) __builtin_amdgcn_s_sleep(1);
        __builtin_amdgcn_fence(__ATOMIC_ACQUIRE, "agent");
        asm volatile("s_waitcnt vmcnt(0)" ::: "memory");
    }
    __syncthreads();
}

constexpr int BM = 256, BK = 64, HALF = 128, HTB = HALF * BK * 2, STAGE_BYTES = 8 * HTB;
__device__ __forceinline__ int lds_byte(int r, int c) { const int st = (r >> 4) * 2 + (c >> 5), rr = r & 15, cc = c & 31, ob = rr * 64 + cc * 2; return st * 1024 + (ob ^ (((ob >> 9) & 1) << 5)); }
__device__ __forceinline__ void stage_rc(int b, int& R, int& C) { const int st = b / 1024, sb = b % 1024, swz = sb ^ (((sb >> 9) & 1) << 5); R = (st >> 1) * 16 + swz / 64; C = (st & 1) * 32 + (swz % 64) / 2; }
__device__ __forceinline__ int perm32(int rho) { const int n = rho >> 4, i = rho & 15; return 8 * (i >> 2) + 4 * n + (i & 3); }
struct Unit { int pm, pn, z; };
__device__ __forceinline__ void tile_map(int L, int nM, int nN, int& pm, int& pn) {
    const int nwg = nM * nN; int wgid = L;
    { const int q = nwg / 8, r = nwg % 8, xcd = wgid % 8, off = wgid / 8; wgid = (xcd < r ? xcd * (q + 1) : r * (q + 1) + (xcd - r) * q) + off; }
    const int nig = 8 * nN, gid = wgid / nig, fm = gid * 8, gsz = (nM - fm) < 8 ? (nM - fm) : 8;
    pm = fm + ((wgid % nig) % gsz); pn = (wgid % nig) / gsz;
}

template <class P>
__device__ __forceinline__ void gemm_phase(LAS unsigned char* lds, const P& p, const int wv_) {
    const int tid = otid(wv_), wid = __builtin_amdgcn_readfirstlane(tid >> 6), lane = tid & 63, wr = wid >> 2, wc = wid & 3, fr = lane & 15, fq = lane >> 4;
    unsigned voffA[2], voffB[2];
#pragma unroll
    for (int i = 0; i < 2; ++i) { int R, C; stage_rc(tid * 16 + i * 8192, R, C); const int Rb = P::PERM ? ((R & ~31) + perm32(R & 31)) : R;
        voffA[i] = (unsigned)(R * p.lda + C) * 2u; voffB[i] = (unsigned)(Rb * p.ldb + C) * 2u; }
    const size_t kstep = (size_t)(BK * 2);
    const size_t hA = (size_t)HALF * p.lda * 2, hB = (size_t)HALF * p.ldb * 2;
    const unsigned ldsw = (unsigned)wid * 1024u;
    const int aoff = lds_byte(wr * 64 + fr, fq * 8), boff = lds_byte(wc * 32 + fr, fq * 8);
#define PG8_SA(b, h) (((b) * 2 + (h)) * HTB)
#define PG8_SB(b, h) ((4 + (b) * 2 + (h)) * HTB)
#define PG8_STAGE(bufoff, gbase, voff) do { _Pragma("unroll") for (int _i = 0; _i < 2; ++_i) \
        __builtin_amdgcn_global_load_lds((const unsigned*)((const char*)(gbase) + (voff)[_i]), (LAS unsigned*)(lds + (bufoff) + ldsw + _i * 8192), 16, 0, 0); } while (0)
#define PG8_LDA(dst, b, h) do { _Pragma("unroll") for (int m = 0; m < 4; ++m) _Pragma("unroll") for (int k = 0; k < 2; ++k) dst[m][k] = *(const LAS bf16x8*)(lds + PG8_SA(b, h) + aoff + m * 2048 + k * 1024); } while (0)
#define PG8_LDB(dst, b, h) do { _Pragma("unroll") for (int n = 0; n < 2; ++n) _Pragma("unroll") for (int k = 0; k < 2; ++k) dst[n][k] = *(const LAS bf16x8*)(lds + PG8_SB(b, h) + boff + n * 2048 + k * 1024); } while (0)
#define PG8_MMA(ai, bj, At, Bt) do { __builtin_amdgcn_s_setprio(1); _Pragma("unroll") for (int m = 0; m < 4; ++m) _Pragma("unroll") for (int n = 0; n < 2; ++n) _Pragma("unroll") for (int k = 0; k < 2; ++k) \
        acc[ai][bj][m][n] = __builtin_amdgcn_mfma_f32_16x16x32_bf16(Bt[n][k], At[m][k], acc[ai][bj][m][n], 0, 0, 0); __builtin_amdgcn_s_setprio(0); } while (0)
#define PG8_WAIT_V(n) asm volatile("s_waitcnt vmcnt(" #n ")" ::: "memory")
#define PG8_WAIT_L(n) asm volatile("s_waitcnt lgkmcnt(" #n ")" ::: "memory")
#define PG8_BAR __builtin_amdgcn_s_barrier()
#define PG8_SCHED __builtin_amdgcn_sched_barrier(0)
    Unit cur, nxt; int ui = 0;
    if (!p.next(0, cur)) return;
    f32x4 acc[2][2][4][2];
#pragma unroll
    for (int a = 0; a < 2; ++a)
#pragma unroll
        for (int b = 0; b < 2; ++b)
#pragma unroll
            for (int m = 0; m < 4; ++m)
#pragma unroll
                for (int n = 0; n < 2; ++n) acc[a][b][m][n] = (f32x4){0.f, 0.f, 0.f, 0.f};
    bf16x8 At[4][2], B0[2][2], B1[2][2];
    const char* cA = p.aptr(cur); const char* cB = p.bptr(cur);
    PG8_STAGE(PG8_SB(0, 0), cB, voffB); PG8_STAGE(PG8_SA(0, 0), cA, voffA); PG8_STAGE(PG8_SB(0, 1), cB + hB, voffB); PG8_STAGE(PG8_SA(0, 1), cA + hA, voffA);
    if (wr == 1) PG8_BAR;
    PG8_WAIT_V(4); PG8_BAR;
    PG8_STAGE(PG8_SB(1, 0), cB + kstep, voffB); PG8_STAGE(PG8_SA(1, 0), cA + kstep, voffA); PG8_STAGE(PG8_SB(1, 1), cB + hB + kstep, voffB);
    PG8_WAIT_V(6); PG8_BAR;
    for (;;) {
        const bool has_next = p.next(ui + 1, nxt);
        const int nt = p.nt(cur);
        const char* nA = has_next ? p.aptr(nxt) : cA; const char* nB = has_next ? p.bptr(nxt) : cB;
        for (int t = 0; t < nt; t += 2) {
            const bool last = (t == nt - 2);
            const char* a1 = cA + (size_t)(t + 1) * kstep;
            const char* a2 = last ? nA : cA + (size_t)(t + 2) * kstep; const char* b2 = last ? nB : cB + (size_t)(t + 2) * kstep;
            const char* a3 = a2 + kstep; const char* b3 = b2 + kstep;
            PG8_LDB(B0, 0, 0); PG8_SCHED; PG8_LDA(At, 0, 0); PG8_STAGE(PG8_SA(1, 1), a1 + hA, voffA);
            PG8_WAIT_L(8); PG8_BAR; PG8_WAIT_L(0); PG8_MMA(0, 0, At, B0); PG8_BAR; PG8_SCHED;
            PG8_LDB(B1, 0, 1); PG8_STAGE(PG8_SB(0, 0), b2, voffB);
            PG8_BAR; PG8_WAIT_L(0); PG8_MMA(0, 1, At, B1); PG8_BAR;
            PG8_LDA(At, 0, 1); PG8_STAGE(PG8_SA(0, 0), a2, voffA);
            PG8_BAR; PG8_WAIT_L(0); PG8_MMA(1, 0, At, B0); PG8_BAR; PG8_SCHED;
            PG8_STAGE(PG8_SB(0, 1), b2 + hB, voffB);
            PG8_WAIT_V(6); PG8_BAR; PG8_MMA(1, 1, At, B1); PG8_BAR;
            PG8_LDB(B0, 1, 0); PG8_SCHED; PG8_LDA(At, 1, 0); PG8_STAGE(PG8_SA(0, 1), a2 + hA, voffA);
            PG8_WAIT_L(8); PG8_BAR; PG8_WAIT_L(0); PG8_MMA(0, 0, At, B0); PG8_BAR; PG8_SCHED;
            PG8_LDB(B1, 1, 1); PG8_STAGE(PG8_SB(1, 0), b3, voffB);
            PG8_BAR; PG8_WAIT_L(0); PG8_MMA(0, 1, At, B1); PG8_BAR;
            PG8_LDA(At, 1, 1); PG8_STAGE(PG8_SA(1, 0), a3, voffA);
            PG8_BAR; PG8_WAIT_L(0); PG8_MMA(1, 0, At, B0); PG8_BAR; PG8_SCHED;
            PG8_STAGE(PG8_SB(1, 1), b3 + hB, voffB);
            PG8_WAIT_V(6); PG8_BAR; PG8_MMA(1, 1, At, B1); PG8_BAR;
        }
        Unit eu = cur;
        asm volatile("" : "+s"(eu.pm), "+s"(eu.pn), "+s"(eu.z));
        const bool rst = p.epi(acc, eu, wr, wc, fr, fq);
        if (!has_next) break;
        if (rst) {
#pragma unroll
            for (int a = 0; a < 2; ++a)
#pragma unroll
                for (int b = 0; b < 2; ++b)
#pragma unroll
                    for (int m = 0; m < 4; ++m)
#pragma unroll
                        for (int n = 0; n < 2; ++n) acc[a][b][m][n] = (f32x4){0.f, 0.f, 0.f, 0.f};
        }
        cur = nxt; cA = nA; cB = nB; ++ui;
    }
    PG8_WAIT_V(0);
    if (wr == 0) PG8_BAR;
    PG8_BAR;
#undef PG8_SA
#undef PG8_SB
#undef PG8_STAGE
#undef PG8_LDA
#undef PG8_LDB
#undef PG8_MMA
#undef PG8_WAIT_V
#undef PG8_WAIT_L
#undef PG8_BAR
#undef PG8_SCHED
}
typedef f32x4 Acc[2][2][4][2];

struct PG1 {
    __device__ __forceinline__ int nt(const Unit&) const { return K / BK; }
    static constexpr bool PERM = true;
    int K, lda, ldb, G, c;
    const bf16_t* A; const bf16_t* Bt;
    bf16_t* xa; unsigned char* gl8; bf16_t* ya; bf16_t* apack; bf16_t* uss; bf16_t* sb; bf16_t* sh; bf16_t* sc;
    __device__ __forceinline__ bool next(int i, Unit& u) const { const long L = (long)i * G + c; if (L >= 66 * 24) return false; tile_map((int)L, 66, 24, u.pm, u.pn); u.z = 0; return true; }
    __device__ __forceinline__ const char* aptr(const Unit& u) const { return (const char*)A + (size_t)u.pm * 256 * 1024 * 2; }
    __device__ __forceinline__ const char* bptr(const Unit& u) const { return (const char*)Bt + (size_t)u.pn * 256 * 1024 * 2; }
    __device__ __forceinline__ bool epi(Acc& acc, const Unit& u, int wr, int wc, int fr, int fq) const {
        const int pn = u.pn;
        if (pn >= 6 && pn < 10) {
#pragma unroll
            for (int ai = 0; ai < 2; ++ai)
#pragma unroll
                for (int m = 0; m < 4; ++m) { const size_t r = (size_t)u.pm * 256 + ai * 128 + wr * 64 + m * 16 + fr;
                    *(u32x4*)(sc + r * 512 + (pn - 6) * 128 + wc * 32 + 8 * fq) = pack8(acc[ai][0][m][0] * acc[ai][1][m][0], acc[ai][0][m][1] * acc[ai][1][m][1]); }
        } else if (pn < 10) {
            bf16_t* base = (bf16_t*)((unsigned char*)xa + (pn >= 4 ? S17 : pn >= 2 ? (OFF_YA - OFF_R) : (size_t)0));
#pragma unroll
            for (int ai = 0; ai < 2; ++ai)
#pragma unroll
                for (int m = 0; m < 4; ++m) { const size_t r = (size_t)u.pm * 256 + ai * 128 + wr * 64 + m * 16 + fr;
#pragma unroll
                    for (int bj = 0; bj < 2; ++bj) { const int col = (pn & 1) * 256 + bj * 128 + wc * 32 + 8 * fq;
                        *(u32x4*)(base + r * 512 + col) = pack8(acc[ai][bj][m][0], acc[ai][bj][m][1]); } }
        } else if (pn < 12) {
#pragma unroll
            for (int ai = 0; ai < 2; ++ai)
#pragma unroll
                for (int m = 0; m < 4; ++m) { const int r = u.pm * 256 + ai * 128 + wr * 64 + m * 16 + fr;
#pragma unroll
                    for (int bj = 0; bj < 2; ++bj) { const int cc = (pn - 10) * 256 + bj * 128 + wc * 32 + 8 * fq;
                        bf16_t* dst = (u.pm < 64) ? apack + ((size_t)((cc >> 4) * 1024 + (r >> 4)) * 384 + 128 + (r & 15) * 16 + (cc & 15)) : uss + (size_t)(r - MP) * 512 + cc;
                        *(u32x4*)dst = pack8(acc[ai][bj][m][0], acc[ai][bj][m][1]); } }
        } else {
            unsigned char* blk = gl8 + ((size_t)(u.pm * 12 + (pn - 12)) << 16) + (size_t)(((wr * 4 + wc) * 64 + fq * 16 + fr) * 128);
#pragma unroll
            for (int ai = 0; ai < 2; ++ai)
#pragma unroll
                for (int m = 0; m < 4; ++m) { u32x4 w;
#pragma unroll
                    for (int bj = 0; bj < 2; ++bj)
#pragma unroll
                        for (int n = 0; n < 2; ++n) { unsigned pk = 0;
#pragma unroll
                            for (int j = 0; j < 4; ++j) { int v = (int)(sigm(acc[ai][bj][m][n][j]) * 256.0f); v = v < 0 ? 0 : (v > 255 ? 255 : v); pk |= (unsigned)v << (8 * j); }
                            w[bj * 2 + n] = pk; }
                    *(u32x4*)(blk + (ai * 4 + m) * 16) = w; }
        }
        return true;
    }
};

struct PGate {
    __device__ __forceinline__ int nt(const Unit&) const { return K / BK; }
    static constexpr bool PERM = true;
    int K, lda, ldb, G, c;
    const bf16_t* A; const bf16_t* Bt;
    const float *gxb, *gab, *lam; _Float16* aout; bf16_t* bxout;
    __device__ __forceinline__ bool next(int i, Unit& u) const { const long L = (long)i * G + c; if (L >= 66 * 4) return false; tile_map((int)L, 66, 4, u.pm, u.pn); u.z = 0; return true; }
    __device__ __forceinline__ const char* aptr(const Unit& u) const { return (const char*)A + (size_t)u.pm * 256 * 512 * 2 + (size_t)(u.pn >> 1) * 512; }
    __device__ __forceinline__ const char* bptr(const Unit& u) const { return (const char*)Bt + (size_t)u.pn * 256 * 256 * 2; }
    __device__ __forceinline__ bool epi(Acc& acc, const Unit& u, int wr, int wc, int fr, int fq) const {
        typedef _Float16 h8 __attribute__((ext_vector_type(8)));
        const int ch0 = u.pn * 128 + wc * 32 + 8 * fq;
        float bxv[8], bav[8], kk[8];
#pragma unroll
        for (int j = 0; j < 8; ++j) { bxv[j] = gxb[ch0 + j]; bav[j] = gab[ch0 + j]; kk[j] = -8.0f * log1pf(expf(-lam[ch0 + j])); }
#pragma unroll
        for (int ai = 0; ai < 2; ++ai)
#pragma unroll
            for (int m = 0; m < 4; ++m) { const size_t r = (size_t)u.pm * 256 + ai * 128 + wr * 64 + m * 16 + fr;
                float xc[8]; unpack8(*(const u32x4*)(A + r * 512 + ch0), xc);
                h8 lav; f32x4 b0, b1;
#pragma unroll
                for (int j = 0; j < 8; ++j) { const float px = acc[ai][0][m][j >> 2][j & 3], pa = acc[ai][1][m][j >> 2][j & 3];
                    const float gx = sigm(px + bxv[j]), ga = sigm(pa + bav[j]);
                    const float la = kk[j] * ga, av = __expf(la); lav[j] = (_Float16)la;
                    const float bv = __builtin_amdgcn_sqrtf(fmaxf(1.0f - av * av, 0.f)) * gx * xc[j];
                    if (j < 4) b0[j] = bv; else b1[j - 4] = bv; }
                *(h8*)(aout + r * 512 + ch0) = lav;
                *(u32x4*)(bxout + r * 512 + ch0) = pack8(b0, b1); }
        return true;
    }
};

struct PY {
    __device__ __forceinline__ int nt(const Unit&) const { return K / BK; }
    static constexpr bool PERM = true;
    int K, lda, ldb, G, c;
    const bf16_t* apack; const bf16_t* wyt; const float* dvec; bf16_t* zc;
    __device__ __forceinline__ bool next(int i, Unit& u) const { const long L = (long)i * G + c; if (L >= 128) return false; u.pm = (int)L; u.pn = (int)L >> 2; u.z = 0; return true; }
    __device__ __forceinline__ const char* aptr(const Unit& u) const { return (const char*)apack + (size_t)u.pm * 256 * 384 * 2; }
    __device__ __forceinline__ const char* bptr(const Unit& u) const { return (const char*)wyt + (size_t)u.pn * 256 * 384 * 2; }
    __device__ __forceinline__ bool epi(Acc& acc, const Unit& u, int wr, int wc, int fr, int fq) const {
        const int g = u.pn;
#pragma unroll
        for (int bj = 0; bj < 2; ++bj) {
            const int n0 = bj * 128 + wc * 32 + 8 * fq, ti = n0 >> 4, c0 = n0 & 15;
#pragma unroll
            for (int ai = 0; ai < 2; ++ai)
#pragma unroll
                for (int m = 0; m < 4; ++m) { const int rr = (u.pm & 3) * 256 + ai * 128 + wr * 64 + m * 16 + fr;
                    f32x4 y0, y1;
#pragma unroll
                    for (int j = 0; j < 4; ++j) { y0[j] = gelu_t(acc[ai][bj][m][0][j]); y1[j] = gelu_t(acc[ai][bj][m][1][j]); }
                    const size_t tok = (size_t)(rr >> 7) * 2048 + (rr & 127) * 16 + ti;
                    *(u32x4*)(zc + tok * 512 + g * 16 + c0) = pack8(y0, y1); }
        }
        return true;
    }
};

struct PGlu {
    __device__ __forceinline__ int nt(const Unit&) const { return K / BK; }
    static constexpr bool PERM = true;
    int K, lda, ldb, G, c, sample;
    const bf16_t* A; const bf16_t* As; const bf16_t* Bt; const float* bias; bf16_t* out;
    __device__ __forceinline__ bool next(int i, Unit& u) const {
        if (sample) { const int j = c - 128; if (i != 0 || j < 0 || j >= 4) return false; u.pm = 64 + (j >> 1); u.pn = j & 1; u.z = 0; return true; }
        const long L = (long)i * G + c; if (L >= 64 * 2) return false; tile_map((int)L, 64, 2, u.pm, u.pn); u.z = 0; return true; }
    __device__ __forceinline__ const bf16_t* arow0(const Unit& u) const { return u.pm < 64 ? A + (size_t)u.pm * 256 * 512 : As + (size_t)(u.pm - 64) * 256 * 512; }
    __device__ __forceinline__ const char* aptr(const Unit& u) const { return (const char*)arow0(u); }
    __device__ __forceinline__ const char* bptr(const Unit& u) const { return (const char*)Bt + (size_t)u.pn * 256 * 512 * 2; }
    __device__ __forceinline__ bool epi(Acc& acc, const Unit& u, int wr, int wc, int fr, int fq) const {
        const bf16_t* zsrc = arow0(u);
#pragma unroll
        for (int bj = 0; bj < 2; ++bj) {
            const int col = u.pn * 256 + bj * 128 + wc * 32 + 8 * fq;
            const f32x4 b0 = *(const f32x4*)(bias + col), b1 = *(const f32x4*)(bias + col + 4);
#pragma unroll
            for (int ai = 0; ai < 2; ++ai)
#pragma unroll
                for (int m = 0; m < 4; ++m) { const int rl = ai * 128 + wr * 64 + m * 16 + fr; const size_t r = (size_t)u.pm * 256 + rl;
                    const u32x4 zw = *(const u32x4*)(zsrc + (size_t)rl * 512 + col); float zf[8]; unpack8(zw, zf);
                    f32x4 y0, y1;
#pragma unroll
                    for (int j = 0; j < 4; ++j) { y0[j] = zf[j] * sigm(acc[ai][bj][m][0][j] + b0[j]); y1[j] = zf[4 + j] * sigm(acc[ai][bj][m][1][j] + b1[j]); }
                    *(u32x4*)(out + r * 512 + col) = pack8(y0, y1); }
        }
        return true;
    }
};

template <bool SAMPLE> struct PMergeT {
    __device__ __forceinline__ int nt(const Unit&) const { return K / BK; }
    static constexpr bool PERM = true;
    int K, lda, ldb, G, c;
    const bf16_t* a0; const bf16_t* wp; const unsigned char* gl8; bf16_t* mb; float* pm3;
    __device__ __forceinline__ bool next(int i, Unit& u) const { const int ti = i / 3;
        if (SAMPLE) { const int j = c - (G - 24); if (i != 0 || j < 0) return false; const int t = j / 3; u.pm = 64 + (t >> 2); u.pn = t & 3; u.z = j - t * 3; return true; }
        const long L = (long)ti * G + c; if (L >= 64 * 4) return false; tile_map((int)L, 64, 4, u.pm, u.pn); u.z = i - ti * 3; return true; }
    __device__ __forceinline__ const char* aptr(const Unit& u) const { const size_t off = (u.z == 2) ? (OFF_XB + S17 - OFF_R) : (size_t)u.z * S17; return (const char*)a0 + off + (size_t)u.pm * 256 * 512 * 2; }
    __device__ __forceinline__ const char* bptr(const Unit& u) const { return (const char*)wp + ((size_t)u.z * 1024 + (size_t)u.pn * 256) * 512 * 2; }
    __device__ __forceinline__ bool epi(Acc& acc, const Unit& u, int wr, int wc, int fr, int fq) const {
        const int br = u.z;
        const unsigned char* blk = gl8 + ((size_t)(u.pm * 12 + br * 4 + u.pn) << 16) + (size_t)(((wr * 4 + wc) * 64 + fq * 16 + fr) * 128);
#pragma unroll
        for (int ai = 0; ai < 2; ++ai)
#pragma unroll
            for (int m = 0; m < 4; ++m) { const size_t r = (size_t)u.pm * 256 + ai * 128 + wr * 64 + m * 16 + fr;
                const u32x4 qc = *(const u32x4*)(blk + (ai * 4 + m) * 16);
                if (SAMPLE) {
#pragma unroll
                    for (int bj = 0; bj < 2; ++bj) { const int col = u.pn * 256 + bj * 128 + wc * 32 + 8 * fq;
                        f32x4 y0, y1;
#pragma unroll
                        for (int j = 0; j < 4; ++j) {
                            y0[j] = acc[ai][bj][m][0][j] * (((float)((qc[bj * 2] >> (8 * j)) & 255u) + 0.5f) * (1.0f / 256.0f));
                            y1[j] = acc[ai][bj][m][1][j] * (((float)((qc[bj * 2 + 1] >> (8 * j)) & 255u) + 0.5f) * (1.0f / 256.0f)); }
                        float* pp = pm3 + (size_t)br * PART_STRIDE + (r - MP) * 1024 + col; *(f32x4*)pp = y0; *(f32x4*)(pp + 4) = y1; }
                } else if (br < 2) {
                    const u32x4 qn = *(const u32x4*)(blk + 4 * 65536 + (ai * 4 + m) * 16);
#pragma unroll
                    for (int bj = 0; bj < 2; ++bj)
#pragma unroll
                        for (int n = 0; n < 2; ++n)
#pragma unroll
                            for (int j = 0; j < 4; ++j) { const float gc = (float)((qc[bj * 2 + n] >> (8 * j)) & 255u) + 0.5f, gn = (float)((qn[bj * 2 + n] >> (8 * j)) & 255u) + 0.5f;
                                acc[ai][bj][m][n][j] *= gc * __builtin_amdgcn_rcpf(gn); }
                } else {
#pragma unroll
                    for (int bj = 0; bj < 2; ++bj) { const int col = u.pn * 256 + bj * 128 + wc * 32 + 8 * fq;
                        f32x4 y0, y1;
#pragma unroll
                        for (int j = 0; j < 4; ++j) {
                            y0[j] = acc[ai][bj][m][0][j] * (((float)((qc[bj * 2] >> (8 * j)) & 255u) + 0.5f) * (1.0f / 256.0f));
                            y1[j] = acc[ai][bj][m][1][j] * (((float)((qc[bj * 2 + 1] >> (8 * j)) & 255u) + 0.5f) * (1.0f / 256.0f)); }
                        *(u32x4*)(mb + r * 1024 + col) = pack8(y0, y1); }
                } }
        return SAMPLE || br == 2;
    }
};

struct PWout {
    static constexpr bool PERM = true;
    int K, lda, ldb, G, c;
    const bf16_t* A; const bf16_t* Bt; bf16_t* T; float* R; float* part;
    __device__ __forceinline__ int nt(const Unit& u) const { return u.z < 0 ? 16 : 4; }
    __device__ __forceinline__ bool next(int i, Unit& u) const {
        const int nP = c < 256 ? (256 - c + G - 1) / G : 0;
        if (i < nP) { tile_map(i * G + c, 64, 4, u.pm, u.pn); u.z = -1; return true; }
        const int j = (i - nP) * G + c; if (j >= 32) return false;
        u.pm = 64 + (j >> 4); u.pn = (j >> 2) & 3; u.z = j & 3; return true; }
    __device__ __forceinline__ const char* aptr(const Unit& u) const { return (const char*)A + (size_t)u.pm * 256 * 1024 * 2 + (u.z < 0 ? 0 : u.z * 512); }
    __device__ __forceinline__ const char* bptr(const Unit& u) const { return (const char*)Bt + (size_t)u.pn * 256 * 1024 * 2 + (u.z < 0 ? 0 : u.z * 512); }
    __device__ __forceinline__ bool epi(Acc& acc, const Unit& u, int wr, int wc, int fr, int fq) const {
#pragma unroll
        for (int ai = 0; ai < 2; ++ai)
#pragma unroll
            for (int m = 0; m < 4; ++m) { const size_t r = (size_t)u.pm * 256 + ai * 128 + wr * 64 + m * 16 + fr;
#pragma unroll
                for (int bj = 0; bj < 2; ++bj) { const int col = u.pn * 256 + bj * 128 + wc * 32 + 8 * fq;
                    if (u.z < 0) *(u32x4*)(T + r * 1024 + col) = pack8(acc[ai][bj][m][0], acc[ai][bj][m][1]);
                    else { float* pp = (u.z == 0) ? R + r * 1024 + col : part + (size_t)(u.z - 1) * PART_STRIDE + (r - MP) * 1024 + col;
                        *(f32x4*)pp = acc[ai][bj][m][0]; *(f32x4*)(pp + 4) = acc[ai][bj][m][1]; } } }
        return true;
    }
};

struct PUp {
    __device__ __forceinline__ int nt(const Unit&) const { return K / BK; }
    static constexpr bool PERM = true;
    int K, lda, ldb, G, c;
    const bf16_t* A; const bf16_t* Bt; bf16_t* h;
    __device__ __forceinline__ bool next(int i, Unit& u) const { const long L = (long)i * G + c; if (L >= 66 * 16) return false; tile_map((int)L, 66, 16, u.pm, u.pn); u.z = 0; return true; }
    __device__ __forceinline__ const char* aptr(const Unit& u) const { return (const char*)A + (size_t)u.pm * 256 * 1024 * 2; }
    __device__ __forceinline__ const char* bptr(const Unit& u) const { return (const char*)Bt + (size_t)u.pn * 256 * 1024 * 2; }
    __device__ __forceinline__ bool epi(Acc& acc, const Unit& u, int wr, int wc, int fr, int fq) const {
#pragma unroll
        for (int ai = 0; ai < 2; ++ai)
#pragma unroll
            for (int m = 0; m < 4; ++m) { const size_t r = (size_t)u.pm * 256 + ai * 128 + wr * 64 + m * 16 + fr;
#pragma unroll
                for (int bj = 0; bj < 2; ++bj) { const int col = u.pn * 256 + bj * 128 + wc * 32 + 8 * fq;
                    f32x4 y0, y1;
#pragma unroll
                    for (int j = 0; j < 4; ++j) { const float v0 = fmaxf(acc[ai][bj][m][0][j], 0.f), v1 = fmaxf(acc[ai][bj][m][1][j], 0.f); y0[j] = v0 * v0; y1[j] = v1 * v1; }
                    *(u32x4*)(h + r * 4096 + col) = pack8(y0, y1); } }
        return true;
    }
};

struct PDown {
    static constexpr bool PERM = true;
    int K, lda, ldb, G, c;
    const bf16_t* A; const bf16_t* Bt; bf16_t* T; float* R; float* part;
    __device__ __forceinline__ int nt(const Unit& u) const { return u.z < 0 ? 64 : 16; }
    __device__ __forceinline__ bool next(int i, Unit& u) const {
        const int nP = c < 256 ? (256 - c + G - 1) / G : 0;
        if (i < nP) { tile_map(i * G + c, 64, 4, u.pm, u.pn); u.z = -1; return true; }
        const int j = (i - nP) * G + c; if (j >= 32) return false;
        u.pm = 64 + (j >> 4); u.pn = (j >> 2) & 3; u.z = j & 3; return true; }
    __device__ __forceinline__ const char* aptr(const Unit& u) const { return (const char*)A + (size_t)u.pm * 256 * 4096 * 2 + (u.z < 0 ? 0 : u.z * 2048); }
    __device__ __forceinline__ const char* bptr(const Unit& u) const { return (const char*)Bt + (size_t)u.pn * 256 * 4096 * 2 + (u.z < 0 ? 0 : u.z * 2048); }
    __device__ __forceinline__ bool epi(Acc& acc, const Unit& u, int wr, int wc, int fr, int fq) const {
#pragma unroll
        for (int ai = 0; ai < 2; ++ai)
#pragma unroll
            for (int m = 0; m < 4; ++m) { const size_t r = (size_t)u.pm * 256 + ai * 128 + wr * 64 + m * 16 + fr;
#pragma unroll
                for (int bj = 0; bj < 2; ++bj) { const int col = u.pn * 256 + bj * 128 + wc * 32 + 8 * fq;
                    if (u.z < 0) *(u32x4*)(T + r * 1024 + col) = pack8(acc[ai][bj][m][0], acc[ai][bj][m][1]);
                    else { float* pp = (u.z == 0) ? R + r * 1024 + col : part + (size_t)(u.z - 1) * PART_STRIDE + (r - MP) * 1024 + col;
                        *(f32x4*)pp = acc[ai][bj][m][0]; *(f32x4*)(pp + 4) = acc[ai][bj][m][1]; } } }
        return true;
    }
};

__device__ __forceinline__ void tdec(AP a, int layer, int t, const float*& W, bf16_t*& Wt, int& K, int& N, int& tk, int& tn4, int& c0, int& c1, int& c2, int& c3) {
    unsigned char* ws = a->ws; int tt;
    if (t < 384) { tt = t; W = a->in[I_WIN] + (size_t)layer * 1024 * 6144; Wt = (bf16_t*)(ws + OFF_WIN); K = 1024; N = 6144; }
    else if (t < 480) { const int q = (t - 384) / 32; tt = (t - 384) % 32; W = a->in[I_PA + q] + (size_t)layer * 512 * 1024; Wt = (bf16_t*)(ws + OFF_WP) + (size_t)q * 1024 * 512; K = 512; N = 1024; }
    else if (t < 496) { tt = t - 480; W = a->in[I_GLW] + (size_t)layer * 512 * 512; Wt = (bf16_t*)(ws + OFF_WGLU); K = 512; N = 512; }
    else if (t < 560) { tt = t - 496; W = a->in[I_WO] + (size_t)layer * 1024 * 1024; Wt = (bf16_t*)(ws + OFF_WOUT); K = 1024; N = 1024; }
    else if (t < 816) { tt = t - 560; W = a->in[I_UP] + (size_t)layer * 1024 * 4096; Wt = (bf16_t*)(ws + OFF_WUP); K = 1024; N = 4096; }
    else { tt = t - 816; W = a->in[I_DN] + (size_t)layer * 4096 * 1024; Wt = (bf16_t*)(ws + OFF_WDOWN); K = 4096; N = 1024; }
    const int ntn = N / 256; tk = tt / ntn; tn4 = tt % ntn;
    c0 = tn4 * 256; c2 = c0 + 128;
    if (t < 384 && tn4 >= 6 && tn4 < 10) { c0 = 1536 + 128 * (tn4 - 6); c2 = 2048 + 128 * (tn4 - 6); }
    c1 = c0 + 64; c3 = c2 + 64;
}
__device__ __forceinline__ void tload(const float* W, int N, int tk, int c0, int c1, int c2, int c3, int tid, f32x4 (&v)[4][2]) {
    const int r = tid >> 3, c8 = (tid & 7) * 8; const float* src = W + (size_t)(tk * 64 + r) * N + c8;
    v[0][0] = *(const f32x4*)(src + c0); v[0][1] = *(const f32x4*)(src + c0 + 4); v[1][0] = *(const f32x4*)(src + c1); v[1][1] = *(const f32x4*)(src + c1 + 4);
    v[2][0] = *(const f32x4*)(src + c2); v[2][1] = *(const f32x4*)(src + c2 + 4); v[3][0] = *(const f32x4*)(src + c3); v[3][1] = *(const f32x4*)(src + c3 + 4);
}

__device__ __forceinline__ void abar_pow(const float* are, const float* aim, const float* ldt, int sp, float e, float& pr, float& pi) {
    const float step = expf(ldt[sp]); const float x = e * step * are[sp], th = e * step * aim[sp];
    float s, c; sincosf(th, &s, &c); const float mg = expf(x); pr = mg * c; pi = mg * s;
}
__device__ __forceinline__ void ssm_coef(const float* are, const float* aim, const float* ldt, int sp, float& cr, float& ci) {
    const float step = expf(ldt[sp]); const float ar = are[sp], ai = aim[sp];
    const float x = step * ar, th = step * ai;
    float s, c; sincosf(th, &s, &c); const float em1 = expm1f(x); const float sh = sinf(0.5f * th);
    const float nr = em1 * c - 2.0f * sh * sh, ni = (em1 + 1.0f) * s;
    const float den = ar * ar + ai * ai;
    cr = (nr * ar + ni * ai) / den; ci = (ni * ar - nr * ai) / den;
}

__device__ __forceinline__ void prep_layer(AP a, int layer, float* sm, const int wv_) {
    unsigned char* ws = a->ws;
    const int G = gridDim.x;
    {
        const int tid = otid(wv_), r = tid >> 3, c8 = (tid & 7) * 8, n = tid >> 3, k8 = (tid & 7) * 8;
        int t = blockIdx.x; f32x4 v[4][2];
        const float* W = nullptr; bf16_t* Wt = nullptr; int K = 0, N = 0, tk = 0, tn4 = 0, c0 = 0, c1 = 0, c2 = 0, c3 = 0;
        if (t < 1072) { tdec(a, layer, t, W, Wt, K, N, tk, tn4, c0, c1, c2, c3); tload(W, N, tk, c0, c1, c2, c3, tid, v); }
        while (t < 1072) {
#pragma unroll
            for (int q = 0; q < 4; ++q)
#pragma unroll
                for (int e = 0; e < 4; ++e) { sm[q * 4160 + r * 65 + c8 + e] = v[q][0][e]; sm[q * 4160 + r * 65 + c8 + 4 + e] = v[q][1][e]; }
            __syncthreads();
            bf16_t* const cWt = Wt; const int cK = K, ctk = tk, ctn4 = tn4; const int tn = t + G;
            if (tn < 1072) { tdec(a, layer, tn, W, Wt, K, N, tk, tn4, c0, c1, c2, c3); tload(W, N, tk, c0, c1, c2, c3, tid, v); }
#pragma unroll
            for (int q = 0; q < 4; ++q) { const float* tt = sm + q * 4160;
                u32x4 w;
                w.x = cvt_pk_bf16(tt[(k8 + 0) * 65 + n], tt[(k8 + 1) * 65 + n]); w.y = cvt_pk_bf16(tt[(k8 + 2) * 65 + n], tt[(k8 + 3) * 65 + n]);
                w.z = cvt_pk_bf16(tt[(k8 + 4) * 65 + n], tt[(k8 + 5) * 65 + n]); w.w = cvt_pk_bf16(tt[(k8 + 6) * 65 + n], tt[(k8 + 7) * 65 + n]);
                *(u32x4*)(cWt + (size_t)(ctn4 * 256 + q * 64 + n) * cK + ctk * 64 + k8) = w; }
            __syncthreads();
            t = tn;
        }
    }
    const int GT = G * NTHR;
    {
        bf16_t* wg = (bf16_t*)(ws + OFF_WGATE);
        for (int idx = blockIdx.x * NTHR + otid(wv_); idx < 1024 * 32; idx += GT) {
            const int n = idx >> 5, k0 = (idx & 31) * 8; const int pn = n >> 8, bj = (n >> 7) & 1, ch = pn * 128 + (n & 127), hd = ch >> 6, j = ch & 63;
            u32x4 w = (u32x4){0u, 0u, 0u, 0u};
            if ((pn >> 1) * 4 + (k0 >> 6) == hd) { const float* src = a->in[bj ? I_GAW : I_GXW] + (size_t)layer * 8 * 64 * 64 + (size_t)hd * 4096 + (size_t)(k0 & 63) * 64 + j;
                w.x = cvt_pk_bf16(src[0], src[64]); w.y = cvt_pk_bf16(src[128], src[192]); w.z = cvt_pk_bf16(src[256], src[320]); w.w = cvt_pk_bf16(src[384], src[448]); }
            *(u32x4*)(wg + (size_t)n * 256 + k0) = w;
        }
    }
    const float* are = a->in[I_SAR] + layer * 2048; const float* aim = a->in[I_SAI] + layer * 2048; const float* ldt = a->in[I_SDT] + layer * 2048;
    const float* bre = a->in[I_SBR] + layer * 32768; const float* bim = a->in[I_SBI] + layer * 32768;
    const float* cre = a->in[I_SCR] + layer * 32768; const float* cim = a->in[I_SCI] + layer * 32768;
    {
        bf16_t* w1 = (bf16_t*)(ws + OFF_W1T);
        for (int idx = blockIdx.x * NTHR + otid(wv_); idx < 32 * 128 * 32; idx += GT) {
            const int g = idx >> 12, n = (idx >> 5) & 127, k0 = (idx & 31) * 8, j = k0 >> 4, c0 = k0 & 15, p = n & 63, part = n >> 6, sp = g * 64 + p;
            float pr, pi, cr, ci; abar_pow(are, aim, ldt, sp, (float)(15 - j), pr, pi); ssm_coef(are, aim, ldt, sp, cr, ci);
            const float qr = pr * cr - pi * ci, qi = pr * ci + pi * cr;
            float o[8];
#pragma unroll
            for (int q = 0; q < 8; ++q) { const float br = bre[sp * 16 + c0 + q], bi = bim[sp * 16 + c0 + q]; o[q] = part ? (qr * bi + qi * br) : (qr * br - qi * bi); }
            u32x4 w; w.x = cvt_pk_bf16(o[0], o[1]); w.y = cvt_pk_bf16(o[2], o[3]); w.z = cvt_pk_bf16(o[4], o[5]); w.w = cvt_pk_bf16(o[6], o[7]);
            *(u32x4*)(w1 + ((size_t)(g * 128 + n) * 256 + k0)) = w;
        }
    }
    {
        bf16_t* wy = (bf16_t*)(ws + OFF_WYT);
        for (int idx = blockIdx.x * NTHR + otid(wv_); idx < 32 * 256 * 16; idx += GT) {
            const int g = idx >> 12, n = (idx >> 4) & 255, k0 = (idx & 15) * 8, i = n >> 4, c = n & 15, part = k0 >> 6, p0 = k0 & 63;
            float o[8];
#pragma unroll
            for (int q = 0; q < 8; ++q) { const int p = p0 + q, sp = g * 64 + p; float pr, pi; abar_pow(are, aim, ldt, sp, (float)(i + 1), pr, pi);
                const float xr = cre[(g * 16 + c) * 64 + p], xi = cim[(g * 16 + c) * 64 + p];
                o[q] = part ? -(xr * pi + xi * pr) : (xr * pr - xi * pi); }
            u32x4 w; w.x = cvt_pk_bf16(o[0], o[1]); w.y = cvt_pk_bf16(o[2], o[3]); w.z = cvt_pk_bf16(o[4], o[5]); w.w = cvt_pk_bf16(o[6], o[7]);
            *(u32x4*)(wy + ((size_t)(g * 256 + n) * 384 + k0)) = w;
        }
        for (int idx = blockIdx.x * NTHR + otid(wv_); idx < 32 * 256 * 16; idx += GT) {
            const int pq = idx & 15, c2 = (idx >> 4) & 15, c = (idx >> 8) & 15, g = idx >> 12;
            float km[16];
#pragma unroll
            for (int d = 0; d < 16; ++d) km[d] = 0.f;
#pragma unroll
            for (int pp = 0; pp < 4; ++pp) { const int p = pq * 4 + pp, sp = g * 64 + p; float ar, ai, cr, ci; abar_pow(are, aim, ldt, sp, 1.0f, ar, ai); ssm_coef(are, aim, ldt, sp, cr, ci);
                const float br = bre[sp * 16 + c2], bi = bim[sp * 16 + c2];
                const float bbr = cr * br - ci * bi, bbi = cr * bi + ci * br;
                const float xr = cre[(g * 16 + c) * 64 + p], xi = cim[(g * 16 + c) * 64 + p];
                float tr = xr * bbr - xi * bbi, ti = xr * bbi + xi * bbr;
#pragma unroll
                for (int d = 0; d < 16; ++d) { km[d] += tr; const float nr = tr * ar - ti * ai, ni = tr * ai + ti * ar; tr = nr; ti = ni; } }
            { const int ln = idx & 63;
#pragma unroll
            for (int d = 0; d < 16; ++d) { km[d] += shx(km[d], 1, ln); km[d] += shx(km[d], 2, ln); km[d] += shx(km[d], 4, ln); km[d] += shx(km[d], 8, ln); } }
            if (c == c2) km[0] += a->in[I_SD][layer * 512 + g * 16 + c];
#pragma unroll
            for (int d = 0; d < 16; ++d) if (d == pq) { const bf16_t kb = f2bf(km[d]);
                for (int i = d; i < 16; ++i) wy[(size_t)(g * 256 + i * 16 + c) * 384 + 128 + (i - d) * 16 + c2] = kb;
                if (d > 0) for (int i = 0; i < 16 - d; ++i) wy[(size_t)(g * 256 + i * 16 + c) * 384 + 128 + (i + d) * 16 + c2] = (bf16_t)0; }
        }
    }
}

__device__ __forceinline__ void prep_x(AP a, const int wv_) {
    bf16_t* xb = (bf16_t*)(a->ws + OFF_XB);
    const int gt = blockIdx.x * NTHR + otid(wv_), GT = gridDim.x * NTHR;
    for (int idx = gt; idx < M * 128; idx += GT) {
        const size_t e = (size_t)idx * 8; const float* src = e < (size_t)MP * 1024 ? a->in[I_XP] + e : a->in[I_XS] + (e - (size_t)MP * 1024);
        const f32x4 v0 = *(const f32x4*)src, v1 = *(const f32x4*)(src + 4);
        *(u32x4*)(xb + e) = pack8(v0, v1);
    }
}

__device__ __forceinline__ void conv_phase(AP a, int layer, bf16_t* bin_out, const int wv_) {
    unsigned char* ws = a->ws;
    const bf16_t* xa = (const bf16_t*)(ws + OFF_R); bf16_t* sb = (bf16_t*)(ws + OFF_R + S17);
    const bf16_t* sc = (const bf16_t*)(ws + OFF_R + 2 * S17);
    bf16_t* xac = (bf16_t*)(ws + OFF_XB);
    const float* caw = a->in[I_CAW] + layer * 4 * 512; const float* cab = a->in[I_CAB] + layer * 512; const float* cbw = a->in[I_CBW] + layer * 3 * 512;
    const int gt = blockIdx.x * NTHR + otid(wv_), GT = gridDim.x * NTHR;
#pragma unroll 1
    for (int pass = 0; pass < 2; ++pass) {
        int idx;
        if (pass == 0) { idx = gt; if (idx >= 2048 * 64) continue; }
        else { const int j = gt - (GT >> 1); if (j < 0 || j >= 128 * 64) continue; idx = 2048 * 64 + j; }
        const int seg = idx >> 6, c0 = (idx & 63) * 8;
        const bool prompt = seg < 2048;
        int row0, nrows;
        float x0[8], x1[8], x2[8], u1[8], u2[8];
        if (prompt) { row0 = seg * 8; nrows = 8; const bool first = (seg & 255) == 0;
            if (first) {
#pragma unroll
                for (int j = 0; j < 8; ++j) { x0[j] = 0.f; x1[j] = 0.f; x2[j] = 0.f; u1[j] = 0.f; u2[j] = 0.f; }
            } else {
                unpack8(*(const u32x4*)(xa + (size_t)(row0 - 3) * 512 + c0), x0); unpack8(*(const u32x4*)(xa + (size_t)(row0 - 2) * 512 + c0), x1); unpack8(*(const u32x4*)(xa + (size_t)(row0 - 1) * 512 + c0), x2);
                unpack8(*(const u32x4*)(sc + (size_t)(row0 - 2) * 512 + c0), u1);
                unpack8(*(const u32x4*)(sc + (size_t)(row0 - 1) * 512 + c0), u2);
            }
        } else { const int b = seg - 2048; row0 = MP + b * 4; nrows = 4;
            const float* lc = a->in[I_SLC] + ((size_t)(layer * 128 + b) * 3) * 512 + c0; const float* scs = a->in[I_SSC] + ((size_t)(layer * 128 + b) * 2) * 512 + c0;
#pragma unroll
            for (int j = 0; j < 8; ++j) { x0[j] = lc[j]; x1[j] = lc[512 + j]; x2[j] = lc[1024 + j]; u1[j] = scs[j]; u2[j] = scs[512 + j]; }
        }
        float w0[8], w1[8], w2[8], w3[8], wb[8], v0[8], v1[8], v2[8];
#pragma unroll
        for (int j = 0; j < 8; ++j) { w0[j] = caw[c0 + j]; w1[j] = caw[512 + c0 + j]; w2[j] = caw[1024 + c0 + j]; w3[j] = caw[1536 + c0 + j]; wb[j] = cab[c0 + j];
            v0[j] = cbw[c0 + j]; v1[j] = cbw[512 + c0 + j]; v2[j] = cbw[1024 + c0 + j]; }
        for (int t0 = 0; t0 < nrows; t0 += 2) {
            u32x4 lx[2], lc[2], lb[2];
#pragma unroll
            for (int k = 0; k < 2; ++k) { const size_t off = (size_t)(row0 + t0 + k) * 512 + c0;
                lx[k] = *(const u32x4*)(xa + off); lc[k] = *(const u32x4*)(sc + off); lb[k] = *(const u32x4*)(sb + off); }
#pragma unroll
            for (int k = 0; k < 2; ++k) { const size_t off = (size_t)(row0 + t0 + k) * 512 + c0;
                float xv[8], scv[8], sbv[8];
                unpack8(lx[k], xv); unpack8(lc[k], scv); unpack8(lb[k], sbv);
                f32x4 o0, o1, q0, q1;
#pragma unroll
                for (int j = 0; j < 8; ++j) {
                    const float o = w0[j] * x0[j] + w1[j] * x1[j] + w2[j] * x2[j] + w3[j] * xv[j] + wb[j];
                    const float uu = scv[j]; const float cu = v0[j] * u1[j] + v1[j] * u2[j] + v2[j] * uu; const float bi = sbv[j] * cu;
                    if (j < 4) { o0[j] = o; q0[j] = bi; } else { o1[j - 4] = o; q1[j - 4] = bi; }
                    x0[j] = x1[j]; x1[j] = x2[j]; x2[j] = xv[j]; u1[j] = u2[j]; u2[j] = uu;
                }
                *(u32x4*)(xac + off) = pack8(o0, o1);
                *(u32x4*)(bin_out + off) = pack8(q0, q1); }
        }
        if (prompt) { if ((seg & 255) == 255) { const int b = seg >> 8;
                float* o1 = a->out + O_LCP + ((size_t)(layer * 8 + b) * 3) * 512 + c0; float* o2 = a->out + O_SCP + ((size_t)(layer * 8 + b) * 2) * 512 + c0;
#pragma unroll
                for (int j = 0; j < 8; ++j) { o1[j] = x0[j]; o1[512 + j] = x1[j]; o1[1024 + j] = x2[j]; o2[j] = u1[j]; o2[512 + j] = u2[j]; } }
        } else { const int b = seg - 2048;
            float* o1 = a->out + O_LCS + ((size_t)(layer * 128 + b) * 3) * 512 + c0; float* o2 = a->out + O_SCS + ((size_t)(layer * 128 + b) * 2) * 512 + c0;
#pragma unroll
            for (int j = 0; j < 8; ++j) { o1[j] = x0[j]; o1[512 + j] = x1[j]; o1[1024 + j] = x2[j]; o2[j] = u1[j]; o2[512 + j] = u2[j]; }
        }
    }
}

__device__ __forceinline__ void ssm_s_gemm(AP a, const int wv_) {
    const bf16_t* apack = (const bf16_t*)(a->ws + OFF_APACK); const bf16_t* w1 = (const bf16_t*)(a->ws + OFF_W1T); float* S = (float*)(a->ws + OFF_S);
    const int tid_ = otid(wv_); const int lane = tid_ & 63, wv = blockIdx.x * 8 + (tid_ >> 6), NW = gridDim.x * 8;
    const int lr = lane & 15, kq = lane >> 4;
    for (int t = wv; t < 1024; t += NW) {
        const int g = t >> 5, rt = (t >> 1) & 15, ct = t & 1;
        f32x4 acc[4][4];
#pragma unroll
        for (int i = 0; i < 4; ++i)
#pragma unroll
            for (int j = 0; j < 4; ++j) acc[i][j] = (f32x4){0.f, 0.f, 0.f, 0.f};
        const bf16_t* ab = apack + ((size_t)(g * 1024 + rt * 64 + lr) * 384 + 128 + kq * 8);
        const bf16_t* bb = w1 + ((size_t)(g * 128 + ct * 64 + lr) * 256 + kq * 8);
#pragma unroll 2
        for (int ks = 0; ks < 8; ++ks) {
            bf16x8 af[4], bf[4];
#pragma unroll
            for (int i = 0; i < 4; ++i) { af[i] = *(const bf16x8*)(ab + (size_t)i * 16 * 384 + ks * 32); bf[i] = *(const bf16x8*)(bb + (size_t)i * 16 * 256 + ks * 32); }
#pragma unroll
            for (int i = 0; i < 4; ++i)
#pragma unroll
                for (int j = 0; j < 4; ++j) acc[i][j] = __builtin_amdgcn_mfma_f32_16x16x32_bf16(bf[j], af[i], acc[i][j], 0, 0, 0);
        }
#pragma unroll
        for (int i = 0; i < 4; ++i)
#pragma unroll
            for (int j = 0; j < 4; ++j) *(f32x4*)(S + (size_t)(g * 1024 + rt * 64 + i * 16 + lr) * 128 + ct * 64 + j * 16 + kq * 4) = acc[i][j];
    }
}

__device__ __forceinline__ void ssm_carry(AP a, int layer, float* sm, const int wv_) {
    bf16_t* apack = (bf16_t*)(a->ws + OFF_APACK); const float* S = (const float*)(a->ws + OFF_S);
    const int tid = otid(wv_), p = tid & 63, seg = tid >> 6;
    for (int pair = blockIdx.x; pair < 256; pair += gridDim.x) {
        const int b = pair >> 5, g = pair & 31, sp = g * 64 + p;
        float ar, ai, Ar, Ai;
        abar_pow(a->in[I_SAR] + layer * 2048, a->in[I_SAI] + layer * 2048, a->in[I_SDT] + layer * 2048, sp, 16.0f, ar, ai);
        abar_pow(a->in[I_SAR] + layer * 2048, a->in[I_SAI] + layer * 2048, a->in[I_SDT] + layer * 2048, sp, 256.0f, Ar, Ai);
        const size_t rbase = (size_t)g * 1024 + b * 128 + seg * 16;
        float sr[16], si[16];
#pragma unroll
        for (int j = 0; j < 16; ++j) { sr[j] = S[(rbase + j) * 128 + p]; si[j] = S[(rbase + j) * 128 + 64 + p]; }
        float hr = 0.f, hi = 0.f;
#pragma unroll
        for (int j = 0; j < 16; ++j) { const float nr = ar * hr - ai * hi + sr[j], ni = ar * hi + ai * hr + si[j]; sr[j] = hr; si[j] = hi; hr = nr; hi = ni; }
        sm[seg * 128 + p] = hr; sm[seg * 128 + 64 + p] = hi;
        __syncthreads();
        float cr = 0.f, ci = 0.f;
        for (int s2 = 0; s2 < seg; ++s2) { const float er = sm[s2 * 128 + p], ei = sm[s2 * 128 + 64 + p]; const float nr = Ar * cr - Ai * ci + er, ni = Ar * ci + Ai * cr + ei; cr = nr; ci = ni; }
        if (seg == 7) { const float fr_ = Ar * cr - Ai * ci + hr, fi_ = Ar * ci + Ai * cr + hi;
            a->out[O_SRP + (size_t)(layer * 8 + b) * 2048 + sp] = fr_; a->out[O_SIP + (size_t)(layer * 8 + b) * 2048 + sp] = fi_; }
#pragma unroll
        for (int j = 0; j < 16; ++j) { apack[(rbase + j) * 384 + p] = f2bf(sr[j] + cr); apack[(rbase + j) * 384 + 64 + p] = f2bf(si[j] + ci);
            const float nr = ar * cr - ai * ci, ni = ar * ci + ai * cr; cr = nr; ci = ni; }
        __syncthreads();
    }
}

__device__ __forceinline__ void ssm_sample(AP a, int layer, int wv, int NW, const int wv_) {
    const bf16_t* uss = (const bf16_t*)(a->ws + OFF_USS); bf16_t* zc = (bf16_t*)(a->ws + OFF_ZCS);
    const float* are = a->in[I_SAR] + layer * 2048; const float* aim = a->in[I_SAI] + layer * 2048; const float* ldt = a->in[I_SDT] + layer * 2048;
    const float* bre = a->in[I_SBR] + layer * 32768; const float* bim = a->in[I_SBI] + layer * 32768;
    const float* cre = a->in[I_SCR] + layer * 32768; const float* cim = a->in[I_SCI] + layer * 32768; const float* dv = a->in[I_SD] + layer * 512;
    const int lane = otid(wv_) & 63;
    for (int t = wv; t < 128 * 32; t += NW) {
        const int b = t >> 5, g = t & 31, sp = g * 64 + lane;
        float ar, ai, cr, ci; abar_pow(are, aim, ldt, sp, 1.0f, ar, ai); ssm_coef(are, aim, ldt, sp, cr, ci);
        float bbr[16], bbi[16], xr[16], xi[16];
#pragma unroll
        for (int c = 0; c < 16; ++c) { const float br = bre[sp * 16 + c], bi = bim[sp * 16 + c]; bbr[c] = cr * br - ci * bi; bbi[c] = cr * bi + ci * br;
            xr[c] = cre[(g * 16 + c) * 64 + lane]; xi[c] = cim[(g * 16 + c) * 64 + lane]; }
        float hr = a->in[I_SSR][(size_t)(layer * 128 + b) * 2048 + sp], hi = a->in[I_SSI][(size_t)(layer * 128 + b) * 2048 + sp];
        const float dme = lane < 16 ? dv[g * 16 + lane] : 0.f;
        for (int tt = 0; tt < 4; ++tt) {
            const bf16_t* up = uss + (size_t)(b * 4 + tt) * 512 + g * 16;
            const u32x4 w0 = *(const u32x4*)up, w1 = *(const u32x4*)(up + 8);
            float u[16]; { float t0[8], t1[8]; unpack8(w0, t0); unpack8(w1, t1);
#pragma unroll
                for (int c = 0; c < 8; ++c) { u[c] = t0[c]; u[8 + c] = t1[c]; } }
            float br_ = 0.f, bi_ = 0.f;
#pragma unroll
            for (int c = 0; c < 16; ++c) { br_ += bbr[c] * u[c]; bi_ += bbi[c] * u[c]; }
            const float nr = ar * hr - ai * hi + br_, ni = ar * hi + ai * hr + bi_; hr = nr; hi = ni;
            float mine = 0.f, ume = 0.f;
#pragma unroll
            for (int c = 0; c < 16; ++c) { float y = xr[c] * hr - xi[c] * hi;
#pragma unroll
                for (int o = 32; o >= 1; o >>= 1) y += shx(y, o, lane);
                if (lane == c) { mine = y; ume = u[c]; } }
            if (lane < 16) zc[(size_t)(b * 4 + tt) * 512 + g * 16 + lane] = f2bf(gelu_t(mine + dme * ume));
        }
        a->out[O_SRS + (size_t)(layer * 128 + b) * 2048 + sp] = hr; a->out[O_SIS + (size_t)(layer * 128 + b) * 2048 + sp] = hi;
    }
}

typedef _Float16 h2_t __attribute__((ext_vector_type(2)));
__device__ __forceinline__ void lru_local(AP a, const int wv_) {
    const _Float16* av = (const _Float16*)(a->ws + OFF_R + 2 * S17); const bf16_t* bx = (const bf16_t*)(a->ws + OFF_R); f32x4* car = (f32x4*)(a->ws + OFF_CAR2);
    const int gt = blockIdx.x * NTHR + otid(wv_), GT = gridDim.x * NTHR;
    for (int idx = gt; idx < 8 * 64 * 256; idx += GT) {
        const int cp = idx & 255, sc = idx >> 8;
        const size_t base = (size_t)sc * 32 * 512 + 2 * cp;
        float P0 = 1.f, h0 = 0.f, P1 = 1.f, h1 = 0.f;
        for (int t0 = 0; t0 < 32; t0 += 16) {
            h2_t al[16]; unsigned bb[16];
#pragma unroll
            for (int j = 0; j < 16; ++j) { al[j] = *(const h2_t*)(av + base + (size_t)(t0 + j) * 512); bb[j] = *(const unsigned*)(bx + base + (size_t)(t0 + j) * 512); }
#pragma unroll
            for (int j = 0; j < 16; ++j) { const float a0 = __expf((float)al[j][0]), a1 = __expf((float)al[j][1]);
                h0 = a0 * h0 + bflo(bb[j]); P0 *= a0; h1 = a1 * h1 + bfhi(bb[j]); P1 *= a1; }
        }
        car[idx] = (f32x4){P0, h0, P1, h1};
    }
}
template <int B>
__device__ __forceinline__ float lru_run(const _Float16* av, const bf16_t* bx, bf16_t* ao, const bf16_t* ya, size_t base, int n, float h) {
    for (int t0 = 0; t0 < n; t0 += B) {
        _Float16 aa[B]; bf16_t bb[B], yy[B];
#pragma unroll
        for (int j = 0; j < B; ++j) { const size_t o = base + (size_t)(t0 + j) * 512; aa[j] = av[o]; bb[j] = bx[o]; yy[j] = ya[o]; }
        bf16_t oo[B];
#pragma unroll
        for (int j = 0; j < B; ++j) { h = __expf((float)aa[j]) * h + bf2f(bb[j]); oo[j] = f2bf(h * gelu_t(bf2f(yy[j]))); }
#pragma unroll
        for (int j = 0; j < B; ++j) ao[base + (size_t)(t0 + j) * 512] = oo[j];
    }
    return h;
}
__device__ __forceinline__ void lru_apply(AP a, int layer, bf16_t* ao, int mode, const int wv_) {
    const _Float16* av = (const _Float16*)(a->ws + OFF_R + 2 * S17); const bf16_t* bx = (const bf16_t*)(a->ws + OFF_R); const f32x2* car = (const f32x2*)(a->ws + OFF_CAR);
    const bf16_t* ya = (const bf16_t*)(a->ws + OFF_YA);
    const int G = gridDim.x, bid = blockIdx.x;
    if (mode == 0) {
        const f32x4* car4 = (const f32x4*)(a->ws + OFF_CAR2);
        for (int idx = bid * NTHR + otid(wv_); idx < 8 * 64 * 256; idx += G * NTHR) {
            const int cp = idx & 255, sc = idx >> 8, seq = sc >> 6, chunk = sc & 63;
            float h0 = 0.f, h1 = 0.f;
            for (int k0 = 0; k0 < 64; k0 += 16) {
                if (k0 < chunk) {
                    f32x4 ph[16];
#pragma unroll
                    for (int k = 0; k < 16; ++k) ph[k] = car4[(seq * 64 + (k0 + k < chunk ? k0 + k : 0)) * 256 + cp];
#pragma unroll
                    for (int k = 0; k < 16; ++k) if (k0 + k < chunk) { h0 = ph[k][0] * h0 + ph[k][1]; h1 = ph[k][2] * h1 + ph[k][3]; }
                }
            }
            const size_t base = (size_t)sc * 32 * 512 + 2 * cp;
            for (int t0 = 0; t0 < 32; t0 += 8) {
                h2_t aa[8]; unsigned bb[8], yy[8], oo[8];
#pragma unroll
                for (int j = 0; j < 8; ++j) { const size_t o = base + (size_t)(t0 + j) * 512; aa[j] = *(const h2_t*)(av + o); bb[j] = *(const unsigned*)(bx + o); yy[j] = *(const unsigned*)(ya + o); }
#pragma unroll
                for (int j = 0; j < 8; ++j) { h0 = __expf((float)aa[j][0]) * h0 + bflo(bb[j]); h1 = __expf((float)aa[j][1]) * h1 + bfhi(bb[j]);
                    oo[j] = cvt_pk_bf16(h0 * gelu_t(bflo(yy[j])), h1 * gelu_t(bfhi(yy[j]))); }
#pragma unroll
                for (int j = 0; j < 8; ++j) *(unsigned*)(ao + base + (size_t)(t0 + j) * 512) = oo[j];
            }
            if (chunk == 63) { float* ho = a->out + O_LHP + (size_t)(layer * 8 + seq) * 512 + 2 * cp; ho[0] = h0; ho[1] = h1; }
        }
    } else {
        for (int j = bid * NTHR + otid(wv_); j < 128 * 256; j += G * NTHR) {
            const int cp = j & 255, b = j >> 8;
            const float* hs = a->in[I_SLH] + (size_t)(layer * 128 + b) * 512 + 2 * cp;
            float h0 = hs[0], h1 = hs[1];
            const size_t base = (size_t)(MP + b * 4) * 512 + 2 * cp;
            h2_t aa[4]; unsigned bb[4], yy[4], oo[4];
#pragma unroll
            for (int t = 0; t < 4; ++t) { const size_t o = base + (size_t)t * 512; aa[t] = *(const h2_t*)(av + o); bb[t] = *(const unsigned*)(bx + o); yy[t] = *(const unsigned*)(ya + o); }
#pragma unroll
            for (int t = 0; t < 4; ++t) { h0 = __expf((float)aa[t][0]) * h0 + bflo(bb[t]); h1 = __expf((float)aa[t][1]) * h1 + bfhi(bb[t]);
                oo[t] = cvt_pk_bf16(h0 * gelu_t(bflo(yy[t])), h1 * gelu_t(bfhi(yy[t]))); }
#pragma unroll
            for (int t = 0; t < 4; ++t) *(unsigned*)(ao + base + (size_t)t * 512) = oo[t];
            float* ho = a->out + O_LHS + (size_t)(layer * 128 + b) * 512 + 2 * cp; ho[0] = h0; ho[1] = h1;
        }
    }
}

template <bool RES16>
__device__ __forceinline__ void ln_phase(const bf16_t* T, const float* Rs, const float* part, const float* resp, const float* ress, const bf16_t* res16,
                                         float* dst32, bf16_t* dst16, const float* gam, const float* bet, const int wv_) {
    const int tid_ = otid(wv_); const int lane = tid_ & 63, wv = blockIdx.x * 8 + (tid_ >> 6), NW = gridDim.x * 8;
    for (int r0 = wv; r0 < M; r0 += 3 * NW) {
        f32x4 v[3][4];
#pragma unroll
        for (int k = 0; k < 3; ++k) { const int rr = r0 + k * NW; const int r = rr < M ? rr : r0;
            if (r < MP) {
#pragma unroll
                for (int i = 0; i < 4; ++i) { const u32x2 w = *(const u32x2*)(T + (size_t)r * 1024 + i * 256 + lane * 4); v[k][i] = (f32x4){bflo(w.x), bfhi(w.x), bflo(w.y), bfhi(w.y)}; }
            } else {
#pragma unroll
                for (int i = 0; i < 4; ++i) v[k][i] = *(const f32x4*)(Rs + (size_t)r * 1024 + i * 256 + lane * 4);
#pragma unroll
                for (int q = 0; q < 3; ++q)
#pragma unroll
                    for (int i = 0; i < 4; ++i) v[k][i] += *(const f32x4*)(part + (size_t)q * PART_STRIDE + (size_t)(r - MP) * 1024 + i * 256 + lane * 4);
            }
            if (RES16) {
#pragma unroll
                for (int i = 0; i < 4; ++i) { const u32x2 w = *(const u32x2*)(res16 + (size_t)r * 1024 + i * 256 + lane * 4); v[k][i] += (f32x4){bflo(w.x), bfhi(w.x), bflo(w.y), bfhi(w.y)} * ALPHA; }
            } else { const float* rp = r < MP ? resp + (size_t)r * 1024 : ress + (size_t)(r - MP) * 1024;
#pragma unroll
                for (int i = 0; i < 4; ++i) v[k][i] += *(const f32x4*)(rp + i * 256 + lane * 4) * ALPHA;
            } }
#pragma unroll
        for (int k = 0; k < 3; ++k) { const int r = r0 + k * NW;
            float s = 0.f;
#pragma unroll
            for (int i = 0; i < 4; ++i) s += (v[k][i][0] + v[k][i][1]) + (v[k][i][2] + v[k][i][3]);
#pragma unroll
            for (int o = 32; o >= 1; o >>= 1) s += shx(s, o, lane);
            const float mu = s * (1.0f / 1024.0f); float q = 0.f;
#pragma unroll
            for (int i = 0; i < 4; ++i) { const f32x4 d = v[k][i] - mu; q += (d[0] * d[0] + d[1] * d[1]) + (d[2] * d[2] + d[3] * d[3]); }
#pragma unroll
            for (int o = 32; o >= 1; o >>= 1) q += shx(q, o, lane);
            const float rs = rsqrtf(q * (1.0f / 1024.0f) + LN_EPS);
            if (r < M) {
#pragma unroll
                for (int i = 0; i < 4; ++i) { const int col = i * 256 + lane * 4; const f32x4 gg = *(const f32x4*)(gam + col), bb = *(const f32x4*)(bet + col);
                    const f32x4 y = (v[k][i] - mu) * rs * gg + bb;
                    if (dst32) *(f32x4*)(dst32 + (size_t)r * 1024 + col) = y;
                    if (dst16) { u32x2 w; w.x = cvt_pk_bf16(y[0], y[1]); w.y = cvt_pk_bf16(y[2], y[3]);
                        *(u32x2*)(dst16 + (size_t)r * 1024 + col) = w; } }
            }
        }
    }
}

__global__ void __launch_bounds__(NTHR, 2) fwd_megakernel(Args a_unused) {
    extern __shared__ __attribute__((aligned(16))) unsigned char lds_raw[];
    cg::grid_group grid = cg::this_grid();
    LAS unsigned char* lds = (LAS unsigned char*)lds_raw;
    const int G = gridDim.x, bid = blockIdx.x;
    int wv_; { const int tw = (int)threadIdx.x >> 6; asm volatile("v_readfirstlane_b32 %0, %1" : "=s"(wv_) : "v"(tw)); }

    const unsigned long long t_start = PROBE_ON ? __builtin_amdgcn_s_memrealtime() : 0ull;
    for (int rep = 0; rep < REP_PREP; ++rep) { const AP a = ld_args(); prep_layer(a, 0, (float*)lds_raw, wv_); prep_x(a, wv_); }
    int pidx = 1; unsigned long long tA = PROBE_A == 0 ? t_start : 0ull, tB = 0ull;
    if (PROBE_ON) { if (PROBE_A == 1) tA = __builtin_amdgcn_s_memrealtime(); if (PROBE_B == 1) tB = __builtin_amdgcn_s_memrealtime(); }
    unsigned bar_n = 0; { const AP a = ld_args(); if (a->ws == nullptr) grid.sync(); }
    bar_n += (unsigned)G; gbar((unsigned*)(ld_args()->ws + OFF_BAR), bar_n, wv_);

#pragma unroll 1
    for (int layer = 0; layer < 2; ++layer) {
        { const AP a = ld_args(); unsigned char* ws = a->ws;
          PG1 p; p.K = 1024; p.lda = 1024; p.ldb = 1024; p.G = opq(G); p.c = opq(bid); p.A = layer == 0 ? (const bf16_t*)(ws + OFF_XB) : (const bf16_t*)a->out; p.Bt = (const bf16_t*)(ws + OFF_WIN);
          p.xa = (bf16_t*)(ws + OFF_R); p.ya = (bf16_t*)(ws + OFF_YA); p.sb = (bf16_t*)(ws + OFF_R + S17); p.sc = (bf16_t*)(ws + OFF_R + 2 * S17); p.sh = (bf16_t*)(ws + OFF_R + 3 * S17);
          p.apack = (bf16_t*)(ws + OFF_APACK); p.uss = (bf16_t*)(ws + OFF_USS); p.gl8 = ws + OFF_GL8;
          for (int rep = 0; rep < REP_G1; ++rep) gemm_phase(lds, p, wv_); }
        GSYNC();
        if (DRY_CONV) { const AP a = ld_args(); conv_phase(a, layer, (bf16_t*)(a->ws + OFF_XB + S17), wv_); }
        { const AP a = ld_args(); conv_phase(a, layer, (bf16_t*)(a->ws + OFF_R + S17), wv_); }
        for (int rep = 0; rep < REP_SG; ++rep) { const AP a = ld_args(); ssm_s_gemm(a, wv_); }
        GSYNC();
        for (int rep = 0; rep < REP_CARRY; ++rep) { const AP a = ld_args(); ssm_carry(a, layer, (float*)lds_raw, wv_); }
        { const AP a = ld_args(); unsigned char* ws = a->ws;
          PGate p; p.K = 256; p.lda = 512; p.ldb = 256; p.G = opq(G); p.c = opq(bid); p.A = (const bf16_t*)(ws + OFF_XB); p.Bt = (const bf16_t*)(ws + OFF_WGATE);
          p.gxb = a->in[I_GXB] + layer * 512; p.gab = a->in[I_GAB] + layer * 512; p.lam = a->in[I_LAM] + layer * 512;
          p.aout = (_Float16*)(ws + OFF_R + 2 * S17); p.bxout = (bf16_t*)(ws + OFF_R);
          for (int rep = 0; rep < REP_GATE; ++rep) gemm_phase(lds, p, wv_); }
        for (int rep = 0; rep < REP_SAMPLE; ++rep) if (bid >= 8) { const AP a = ld_args(); ssm_sample(a, layer, (bid - 8) * 8 + wv_, (G - 8) * 8, wv_); }
        GSYNC();
        { const AP a = ld_args(); unsigned char* ws = a->ws;
          PY p; p.K = 384; p.lda = 384; p.ldb = 384; p.G = opq(G); p.c = opq(bid); p.apack = (const bf16_t*)(ws + OFF_APACK); p.wyt = (const bf16_t*)(ws + OFF_WYT);
          p.dvec = a->in[I_SD] + layer * 512; p.zc = (bf16_t*)(ws + OFF_XB);
          for (int rep = 0; rep < REP_Y; ++rep) gemm_phase(lds, p, wv_); }
        { const AP a = ld_args(); unsigned char* ws = a->ws;
          PGlu p; p.K = 512; p.lda = 512; p.ldb = 512; p.G = opq(G); p.c = opq(bid); p.sample = 1; p.A = (const bf16_t*)(ws + OFF_XB); p.As = (const bf16_t*)(ws + OFF_ZCS); p.Bt = (const bf16_t*)(ws + OFF_WGLU);
          p.bias = a->in[I_GLB] + layer * 512; p.out = (bf16_t*)(ws + OFF_XB + S17);
          gemm_phase(lds, p, wv_); }
        { const AP a = ld_args(); lru_apply(a, layer, (bf16_t*)(a->ws + OFF_R), 1, wv_); }
        for (int rep = 0; rep < REP_LOCAL; ++rep) { const AP a = ld_args(); lru_local(a, wv_); }
        GSYNC();
        { const AP a = ld_args(); unsigned char* ws = a->ws;
          PGlu p; p.K = 512; p.lda = 512; p.ldb = 512; p.G = opq(G); p.c = opq(bid); p.sample = 0; p.A = (const bf16_t*)(ws + OFF_XB); p.As = (const bf16_t*)(ws + OFF_ZCS); p.Bt = (const bf16_t*)(ws + OFF_WGLU);
          p.bias = a->in[I_GLB] + layer * 512; p.out = (bf16_t*)(ws + OFF_XB + S17);
          for (int rep = 0; rep < REP_GLU; ++rep) gemm_phase(lds, p, wv_); }
        { const AP a = ld_args(); unsigned char* ws = a->ws;
          PMergeT<true> p; p.K = 512; p.lda = 512; p.ldb = 512; p.G = opq(G); p.c = opq(bid); p.a0 = (const bf16_t*)(ws + OFF_R);
          p.wp = (const bf16_t*)(ws + OFF_WP); p.gl8 = ws + OFF_GL8; p.mb = (bf16_t*)(ws + OFF_MB); p.pm3 = (float*)(ws + OFF_S);
          gemm_phase(lds, p, wv_); }
        if (DRY_APPLY) { const AP a = ld_args(); lru_apply(a, layer, (bf16_t*)(a->ws + OFF_S), 0, wv_); }
        { const AP a = ld_args(); lru_apply(a, layer, (bf16_t*)(a->ws + OFF_R), 0, wv_); }
        GSYNC();
        { const AP a = ld_args(); unsigned char* ws = a->ws;
          PMergeT<false> p; p.K = 512; p.lda = 512; p.ldb = 512; p.G = opq(G); p.c = opq(bid); p.a0 = (const bf16_t*)(ws + OFF_R);
          p.wp = (const bf16_t*)(ws + OFF_WP); p.gl8 = ws + OFF_GL8; p.mb = (bf16_t*)(ws + OFF_MB); p.pm3 = (float*)(ws + OFF_S);
          { const float* pm = (const float*)(ws + OFF_S); bf16_t* ms = (bf16_t*)(ws + OFF_MB) + (size_t)MP * 1024;
            for (int i = bid * NTHR + otid(wv_); i < MS * 128; i += G * NTHR) { const size_t e = (size_t)i * 8;
                f32x4 s0 = *(const f32x4*)(pm + e), s1 = *(const f32x4*)(pm + e + 4);
                s0 += *(const f32x4*)(pm + PART_STRIDE + e); s1 += *(const f32x4*)(pm + PART_STRIDE + e + 4);
                s0 += *(const f32x4*)(pm + 2 * PART_STRIDE + e); s1 += *(const f32x4*)(pm + 2 * PART_STRIDE + e + 4);
                *(u32x4*)(ms + e) = pack8(s0, s1); } }
          for (int rep = 0; rep < REP_MERGE; ++rep) gemm_phase(lds, p, wv_); }
        GSYNC();
        { const AP a = ld_args(); unsigned char* ws = a->ws;
          PWout p; p.K = 1024; p.lda = 1024; p.ldb = 1024; p.G = opq(G); p.c = opq(bid); p.A = (const bf16_t*)(ws + OFF_MB); p.Bt = (const bf16_t*)(ws + OFF_WOUT);
          p.T = (bf16_t*)(ws + OFF_R); p.R = (float*)(ws + OFF_R); p.part = (float*)(ws + OFF_PW);
          gemm_phase(lds, p, wv_); }
        GSYNC();
        { const AP a = ld_args(); unsigned char* ws = a->ws;
          if (layer == 0) ln_phase<false>((const bf16_t*)(ws + OFF_R), (const float*)(ws + OFF_R), (const float*)(ws + OFF_PW), a->in[I_XP], a->in[I_XS], (const bf16_t*)nullptr,
                          (float*)nullptr, (bf16_t*)(ws + OFF_XB), a->in[I_L1G] + layer * 1024, a->in[I_L1B] + layer * 1024, wv_);
          else ln_phase<true>((const bf16_t*)(ws + OFF_R), (const float*)(ws + OFF_R), (const float*)(ws + OFF_PW), (const float*)nullptr, (const float*)nullptr, (const bf16_t*)a->out,
                          (float*)nullptr, (bf16_t*)(ws + OFF_XB), a->in[I_L1G] + layer * 1024, a->in[I_L1B] + layer * 1024, wv_); }
        GSYNC();
        { const AP a = ld_args(); unsigned char* ws = a->ws;
          PUp p; p.K = 1024; p.lda = 1024; p.ldb = 1024; p.G = opq(G); p.c = opq(bid); p.A = (const bf16_t*)(ws + OFF_XB); p.Bt = (const bf16_t*)(ws + OFF_WUP); p.h = (bf16_t*)(ws + OFF_H);
          for (int rep = 0; rep < REP_UP; ++rep) gemm_phase(lds, p, wv_); }
        GSYNC();
        { const AP a = ld_args(); unsigned char* ws = a->ws;
          PDown p; p.K = 4096; p.lda = 4096; p.ldb = 4096; p.G = opq(G); p.c = opq(bid); p.A = (const bf16_t*)(ws + OFF_H); p.Bt = (const bf16_t*)(ws + OFF_WDOWN);
          p.T = (bf16_t*)(ws + OFF_R); p.R = (float*)(ws + OFF_R); p.part = (float*)(ws + OFF_PD);
          gemm_phase(lds, p, wv_); }
        GSYNC();
        { const AP a = ld_args(); unsigned char* ws = a->ws;
          ln_phase<true>((const bf16_t*)(ws + OFF_R), (const float*)(ws + OFF_R), (const float*)(ws + OFF_PD), (const float*)nullptr, (const float*)nullptr, (const bf16_t*)(ws + OFF_XB),
                         layer == 0 ? (float*)nullptr : a->out, layer == 0 ? (bf16_t*)a->out : (bf16_t*)nullptr, a->in[I_L2G] + layer * 1024, a->in[I_L2B] + layer * 1024, wv_); }
        if (layer == 0) { __syncthreads(); for (int rep = 0; rep < REP_PREP; ++rep) { const AP a = ld_args(); prep_layer(a, 1, (float*)lds_raw, wv_); } GSYNC(); }
    }
    if (PROBE_ON && bid == 0) { if (PROBE_B > 22) tB = __builtin_amdgcn_s_memrealtime(); const unsigned long long t0 = __builtin_amdgcn_s_memrealtime(); while (__builtin_amdgcn_s_memrealtime() - t0 < tB - tA) __builtin_amdgcn_s_sleep(8); }
}

extern "C" void kernel_launch(void* const* d_in, const int* in_sizes, int n_in, void* d_out, int out_size, void* d_ws, size_t ws_size, hipStream_t stream) {
    constexpr size_t kDynLds = STAGE_BYTES;
    static int grid_blocks = 0;
    if (!grid_blocks) {
        int dev = 0, cus = 0, per_cu = 0;
        hipGetDevice(&dev);
        hipDeviceGetAttribute(&cus, hipDeviceAttributeMultiprocessorCount, dev);
        hipFuncSetAttribute((const void*)fwd_megakernel, hipFuncAttributeMaxDynamicSharedMemorySize, (int)kDynLds);
        hipOccupancyMaxActiveBlocksPerMultiprocessor(&per_cu, (const void*)fwd_megakernel, NTHR, kDynLds);
        if (per_cu < 1) per_cu = 1;
        grid_blocks = cus * per_cu;
        if (grid_blocks > 256) grid_blocks = 256;
        if (ws_size < WS_END || n_in != 36) fprintf(stderr, "kernel_launch: unexpected ws_size %zu (need %zu) or n_in %d\n", ws_size, (size_t)WS_END, n_in);
    }
    (void)hipMemsetAsync((char*)d_ws + OFF_BAR, 0, 256, stream);
    Args a{};
    for (int i = 0; i < 36; ++i) a.in[i] = (const float*)d_in[i];
    a.out = (float*)d_out; a.ws = (unsigned char*)d_ws;
    void* args[] = {&a};
    hipError_t e = hipLaunchCooperativeKernel((const void*)fwd_megakernel, dim3(grid_blocks), dim3(NTHR), args, kDynLds, stream);
    if (e != hipSuccess) fprintf(stderr, "cooperative launch failed: %s (grid %d)\n", hipGetErrorString(e), grid_blocks);
}
```
